# Optimizing an MI355X kernel written in HIP

```python
import math
import jax, jax.numpy as jnp
from jax import lax
import numpy as np

D_MODEL = 1024
BATCH = 32
SEQ = 2048
DEPTH = 2

HEAD_DIM = 64
A_HEADS = 6
IDX_HEADS = 8
IDX_DIM = 64
A_TOPK_MAX = 256
A_Q_BLOCK = 128
B_SLOTS = 4
B_PATTERNS = ((128, 1), (512, 4), (2048, 16))
B_GROUPS = 3
B_PAD = 2048
B_Q_BLOCK = 64
C_HEADS = 6
C_BLOCK = 256
C_TOPK = 3
C_Q_CHUNK = 32
N_BUCKETS = 32
MAX_DISTANCE = 2048
N_BIAS_HEADS = A_HEADS + B_GROUPS * B_SLOTS + C_HEADS
D_FF = 4 * D_MODEL
PLE_DIM = 256
N_BRANCH = 3
ALPHA = (2 * DEPTH) ** 0.25
BETA = (8 * DEPTH) ** -0.25
LN_EPS = 1e-5
NEG = -1e30

IN_WIDTHS = (
    A_HEADS * HEAD_DIM, HEAD_DIM, HEAD_DIM,
    IDX_HEADS * IDX_DIM, IDX_DIM, IDX_HEADS,
    B_GROUPS * B_SLOTS * HEAD_DIM, B_SLOTS * HEAD_DIM, B_SLOTS * HEAD_DIM,
    C_HEADS * HEAD_DIM, C_HEADS * HEAD_DIM, C_HEADS * HEAD_DIM,
)
D_IN = sum(IN_WIDTHS)
SPLIT_POINTS = tuple(int(c) for c in np.cumsum(IN_WIDTHS)[:-1])

kernel_name = "hybrid_dsa_dilated_moba_deepnorm"


def layer_norm(x, g, b):
    xf = x.astype(jnp.float32)
    mu = jnp.mean(xf, axis=-1, keepdims=True)
    var = jnp.mean(jnp.square(xf - mu), axis=-1, keepdims=True)
    return ((xf - mu) * lax.rsqrt(var + LN_EPS) * g + b).astype(x.dtype)


def rel_bucket(dist):
    n = jnp.maximum(dist, 0)
    max_exact = N_BUCKETS // 2
    nf = jnp.maximum(n, 1).astype(jnp.float32)
    large = max_exact + (jnp.log(nf / max_exact) / math.log(MAX_DISTANCE / max_exact)
                         * (N_BUCKETS - max_exact)).astype(jnp.int32)
    large = jnp.minimum(large, N_BUCKETS - 1)
    return jnp.where(n < max_exact, n, large)


def masked_softmax(logits, mask):
    return jax.nn.softmax(jnp.where(mask, logits.astype(jnp.float32), NEG), axis=-1)


def dsa_mixer(q, k, v, iq, ik, iw, bias_tab):
    bsz, s_len = q.shape[0], q.shape[1]
    topk = min(A_TOPK_MAX, s_len // 4)
    scale = HEAD_DIM ** -0.5
    iscale = IDX_DIM ** -0.5
    kpos = jnp.arange(s_len)
    qloc = jnp.arange(A_Q_BLOCK)

    def block(t0):
        qb = lax.dynamic_slice_in_dim(q, t0, A_Q_BLOCK, axis=1)
        iqb = lax.dynamic_slice_in_dim(iq, t0, A_Q_BLOCK, axis=1)
        iwb = lax.dynamic_slice_in_dim(iw, t0, A_Q_BLOCK, axis=1)
        tpos = t0 + qloc
        sc = jnp.einsum('bqhd,bsd->bqhs', iqb, ik) * iscale
        index = jnp.einsum('bqh,bqhs->bqs', iwb, jax.nn.relu(sc)).astype(jnp.float32)
        causal = kpos[None, :] <= tpos[:, None]
        index = jnp.where(causal[None], index, -jnp.inf)
        _, sel = lax.top_k(index, topk)
        ksel = jax.vmap(lambda kb, ib: kb[ib])(k, sel)
        vsel = jax.vmap(lambda vb, ib: vb[ib])(v, sel)
        dist = tpos[None, :, None] - sel
        bias = jnp.moveaxis(bias_tab[rel_bucket(dist)], -1, 2)
        logits = jnp.einsum('bqhd,bqkd->bqhk', qb, ksel).astype(jnp.float32) * scale + bias
        probs = masked_softmax(logits, (dist >= 0)[:, :, None, :])
        return jnp.einsum('bqhk,bqkd->bqhd', probs.astype(v.dtype), vsel)

    starts = jnp.arange(s_len // A_Q_BLOCK) * A_Q_BLOCK
    out = lax.map(block, starts)
    return jnp.moveaxis(out, 0, 1).reshape(bsz, s_len, A_HEADS * HEAD_DIM)


def dilated_mixer(q, k, v, bias_tab):
    bsz, s_len = q.shape[0], q.shape[1]
    scale = HEAD_DIM ** -0.5
    kp = jnp.pad(k, ((0, 0), (B_PAD, 0), (0, 0), (0, 0)))
    vp = jnp.pad(v, ((0, 0), (B_PAD, 0), (0, 0), (0, 0)))
    qloc = jnp.arange(B_Q_BLOCK)

    def block(t0):
        qb = lax.dynamic_slice_in_dim(q, t0, B_Q_BLOCK, axis=1)
        tpos = t0 + qloc
        maxes, denoms, outs = [], [], []
        for g, (win, dil) in enumerate(B_PATTERNS):
            offs = jnp.arange(win // dil + 1) * dil
            kc = lax.dynamic_slice_in_dim(kp, t0 + B_PAD - win, B_Q_BLOCK + win, axis=1)
            vc = lax.dynamic_slice_in_dim(vp, t0 + B_PAD - win, B_Q_BLOCK + win, axis=1)
            lidx = qloc[:, None] + win - offs[None, :]
            kg = kc[:, lidx]
            vg = vc[:, lidx]
            bias = bias_tab[rel_bucket(offs), g * B_SLOTS:(g + 1) * B_SLOTS].T
            logits = jnp.einsum('bqhd,bqjhd->bqhj', qb[:, :, g], kg).astype(jnp.float32) * scale + bias
            valid = (tpos[:, None] - offs[None, :]) >= 0
            logits = jnp.where(valid[None, :, None, :], logits, NEG)
            m = jnp.max(logits, axis=-1, keepdims=True)
            e = jnp.exp(logits - m)
            den = jnp.sum(e, axis=-1, keepdims=True)
            outs.append(jnp.einsum('bqhj,bqjhd->bqhd', (e / den).astype(v.dtype), vg))
            maxes.append(m)
            denoms.append(den)
        m_all = jnp.stack(maxes)
        wts = jnp.stack(denoms) * jnp.exp(m_all - jnp.max(m_all, axis=0, keepdims=True))
        wts = wts / jnp.sum(wts, axis=0, keepdims=True)
        return jnp.sum(wts.astype(v.dtype) * jnp.stack(outs), axis=0)

    starts = jnp.arange(s_len // B_Q_BLOCK) * B_Q_BLOCK
    out = lax.map(block, starts)
    return jnp.moveaxis(out, 0, 1).reshape(bsz, s_len, B_SLOTS * HEAD_DIM)


def moba_mixer(q, k, v, bias_tab):
    bsz, s_len, n_h, dh = q.shape
    scale = dh ** -0.5
    nblk = -(-s_len // C_BLOCK)
    pad = nblk * C_BLOCK - s_len
    kp = jnp.pad(k, ((0, 0), (0, pad), (0, 0), (0, 0)))
    vp = jnp.pad(v, ((0, 0), (0, pad), (0, 0), (0, 0)))
    kb = kp.reshape(bsz, nblk, C_BLOCK, n_h, dh)
    k_mean = jnp.mean(kb, axis=2)
    kbh = jnp.moveaxis(kb, 3, 1)
    vbh = jnp.moveaxis(vp.reshape(bsz, nblk, C_BLOCK, n_h, dh), 3, 1)
    ntop = min(C_TOPK, nblk)
    bi = jnp.arange(bsz)[:, None, None, None]
    hi = jnp.arange(n_h)[None, None, :, None]
    tab_h = bias_tab.T
    kin = jnp.arange(C_BLOCK)
    qloc = jnp.arange(C_Q_CHUNK)

    def chunk(t0):
        qc = lax.dynamic_slice_in_dim(q, t0, C_Q_CHUNK, axis=1)
        tpos = t0 + qloc
        cur = t0 // C_BLOCK
        gate = jnp.einsum('bqhd,bnhd->bqhn', qc, k_mean).astype(jnp.float32)
        gate = jnp.where(jnp.arange(nblk) < cur, gate, -jnp.inf)
        _, sel = lax.top_k(gate, ntop)
        ksel = kbh[bi, hi, sel]
        vsel = vbh[bi, hi, sel]
        dist_sel = tpos[None, :, None, None, None] - (sel[..., None] * C_BLOCK + kin)
        bias_sel = tab_h[hi[..., None], rel_bucket(dist_sel)]
        l_sel = jnp.einsum('bqhd,bqhnkd->bqhnk', qc, ksel).astype(jnp.float32) * scale + bias_sel
        valid_sel = jnp.broadcast_to((sel < cur)[..., None], l_sel.shape)
        kown = lax.dynamic_slice_in_dim(kp, cur * C_BLOCK, C_BLOCK, axis=1)
        vown = lax.dynamic_slice_in_dim(vp, cur * C_BLOCK, C_BLOCK, axis=1)
        dist_own = tpos[:, None] - (cur * C_BLOCK + kin)[None, :]
        bias_own = jnp.moveaxis(bias_tab[rel_bucket(dist_own)], -1, 1)[None]
        l_own = jnp.einsum('bqhd,bkhd->bqhk', qc, kown).astype(jnp.float32) * scale + bias_own
        valid_own = jnp.broadcast_to((dist_own >= 0)[None, :, None, :], l_own.shape)
        n_sel = ntop * C_BLOCK
        logits = jnp.concatenate([l_sel.reshape(bsz, C_Q_CHUNK, n_h, n_sel), l_own], axis=-1)
        mask = jnp.concatenate([valid_sel.reshape(bsz, C_Q_CHUNK, n_h, n_sel), valid_own], axis=-1)
        probs = masked_softmax(logits, mask).astype(v.dtype)
        p_sel = probs[..., :n_sel].reshape(bsz, C_Q_CHUNK, n_h, ntop, C_BLOCK)
        p_own = probs[..., n_sel:]
        return (jnp.einsum('bqhnk,bqhnkd->bqhd', p_sel, vsel)
                + jnp.einsum('bqhk,bkhd->bqhd', p_own, vown))

    starts = jnp.arange(s_len // C_Q_CHUNK) * C_Q_CHUNK
    out = lax.map(chunk, starts)
    return jnp.moveaxis(out, 0, 1).reshape(bsz, s_len, n_h * dh)


def setup_inputs(seed: int = 0) -> dict:
    key = jax.random.key(seed)
    ks = jax.random.split(key, 20)

    def nrm(k, shape, fan_in, gain=1.0):
        return jax.random.normal(k, shape, jnp.float32) * (gain * fan_in ** -0.5)

    def small(k, shape, s=0.02):
        return jax.random.normal(k, shape, jnp.float32) * s

    a_w = A_HEADS * HEAD_DIM
    b_w = B_SLOTS * HEAD_DIM
    c_w = C_HEADS * HEAD_DIM
    return {
        "x": jax.random.normal(ks[0], (BATCH, SEQ, D_MODEL), jnp.float32),
        "p": jax.random.normal(ks[1], (DEPTH, BATCH, SEQ, PLE_DIM), jnp.float32),
        "w_in": nrm(ks[2], (DEPTH, D_MODEL, D_IN), D_MODEL),
        "w_gate": nrm(ks[3], (DEPTH, D_MODEL, N_BRANCH * D_MODEL), D_MODEL),
        "w_br_a": nrm(ks[4], (DEPTH, a_w, D_MODEL), a_w, BETA),
        "w_br_b": nrm(ks[5], (DEPTH, b_w, D_MODEL), b_w, BETA),
        "w_br_c": nrm(ks[6], (DEPTH, c_w, D_MODEL), c_w, BETA),
        "w_out": nrm(ks[7], (DEPTH, D_MODEL, D_MODEL), D_MODEL, BETA),
        "ln1_g": 1.0 + small(ks[8], (DEPTH, D_MODEL)),
        "ln1_b": small(ks[9], (DEPTH, D_MODEL)),
        "w_up": nrm(ks[10], (DEPTH, D_MODEL, D_FF), D_MODEL, BETA),
        "w_down": nrm(ks[11], (DEPTH, D_FF, D_MODEL), D_FF, BETA),
        "w_ple_gate": nrm(ks[12], (DEPTH, D_MODEL, D_MODEL), D_MODEL),
        "w_ple": nrm(ks[13], (DEPTH, PLE_DIM, D_MODEL), PLE_DIM, BETA),
        "ln2_g": 1.0 + small(ks[14], (DEPTH, D_MODEL)),
        "ln2_b": small(ks[15], (DEPTH, D_MODEL)),
        "rel_bias": small(ks[16], (N_BUCKETS, N_BIAS_HEADS), 0.1),
    }


def reference(x, p, w_in, w_gate, w_br_a, w_br_b, w_br_c, w_out, ln1_g, ln1_b,
              w_up, w_down, w_ple_gate, w_ple, ln2_g, ln2_b, rel_bias):
    bsz, s_len, _ = x.shape
    bias_a = rel_bias[:, :A_HEADS]
    bias_b = rel_bias[:, A_HEADS:A_HEADS + B_GROUPS * B_SLOTS]
    bias_c = rel_bias[:, A_HEADS + B_GROUPS * B_SLOTS:]
    for i in range(DEPTH):
        proj = x @ w_in[i]
        aq, ak, av, iq, ik, iw, bq, bk, bv, cq, ck, cv = jnp.split(proj, SPLIT_POINTS, axis=-1)
        o_a = dsa_mixer(aq.reshape(bsz, s_len, A_HEADS, HEAD_DIM), ak, av,
                        iq.reshape(bsz, s_len, IDX_HEADS, IDX_DIM), ik, iw, bias_a)
        o_b = dilated_mixer(bq.reshape(bsz, s_len, B_GROUPS, B_SLOTS, HEAD_DIM),
                            bk.reshape(bsz, s_len, B_SLOTS, HEAD_DIM),
                            bv.reshape(bsz, s_len, B_SLOTS, HEAD_DIM), bias_b)
        o_c = moba_mixer(cq.reshape(bsz, s_len, C_HEADS, HEAD_DIM),
                         ck.reshape(bsz, s_len, C_HEADS, HEAD_DIM),
                         cv.reshape(bsz, s_len, C_HEADS, HEAD_DIM), bias_c)
        gates = jax.nn.sigmoid(x @ w_gate[i]).reshape(bsz, s_len, N_BRANCH, D_MODEL)
        merged = (gates[:, :, 0] * (o_a @ w_br_a[i])
                  + gates[:, :, 1] * (o_b @ w_br_b[i])
                  + gates[:, :, 2] * (o_c @ w_br_c[i]))
        x = layer_norm(ALPHA * x + merged @ w_out[i], ln1_g[i], ln1_b[i])
        h = jnp.square(jax.nn.relu(x @ w_up[i])) @ w_down[i]
        ple = jax.nn.sigmoid(x @ w_ple_gate[i]) * (p[i] @ w_ple[i])
        x = layer_norm(ALPHA * x + h + ple, ln2_g[i], ln2_b[i])
    return x
```

```cpp
#include <hip/hip_runtime.h>
#include <hip/hip_cooperative_groups.h>
#include <cstdio>
namespace cg = cooperative_groups;

#define LAS __attribute__((address_space(3)))
#define DI __device__ __forceinline__
typedef unsigned short bf16_t;
typedef short bf16x8 __attribute__((ext_vector_type(8)));
typedef float f32x2 __attribute__((ext_vector_type(2)));
typedef float f32x4 __attribute__((ext_vector_type(4)));
typedef float f32x16 __attribute__((ext_vector_type(16)));
typedef unsigned u32x2 __attribute__((ext_vector_type(2)));
typedef unsigned u32x4 __attribute__((ext_vector_type(4)));
typedef __bf16 bf2_t __attribute__((ext_vector_type(2)));

constexpr int MTOK = 65536, SEQ = 2048, DM = 1024, NB = 32, DFF = 4096, PLE = 256;
constexpr int RM_LD = 2816;
constexpr int C_AQ = 0, C_AK = 384, C_IQ = 448, C_IK = 960, C_BQ = 1024, C_BK = 1792, C_CQ = 2048, C_CK = 2432;
constexpr int T_ROWS = 768;
constexpr int R_AV = 0, R_BV = 64, R_CV = 320, R_IW = 704;
constexpr int NWIN = 3584;
constexpr float ALPHA = 1.41421356237309515f;
constexpr float LOG2E = 1.44269504088896341f;
constexpr float SC2 = 0.125f * LOG2E;
constexpr float NEGF = -1e30f;
constexpr int LDS_BYTES = 131072;

constexpr size_t WO_IN = 0;
constexpr size_t WO_G = WO_IN + (size_t)NWIN * 1024;
constexpr size_t WO_BA = WO_G + (size_t)3072 * 1024;
constexpr size_t WO_BB = WO_BA + (size_t)1024 * 384;
constexpr size_t WO_BC = WO_BB + (size_t)1024 * 256;
constexpr size_t WO_OUT = WO_BC + (size_t)1024 * 384;
constexpr size_t WO_UP = WO_OUT + (size_t)1024 * 1024;
constexpr size_t WO_DN = WO_UP + (size_t)4096 * 1024;
constexpr size_t WO_PG = WO_DN + (size_t)1024 * 4096;
constexpr size_t WO_PL = WO_PG + (size_t)1024 * 1024;
constexpr size_t W_LAYER = WO_PL + (size_t)1024 * 256;

constexpr size_t WS_WB = 0;
constexpr size_t WS_LUT = WS_WB + 2 * W_LAYER * 2;
constexpr size_t WS_KMEAN = WS_LUT + (size_t)24 * 2048 * 4;
constexpr size_t WS_MASK = WS_KMEAN + (size_t)32 * 6 * 8 * 64 * 4;
constexpr size_t WS_XB = WS_MASK + (size_t)MTOK * 64 * 4;
constexpr size_t WS_PB = WS_XB + (size_t)MTOK * 1024 * 2;
constexpr size_t WS_OABC = WS_PB + (size_t)2 * MTOK * 256 * 2;
constexpr size_t WS_R1 = WS_OABC + (size_t)MTOK * 1024 * 2;
constexpr size_t WS_END = WS_R1 + (size_t)MTOK * 4096 * 2;

struct Args {
    const float* in[17];
    float* out;
    unsigned char* ws;
    int ph_lo, ph_hi;
};

DI unsigned short f2bf(float f) { unsigned u = __float_as_uint(f); u += 0x7FFFu + ((u >> 16) & 1u); return (unsigned short)(u >> 16); }
DI unsigned pk2(float lo, float hi) { f32x2 v = {lo, hi}; bf2_t b = __builtin_convertvector(v, bf2_t); return __builtin_bit_cast(unsigned, b); }
DI float bf_lo(unsigned w) { return __uint_as_float(w << 16); }
DI float bf_hi(unsigned w) { return __uint_as_float(w & 0xFFFF0000u); }
DI float bf2f(bf16_t b) { return __uint_as_float(((unsigned)b) << 16); }
DI float sigmoidf_(float x) { return __builtin_amdgcn_rcpf(1.0f + __expf(-x)); }
#define MFMA32(a, b, c) __builtin_amdgcn_mfma_f32_32x32x16_bf16((a), (b), (c), 0, 0, 0)

namespace pg8 {
constexpr int BM = 256, BK = 64, HALF = 128, HTB = HALF * BK * 2, NXCD = 8, WGM = 8;
DI int lds_byte(int r, int c) { const int st = (r >> 4) * 2 + (c >> 5), rr = r & 15, cc = c & 31, ob = rr * 64 + cc * 2; return st * 1024 + (ob ^ (((ob >> 9) & 1) << 5)); }
DI void stage_rc(int b, int& R, int& C) { const int st = b / 1024, sb = b % 1024, swz = sb ^ (((sb >> 9) & 1) << 5); R = (st >> 1) * 16 + swz / 64; C = (st & 1) * 32 + (swz % 64) / 2; }
DI int perm32(int rho) { const int n = rho >> 4, i = rho & 15; return 8 * (i >> 2) + 4 * n + (i & 3); }

struct Unit { int pm, pn; };
struct Gemm { const bf16_t* A; const bf16_t* Bt; int lda, ldb, K; };

struct StaticOrder {
    int nM, nN, nwg, G, c;
    DI void init(int nM_, int nN_, int G_, int c_) { nM = nM_; nN = nN_; nwg = nM * nN; G = G_; c = c_; }
    DI bool next(int i, Unit& u) const {
        const long L = (long)i * G + c; if (L >= nwg) return false;
        int wgid = (int)L; { const int q = nwg / NXCD, r = nwg % NXCD, xcd = wgid % NXCD, off = wgid / NXCD; wgid = (xcd < r ? xcd * (q + 1) : r * (q + 1) + (xcd - r) * q) + off; }
        const int nig = WGM * nN, gid = wgid / nig, fm = gid * WGM, gsz = (nM - fm) < WGM ? (nM - fm) : WGM;
        u.pm = fm + ((wgid % nig) % gsz); u.pn = (wgid % nig) / gsz; return true;
    }
};
struct Order3 {
    StaticOrder base;
    DI bool next(int i, Unit& u) const { Unit v; if (!base.next(i / 3, v)) return false; u.pm = v.pm; u.pn = (i % 3) * 4 + v.pn; return true; }
};

template <int ACT  > struct EpiBf16 {
    static constexpr bool PERM = true;
    bf16_t* O; int ldc;
    DI void operator()(const f32x4 (&acc)[2][2][4][2], const Unit& u, int wr, int wc, int fr, int fq) const {
        const int row0 = u.pm * BM + wr * 64 + fr, col0 = u.pn * BM + wc * 32 + 8 * fq;
#pragma unroll
        for (int ai = 0; ai < 2; ++ai)
#pragma unroll
            for (int m = 0; m < 4; ++m) { bf16_t* rowp = O + (size_t)(row0 + ai * HALF + m * 16) * ldc + col0;
#pragma unroll
                for (int bj = 0; bj < 2; ++bj) { f32x4 v0 = acc[ai][bj][m][0], v1 = acc[ai][bj][m][1];
                    if (ACT == 1) {
#pragma unroll
                        for (int j = 0; j < 4; ++j) { float a = fmaxf(v0[j], 0.f), b = fmaxf(v1[j], 0.f); v0[j] = a * a; v1[j] = b * b; } }
                    u32x4 w; w.x = pk2(v0[0], v0[1]); w.y = pk2(v0[2], v0[3]); w.z = pk2(v1[0], v1[1]); w.w = pk2(v1[2], v1[3]);
                    *(u32x4*)(rowp + bj * HALF) = w; } }
    }
};
struct EpiGate {
    static constexpr bool PERM = true;
    const bf16_t* obr; bf16_t* mg;
    DI void operator()(const f32x4 (&acc)[2][2][4][2], const Unit& u, int wr, int wc, int fr, int fq) const {
        const int b = u.pn >> 2, colt = (u.pn & 3) * BM;
        const int row0 = u.pm * BM + wr * 64 + fr, col0 = colt + wc * 32 + 8 * fq;
#pragma unroll
        for (int ai = 0; ai < 2; ++ai)
#pragma unroll
            for (int m = 0; m < 4; ++m) { const size_t row = (size_t)(row0 + ai * HALF + m * 16);
#pragma unroll
                for (int bj = 0; bj < 2; ++bj) { const f32x4 v0 = acc[ai][bj][m][0], v1 = acc[ai][bj][m][1];
                    const u32x4 ob = *(const u32x4*)(obr + row * 3072 + b * 1024 + col0 + bj * HALF);
                    bf16_t* mp = mg + row * 1024 + col0 + bj * HALF;
                    float r[8];
                    r[0] = sigmoidf_(v0[0]) * bf_lo(ob.x); r[1] = sigmoidf_(v0[1]) * bf_hi(ob.x); r[2] = sigmoidf_(v0[2]) * bf_lo(ob.y); r[3] = sigmoidf_(v0[3]) * bf_hi(ob.y);
                    r[4] = sigmoidf_(v1[0]) * bf_lo(ob.z); r[5] = sigmoidf_(v1[1]) * bf_hi(ob.z); r[6] = sigmoidf_(v1[2]) * bf_lo(ob.w); r[7] = sigmoidf_(v1[3]) * bf_hi(ob.w);
                    if (b > 0) { const u32x4 pm_ = *(const u32x4*)mp;
                        r[0] += bf_lo(pm_.x); r[1] += bf_hi(pm_.x); r[2] += bf_lo(pm_.y); r[3] += bf_hi(pm_.y); r[4] += bf_lo(pm_.z); r[5] += bf_hi(pm_.z); r[6] += bf_lo(pm_.w); r[7] += bf_hi(pm_.w); }
                    u32x4 w; w.x = pk2(r[0], r[1]); w.y = pk2(r[2], r[3]); w.z = pk2(r[4], r[5]); w.w = pk2(r[6], r[7]);
                    *(u32x4*)mp = w; } }
    }
};
struct EpiT1 {
    static constexpr bool PERM = true;
    bf16_t* T;
    DI void operator()(const f32x4 (&acc)[2][2][4][2], const Unit& u, int wr, int wc, int fr, int fq) const {
        const int row0 = u.pm * BM + wr * 64 + fr, col0 = u.pn * BM + wc * 32 + 8 * fq;
#pragma unroll
        for (int ai = 0; ai < 2; ++ai)
#pragma unroll
            for (int m = 0; m < 4; ++m) { const size_t row = (size_t)(row0 + ai * HALF + m * 16);
#pragma unroll
                for (int bj = 0; bj < 2; ++bj) { const f32x4 v0 = acc[ai][bj][m][0], v1 = acc[ai][bj][m][1];
                    bf16_t* tp = T + row * 1024 + col0 + bj * HALF;
                    const u32x4 ob = *(const u32x4*)tp;
                    float r[8];
                    r[0] = sigmoidf_(v0[0]) * bf_lo(ob.x); r[1] = sigmoidf_(v0[1]) * bf_hi(ob.x); r[2] = sigmoidf_(v0[2]) * bf_lo(ob.y); r[3] = sigmoidf_(v0[3]) * bf_hi(ob.y);
                    r[4] = sigmoidf_(v1[0]) * bf_lo(ob.z); r[5] = sigmoidf_(v1[1]) * bf_hi(ob.z); r[6] = sigmoidf_(v1[2]) * bf_lo(ob.w); r[7] = sigmoidf_(v1[3]) * bf_hi(ob.w);
                    u32x4 w; w.x = pk2(r[0], r[1]); w.y = pk2(r[2], r[3]); w.z = pk2(r[4], r[5]); w.w = pk2(r[6], r[7]);
                    *(u32x4*)tp = w; } }
    }
};
template <bool HAS_T> struct EpiRes {
    static constexpr bool PERM = false;
    const float* xin; float* y; const bf16_t* T;
    DI void operator()(const f32x4 (&acc)[2][2][4][2], const Unit& u, int wr, int wc, int fr, int fq) const {
        const int row0 = u.pm * BM + wr * 64 + fr, col0 = u.pn * BM + wc * 32 + 4 * fq;
#pragma unroll
        for (int ai = 0; ai < 2; ++ai)
#pragma unroll
            for (int m = 0; m < 4; ++m) { const size_t ro = (size_t)(row0 + ai * HALF + m * 16) * 1024 + col0;
#pragma unroll
                for (int bj = 0; bj < 2; ++bj)
#pragma unroll
                    for (int n = 0; n < 2; ++n) { const size_t o = ro + bj * HALF + n * 16;
                        const f32x4 xv = *(const f32x4*)(xin + o); f32x4 r = acc[ai][bj][m][n] + xv * ALPHA;
                        if (HAS_T) { const u32x2 tv = *(const u32x2*)(T + o); r[0] += bf_lo(tv.x); r[1] += bf_hi(tv.x); r[2] += bf_lo(tv.y); r[3] += bf_hi(tv.y); }
                        *(f32x4*)(y + o) = r; } }
    }
};

template <class Epi, class Sched>
DI void gemm_phase(LAS unsigned char* lds, const Gemm g, const Sched& S, const Epi& E, const int tid) {
    const int wid = __builtin_amdgcn_readfirstlane(tid >> 6), lane = tid & 63, wr = wid >> 2, wc = wid & 3, fr = lane & 15, fq = lane >> 4;
    const int K = g.K, nt = K / BK;
    unsigned voffA[2], voffB[2];
#pragma unroll
    for (int i = 0; i < 2; ++i) { int R, C; stage_rc(tid * 16 + i * 8192, R, C); const int Rb = Epi::PERM ? ((R & ~31) + perm32(R & 31)) : R;
        voffA[i] = (unsigned)(R * g.lda + C) * 2u; voffB[i] = (unsigned)(Rb * g.ldb + C) * 2u; }
    const size_t kstep = (size_t)(BK * 2);
    const size_t hstepA = (size_t)HALF * g.lda * 2, hstepB = (size_t)HALF * g.ldb * 2;
    const size_t tstepA = 2 * hstepA, tstepB = 2 * hstepB;
    const unsigned ldsw = (unsigned)wid * 1024u;
    const int aoff = lds_byte(wr * 64 + fr, fq * 8), boff = lds_byte(wc * 32 + fr, fq * 8);
#define PG8_SA(b, h) (((b) * 2 + (h)) * HTB)
#define PG8_SB(b, h) ((4 + (b) * 2 + (h)) * HTB)
#define PG8_STAGE(bufoff, gbase, voff) do { _Pragma("unroll") for (int _i = 0; _i < 2; ++_i) \
        __builtin_amdgcn_global_load_lds((const unsigned*)((const char*)(gbase) + (voff)[_i]), (LAS unsigned*)(lds + (bufoff) + ldsw + _i * 8192), 16, 0, 0); } while (0)
#define PG8_LDA(dst, b, h) do { _Pragma("unroll") for (int m = 0; m < 4; ++m) _Pragma("unroll") for (int k = 0; k < 2; ++k) dst[m][k] = *(const LAS bf16x8*)(lds + PG8_SA(b, h) + aoff + m * 2048 + k * 1024); } while (0)
#define PG8_LDB(dst, b, h) do { _Pragma("unroll") for (int n = 0; n < 2; ++n) _Pragma("unroll") for (int k = 0; k < 2; ++k) dst[n][k] = *(const LAS bf16x8*)(lds + PG8_SB(b, h) + boff + n * 2048 + k * 1024); } while (0)
#define PG8_MMA(ai, bj, At, Bt) do { __builtin_amdgcn_s_setprio(1); _Pragma("unroll") for (int m = 0; m < 4; ++m) _Pragma("unroll") for (int n = 0; n < 2; ++n) _Pragma("unroll") for (int k = 0; k < 2; ++k) \
        acc[ai][bj][m][n] = __builtin_amdgcn_mfma_f32_16x16x32_bf16(Bt[n][k], At[m][k], acc[ai][bj][m][n], 0, 0, 0); __builtin_amdgcn_s_setprio(0); } while (0)
#define PG8_WAIT_V(n) asm volatile("s_waitcnt vmcnt(" #n ")" ::: "memory")
#define PG8_WAIT_L(n) asm volatile("s_waitcnt lgkmcnt(" #n ")" ::: "memory")
#define PG8_BAR __builtin_amdgcn_s_barrier()
#define PG8_SCHED __builtin_amdgcn_sched_barrier(0)
    Unit cur, nxt; int ui = 0;
    if (!S.next(0, cur)) return;
    f32x4 acc[2][2][4][2];
#pragma unroll
    for (int a = 0; a < 2; ++a)
#pragma unroll
        for (int b = 0; b < 2; ++b)
#pragma unroll
            for (int m = 0; m < 4; ++m)
#pragma unroll
                for (int n = 0; n < 2; ++n) acc[a][b][m][n] = (f32x4){0.f, 0.f, 0.f, 0.f};
    bf16x8 At[4][2], B0[2][2], B1[2][2];
    const char* cA = (const char*)g.A + (size_t)cur.pm * tstepA; const char* cB = (const char*)g.Bt + (size_t)cur.pn * tstepB;
    PG8_STAGE(PG8_SB(0, 0), cB, voffB); PG8_STAGE(PG8_SA(0, 0), cA, voffA); PG8_STAGE(PG8_SB(0, 1), cB + hstepB, voffB); PG8_STAGE(PG8_SA(0, 1), cA + hstepA, voffA);
    if (wr == 1) PG8_BAR;
    PG8_WAIT_V(4); PG8_BAR;
    PG8_STAGE(PG8_SB(1, 0), cB + kstep, voffB); PG8_STAGE(PG8_SA(1, 0), cA + kstep, voffA); PG8_STAGE(PG8_SB(1, 1), cB + hstepB + kstep, voffB);
    PG8_WAIT_V(6); PG8_BAR;
    for (;;) {
        const bool has_next = S.next(ui + 1, nxt);
        const char* nA = has_next ? (const char*)g.A + (size_t)nxt.pm * tstepA : cA; const char* nB = has_next ? (const char*)g.Bt + (size_t)nxt.pn * tstepB : cB;
        for (int t = 0; t < nt; t += 2) {
            const bool last = (t == nt - 2);
            const char* a1 = cA + (size_t)(t + 1) * kstep;
            const char* a2 = last ? nA : cA + (size_t)(t + 2) * kstep; const char* b2 = last ? nB : cB + (size_t)(t + 2) * kstep;
            const char* a3 = a2 + kstep; const char* b3 = b2 + kstep;
            PG8_LDB(B0, 0, 0); PG8_SCHED; PG8_LDA(At, 0, 0); PG8_STAGE(PG8_SA(1, 1), a1 + hstepA, voffA);
            PG8_WAIT_L(8); PG8_BAR; PG8_WAIT_L(0); PG8_MMA(0, 0, At, B0); PG8_BAR; PG8_SCHED;
            PG8_LDB(B1, 0, 1); PG8_STAGE(PG8_SB(0, 0), b2, voffB);
            PG8_BAR; PG8_WAIT_L(0); PG8_MMA(0, 1, At, B1); PG8_BAR;
            PG8_LDA(At, 0, 1); PG8_STAGE(PG8_SA(0, 0), a2, voffA);
            PG8_BAR; PG8_WAIT_L(0); PG8_MMA(1, 0, At, B0); PG8_BAR; PG8_SCHED;
            PG8_STAGE(PG8_SB(0, 1), b2 + hstepB, voffB);
            PG8_WAIT_V(6); PG8_BAR; PG8_MMA(1, 1, At, B1); PG8_BAR;
            PG8_LDB(B0, 1, 0); PG8_SCHED; PG8_LDA(At, 1, 0); PG8_STAGE(PG8_SA(0, 1), a2 + hstepA, voffA);
            PG8_WAIT_L(8); PG8_BAR; PG8_WAIT_L(0); PG8_MMA(0, 0, At, B0); PG8_BAR; PG8_SCHED;
            PG8_LDB(B1, 1, 1); PG8_STAGE(PG8_SB(1, 0), b3, voffB);
            PG8_BAR; PG8_WAIT_L(0); PG8_MMA(0, 1, At, B1); PG8_BAR;
            PG8_LDA(At, 1, 1); PG8_STAGE(PG8_SA(1, 0), a3, voffA);
            PG8_BAR; PG8_WAIT_L(0); PG8_MMA(1, 0, At, B0); PG8_BAR; PG8_SCHED;
            PG8_STAGE(PG8_SB(1, 1), b3 + hstepB, voffB);
            PG8_WAIT_V(6); PG8_BAR; PG8_MMA(1, 1, At, B1); PG8_BAR;
        }
        E(acc, cur, wr, wc, fr, fq);
        if (!has_next) break;
#pragma unroll
        for (int a = 0; a < 2; ++a)
#pragma unroll
            for (int b = 0; b < 2; ++b)
#pragma unroll
                for (int m = 0; m < 4; ++m)
#pragma unroll
                    for (int n = 0; n < 2; ++n) acc[a][b][m][n] = (f32x4){0.f, 0.f, 0.f, 0.f};
        cur = nxt; cA = nA; cB = nB; ++ui;
    }
    PG8_WAIT_V(0);
    if (wr == 0) PG8_BAR;
    PG8_BAR;
#undef PG8_SA
#undef PG8_SB
#undef PG8_STAGE
#undef PG8_LDA
#undef PG8_LDB
#undef PG8_MMA
#undef PG8_WAIT_V
#undef PG8_WAIT_L
#undef PG8_BAR
#undef PG8_SCHED
}
}

DI int win_srccol(int n) {
    if (n < 384) return n;
    if (n < 448) return 384 + (n - 384);
    if (n < 960) return 512 + (n - 448);
    if (n < 1024) return 1024 + (n - 960);
    if (n < 1792) return 1096 + (n - 1024);
    if (n < 2048) return 1864 + (n - 1792);
    if (n < 2432) return 2376 + (n - 2048);
    if (n < 2816) return 2760 + (n - 2432);
    if (n < 2880) return 448 + (n - 2816);
    if (n < 3136) return 2120 + (n - 2880);
    if (n < 3520) return 3144 + (n - 3136);
    if (n < 3528) return 1088 + (n - 3520);
    return -1;
}
DI void convT(unsigned char* shm, const float* src, int K, int Nsrc, bf16_t* dst, int Ndst, int mode, const int tid) {
    unsigned short* tl = (unsigned short*)shm;
    const int ntk = K / 64, ntiles = (Ndst / 64) * ntk;
    for (int tile = blockIdx.x; tile < ntiles; tile += gridDim.x) {
        const int n0 = (tile / ntk) * 64, k0 = (tile % ntk) * 64;
        const int nx = tid & 63, ky = tid >> 6;
        const int sc = mode ? win_srccol(n0 + nx) : (n0 + nx);
#pragma unroll
        for (int p = 0; p < 8; ++p) { const int k = k0 + ky + 8 * p; const float v = sc >= 0 ? src[(size_t)k * Nsrc + sc] : 0.f; tl[nx * 66 + ky + 8 * p] = f2bf(v); }
        __syncthreads();
#pragma unroll
        for (int p = 0; p < 8; ++p) { const int n = ky + 8 * p; dst[(size_t)(n0 + n) * K + k0 + nx] = tl[n * 66 + nx]; }
        __syncthreads();
    }
}
DI void conv_vec(const float* src, bf16_t* dst, size_t n8, const int tid) {
    for (size_t i = (size_t)blockIdx.x * 512 + tid; i < n8; i += (size_t)gridDim.x * 512) {
        const f32x4 a = *(const f32x4*)(src + i * 8), b = *(const f32x4*)(src + i * 8 + 4);
        u32x4 w; w.x = pk2(a[0], a[1]); w.y = pk2(a[2], a[3]); w.z = pk2(b[0], b[1]); w.w = pk2(b[2], b[3]);
        *(u32x4*)(dst + i * 8) = w;
    }
}
DI int rel_bucket(int n) {
    if (n < 16) return n;
    int large = 16 + (int)(logf((float)n / 16.0f) / 4.852030263919617f * 16.0f);
    return large < 31 ? large : 31;
}
DI void phase_convert(const Args& a, unsigned char* shm, const int tid) {
    bf16_t* wb = (bf16_t*)(a.ws + WS_WB);
    for (int l = 0; l < 2; ++l) {
        bf16_t* w = wb + (size_t)l * W_LAYER;
        convT(shm, a.in[2] + (size_t)l * 1024 * 3528, 1024, 3528, w + WO_IN, NWIN, 1, tid);
        convT(shm, a.in[3] + (size_t)l * 1024 * 3072, 1024, 3072, w + WO_G, 3072, 0, tid);
        convT(shm, a.in[4] + (size_t)l * 384 * 1024, 384, 1024, w + WO_BA, 1024, 0, tid);
        convT(shm, a.in[5] + (size_t)l * 256 * 1024, 256, 1024, w + WO_BB, 1024, 0, tid);
        convT(shm, a.in[6] + (size_t)l * 384 * 1024, 384, 1024, w + WO_BC, 1024, 0, tid);
        convT(shm, a.in[7] + (size_t)l * 1024 * 1024, 1024, 1024, w + WO_OUT, 1024, 0, tid);
        convT(shm, a.in[10] + (size_t)l * 1024 * 4096, 1024, 4096, w + WO_UP, 4096, 0, tid);
        convT(shm, a.in[11] + (size_t)l * 4096 * 1024, 4096, 1024, w + WO_DN, 1024, 0, tid);
        convT(shm, a.in[12] + (size_t)l * 1024 * 1024, 1024, 1024, w + WO_PG, 1024, 0, tid);
        convT(shm, a.in[13] + (size_t)l * 256 * 1024, 256, 1024, w + WO_PL, 1024, 0, tid);
    }
    conv_vec(a.in[0], (bf16_t*)(a.ws + WS_XB), (size_t)MTOK * 1024 / 8, tid);
    conv_vec(a.in[1], (bf16_t*)(a.ws + WS_PB), (size_t)2 * MTOK * 256 / 8, tid);
    float* lut = (float*)(a.ws + WS_LUT);
    const float* rb = a.in[16];
    for (int i = blockIdx.x * 512 + tid; i < 24 * 2048; i += gridDim.x * 512) {
        const int hd = i >> 11, d = i & 2047;
        lut[i] = rb[rel_bucket(d) * 24 + hd] * LOG2E;
    }
}

DI float wave_sum(float v) {
#pragma unroll
    for (int o = 32; o >= 1; o >>= 1) v += __shfl_xor(v, o);
    return v;
}
DI void phase_ln(float* y, bf16_t* xb, const float* g, const float* b, const int tid) {
    const int wid = tid >> 6, lane = tid & 63;
    f32x4 gv[4], bv[4];
#pragma unroll
    for (int k = 0; k < 4; ++k) { gv[k] = *(const f32x4*)(g + k * 256 + lane * 4); bv[k] = *(const f32x4*)(b + k * 256 + lane * 4); }
    for (int row = blockIdx.x * 8 + wid; row < MTOK; row += gridDim.x * 8) {
        float* yp = y + (size_t)row * 1024;
        f32x4 v[4]; float s = 0.f;
#pragma unroll
        for (int k = 0; k < 4; ++k) { v[k] = *(const f32x4*)(yp + k * 256 + lane * 4); s += v[k][0] + v[k][1] + v[k][2] + v[k][3]; }
        const float mean = wave_sum(s) * (1.0f / 1024.0f);
        float q = 0.f;
#pragma unroll
        for (int k = 0; k < 4; ++k) { v[k] = v[k] - mean; q += v[k][0] * v[k][0] + v[k][1] * v[k][1] + v[k][2] * v[k][2] + v[k][3] * v[k][3]; }
        const float var = wave_sum(q) * (1.0f / 1024.0f);
        const float rs = 1.0f / sqrtf(var + 1e-5f);
#pragma unroll
        for (int k = 0; k < 4; ++k) { const f32x4 o = v[k] * rs * gv[k] + bv[k];
            *(f32x4*)(yp + k * 256 + lane * 4) = o;
            u32x2 w; w.x = pk2(o[0], o[1]); w.y = pk2(o[2], o[3]);
            *(u32x2*)(xb + (size_t)row * 1024 + k * 256 + lane * 4) = w; }
    }
}

DI int pi_row(int r) { return (r & 3) | (((r >> 3) & 1) << 2) | (((r >> 2) & 1) << 3) | (r & 16); }
DI void task_rot(int tau, int& b, int& qt) { b = tau >> 6; qt = ((tau & 63) + 8 * (tau >> 8)) & 63; }

DI void a1_task(unsigned char* shm, const bf16_t* prm, const bf16_t* prt, unsigned* mask, int b, int qt, const int tid) {
    const int wid = __builtin_amdgcn_readfirstlane(tid >> 6), lane = tid & 63, r = lane & 31, h = lane >> 5;
    const int t0 = qt * 32, tok0 = b * SEQ;
    unsigned* cnt = (unsigned*)(shm + 33280);
#pragma unroll
    for (int p = 0; p < 4; ++p) { const int c = tid + p * 512, row = c >> 6, ch = c & 63;
        *(u32x4*)(shm + row * 1040 + ch * 16) = *(const u32x4*)(prm + (size_t)(tok0 + t0 + row) * RM_LD + C_IQ + ch * 8); }
    cnt[tid] = 0u; cnt[tid + 512] = 0u;
    float* wqs = (float*)(shm + 33280 + 4096);
    if (tid < 256) wqs[tid] = bf2f(prt[(size_t)(R_IW + (tid >> 5)) * MTOK + tok0 + t0 + (tid & 31)]);
    __syncthreads();
    unsigned key[8][16];
    const bf16_t* kp = prm + (size_t)(tok0 + pi_row(r)) * RM_LD + C_IK + 8 * h;
#pragma unroll
    for (int jt = 0; jt < 8; ++jt) {
        const int kt = wid + 8 * jt;
        if (kt <= qt) {
            const int s0 = kt * 32;
            bf16x8 kf[4];
#pragma unroll
            for (int ks = 0; ks < 4; ++ks) kf[ks] = *(const bf16x8*)(kp + (size_t)s0 * RM_LD + 16 * ks);
            float idx[16];
#pragma unroll
            for (int i = 0; i < 16; ++i) idx[i] = 0.f;
#pragma unroll 1
            for (int hh = 0; hh < 8; ++hh) {
                f32x16 acc;
#pragma unroll
                for (int i = 0; i < 16; ++i) acc[i] = 0.f;
                const unsigned char* qb = shm + r * 1040 + hh * 128 + 16 * h;
#pragma unroll
                for (int ks = 0; ks < 4; ++ks) { const bf16x8 qf = *(const bf16x8*)(qb + 32 * ks); acc = MFMA32(kf[ks], qf, acc); }
                const float wv = wqs[hh * 32 + r];
#pragma unroll
                for (int i = 0; i < 16; ++i) idx[i] = fmaf(wv, fmaxf(acc[i], 0.f), idx[i]);
            }
#pragma unroll
            for (int i = 0; i < 16; ++i) {
                const int s = s0 + 16 * (i >> 3) + 8 * h + (i & 7);
                const unsigned u = __float_as_uint(idx[i] + 0.0f);
                const unsigned k = (u & 0x80000000u) ? ~u : (u | 0x80000000u);
                key[jt][i] = (s <= t0 + r) ? k : 0u;
            }
        } else {
#pragma unroll
            for (int i = 0; i < 16; ++i) key[jt][i] = 0u;
        }
    }
    unsigned T = 0u;
    for (int bit = 31; bit >= 0; --bit) {
        const unsigned cand = T | (1u << bit);
        int c = 0;
#pragma unroll
        for (int jt = 0; jt < 8; ++jt)
#pragma unroll
            for (int i = 0; i < 16; ++i) c += (key[jt][i] >= cand) ? 1 : 0;
        c += __shfl_xor(c, 32);
        if (h == 0 && c) atomicAdd(&cnt[(31 - bit) * 32 + r], (unsigned)c);
        __syncthreads();
        if (cnt[(31 - bit) * 32 + r] >= 256u) T = cand;
    }
    if (T < 1u) T = 1u;
#pragma unroll
    for (int jt = 0; jt < 8; ++jt) {
        const int kt = wid + 8 * jt;
        if (kt <= qt) {
            unsigned part = 0u;
#pragma unroll
            for (int i = 0; i < 16; ++i) part |= (key[jt][i] >= T ? 1u : 0u) << (16 * (i >> 3) + 8 * h + (i & 7));
            part |= (unsigned)__shfl_xor((int)part, 32);
            if (h == 0) mask[(size_t)(tok0 + t0 + r) * 64 + kt] = part;
        }
    }
    __syncthreads();
}
DI void phase_a1(const Args& a, unsigned char* shm, const int tid) {
    const bf16_t* prm = (const bf16_t*)(a.ws + WS_R1);
    const bf16_t* prt = prm + (size_t)MTOK * RM_LD;
    unsigned* mask = (unsigned*)(a.ws + WS_MASK);
    float* kmean = (float*)(a.ws + WS_KMEAN);
    for (int j = blockIdx.x; j < 2048 + 192; j += gridDim.x) {
        if (j < 2048) { int b, qt; task_rot(j, b, qt); a1_task(shm, prm, prt, mask, b, qt, tid); }
        else {
            const int id = (j - 2048) * 8 + (tid >> 6), lane = tid & 63;
            const int b = id / 48, hd = (id >> 3) % 6, n = id & 7;
            const bf16_t* p = prm + (size_t)(b * SEQ + n * 256) * RM_LD + C_CK + hd * 64 + lane;
            float s = 0.f;
            for (int t = 0; t < 256; ++t) s += bf2f(p[(size_t)t * RM_LD]);
            kmean[(size_t)((b * 6 + hd) * 8 + n) * 64 + lane] = s * (1.0f / 256.0f);
        }
    }
}

struct AttnSt { float m, l; f32x16 o0, o1; };
template <int MODE>
DI void attn_tile(const bf16x8 (&qf)[4], const bf16_t* Kp, const bf16_t* Vp, int kt, int d00, const float* lut, AttnSt& st,
                  const unsigned* maskrow, int h8, int win, int dmask, bool lane_sel) {
    const int s0 = kt * 32;
    bf16x8 kf[4], vf[2][2];
#pragma unroll
    for (int ks = 0; ks < 4; ++ks) kf[ks] = *(const bf16x8*)(Kp + (size_t)s0 * RM_LD + 16 * ks);
#pragma unroll
    for (int mt = 0; mt < 2; ++mt)
#pragma unroll
        for (int s = 0; s < 2; ++s) vf[mt][s] = *(const bf16x8*)(Vp + (size_t)(32 * mt) * MTOK + s0 + 16 * s);
    unsigned W = 0u;
    if (MODE == 0) W = maskrow[kt] >> h8;
    f32x16 sx;
#pragma unroll
    for (int i = 0; i < 16; ++i) sx[i] = 0.f;
#pragma unroll
    for (int ks = 0; ks < 4; ++ks) sx = MFMA32(kf[ks], qf[ks], sx);
    const int d0 = d00 - s0;
    float sv[16]; float mx = NEGF;
#pragma unroll
    for (int i = 0; i < 16; ++i) {
        const int ci = 16 * (i >> 3) + (i & 7);
        const int dist = d0 - ci;
        bool v;
        if (MODE == 0) v = ((W >> ci) & 1u) != 0u;
        else if (MODE == 1) v = (dist >= 0) && (dist <= win) && ((dist & dmask) == 0);
        else if (MODE == 2) v = lane_sel;
        else v = dist >= 0;
        const float bias = lut[dist & 2047];
        float s = fmaf(sx[i], SC2, bias);
        s = v ? s : NEGF;
        sv[i] = s; mx = fmaxf(mx, s);
    }
    mx = fmaxf(mx, __shfl_xor(mx, 32));
    const float mnew = fmaxf(st.m, mx);
    const float alpha = __builtin_amdgcn_exp2f(st.m - mnew);
    float ps = 0.f; float p[16];
#pragma unroll
    for (int i = 0; i < 16; ++i) { float e = __builtin_amdgcn_exp2f(sv[i] - mnew); e = (sv[i] > -1e29f) ? e : 0.f; p[i] = e; ps += e; }
    st.l = st.l * alpha + ps; st.m = mnew;
#pragma unroll
    for (int i = 0; i < 16; ++i) { st.o0[i] *= alpha; st.o1[i] *= alpha; }
    u32x4 w0, w1;
    w0.x = pk2(p[0], p[1]); w0.y = pk2(p[2], p[3]); w0.z = pk2(p[4], p[5]); w0.w = pk2(p[6], p[7]);
    w1.x = pk2(p[8], p[9]); w1.y = pk2(p[10], p[11]); w1.z = pk2(p[12], p[13]); w1.w = pk2(p[14], p[15]);
    const bf16x8 pf0 = __builtin_bit_cast(bf16x8, w0), pf1 = __builtin_bit_cast(bf16x8, w1);
    st.o0 = MFMA32(vf[0][0], pf0, st.o0); st.o0 = MFMA32(vf[0][1], pf1, st.o0);
    st.o1 = MFMA32(vf[1][0], pf0, st.o1); st.o1 = MFMA32(vf[1][1], pf1, st.o1);
}

DI void load_lut(float* lut, const float* glut, int col, int lane) {
    __builtin_amdgcn_fence(__ATOMIC_ACQ_REL, "wavefront");
#pragma unroll
    for (int k = 0; k < 8; ++k) *(f32x4*)(lut + k * 256 + lane * 4) = *(const f32x4*)(glut + (size_t)col * 2048 + k * 256 + lane * 4);
    __builtin_amdgcn_fence(__ATOMIC_ACQ_REL, "wavefront");
    __builtin_amdgcn_wave_barrier();
}

DI void attn_job(const Args& a, float* lut, int type, int b, int qt, int hd, const int tid) {
    const int lane = tid & 63, r = lane & 31, h = lane >> 5;
    const bf16_t* prm = (const bf16_t*)(a.ws + WS_R1);
    const bf16_t* prt = prm + (size_t)MTOK * RM_LD;
    const float* glut = (const float*)(a.ws + WS_LUT);
    const unsigned* mask = (const unsigned*)(a.ws + WS_MASK);
    const float* kmean = (const float*)(a.ws + WS_KMEAN);
    bf16_t* oabc = (bf16_t*)(a.ws + WS_OABC);
    const int t0 = qt * 32, tok0 = b * SEQ;
    const int d00 = t0 + r - 8 * h, h8 = 8 * h;
    const unsigned* maskrow = mask + (size_t)(tok0 + t0 + r) * 64;
    AttnSt st; st.m = NEGF; st.l = 0.f;
#pragma unroll
    for (int i = 0; i < 16; ++i) { st.o0[i] = 0.f; st.o1[i] = 0.f; }
    const int ng = (type == 1) ? 3 : 1;
    int ocol;
    for (int g = 0; g < ng; ++g) {
        int qcol, kcol, vrow, bcol;
        if (type == 0) { qcol = C_AQ + hd * 64; kcol = C_AK; vrow = R_AV; bcol = hd; ocol = hd * 64; }
        else if (type == 1) { qcol = C_BQ + (g * 4 + hd) * 64; kcol = C_BK + hd * 64; vrow = R_BV + hd * 64; bcol = 6 + g * 4 + hd; ocol = 384 + hd * 64; }
        else { qcol = C_CQ + hd * 64; kcol = C_CK + hd * 64; vrow = R_CV + hd * 64; bcol = 18 + hd; ocol = 640 + hd * 64; }
        load_lut(lut, glut, bcol, lane);
        bf16x8 qf[4];
        const bf16_t* qp = prm + (size_t)(tok0 + t0 + r) * RM_LD + qcol + 8 * h;
#pragma unroll
        for (int ks = 0; ks < 4; ++ks) qf[ks] = *(const bf16x8*)(qp + 16 * ks);
        const bf16_t* Kp = prm + (size_t)(tok0 + pi_row(r)) * RM_LD + kcol + 8 * h;
        const bf16_t* Vp = prt + (size_t)(vrow + r) * MTOK + tok0 + 8 * h;
        if (type == 0) {
            for (int kt = 0; kt <= qt; ++kt) attn_tile<0>(qf, Kp, Vp, kt, d00, lut, st, maskrow, h8, 0, 0, false);
        } else if (type == 1) {
            const int win = (g == 0) ? 128 : (g == 1 ? 512 : 2048), dmask = (g == 0) ? 0 : (g == 1 ? 3 : 15);
            int lo = t0 - win; if (lo < 0) lo = 0;
            for (int kt = lo >> 5; kt <= qt; ++kt) attn_tile<1>(qf, Kp, Vp, kt, d00, lut, st, maskrow, h8, win, dmask, false);
        } else {
            const int cur = qt >> 3;
            float gate[7];
            const float* km = kmean + (size_t)((b * 6 + hd) * 8) * 64 + 8 * h;
#pragma unroll
            for (int n = 0; n < 7; ++n) {
                float s = 0.f;
                if (n < cur) {
#pragma unroll
                    for (int ks = 0; ks < 4; ++ks) {
                        const f32x4 k0 = *(const f32x4*)(km + n * 64 + 16 * ks), k1 = *(const f32x4*)(km + n * 64 + 16 * ks + 4);
                        const u32x4 qw = __builtin_bit_cast(u32x4, qf[ks]);
                        s += bf_lo(qw.x) * k0[0] + bf_hi(qw.x) * k0[1] + bf_lo(qw.y) * k0[2] + bf_hi(qw.y) * k0[3]
                           + bf_lo(qw.z) * k1[0] + bf_hi(qw.z) * k1[1] + bf_lo(qw.w) * k1[2] + bf_hi(qw.w) * k1[3];
                    }
                    s += __shfl_xor(s, 32);
                } else s = -__builtin_inff();
                gate[n] = s;
            }
            unsigned sel = 0u;
#pragma unroll
            for (int rd = 0; rd < 3; ++rd) {
                float bv = -__builtin_inff(); int bi = -1;
#pragma unroll
                for (int n = 0; n < 7; ++n) if (gate[n] > bv) { bv = gate[n]; bi = n; }
                if (bi >= 0) sel |= 1u << bi;
#pragma unroll
                for (int n = 0; n < 7; ++n) if (n == bi) gate[n] = -__builtin_inff();
            }
            for (int n = 0; n < cur; ++n) {
                const bool ls = ((sel >> n) & 1u) != 0u;
                if (__ballot(ls) == 0ull) continue;
                for (int kt = n * 8; kt < n * 8 + 8; ++kt) attn_tile<2>(qf, Kp, Vp, kt, d00, lut, st, maskrow, h8, 0, 0, ls);
            }
            for (int kt = cur * 8; kt <= qt; ++kt) attn_tile<3>(qf, Kp, Vp, kt, d00, lut, st, maskrow, h8, 0, 0, false);
        }
    }
    const float lt = st.l + __shfl_xor(st.l, 32);
    const float inv = 1.0f / lt;
    bf16_t* op = oabc + (size_t)(tok0 + t0 + r) * 1024 + ocol + 4 * h;
#pragma unroll
    for (int g4 = 0; g4 < 4; ++g4) {
        u32x2 w;
        w.x = pk2(st.o0[4 * g4] * inv, st.o0[4 * g4 + 1] * inv); w.y = pk2(st.o0[4 * g4 + 2] * inv, st.o0[4 * g4 + 3] * inv);
        *(u32x2*)(op + 8 * g4) = w;
        w.x = pk2(st.o1[4 * g4] * inv, st.o1[4 * g4 + 1] * inv); w.y = pk2(st.o1[4 * g4 + 2] * inv, st.o1[4 * g4 + 3] * inv);
        *(u32x2*)(op + 32 + 8 * g4) = w;
    }
}
DI void phase_attn(const Args& a, unsigned char* shm, const int tid) {
    const int wid = __builtin_amdgcn_readfirstlane(tid >> 6);
    float* lut = (float*)(shm + wid * 8192);
    int it = 0;
    for (int j = blockIdx.x; j < 2048; j += gridDim.x, ++it) {
        int b, qt; task_rot(j, b, qt);
        const int role = (wid + it) & 7;
        if (role < 6) { attn_job(a, lut, 0, b, qt, role, tid); attn_job(a, lut, 2, b, qt, role, tid); }
        else { attn_job(a, lut, 1, b, qt, role - 6, tid); attn_job(a, lut, 1, b, qt, role - 4, tid); }
    }
}

__global__ void __launch_bounds__(512, 2) mega_fwd(Args a) {
    extern __shared__ __attribute__((aligned(16))) unsigned char shm[];
    cg::grid_group grid = cg::this_grid();
    LAS unsigned char* lds = (LAS unsigned char*)shm;
    const int G = gridDim.x, c = blockIdx.x;
    bf16_t* xb = (bf16_t*)(a.ws + WS_XB);
    bf16_t* r1 = (bf16_t*)(a.ws + WS_R1);
    bf16_t* oabc = (bf16_t*)(a.ws + WS_OABC);
    for (int ph = a.ph_lo; ph < a.ph_hi; ++ph) {
        int tid = threadIdx.x; asm volatile("" : "+v"(tid));
        if (ph == 0) phase_convert(a, shm, tid);
        else {
            const int l = (ph - 1) / 9, sp = (ph - 1) % 9;
            const bf16_t* w = (const bf16_t*)(a.ws + WS_WB) + (size_t)l * W_LAYER;
            const float* xin = (l == 0) ? a.in[0] : a.out;
            if (sp == 0) {
                { pg8::Gemm g{xb, w + WO_IN, 1024, 1024, 1024}; pg8::StaticOrder S; S.init(256, 11, G, c); pg8::EpiBf16<0> E{r1, RM_LD}; pg8::gemm_phase(lds, g, S, E, tid); }
                { pg8::Gemm g{w + WO_IN + (size_t)RM_LD * 1024, xb, 1024, 1024, 1024}; pg8::StaticOrder S; S.init(3, 256, G, c); pg8::EpiBf16<0> E{r1 + (size_t)MTOK * RM_LD, MTOK}; pg8::gemm_phase(lds, g, S, E, tid); }
            } else if (sp == 1) phase_a1(a, shm, tid);
            else if (sp == 2) phase_attn(a, shm, tid);
            else if (sp == 3) {
                pg8::StaticOrder S; S.init(256, 4, G, c);
                { pg8::Gemm g{oabc, w + WO_BA, 1024, 384, 384}; pg8::EpiBf16<0> E{r1, 3072}; pg8::gemm_phase(lds, g, S, E, tid); }
                { pg8::Gemm g{oabc + 384, w + WO_BB, 1024, 256, 256}; pg8::EpiBf16<0> E{r1 + 1024, 3072}; pg8::gemm_phase(lds, g, S, E, tid); }
                { pg8::Gemm g{oabc + 640, w + WO_BC, 1024, 384, 384}; pg8::EpiBf16<0> E{r1 + 2048, 3072}; pg8::gemm_phase(lds, g, S, E, tid); }
                { pg8::Gemm g{xb, w + WO_G, 1024, 1024, 1024}; pg8::Order3 S3; S3.base = S; pg8::EpiGate E{r1, r1 + (size_t)MTOK * 3072}; pg8::gemm_phase(lds, g, S3, E, tid); }
            } else if (sp == 4) {
                pg8::Gemm g{r1 + (size_t)MTOK * 3072, w + WO_OUT, 1024, 1024, 1024}; pg8::StaticOrder S; S.init(256, 4, G, c);
                pg8::EpiRes<false> E{xin, a.out, nullptr}; pg8::gemm_phase(lds, g, S, E, tid);
            } else if (sp == 5) phase_ln(a.out, xb, a.in[8] + l * 1024, a.in[9] + l * 1024, tid);
            else if (sp == 6) {
                { pg8::Gemm g{xb, w + WO_UP, 1024, 1024, 1024}; pg8::StaticOrder S; S.init(256, 16, G, c); pg8::EpiBf16<1> E{r1, 4096}; pg8::gemm_phase(lds, g, S, E, tid); }
                pg8::StaticOrder S; S.init(256, 4, G, c);
                { pg8::Gemm g{(const bf16_t*)(a.ws + WS_PB) + (size_t)l * MTOK * 256, w + WO_PL, 256, 256, 256}; pg8::EpiBf16<0> E{oabc, 1024}; pg8::gemm_phase(lds, g, S, E, tid); }
                { pg8::Gemm g{xb, w + WO_PG, 1024, 1024, 1024}; pg8::EpiT1 E{oabc}; pg8::gemm_phase(lds, g, S, E, tid); }
            } else if (sp == 7) {
                pg8::Gemm g{r1, w + WO_DN, 4096, 4096, 4096}; pg8::StaticOrder S; S.init(256, 4, G, c);
                pg8::EpiRes<true> E{a.out, a.out, oabc}; pg8::gemm_phase(lds, g, S, E, tid);
            } else phase_ln(a.out, xb, a.in[14] + l * 1024, a.in[15] + l * 1024, tid);
        }
        if (ph + 1 < a.ph_hi) grid.sync();
    }
}

#ifndef N_LAUNCH_MODE
#define N_LAUNCH_MODE 1
#endif
extern "C" void kernel_launch(void* const* d_in, const int* in_sizes, int n_in, void* d_out, int out_size, void* d_ws, size_t ws_size, hipStream_t stream) {
    static int grid = 0;
    if (grid == 0) {
        if (n_in != 17 || out_size != MTOK * DM || ws_size < WS_END) { fprintf(stderr, "kernel_launch: unexpected shapes (n_in %d out %d ws %zu need %zu)\n", n_in, out_size, ws_size, (size_t)WS_END); grid = -1; return; }
        int dev = 0, cus = 0, per_cu = 0;
        hipGetDevice(&dev);
        hipDeviceGetAttribute(&cus, hipDeviceAttributeMultiprocessorCount, dev);
        if (hipFuncSetAttribute((const void*)mega_fwd, hipFuncAttributeMaxDynamicSharedMemorySize, LDS_BYTES) != hipSuccess) { fprintf(stderr, "kernel_launch: hipFuncSetAttribute failed\n"); grid = -1; return; }
        hipOccupancyMaxActiveBlocksPerMultiprocessor(&per_cu, (const void*)mega_fwd, 512, LDS_BYTES);
        if (per_cu < 1) { fprintf(stderr, "kernel_launch: occupancy query says %d\n", per_cu); per_cu = 1; }
        (void)hipGetLastError();
        grid = cus * per_cu;
    }
    if (grid < 0) return;
    Args a{};
    for (int i = 0; i < 17; ++i) a.in[i] = (const float*)d_in[i];
    a.out = (float*)d_out; a.ws = (unsigned char*)d_ws;
#if N_LAUNCH_MODE == 0
    for (int ph = 0; ph < 19; ++ph) {
        a.ph_lo = ph; a.ph_hi = ph + 1;
        hipLaunchKernelGGL(mega_fwd, dim3(grid), dim3(512), LDS_BYTES, stream, a);
    }
#else
    a.ph_lo = 0; a.ph_hi = 19;
    void* args[] = {&a};
    hipError_t e = hipLaunchCooperativeKernel((const void*)mega_fwd, dim3(grid), dim3(512), args, LDS_BYTES, stream);
    if (e != hipSuccess) fprintf(stderr, "cooperative launch failed: %s (grid %d)\n", hipGetErrorString(e), grid);
#endif
}
```

```cpp
#include <hip/hip_runtime.h>
#include <hip/hip_cooperative_groups.h>
#include <cstdio>
namespace cg = cooperative_groups;

#define LAS __attribute__((address_space(3)))
#define DI __device__ __forceinline__
typedef unsigned short bf16_t;
typedef short bf16x8 __attribute__((ext_vector_type(8)));
typedef float f32x2 __attribute__((ext_vector_type(2)));
typedef float f32x4 __attribute__((ext_vector_type(4)));
typedef float f32x16 __attribute__((ext_vector_type(16)));
typedef unsigned u32x2 __attribute__((ext_vector_type(2)));
typedef unsigned u32x4 __attribute__((ext_vector_type(4)));
typedef __bf16 bf2_t __attribute__((ext_vector_type(2)));

constexpr int MTOK = 65536, SEQ = 2048, DM = 1024, NB = 32, DFF = 4096, PLE = 256;
constexpr int RM_LD = 2816;
constexpr int C_AQ = 0, C_AK = 384, C_IQ = 448, C_IK = 960, C_BQ = 1024, C_BK = 1792, C_CQ = 2048, C_CK = 2432;
constexpr int T_ROWS = 768;
constexpr int R_AV = 0, R_BV = 64, R_CV = 320, R_IW = 704;
constexpr int NWIN = 3584;
constexpr float ALPHA = 1.41421356237309515f;
constexpr float LOG2E = 1.44269504088896341f;
constexpr float SC2 = 0.125f * LOG2E;
constexpr float NEGF = -1e30f;
constexpr int LDS_BYTES = 131072;

constexpr size_t WO_IN = 0;
constexpr size_t WO_G = WO_IN + (size_t)NWIN * 1024;
constexpr size_t WO_BA = WO_G + (size_t)3072 * 1024;
constexpr size_t WO_BB = WO_BA + (size_t)1024 * 384;
constexpr size_t WO_BC = WO_BB + (size_t)1024 * 256;
constexpr size_t WO_OUT = WO_BC + (size_t)1024 * 384;
constexpr size_t WO_UP = WO_OUT + (size_t)1024 * 1024;
constexpr size_t WO_DN = WO_UP + (size_t)4096 * 1024;
constexpr size_t WO_PG = WO_DN + (size_t)1024 * 4096;
constexpr size_t WO_PL = WO_PG + (size_t)1024 * 1024;
constexpr size_t W_LAYER = WO_PL + (size_t)1024 * 256;

constexpr size_t WS_WB = 0;
constexpr size_t WS_LUT = WS_WB + 2 * W_LAYER * 2;
constexpr size_t WS_KMEAN = WS_LUT + (size_t)24 * 2048 * 4;
constexpr size_t WS_MASK = WS_KMEAN + (size_t)32 * 6 * 8 * 64 * 4;
constexpr size_t WS_XB = WS_MASK + (size_t)MTOK * 64 * 4;
constexpr size_t WS_PB = WS_XB + (size_t)MTOK * 1024 * 2;
constexpr size_t WS_OABC = WS_PB + (size_t)2 * MTOK * 256 * 2;
constexpr size_t WS_R1 = WS_OABC + (size_t)MTOK * 1024 * 2;
constexpr size_t WS_END = WS_R1 + (size_t)MTOK * 4096 * 2;

struct Args {
    const float* in[17];
    float* out;
    unsigned char* ws;
    int ph_lo, ph_hi;
};

DI unsigned short f2bf(float f) { unsigned u = __float_as_uint(f); u += 0x7FFFu + ((u >> 16) & 1u); return (unsigned short)(u >> 16); }
DI unsigned pk2(float lo, float hi) { f32x2 v = {lo, hi}; bf2_t b = __builtin_convertvector(v, bf2_t); return __builtin_bit_cast(unsigned, b); }
DI float bf_lo(unsigned w) { return __uint_as_float(w << 16); }
DI float bf_hi(unsigned w) { return __uint_as_float(w & 0xFFFF0000u); }
DI float bf2f(bf16_t b) { return __uint_as_float(((unsigned)b) << 16); }
DI float sigmoidf_(float x) { return __builtin_amdgcn_rcpf(1.0f + __expf(-x)); }
#define MFMA32(a, b, c) __builtin_amdgcn_mfma_f32_32x32x16_bf16((a), (b), (c), 0, 0, 0)

namespace pg8 {
constexpr int BM = 256, BK = 64, HALF = 128, HTB = HALF * BK * 2, NXCD = 8, WGM = 8;
DI int lds_byte(int r, int c) { const int st = (r >> 4) * 2 + (c >> 5), rr = r & 15, cc = c & 31, ob = rr * 64 + cc * 2; return st * 1024 + (ob ^ (((ob >> 9) & 1) << 5)); }
DI void stage_rc(int b, int& R, int& C) { const int st = b / 1024, sb = b % 1024, swz = sb ^ (((sb >> 9) & 1) << 5); R = (st >> 1) * 16 + swz / 64; C = (st & 1) * 32 + (swz % 64) / 2; }
DI int perm32(int rho) { const int n = rho >> 4, i = rho & 15; return 8 * (i >> 2) + 4 * n + (i & 3); }

struct Unit { int pm, pn; };
struct Gemm { const bf16_t* A; const bf16_t* Bt; int lda, ldb, K; };

struct StaticOrder {
    int nM, nN, nwg, G, c;
    DI void init(int nM_, int nN_, int G_, int c_) { nM = nM_; nN = nN_; nwg = nM * nN; G = G_; c = c_; }
    DI bool next(int i, Unit& u) const {
        const long L = (long)i * G + c; if (L >= nwg) return false;
        int wgid = (int)L; { const int q = nwg / NXCD, r = nwg % NXCD, xcd = wgid % NXCD, off = wgid / NXCD; wgid = (xcd < r ? xcd * (q + 1) : r * (q + 1) + (xcd - r) * q) + off; }
        const int nig = WGM * nN, gid = wgid / nig, fm = gid * WGM, gsz = (nM - fm) < WGM ? (nM - fm) : WGM;
        u.pm = fm + ((wgid % nig) % gsz); u.pn = (wgid % nig) / gsz; return true;
    }
};
struct Order3 {
    StaticOrder base;
    DI bool next(int i, Unit& u) const { Unit v; if (!base.next(i / 3, v)) return false; u.pm = v.pm; u.pn = (i % 3) * 4 + v.pn; return true; }
};

template <int ACT  > struct EpiBf16 {
    static constexpr bool PERM = true;
    bf16_t* O; int ldc;
    DI void operator()(const f32x4 (&acc)[2][2][4][2], const Unit& u, int wr, int wc, int fr, int fq) const {
        const int row0 = u.pm * BM + wr * 64 + fr, col0 = u.pn * BM + wc * 32 + 8 * fq;
#pragma unroll
        for (int ai = 0; ai < 2; ++ai)
#pragma unroll
            for (int m = 0; m < 4; ++m) { bf16_t* rowp = O + (size_t)(row0 + ai * HALF + m * 16) * ldc + col0;
#pragma unroll
                for (int bj = 0; bj < 2; ++bj) { f32x4 v0 = acc[ai][bj][m][0], v1 = acc[ai][bj][m][1];
                    if (ACT == 1) {
#pragma unroll
                        for (int j = 0; j < 4; ++j) { float a = fmaxf(v0[j], 0.f), b = fmaxf(v1[j], 0.f); v0[j] = a * a; v1[j] = b * b; } }
                    u32x4 w; w.x = pk2(v0[0], v0[1]); w.y = pk2(v0[2], v0[3]); w.z = pk2(v1[0], v1[1]); w.w = pk2(v1[2], v1[3]);
                    *(u32x4*)(rowp + bj * HALF) = w; } }
    }
};
struct EpiGate {
    static constexpr bool PERM = true;
    const bf16_t* obr; bf16_t* mg;
    DI void operator()(const f32x4 (&acc)[2][2][4][2], const Unit& u, int wr, int wc, int fr, int fq) const {
        const int b = u.pn >> 2, colt = (u.pn & 3) * BM;
        const int row0 = u.pm * BM + wr * 64 + fr, col0 = colt + wc * 32 + 8 * fq;
#pragma unroll
        for (int ai = 0; ai < 2; ++ai)
#pragma unroll
            for (int m = 0; m < 4; ++m) { const size_t row = (size_t)(row0 + ai * HALF + m * 16);
#pragma unroll
                for (int bj = 0; bj < 2; ++bj) { const f32x4 v0 = acc[ai][bj][m][0], v1 = acc[ai][bj][m][1];
                    const u32x4 ob = *(const u32x4*)(obr + row * 3072 + b * 1024 + col0 + bj * HALF);
                    bf16_t* mp = mg + row * 1024 + col0 + bj * HALF;
                    float r[8];
                    r[0] = sigmoidf_(v0[0]) * bf_lo(ob.x); r[1] = sigmoidf_(v0[1]) * bf_hi(ob.x); r[2] = sigmoidf_(v0[2]) * bf_lo(ob.y); r[3] = sigmoidf_(v0[3]) * bf_hi(ob.y);
                    r[4] = sigmoidf_(v1[0]) * bf_lo(ob.z); r[5] = sigmoidf_(v1[1]) * bf_hi(ob.z); r[6] = sigmoidf_(v1[2]) * bf_lo(ob.w); r[7] = sigmoidf_(v1[3]) * bf_hi(ob.w);
                    if (b > 0) { const u32x4 pm_ = *(const u32x4*)mp;
                        r[0] += bf_lo(pm_.x); r[1] += bf_hi(pm_.x); r[2] += bf_lo(pm_.y); r[3] += bf_hi(pm_.y); r[4] += bf_lo(pm_.z); r[5] += bf_hi(pm_.z); r[6] += bf_lo(pm_.w); r[7] += bf_hi(pm_.w); }
                    u32x4 w; w.x = pk2(r[0], r[1]); w.y = pk2(r[2], r[3]); w.z = pk2(r[4], r[5]); w.w = pk2(r[6], r[7]);
                    *(u32x4*)mp = w; } }
    }
};
struct EpiT1 {
    static constexpr bool PERM = true;
    bf16_t* T;
    DI void operator()(const f32x4 (&acc)[2][2][4][2], const Unit& u, int wr, int wc, int fr, int fq) const {
        const int row0 = u.pm * BM + wr * 64 + fr, col0 = u.pn * BM + wc * 32 + 8 * fq;
#pragma unroll
        for (int ai = 0; ai < 2; ++ai)
#pragma unroll
            for (int m = 0; m < 4; ++m) { const size_t row = (size_t)(row0 + ai * HALF + m * 16);
#pragma unroll
                for (int bj = 0; bj < 2; ++bj) { const f32x4 v0 = acc[ai][bj][m][0], v1 = acc[ai][bj][m][1];
                    bf16_t* tp = T + row * 1024 + col0 + bj * HALF;
                    const u32x4 ob = *(const u32x4*)tp;
                    float r[8];
                    r[0] = sigmoidf_(v0[0]) * bf_lo(ob.x); r[1] = sigmoidf_(v0[1]) * bf_hi(ob.x); r[2] = sigmoidf_(v0[2]) * bf_lo(ob.y); r[3] = sigmoidf_(v0[3]) * bf_hi(ob.y);
                    r[4] = sigmoidf_(v1[0]) * bf_lo(ob.z); r[5] = sigmoidf_(v1[1]) * bf_hi(ob.z); r[6] = sigmoidf_(v1[2]) * bf_lo(ob.w); r[7] = sigmoidf_(v1[3]) * bf_hi(ob.w);
                    u32x4 w; w.x = pk2(r[0], r[1]); w.y = pk2(r[2], r[3]); w.z = pk2(r[4], r[5]); w.w = pk2(r[6], r[7]);
                    *(u32x4*)tp = w; } }
    }
};
template <bool HAS_T> struct EpiRes {
    static constexpr bool PERM = false;
    const float* xin; float* y; const bf16_t* T;
    DI void operator()(const f32x4 (&acc)[2][2][4][2], const Unit& u, int wr, int wc, int fr, int fq) const {
        const int row0 = u.pm * BM + wr * 64 + fr, col0 = u.pn * BM + wc * 32 + 4 * fq;
#pragma unroll
        for (int ai = 0; ai < 2; ++ai)
#pragma unroll
            for (int m = 0; m < 4; ++m) { const size_t ro = (size_t)(row0 + ai * HALF + m * 16) * 1024 + col0;
#pragma unroll
                for (int bj = 0; bj < 2; ++bj)
#pragma unroll
                    for (int n = 0; n < 2; ++n) { const size_t o = ro + bj * HALF + n * 16;
                        const f32x4 xv = *(const f32x4*)(xin + o); f32x4 r = acc[ai][bj][m][n] + xv * ALPHA;
                        if (HAS_T) { const u32x2 tv = *(const u32x2*)(T + o); r[0] += bf_lo(tv.x); r[1] += bf_hi(tv.x); r[2] += bf_lo(tv.y); r[3] += bf_hi(tv.y); }
                        *(f32x4*)(y + o) = r; } }
    }
};

template <class Epi, class Sched>
DI void gemm_phase(LAS unsigned char* lds, const Gemm g, const Sched& S, const Epi& E, const int tid) {
    const int wid = __builtin_amdgcn_readfirstlane(tid >> 6), lane = tid & 63, wr = wid >> 2, wc = wid & 3, fr = lane & 15, fq = lane >> 4;
    const int K = g.K, nt = K / BK;
    unsigned voffA[2], voffB[2];
#pragma unroll
    for (int i = 0; i < 2; ++i) { int R, C; stage_rc(tid * 16 + i * 8192, R, C); const int Rb = Epi::PERM ? ((R & ~31) + perm32(R & 31)) : R;
        voffA[i] = (unsigned)(R * g.lda + C) * 2u; voffB[i] = (unsigned)(Rb * g.ldb + C) * 2u; }
    const size_t kstep = (size_t)(BK * 2);
    const size_t hstepA = (size_t)HALF * g.lda * 2, hstepB = (size_t)HALF * g.ldb * 2;
    const size_t tstepA = 2 * hstepA, tstepB = 2 * hstepB;
    const unsigned ldsw = (unsigned)wid * 1024u;
    const int aoff = lds_byte(wr * 64 + fr, fq * 8), boff = lds_byte(wc * 32 + fr, fq * 8);
#define PG8_SA(b, h) (((b) * 2 + (h)) * HTB)
#define PG8_SB(b, h) ((4 + (b) * 2 + (h)) * HTB)
#define PG8_STAGE(bufoff, gbase, voff) do { _Pragma("unroll") for (int _i = 0; _i < 2; ++_i) \
        __builtin_amdgcn_global_load_lds((const unsigned*)((const char*)(gbase) + (voff)[_i]), (LAS unsigned*)(lds + (bufoff) + ldsw + _i * 8192), 16, 0, 0); } while (0)
#define PG8_LDA(dst, b, h) do { _Pragma("unroll") for (int m = 0; m < 4; ++m) _Pragma("unroll") for (int k = 0; k < 2; ++k) dst[m][k] = *(const LAS bf16x8*)(lds + PG8_SA(b, h) + aoff + m * 2048 + k * 1024); } while (0)
#define PG8_LDB(dst, b, h) do { _Pragma("unroll") for (int n = 0; n < 2; ++n) _Pragma("unroll") for (int k = 0; k < 2; ++k) dst[n][k] = *(const LAS bf16x8*)(lds + PG8_SB(b, h) + boff + n * 2048 + k * 1024); } while (0)
#define PG8_MMA(ai, bj, At, Bt) do { __builtin_amdgcn_s_setprio(1); _Pragma("unroll") for (int m = 0; m < 4; ++m) _Pragma("unroll") for (int n = 0; n < 2; ++n) _Pragma("unroll") for (int k = 0; k < 2; ++k) \
        acc[ai][bj][m][n] = __builtin_amdgcn_mfma_f32_16x16x32_bf16(Bt[n][k], At[m][k], acc[ai][bj][m][n], 0, 0, 0); __builtin_amdgcn_s_setprio(0); } while (0)
#define PG8_WAIT_V(n) asm volatile("s_waitcnt vmcnt(" #n ")" ::: "memory")
#define PG8_WAIT_L(n) asm volatile("s_waitcnt lgkmcnt(" #n ")" ::: "memory")
#define PG8_BAR __builtin_amdgcn_s_barrier()
#define PG8_SCHED __builtin_amdgcn_sched_barrier(0)
    Unit cur, nxt; int ui = 0;
    if (!S.next(0, cur)) return;
    f32x4 acc[2][2][4][2];
#pragma unroll
    for (int a = 0; a < 2; ++a)
#pragma unroll
        for (int b = 0; b < 2; ++b)
#pragma unroll
            for (int m = 0; m < 4; ++m)
#pragma unroll
                for (int n = 0; n < 2; ++n) acc[a][b][m][n] = (f32x4){0.f, 0.f, 0.f, 0.f};
    bf16x8 At[4][2], B0[2][2], B1[2][2];
    const char* cA = (const char*)g.A + (size_t)cur.pm * tstepA; const char* cB = (const char*)g.Bt + (size_t)cur.pn * tstepB;
    PG8_STAGE(PG8_SB(0, 0), cB, voffB); PG8_STAGE(PG8_SA(0, 0), cA, voffA); PG8_STAGE(PG8_SB(0, 1), cB + hstepB, voffB); PG8_STAGE(PG8_SA(0, 1), cA + hstepA, voffA);
    if (wr == 1) PG8_BAR;
    PG8_WAIT_V(4); PG8_BAR;
    PG8_STAGE(PG8_SB(1, 0), cB + kstep, voffB); PG8_STAGE(PG8_SA(1, 0), cA + kstep, voffA); PG8_STAGE(PG8_SB(1, 1), cB + hstepB + kstep, voffB);
    PG8_WAIT_V(6); PG8_BAR;
    for (;;) {
        const bool has_next = S.next(ui + 1, nxt);
        const char* nA = has_next ? (const char*)g.A + (size_t)nxt.pm * tstepA : cA; const char* nB = has_next ? (const char*)g.Bt + (size_t)nxt.pn * tstepB : cB;
        for (int t = 0; t < nt; t += 2) {
            const bool last = (t == nt - 2);
            const char* a1 = cA + (size_t)(t + 1) * kstep;
            const char* a2 = last ? nA : cA + (size_t)(t + 2) * kstep; const char* b2 = last ? nB : cB + (size_t)(t + 2) * kstep;
            const char* a3 = a2 + kstep; const char* b3 = b2 + kstep;
            PG8_LDB(B0, 0, 0); PG8_SCHED; PG8_LDA(At, 0, 0); PG8_STAGE(PG8_SA(1, 1), a1 + hstepA, voffA);
            PG8_WAIT_L(8); PG8_BAR; PG8_WAIT_L(0); PG8_MMA(0, 0, At, B0); PG8_BAR; PG8_SCHED;
            PG8_LDB(B1, 0, 1); PG8_STAGE(PG8_SB(0, 0), b2, voffB);
            PG8_BAR; PG8_WAIT_L(0); PG8_MMA(0, 1, At, B1); PG8_BAR;
            PG8_LDA(At, 0, 1); PG8_STAGE(PG8_SA(0, 0), a2, voffA);
            PG8_BAR; PG8_WAIT_L(0); PG8_MMA(1, 0, At, B0); PG8_BAR; PG8_SCHED;
            PG8_STAGE(PG8_SB(0, 1), b2 + hstepB, voffB);
            PG8_WAIT_V(6); PG8_BAR; PG8_MMA(1, 1, At, B1); PG8_BAR;
            PG8_LDB(B0, 1, 0); PG8_SCHED; PG8_LDA(At, 1, 0); PG8_STAGE(PG8_SA(0, 1), a2 + hstepA, voffA);
            PG8_WAIT_L(8); PG8_BAR; PG8_WAIT_L(0); PG8_MMA(0, 0, At, B0); PG8_BAR; PG8_SCHED;
            PG8_LDB(B1, 1, 1); PG8_STAGE(PG8_SB(1, 0), b3, voffB);
            PG8_BAR; PG8_WAIT_L(0); PG8_MMA(0, 1, At, B1); PG8_BAR;
            PG8_LDA(At, 1, 1); PG8_STAGE(PG8_SA(1, 0), a3, voffA);
            PG8_BAR; PG8_WAIT_L(0); PG8_MMA(1, 0, At, B0); PG8_BAR; PG8_SCHED;
            PG8_STAGE(PG8_SB(1, 1), b3 + hstepB, voffB);
            PG8_WAIT_V(6); PG8_BAR; PG8_MMA(1, 1, At, B1); PG8_BAR;
        }
        E(acc, cur, wr, wc, fr, fq);
        if (!has_next) break;
#pragma unroll
        for (int a = 0; a < 2; ++a)
#pragma unroll
            for (int b = 0; b < 2; ++b)
#pragma unroll
                for (int m = 0; m < 4; ++m)
#pragma unroll
                    for (int n = 0; n < 2; ++n) acc[a][b][m][n] = (f32x4){0.f, 0.f, 0.f, 0.f};
        cur = nxt; cA = nA; cB = nB; ++ui;
    }
    PG8_WAIT_V(0);
    if (wr == 0) PG8_BAR;
    PG8_BAR;
#undef PG8_SA
#undef PG8_SB
#undef PG8_STAGE
#undef PG8_LDA
#undef PG8_LDB
#undef PG8_MMA
#undef PG8_WAIT_V
#undef PG8_WAIT_L
#undef PG8_BAR
#undef PG8_SCHED
}
}

DI int win_srccol(int n) {
    if (n < 384) return n;
    if (n < 448) return 384 + (n - 384);
    if (n < 960) return 512 + (n - 448);
    if (n < 1024) return 1024 + (n - 960);
    if (n < 1792) return 1096 + (n - 1024);
    if (n < 2048) return 1864 + (n - 1792);
    if (n < 2432) return 2376 + (n - 2048);
    if (n < 2816) return 2760 + (n - 2432);
    if (n < 2880) return 448 + (n - 2816);
    if (n < 3136) return 2120 + (n - 2880);
    if (n < 3520) return 3144 + (n - 3136);
    if (n < 3528) return 1088 + (n - 3520);
    return -1;
}
DI void convT(unsigned char* shm, const float* src, int K, int Nsrc, bf16_t* dst, int Ndst, int mode, const int tid) {
    unsigned short* tl = (unsigned short*)shm;
    const int ntk = K / 64, ntiles = (Ndst / 64) * ntk;
    for (int tile = blockIdx.x; tile < ntiles; tile += gridDim.x) {
        const int n0 = (tile / ntk) * 64, k0 = (tile % ntk) * 64;
        const int nx = tid & 63, ky = tid >> 6;
        const int sc = mode ? win_srccol(n0 + nx) : (n0 + nx);
#pragma unroll
        for (int p = 0; p < 8; ++p) { const int k = k0 + ky + 8 * p; const float v = sc >= 0 ? src[(size_t)k * Nsrc + sc] : 0.f; tl[nx * 66 + ky + 8 * p] = f2bf(v); }
        __syncthreads();
#pragma unroll
        for (int p = 0; p < 8; ++p) { const int n = ky + 8 * p; dst[(size_t)(n0 + n) * K + k0 + nx] = tl[n * 66 + nx]; }
        __syncthreads();
    }
}
DI void conv_vec(const float* src, bf16_t* dst, size_t n8, const int tid) {
    for (size_t i = (size_t)blockIdx.x * 512 + tid; i < n8; i += (size_t)gridDim.x * 512) {
        const f32x4 a = *(const f32x4*)(src + i * 8), b = *(const f32x4*)(src + i * 8 + 4);
        u32x4 w; w.x = pk2(a[0], a[1]); w.y = pk2(a[2], a[3]); w.z = pk2(b[0], b[1]); w.w = pk2(b[2], b[3]);
        *(u32x4*)(dst + i * 8) = w;
    }
}
DI int rel_bucket(int n) {
    if (n < 16) return n;
    int large = 16 + (int)(logf((float)n / 16.0f) / 4.852030263919617f * 16.0f);
    return large < 31 ? large : 31;
}
DI void phase_convert(const Args& a, unsigned char* shm, const int tid) {
    bf16_t* wb = (bf16_t*)(a.ws + WS_WB);
    for (int l = 0; l < 2; ++l) {
        bf16_t* w = wb + (size_t)l * W_LAYER;
        convT(shm, a.in[2] + (size_t)l * 1024 * 3528, 1024, 3528, w + WO_IN, NWIN, 1, tid);
        convT(shm, a.in[3] + (size_t)l * 1024 * 3072, 1024, 3072, w + WO_G, 3072, 0, tid);
        convT(shm, a.in[4] + (size_t)l * 384 * 1024, 384, 1024, w + WO_BA, 1024, 0, tid);
        convT(shm, a.in[5] + (size_t)l * 256 * 1024, 256, 1024, w + WO_BB, 1024, 0, tid);
        convT(shm, a.in[6] + (size_t)l * 384 * 1024, 384, 1024, w + WO_BC, 1024, 0, tid);
        convT(shm, a.in[7] + (size_t)l * 1024 * 1024, 1024, 1024, w + WO_OUT, 1024, 0, tid);
        convT(shm, a.in[10] + (size_t)l * 1024 * 4096, 1024, 4096, w + WO_UP, 4096, 0, tid);
        convT(shm, a.in[11] + (size_t)l * 4096 * 1024, 4096, 1024, w + WO_DN, 1024, 0, tid);
        convT(shm, a.in[12] + (size_t)l * 1024 * 1024, 1024, 1024, w + WO_PG, 1024, 0, tid);
        convT(shm, a.in[13] + (size_t)l * 256 * 1024, 256, 1024, w + WO_PL, 1024, 0, tid);
    }
    conv_vec(a.in[0], (bf16_t*)(a.ws + WS_XB), (size_t)MTOK * 1024 / 8, tid);
    conv_vec(a.in[1], (bf16_t*)(a.ws + WS_PB), (size_t)2 * MTOK * 256 / 8, tid);
    float* lut = (float*)(a.ws + WS_LUT);
    const float* rb = a.in[16];
    for (int i = blockIdx.x * 512 + tid; i < 24 * 2048; i += gridDim.x * 512) {
        const int hd = i >> 11, d = i & 2047;
        lut[i] = rb[rel_bucket(d) * 24 + hd] * LOG2E;
    }
}

DI float wave_sum(float v) {
#pragma unroll
    for (int o = 32; o >= 1; o >>= 1) v += __shfl_xor(v, o);
    return v;
}
DI void phase_ln(float* y, bf16_t* xb, const float* g, const float* b, const int tid) {
    const int wid = tid >> 6, lane = tid & 63;
    f32x4 gv[4], bv[4];
#pragma unroll
    for (int k = 0; k < 4; ++k) { gv[k] = *(const f32x4*)(g + k * 256 + lane * 4); bv[k] = *(const f32x4*)(b + k * 256 + lane * 4); }
    for (int row = blockIdx.x * 8 + wid; row < MTOK; row += gridDim.x * 8) {
        float* yp = y + (size_t)row * 1024;
        f32x4 v[4]; float s = 0.f;
#pragma unroll
        for (int k = 0; k < 4; ++k) { v[k] = *(const f32x4*)(yp + k * 256 + lane * 4); s += v[k][0] + v[k][1] + v[k][2] + v[k][3]; }
        const float mean = wave_sum(s) * (1.0f / 1024.0f);
        float q = 0.f;
#pragma unroll
        for (int k = 0; k < 4; ++k) { v[k] = v[k] - mean; q += v[k][0] * v[k][0] + v[k][1] * v[k][1] + v[k][2] * v[k][2] + v[k][3] * v[k][3]; }
        const float var = wave_sum(q) * (1.0f / 1024.0f);
        const float rs = 1.0f / sqrtf(var + 1e-5f);
#pragma unroll
        for (int k = 0; k < 4; ++k) { const f32x4 o = v[k] * rs * gv[k] + bv[k];
            *(f32x4*)(yp + k * 256 + lane * 4) = o;
            u32x2 w; w.x = pk2(o[0], o[1]); w.y = pk2(o[2], o[3]);
            *(u32x2*)(xb + (size_t)row * 1024 + k * 256 + lane * 4) = w; }
    }
}

DI int pi_row(int r) { return (r & 3) | (((r >> 3) & 1) << 2) | (((r >> 2) & 1) << 3) | (r & 16); }
DI void task_rot(int tau, int& b, int& qt) { b = tau >> 6; qt = ((tau & 63) + 8 * (tau >> 8)) & 63; }
DI bool task_map(int k, int& b, int& qt) {
    if (gridDim.x == 256) { if (k >= 8) return false; const int xcd = blockIdx.x & 7, slot = blockIdx.x >> 3; b = xcd + 8 * (k >> 1); qt = (k & 1) ? 63 - slot : slot; return true; }
    const int tau = blockIdx.x + k * gridDim.x; if (tau >= 2048) return false; task_rot(tau, b, qt); return true;
}

DI void a1_task(unsigned char* shm, const bf16_t* prm, const bf16_t* prt, unsigned* mask, int b, int qt, const int tid) {
    const int wid = __builtin_amdgcn_readfirstlane(tid >> 6), lane = tid & 63, r = lane & 31, h = lane >> 5;
    const int t0 = qt * 32, tok0 = b * SEQ;
    unsigned* cnt = (unsigned*)(shm + 33280);
#pragma unroll
    for (int p = 0; p < 4; ++p) { const int c = tid + p * 512, row = c >> 6, ch = c & 63;
        *(u32x4*)(shm + row * 1040 + ch * 16) = *(const u32x4*)(prm + (size_t)(tok0 + t0 + row) * RM_LD + C_IQ + ch * 8); }
    cnt[tid] = 0u; cnt[tid + 512] = 0u;
    float* wqs = (float*)(shm + 33280 + 4096);
    if (tid < 256) wqs[tid] = bf2f(prt[(size_t)(R_IW + (tid >> 5)) * MTOK + tok0 + t0 + (tid & 31)]);
    __syncthreads();
    unsigned key[8][16];
    const bf16_t* kp = prm + (size_t)(tok0 + pi_row(r)) * RM_LD + C_IK + 8 * h;
#pragma unroll
    for (int jt = 0; jt < 8; ++jt) {
        const int kt = wid + 8 * jt;
        if (kt <= qt) {
            const int s0 = kt * 32;
            bf16x8 kf[4];
#pragma unroll
            for (int ks = 0; ks < 4; ++ks) kf[ks] = *(const bf16x8*)(kp + (size_t)s0 * RM_LD + 16 * ks);
            float idx[16];
#pragma unroll
            for (int i = 0; i < 16; ++i) idx[i] = 0.f;
#pragma unroll 1
            for (int hh = 0; hh < 8; ++hh) {
                f32x16 acc;
#pragma unroll
                for (int i = 0; i < 16; ++i) acc[i] = 0.f;
                const unsigned char* qb = shm + r * 1040 + hh * 128 + 16 * h;
#pragma unroll
                for (int ks = 0; ks < 4; ++ks) { const bf16x8 qf = *(const bf16x8*)(qb + 32 * ks); acc = MFMA32(kf[ks], qf, acc); }
                const float wv = wqs[hh * 32 + r];
#pragma unroll
                for (int i = 0; i < 16; ++i) idx[i] = fmaf(wv, fmaxf(acc[i], 0.f), idx[i]);
            }
#pragma unroll
            for (int i = 0; i < 16; ++i) {
                const int s = s0 + 16 * (i >> 3) + 8 * h + (i & 7);
                const unsigned u = __float_as_uint(idx[i] + 0.0f);
                const unsigned k = (u & 0x80000000u) ? ~u : (u | 0x80000000u);
                key[jt][i] = (s <= t0 + r) ? k : 0u;
            }
        } else {
#pragma unroll
            for (int i = 0; i < 16; ++i) key[jt][i] = 0u;
        }
    }
    unsigned T = 0u;
    for (int bit = 31; bit >= 0; --bit) {
        const unsigned cand = T | (1u << bit);
        int c = 0;
#pragma unroll
        for (int jt = 0; jt < 8; ++jt)
#pragma unroll
            for (int i = 0; i < 16; ++i) c += (key[jt][i] >= cand) ? 1 : 0;
        c += __shfl_xor(c, 32);
        if (h == 0 && c) atomicAdd(&cnt[(31 - bit) * 32 + r], (unsigned)c);
        __syncthreads();
        if (cnt[(31 - bit) * 32 + r] >= 256u) T = cand;
    }
    if (T < 1u) T = 1u;
#pragma unroll
    for (int jt = 0; jt < 8; ++jt) {
        const int kt = wid + 8 * jt;
        if (kt <= qt) {
            unsigned part = 0u;
#pragma unroll
            for (int i = 0; i < 16; ++i) part |= (key[jt][i] >= T ? 1u : 0u) << (16 * (i >> 3) + 8 * h + (i & 7));
            part |= (unsigned)__shfl_xor((int)part, 32);
            if (h == 0) mask[(size_t)(tok0 + t0 + r) * 64 + kt] = part;
        }
    }
    __syncthreads();
}
DI void phase_a1(const Args& a, unsigned char* shm, const int tid) {
    const bf16_t* prm = (const bf16_t*)(a.ws + WS_R1);
    const bf16_t* prt = prm + (size_t)MTOK * RM_LD;
    unsigned* mask = (unsigned*)(a.ws + WS_MASK);
    float* kmean = (float*)(a.ws + WS_KMEAN);
    for (int k = 0;; ++k) { int b, qt; if (!task_map(k, b, qt)) break; a1_task(shm, prm, prt, mask, b, qt, tid); }
    for (int j = 2048 + blockIdx.x; j < 2048 + 192; j += gridDim.x) {
        {
            const int id = (j - 2048) * 8 + (tid >> 6), lane = tid & 63;
            const int b = id / 48, hd = (id >> 3) % 6, n = id & 7;
            const bf16_t* p = prm + (size_t)(b * SEQ + n * 256) * RM_LD + C_CK + hd * 64 + lane;
            float s = 0.f;
            for (int t = 0; t < 256; ++t) s += bf2f(p[(size_t)t * RM_LD]);
            kmean[(size_t)((b * 6 + hd) * 8 + n) * 64 + lane] = s * (1.0f / 256.0f);
        }
    }
}

struct AttnSt { float m, l; f32x16 o0, o1; };
struct AttnCtx {
    LAS unsigned char* wl;
    const float* lut;
    const bf16_t* kg;
    const bf16_t* vg;
    unsigned koff[4], voff[4];
    int kfo[4], vfo[2][2];
};
DI void attn_dma(const AttnCtx& c, int kt) {
    const char* kb = (const char*)(c.kg + (size_t)(kt * 32) * RM_LD);
    const char* vb = (const char*)(c.vg + kt * 32);
#pragma unroll
    for (int j = 0; j < 4; ++j) __builtin_amdgcn_global_load_lds((const unsigned*)(kb + c.koff[j]), (LAS unsigned*)(c.wl + 8192 + j * 1024), 16, 0, 0);
#pragma unroll
    for (int j = 0; j < 4; ++j) __builtin_amdgcn_global_load_lds((const unsigned*)(vb + c.voff[j]), (LAS unsigned*)(c.wl + 12288 + j * 1024), 16, 0, 0);
}
template <int MODE, bool UNI>
DI void attn_compute(const bf16x8 (&qf)[4], const bf16x8 (&kf)[4], const bf16x8 (&vf)[2][2], int kt, int d00, const float* lut, float ubias, AttnSt& st,
                     unsigned W, int win, int dmask, bool lane_sel) {
    const int s0 = kt * 32;
    f32x16 sx;
#pragma unroll
    for (int i = 0; i < 16; ++i) sx[i] = 0.f;
#pragma unroll
    for (int ks = 0; ks < 4; ++ks) sx = MFMA32(kf[ks], qf[ks], sx);
    const int d0 = d00 - s0;
    float sv[16]; float mx = NEGF;
#pragma unroll
    for (int i = 0; i < 16; ++i) {
        const int ci = 16 * (i >> 3) + (i & 7);
        const int dist = d0 - ci;
        bool v;
        if (MODE == 0) v = ((W >> ci) & 1u) != 0u;
        else if (MODE == 1) v = ((unsigned)dist <= (unsigned)win) && ((dist & dmask) == 0);
        else if (MODE == 2) v = lane_sel;
        else v = dist >= 0;
        const float bias = UNI ? ubias : lut[dist & 2047];
        float s = fmaf(sx[i], SC2, bias);
        s = v ? s : NEGF;
        sv[i] = s; mx = fmaxf(mx, s);
    }
    mx = fmaxf(mx, __shfl_xor(mx, 32));
    const float mnew = fmaxf(st.m, mx);
    const float msafe = (mnew > -1e29f) ? mnew : 0.f;
    if (__ballot(mnew > st.m) != 0ull) {
        const float alpha = __builtin_amdgcn_exp2f(st.m - msafe);
        st.l *= alpha; st.m = mnew;
#pragma unroll
        for (int i = 0; i < 16; ++i) { st.o0[i] *= alpha; st.o1[i] *= alpha; }
    }
    float ps = 0.f; float p[16];
#pragma unroll
    for (int i = 0; i < 16; ++i) { const float e = __builtin_amdgcn_exp2f(sv[i] - msafe); p[i] = e; ps += e; }
    st.l += ps;
    u32x4 w0, w1;
    w0.x = pk2(p[0], p[1]); w0.y = pk2(p[2], p[3]); w0.z = pk2(p[4], p[5]); w0.w = pk2(p[6], p[7]);
    w1.x = pk2(p[8], p[9]); w1.y = pk2(p[10], p[11]); w1.z = pk2(p[12], p[13]); w1.w = pk2(p[14], p[15]);
    const bf16x8 pf0 = __builtin_bit_cast(bf16x8, w0), pf1 = __builtin_bit_cast(bf16x8, w1);
    st.o0 = MFMA32(vf[0][0], pf0, st.o0); st.o0 = MFMA32(vf[0][1], pf1, st.o0);
    st.o1 = MFMA32(vf[1][0], pf0, st.o1); st.o1 = MFMA32(vf[1][1], pf1, st.o1);
}
template <int MODE>
DI void attn_range(const AttnCtx& c, const bf16x8 (&qf)[4], int lo, int hi, int t0, int d00, AttnSt& st, const unsigned* maskrow, int h8, int win, int dmask, bool lane_sel) {
    if (lo > hi) return;
    attn_dma(c, lo);
    unsigned Wn = 0u;
    if (MODE == 0) Wn = maskrow[lo];
#pragma unroll 1
    for (int kt = lo; kt <= hi; ++kt) {
        asm volatile("s_waitcnt vmcnt(0)" ::: "memory");
        bf16x8 kf[4], vf[2][2];
#pragma unroll
        for (int ks = 0; ks < 4; ++ks) kf[ks] = *(const LAS bf16x8*)(c.wl + 8192 + c.kfo[ks]);
#pragma unroll
        for (int mt = 0; mt < 2; ++mt)
#pragma unroll
            for (int s = 0; s < 2; ++s) vf[mt][s] = *(const LAS bf16x8*)(c.wl + 12288 + c.vfo[mt][s]);
        const unsigned W = Wn >> h8;
        const int dlo = t0 - kt * 32 - 31;
        float ub = 0.f; bool uni = false;
        if (dlo >= 182) { const unsigned ua = __builtin_amdgcn_readfirstlane(__float_as_uint(c.lut[dlo])), ue = __builtin_amdgcn_readfirstlane(__float_as_uint(c.lut[dlo + 62])); uni = (ua == ue); ub = __uint_as_float(ua); }
        asm volatile("s_waitcnt lgkmcnt(0)" ::: "memory");
        if (kt < hi) { attn_dma(c, kt + 1); if (MODE == 0) Wn = maskrow[kt + 1]; }
        if (false) attn_compute<MODE, true>(qf, kf, vf, kt, d00, c.lut, ub, st, W, win, dmask, lane_sel);
        else attn_compute<MODE, false>(qf, kf, vf, kt, d00, c.lut, 0.f, st, W, win, dmask, lane_sel);
    }
}

DI void load_lut(float* lut, const float* glut, int col, int lane) {
    __builtin_amdgcn_fence(__ATOMIC_ACQ_REL, "wavefront");
#pragma unroll
    for (int k = 0; k < 8; ++k) *(f32x4*)(lut + k * 256 + lane * 4) = *(const f32x4*)(glut + (size_t)col * 2048 + k * 256 + lane * 4);
    __builtin_amdgcn_fence(__ATOMIC_ACQ_REL, "wavefront");
    __builtin_amdgcn_wave_barrier();
}

DI void attn_job(const Args& a, unsigned char* wsh, LAS unsigned char* wl, int type, int b, int qt, int hd, const int tid) {
    const int lane = tid & 63, r = lane & 31, h = lane >> 5;
    const bf16_t* prm = (const bf16_t*)(a.ws + WS_R1);
    const bf16_t* prt = prm + (size_t)MTOK * RM_LD;
    const float* glut = (const float*)(a.ws + WS_LUT);
    const unsigned* mask = (const unsigned*)(a.ws + WS_MASK);
    const float* kmean = (const float*)(a.ws + WS_KMEAN);
    bf16_t* oabc = (bf16_t*)(a.ws + WS_OABC);
    float* lut = (float*)wsh;
    const int t0 = qt * 32, tok0 = b * SEQ;
    const int d00 = t0 + r - 8 * h, h8 = 8 * h;
    const unsigned* maskrow = mask + (size_t)(tok0 + t0 + r) * 64;
    AttnCtx c; c.wl = wl; c.lut = lut;
#pragma unroll
    for (int j = 0; j < 4; ++j) {
        const int rk = 8 * j + (lane >> 3), ck = (lane & 7) ^ ((rk >> 1) & 7);
        c.koff[j] = (unsigned)(pi_row(rk) * RM_LD + ck * 8) * 2u;
        const int rv = 16 * j + (lane >> 2), cv = (lane & 3) ^ ((rv >> 2) & 3);
        c.voff[j] = (unsigned)(rv * MTOK + cv * 8) * 2u;
        c.kfo[j] = r * 128 + (((2 * j + h) ^ ((r >> 1) & 7)) * 16);
    }
#pragma unroll
    for (int mt = 0; mt < 2; ++mt)
#pragma unroll
        for (int s = 0; s < 2; ++s) c.vfo[mt][s] = (32 * mt + r) * 64 + (((2 * s + h) ^ ((r >> 2) & 3)) * 16);
    AttnSt st; st.m = NEGF; st.l = 0.f;
#pragma unroll
    for (int i = 0; i < 16; ++i) { st.o0[i] = 0.f; st.o1[i] = 0.f; }
    const int ng = (type == 1) ? 3 : 1;
    int ocol = 0;
    for (int g = 0; g < ng; ++g) {
        int qcol, kcol, vrow, bcol;
        if (type == 0) { qcol = C_AQ + hd * 64; kcol = C_AK; vrow = R_AV; bcol = hd; ocol = hd * 64; }
        else if (type == 1) { qcol = C_BQ + (g * 4 + hd) * 64; kcol = C_BK + hd * 64; vrow = R_BV + hd * 64; bcol = 6 + g * 4 + hd; ocol = 384 + hd * 64; }
        else { qcol = C_CQ + hd * 64; kcol = C_CK + hd * 64; vrow = R_CV + hd * 64; bcol = 18 + hd; ocol = 640 + hd * 64; }
        load_lut(lut, glut, bcol, lane);
        bf16x8 qf[4];
        const bf16_t* qp = prm + (size_t)(tok0 + t0 + r) * RM_LD + qcol + 8 * h;
#pragma unroll
        for (int ks = 0; ks < 4; ++ks) qf[ks] = *(const bf16x8*)(qp + 16 * ks);
        c.kg = prm + (size_t)tok0 * RM_LD + kcol;
        c.vg = prt + (size_t)vrow * MTOK + tok0;
        if (type == 0) {
            attn_range<0>(c, qf, 0, qt, t0, d00, st, maskrow, h8, 0, 0, false);
        } else if (type == 1) {
            const int win = (g == 0) ? 128 : (g == 1 ? 512 : 2048), dmask = (g == 0) ? 0 : (g == 1 ? 3 : 15);
            int lo = t0 - win; if (lo < 0) lo = 0;
            attn_range<1>(c, qf, lo >> 5, qt, t0, d00, st, maskrow, h8, win, dmask, false);
        } else {
            const int cur = qt >> 3;
            float gate[7];
            const float* km = kmean + (size_t)((b * 6 + hd) * 8) * 64 + 8 * h;
#pragma unroll
            for (int n = 0; n < 7; ++n) {
                float s = 0.f;
                if (n < cur) {
#pragma unroll
                    for (int ks = 0; ks < 4; ++ks) {
                        const f32x4 k0 = *(const f32x4*)(km + n * 64 + 16 * ks), k1 = *(const f32x4*)(km + n * 64 + 16 * ks + 4);
                        const u32x4 qw = __builtin_bit_cast(u32x4, qf[ks]);
                        s += bf_lo(qw.x) * k0[0] + bf_hi(qw.x) * k0[1] + bf_lo(qw.y) * k0[2] + bf_hi(qw.y) * k0[3]
                           + bf_lo(qw.z) * k1[0] + bf_hi(qw.z) * k1[1] + bf_lo(qw.w) * k1[2] + bf_hi(qw.w) * k1[3];
                    }
                    s += __shfl_xor(s, 32);
                } else s = -__builtin_inff();
                gate[n] = s;
            }
            unsigned sel = 0u;
#pragma unroll
            for (int rd = 0; rd < 3; ++rd) {
                float bv = -__builtin_inff(); int bi = -1;
#pragma unroll
                for (int n = 0; n < 7; ++n) if (gate[n] > bv) { bv = gate[n]; bi = n; }
                if (bi >= 0) sel |= 1u << bi;
#pragma unroll
                for (int n = 0; n < 7; ++n) if (n == bi) gate[n] = -__builtin_inff();
            }
            for (int n = 0; n < cur; ++n) {
                const bool ls = ((sel >> n) & 1u) != 0u;
                if (__ballot(ls) == 0ull) continue;
                attn_range<2>(c, qf, n * 8, n * 8 + 7, t0, d00, st, maskrow, h8, 0, 0, ls);
            }
            attn_range<3>(c, qf, cur * 8, qt, t0, d00, st, maskrow, h8, 0, 0, false);
        }
    }
    const float lt = st.l + __shfl_xor(st.l, 32);
    const float inv = 1.0f / lt;
    bf16_t* op = oabc + (size_t)(tok0 + t0 + r) * 1024 + ocol + 4 * h;
#pragma unroll
    for (int g4 = 0; g4 < 4; ++g4) {
        u32x2 w;
        w.x = pk2(st.o0[4 * g4] * inv, st.o0[4 * g4 + 1] * inv); w.y = pk2(st.o0[4 * g4 + 2] * inv, st.o0[4 * g4 + 3] * inv);
        *(u32x2*)(op + 8 * g4) = w;
        w.x = pk2(st.o1[4 * g4] * inv, st.o1[4 * g4 + 1] * inv); w.y = pk2(st.o1[4 * g4 + 2] * inv, st.o1[4 * g4 + 3] * inv);
        *(u32x2*)(op + 32 + 8 * g4) = w;
    }
}
DI void phase_attn(const Args& a, unsigned char* shm, const int tid) {
    const int wid = __builtin_amdgcn_readfirstlane(tid >> 6);
    unsigned char* wsh = shm + wid * 16384;
    LAS unsigned char* wl = (LAS unsigned char*)shm + wid * 16384;
    for (int it = 0;; ++it) {
        int b, qt; if (!task_map(it, b, qt)) break;
        const int role = (wid + it) & 7;
        if (role < 6) { attn_job(a, wsh, wl, 0, b, qt, role, tid); attn_job(a, wsh, wl, 2, b, qt, role, tid); }
        else { attn_job(a, wsh, wl, 1, b, qt, role - 6, tid); attn_job(a, wsh, wl, 1, b, qt, role - 4, tid); }
    }
}

__global__ void __launch_bounds__(512, 2) mega_fwd(Args a_) {
    extern __shared__ __attribute__((aligned(16))) unsigned char shm[];
    cg::grid_group grid = cg::this_grid();
    LAS unsigned char* lds = (LAS unsigned char*)shm;
    const int G = gridDim.x, c = blockIdx.x;
#ifndef PROBE_REP
#define PROBE_REP -2
#endif
    const int ph_lo = a_.ph_lo, ph_hi = a_.ph_hi;
    const int wave_id = __builtin_amdgcn_readfirstlane(threadIdx.x >> 6);
    for (int phx = 2 * ph_lo; phx < 2 * ph_hi; ++phx) {
        const int ph = phx >> 1;
        if (phx & 1) { const bool rep = (PROBE_REP == -1) ? (ph == 0) : (ph > 0 && (ph - 1) % 9 == PROBE_REP); if (!rep) continue; }
        const Args& a = a_;
        int tid = wave_id * 64 + (int)__builtin_amdgcn_mbcnt_hi(~0u, __builtin_amdgcn_mbcnt_lo(~0u, 0u)); asm volatile("" : "+v"(tid));
        bf16_t* xb = (bf16_t*)(a.ws + WS_XB);
        bf16_t* r1 = (bf16_t*)(a.ws + WS_R1);
        bf16_t* oabc = (bf16_t*)(a.ws + WS_OABC);
        if (ph == 0) phase_convert(a, shm, tid);
        else {
            const int l = (ph - 1) / 9, sp = (ph - 1) % 9;
            const bf16_t* w = (const bf16_t*)(a.ws + WS_WB) + (size_t)l * W_LAYER;
            const float* xin = (l == 0) ? a.in[0] : a.out;
            if (sp == 0) {
                { pg8::Gemm g{xb, w + WO_IN, 1024, 1024, 1024}; pg8::StaticOrder S; S.init(256, 11, G, c); pg8::EpiBf16<0> E{r1, RM_LD}; pg8::gemm_phase(lds, g, S, E, tid); }
                { pg8::Gemm g{w + WO_IN + (size_t)RM_LD * 1024, xb, 1024, 1024, 1024}; pg8::StaticOrder S; S.init(3, 256, G, c); pg8::EpiBf16<0> E{r1 + (size_t)MTOK * RM_LD, MTOK}; pg8::gemm_phase(lds, g, S, E, tid); }
            } else if (sp == 1) phase_a1(a, shm, tid);
            else if (sp == 2) phase_attn(a, shm, tid);
            else if (sp == 3) {
                pg8::StaticOrder S; S.init(256, 4, G, c);
                { pg8::Gemm g{oabc, w + WO_BA, 1024, 384, 384}; pg8::EpiBf16<0> E{r1, 3072}; pg8::gemm_phase(lds, g, S, E, tid); }
                { pg8::Gemm g{oabc + 384, w + WO_BB, 1024, 256, 256}; pg8::EpiBf16<0> E{r1 + 1024, 3072}; pg8::gemm_phase(lds, g, S, E, tid); }
                { pg8::Gemm g{oabc + 640, w + WO_BC, 1024, 384, 384}; pg8::EpiBf16<0> E{r1 + 2048, 3072}; pg8::gemm_phase(lds, g, S, E, tid); }
                { pg8::Gemm g{xb, w + WO_G, 1024, 1024, 1024}; pg8::Order3 S3; S3.base = S; pg8::EpiGate E{r1, r1 + (size_t)MTOK * 3072}; pg8::gemm_phase(lds, g, S3, E, tid); }
            } else if (sp == 4) {
                pg8::Gemm g{r1 + (size_t)MTOK * 3072, w + WO_OUT, 1024, 1024, 1024}; pg8::StaticOrder S; S.init(256, 4, G, c);
                pg8::EpiRes<false> E{xin, a.out, nullptr}; pg8::gemm_phase(lds, g, S, E, tid);
            } else if (sp == 5) phase_ln(a.out, xb, a.in[8] + l * 1024, a.in[9] + l * 1024, tid);
            else if (sp == 6) {
                { pg8::Gemm g{xb, w + WO_UP, 1024, 1024, 1024}; pg8::StaticOrder S; S.init(256, 16, G, c); pg8::EpiBf16<1> E{r1, 4096}; pg8::gemm_phase(lds, g, S, E, tid); }
                pg8::StaticOrder S; S.init(256, 4, G, c);
                { pg8::Gemm g{(const bf16_t*)(a.ws + WS_PB) + (size_t)l * MTOK * 256, w + WO_PL, 256, 256, 256}; pg8::EpiBf16<0> E{oabc, 1024}; pg8::gemm_phase(lds, g, S, E, tid); }
                { pg8::Gemm g{xb, w + WO_PG, 1024, 1024, 1024}; pg8::EpiT1 E{oabc}; pg8::gemm_phase(lds, g, S, E, tid); }
            } else if (sp == 7) {
                pg8::Gemm g{r1, w + WO_DN, 4096, 4096, 4096}; pg8::StaticOrder S; S.init(256, 4, G, c);
                pg8::EpiRes<true> E{a.out, a.out, oabc}; pg8::gemm_phase(lds, g, S, E, tid);
            } else phase_ln(a.out, xb, a.in[14] + l * 1024, a.in[15] + l * 1024, tid);
        }
        if (phx + 1 < 2 * ph_hi) grid.sync();
    }
}

#ifndef N_LAUNCH_MODE
#define N_LAUNCH_MODE 1
#endif
extern "C" void kernel_launch(void* const* d_in, const int* in_sizes, int n_in, void* d_out, int out_size, void* d_ws, size_t ws_size, hipStream_t stream) {
    static int grid = 0;
    if (grid == 0) {
        if (n_in != 17 || out_size != MTOK * DM || ws_size < WS_END) { fprintf(stderr, "kernel_launch: unexpected shapes (n_in %d out %d ws %zu need %zu)\n", n_in, out_size, ws_size, (size_t)WS_END); grid = -1; return; }
        int dev = 0, cus = 0, per_cu = 0;
        hipGetDevice(&dev);
        hipDeviceGetAttribute(&cus, hipDeviceAttributeMultiprocessorCount, dev);
        if (hipFuncSetAttribute((const void*)mega_fwd, hipFuncAttributeMaxDynamicSharedMemorySize, LDS_BYTES) != hipSuccess) { fprintf(stderr, "kernel_launch: hipFuncSetAttribute failed\n"); grid = -1; return; }
        hipOccupancyMaxActiveBlocksPerMultiprocessor(&per_cu, (const void*)mega_fwd, 512, LDS_BYTES);
        if (per_cu < 1) { fprintf(stderr, "kernel_launch: occupancy query says %d\n", per_cu); per_cu = 1; }
        (void)hipGetLastError();
        grid = cus * per_cu;
    }
    if (grid < 0) return;
    Args a{};
    for (int i = 0; i < 17; ++i) a.in[i] = (const float*)d_in[i];
    a.out = (float*)d_out; a.ws = (unsigned char*)d_ws;
#if N_LAUNCH_MODE == 0
    for (int ph = 0; ph < 19; ++ph) {
        a.ph_lo = ph; a.ph_hi = ph + 1;
        hipLaunchKernelGGL(mega_fwd, dim3(grid), dim3(512), LDS_BYTES, stream, a);
    }
#else
    a.ph_lo = 0; a.ph_hi = 19;
    void* args[] = {&a};
    hipError_t e = hipLaunchCooperativeKernel((const void*)mega_fwd, dim3(grid), dim3(512), args, LDS_BYTES, stream);
    if (e != hipSuccess) fprintf(stderr, "cooperative launch failed: %s (grid %d)\n", hipGetErrorString(e), grid);
#endif
}
```

```cpp
#include <hip/hip_runtime.h>
#include <hip/hip_cooperative_groups.h>
#include <cstdio>
namespace cg = cooperative_groups;

#define LAS __attribute__((address_space(3)))
#define DI __device__ __forceinline__
typedef unsigned short bf16_t;
typedef short bf16x8 __attribute__((ext_vector_type(8)));
typedef float f32x2 __attribute__((ext_vector_type(2)));
typedef float f32x4 __attribute__((ext_vector_type(4)));
typedef float f32x16 __attribute__((ext_vector_type(16)));
typedef unsigned u32x2 __attribute__((ext_vector_type(2)));
typedef unsigned u32x4 __attribute__((ext_vector_type(4)));
typedef __bf16 bf2_t __attribute__((ext_vector_type(2)));

constexpr int MTOK = 65536, SEQ = 2048, DM = 1024, NB = 32, DFF = 4096, PLE = 256;
constexpr int RM_LD = 2816;
constexpr int C_AQ = 0, C_AK = 384, C_IQ = 448, C_IK = 960, C_BQ = 1024, C_BK = 1792, C_CQ = 2048, C_CK = 2432;
constexpr int T_ROWS = 768;
constexpr int R_AV = 0, R_BV = 64, R_CV = 320, R_IW = 704;
constexpr int NWIN = 3584;
constexpr float ALPHA = 1.41421356237309515f;
constexpr float LOG2E = 1.44269504088896341f;
constexpr float SC2 = 0.125f * LOG2E;
constexpr float NEGF = -1e30f;
constexpr int LDS_BYTES = 131072 + 16;

constexpr size_t WO_IN = 0;
constexpr size_t WO_G = WO_IN + (size_t)NWIN * 1024;
constexpr size_t WO_BA = WO_G + (size_t)3072 * 1024;
constexpr size_t WO_BB = WO_BA + (size_t)1024 * 384;
constexpr size_t WO_BC = WO_BB + (size_t)1024 * 256;
constexpr size_t WO_OUT = WO_BC + (size_t)1024 * 384;
constexpr size_t WO_UP = WO_OUT + (size_t)1024 * 1024;
constexpr size_t WO_DN = WO_UP + (size_t)4096 * 1024;
constexpr size_t WO_PG = WO_DN + (size_t)1024 * 4096;
constexpr size_t WO_PL = WO_PG + (size_t)1024 * 1024;
constexpr size_t W_LAYER = WO_PL + (size_t)1024 * 256;

constexpr size_t WS_WB = 0;
constexpr size_t WS_LUT = WS_WB + 2 * W_LAYER * 2;
constexpr size_t WS_KMEAN = WS_LUT + (size_t)24 * 2048 * 4;
constexpr size_t WS_MASK = WS_KMEAN + (size_t)32 * 6 * 8 * 64 * 4;
constexpr size_t WS_XB = WS_MASK + (size_t)MTOK * 64 * 4;
constexpr size_t WS_PB = WS_XB + (size_t)MTOK * 1024 * 2;
constexpr size_t WS_OABC = WS_PB + (size_t)2 * MTOK * 256 * 2;
constexpr size_t WS_R1 = WS_OABC + (size_t)MTOK * 1024 * 2;
constexpr size_t WS_BAR = WS_R1 + (size_t)MTOK * 4096 * 2;
constexpr size_t WS_END = WS_BAR + (size_t)3456 * 4;

struct Args {
    const float* in[17];
    float* out;
    unsigned char* ws;
    int ph_lo, ph_hi;
};

DI unsigned short f2bf(float f) { unsigned u = __float_as_uint(f); u += 0x7FFFu + ((u >> 16) & 1u); return (unsigned short)(u >> 16); }
DI unsigned pk2(float lo, float hi) { f32x2 v = {lo, hi}; bf2_t b = __builtin_convertvector(v, bf2_t); return __builtin_bit_cast(unsigned, b); }
DI float bf_lo(unsigned w) { return __uint_as_float(w << 16); }
DI float bf_hi(unsigned w) { return __uint_as_float(w & 0xFFFF0000u); }
DI float bf2f(bf16_t b) { return __uint_as_float(((unsigned)b) << 16); }
DI float sigmoidf_(float x) { return __builtin_amdgcn_rcpf(1.0f + __expf(-x)); }
#define MFMA32(a, b, c) __builtin_amdgcn_mfma_f32_32x32x16_bf16((a), (b), (c), 0, 0, 0)

namespace pg8 {
constexpr int BM = 256, BK = 64, HALF = 128, HTB = HALF * BK * 2, NXCD = 8, WGM = 8;
DI int lds_byte(int r, int c) { const int st = (r >> 4) * 2 + (c >> 5), rr = r & 15, cc = c & 31, ob = rr * 64 + cc * 2; return st * 1024 + (ob ^ (((ob >> 9) & 1) << 5)); }
DI void stage_rc(int b, int& R, int& C) { const int st = b / 1024, sb = b % 1024, swz = sb ^ (((sb >> 9) & 1) << 5); R = (st >> 1) * 16 + swz / 64; C = (st & 1) * 32 + (swz % 64) / 2; }
DI int perm32(int rho) { const int n = rho >> 4, i = rho & 15; return 8 * (i >> 2) + 4 * n + (i & 3); }

struct Unit { int pm, pn; };
struct Gemm { const bf16_t* A; const bf16_t* Bt; int lda, ldb, K; };

struct StaticOrder {
    int nM, nN, nwg, G, c;
    DI void init(int nM_, int nN_, int G_, int c_) { nM = nM_; nN = nN_; nwg = nM * nN; G = G_; c = c_; }
    DI bool next(int i, Unit& u) const {
        const long L = (long)i * G + c; if (L >= nwg) return false;
        int wgid = (int)L; { const int q = nwg / NXCD, r = nwg % NXCD, xcd = wgid % NXCD, off = wgid / NXCD; wgid = (xcd < r ? xcd * (q + 1) : r * (q + 1) + (xcd - r) * q) + off; }
        const int nig = WGM * nN, gid = wgid / nig, fm = gid * WGM, gsz = (nM - fm) < WGM ? (nM - fm) : WGM;
        u.pm = fm + ((wgid % nig) % gsz); u.pn = (wgid % nig) / gsz; return true;
    }
};
struct Order3 {
    StaticOrder base;
    DI bool next(int i, Unit& u) const { Unit v; if (!base.next(i / 3, v)) return false; u.pm = v.pm; u.pn = (i % 3) * 4 + v.pn; return true; }
};

template <int ACT  > struct EpiBf16 {
    static constexpr bool PERM = true;
    bf16_t* O; int ldc;
    DI void operator()(const f32x4 (&acc)[2][2][4][2], const Unit& u, int wr, int wc, int fr, int fq) const {
        const int row0 = u.pm * BM + wr * 64 + fr, col0 = u.pn * BM + wc * 32 + 8 * fq;
#pragma unroll
        for (int ai = 0; ai < 2; ++ai)
#pragma unroll
            for (int m = 0; m < 4; ++m) { bf16_t* rowp = O + (size_t)(row0 + ai * HALF + m * 16) * ldc + col0;
#pragma unroll
                for (int bj = 0; bj < 2; ++bj) { f32x4 v0 = acc[ai][bj][m][0], v1 = acc[ai][bj][m][1];
                    if (ACT == 1) {
#pragma unroll
                        for (int j = 0; j < 4; ++j) { float a = fmaxf(v0[j], 0.f), b = fmaxf(v1[j], 0.f); v0[j] = a * a; v1[j] = b * b; } }
                    u32x4 w; w.x = pk2(v0[0], v0[1]); w.y = pk2(v0[2], v0[3]); w.z = pk2(v1[0], v1[1]); w.w = pk2(v1[2], v1[3]);
                    *(u32x4*)(rowp + bj * HALF) = w; } }
    }
};
struct EpiGate {
    static constexpr bool PERM = true;
    const bf16_t* obr; bf16_t* mg;
    DI void operator()(const f32x4 (&acc)[2][2][4][2], const Unit& u, int wr, int wc, int fr, int fq) const {
        const int b = u.pn >> 2, colt = (u.pn & 3) * BM;
        const int row0 = u.pm * BM + wr * 64 + fr, col0 = colt + wc * 32 + 8 * fq;
#pragma unroll
        for (int ai = 0; ai < 2; ++ai)
#pragma unroll
            for (int m = 0; m < 4; ++m) { const size_t row = (size_t)(row0 + ai * HALF + m * 16);
#pragma unroll
                for (int bj = 0; bj < 2; ++bj) { const f32x4 v0 = acc[ai][bj][m][0], v1 = acc[ai][bj][m][1];
                    const u32x4 ob = *(const u32x4*)(obr + row * 3072 + b * 1024 + col0 + bj * HALF);
                    bf16_t* mp = mg + row * 1024 + col0 + bj * HALF;
                    float r[8];
                    r[0] = sigmoidf_(v0[0]) * bf_lo(ob.x); r[1] = sigmoidf_(v0[1]) * bf_hi(ob.x); r[2] = sigmoidf_(v0[2]) * bf_lo(ob.y); r[3] = sigmoidf_(v0[3]) * bf_hi(ob.y);
                    r[4] = sigmoidf_(v1[0]) * bf_lo(ob.z); r[5] = sigmoidf_(v1[1]) * bf_hi(ob.z); r[6] = sigmoidf_(v1[2]) * bf_lo(ob.w); r[7] = sigmoidf_(v1[3]) * bf_hi(ob.w);
                    if (b > 0) { const u32x4 pm_ = *(const u32x4*)mp;
                        r[0] += bf_lo(pm_.x); r[1] += bf_hi(pm_.x); r[2] += bf_lo(pm_.y); r[3] += bf_hi(pm_.y); r[4] += bf_lo(pm_.z); r[5] += bf_hi(pm_.z); r[6] += bf_lo(pm_.w); r[7] += bf_hi(pm_.w); }
                    u32x4 w; w.x = pk2(r[0], r[1]); w.y = pk2(r[2], r[3]); w.z = pk2(r[4], r[5]); w.w = pk2(r[6], r[7]);
                    *(u32x4*)mp = w; } }
    }
};
struct EpiT1 {
    static constexpr bool PERM = true;
    bf16_t* T;
    DI void operator()(const f32x4 (&acc)[2][2][4][2], const Unit& u, int wr, int wc, int fr, int fq) const {
        const int row0 = u.pm * BM + wr * 64 + fr, col0 = u.pn * BM + wc * 32 + 8 * fq;
#pragma unroll
        for (int ai = 0; ai < 2; ++ai)
#pragma unroll
            for (int m = 0; m < 4; ++m) { const size_t row = (size_t)(row0 + ai * HALF + m * 16);
#pragma unroll
                for (int bj = 0; bj < 2; ++bj) { const f32x4 v0 = acc[ai][bj][m][0], v1 = acc[ai][bj][m][1];
                    bf16_t* tp = T + row * 1024 + col0 + bj * HALF;
                    const u32x4 ob = *(const u32x4*)tp;
                    float r[8];
                    r[0] = sigmoidf_(v0[0]) * bf_lo(ob.x); r[1] = sigmoidf_(v0[1]) * bf_hi(ob.x); r[2] = sigmoidf_(v0[2]) * bf_lo(ob.y); r[3] = sigmoidf_(v0[3]) * bf_hi(ob.y);
                    r[4] = sigmoidf_(v1[0]) * bf_lo(ob.z); r[5] = sigmoidf_(v1[1]) * bf_hi(ob.z); r[6] = sigmoidf_(v1[2]) * bf_lo(ob.w); r[7] = sigmoidf_(v1[3]) * bf_hi(ob.w);
                    u32x4 w; w.x = pk2(r[0], r[1]); w.y = pk2(r[2], r[3]); w.z = pk2(r[4], r[5]); w.w = pk2(r[6], r[7]);
                    *(u32x4*)tp = w; } }
    }
};
template <bool HAS_T> struct EpiRes {
    static constexpr bool PERM = false;
    const float* xin; float* y; const bf16_t* T;
    DI void operator()(const f32x4 (&acc)[2][2][4][2], const Unit& u, int wr, int wc, int fr, int fq) const {
        const int row0 = u.pm * BM + wr * 64 + fr, col0 = u.pn * BM + wc * 32 + 4 * fq;
#pragma unroll
        for (int ai = 0; ai < 2; ++ai)
#pragma unroll
            for (int m = 0; m < 4; ++m) { const size_t ro = (size_t)(row0 + ai * HALF + m * 16) * 1024 + col0;
#pragma unroll
                for (int bj = 0; bj < 2; ++bj)
#pragma unroll
                    for (int n = 0; n < 2; ++n) { const size_t o = ro + bj * HALF + n * 16;
                        const f32x4 xv = *(const f32x4*)(xin + o); f32x4 r = acc[ai][bj][m][n] + xv * ALPHA;
                        if (HAS_T) { const u32x2 tv = *(const u32x2*)(T + o); r[0] += bf_lo(tv.x); r[1] += bf_hi(tv.x); r[2] += bf_lo(tv.y); r[3] += bf_hi(tv.y); }
                        *(f32x4*)(y + o) = r; } }
    }
};

template <class Epi, class Sched>
DI void gemm_phase(LAS unsigned char* lds, const Gemm g, const Sched& S, const Epi& E, const int tid) {
    const int wid = __builtin_amdgcn_readfirstlane(tid >> 6), lane = tid & 63, wr = wid >> 2, wc = wid & 3, fr = lane & 15, fq = lane >> 4;
    const int K = g.K, nt = K / BK;
    unsigned voffA_, voffB_;
    { int R, C; stage_rc(tid * 16, R, C); const int Rb = Epi::PERM ? ((R & ~31) + perm32(R & 31)) : R;
      voffA_ = (unsigned)(R * g.lda + C) * 2u; voffB_ = (unsigned)(Rb * g.ldb + C) * 2u; }
    const size_t p64offA = (size_t)64 * g.lda * 2, p64offB = (size_t)64 * g.ldb * 2;
    const size_t kstep = (size_t)(BK * 2);
    const size_t hstepA = (size_t)HALF * g.lda * 2, hstepB = (size_t)HALF * g.ldb * 2;
    const size_t tstepA = 2 * hstepA, tstepB = 2 * hstepB;
    const unsigned ldsw = (unsigned)wid * 1024u;
    const int aoff = lds_byte(wr * 64 + fr, fq * 8), boff = lds_byte(wc * 32 + fr, fq * 8);
#define PG8_SA(b, h) (((b) * 2 + (h)) * HTB)
#define PG8_SB(b, h) ((4 + (b) * 2 + (h)) * HTB)
#define PG8_STAGE(bufoff, gbase, voff) do { _Pragma("unroll") for (int _i = 0; _i < 2; ++_i) \
        __builtin_amdgcn_global_load_lds((const unsigned*)((const char*)(gbase) + (size_t)_i * p64##voff + (v##voff##_)), (LAS unsigned*)(lds + (bufoff) + ldsw + _i * 8192), 16, 0, 0); } while (0)
#define PG8_LDA(dst, b, h) do { _Pragma("unroll") for (int m = 0; m < 4; ++m) _Pragma("unroll") for (int k = 0; k < 2; ++k) dst[m][k] = *(const LAS bf16x8*)(lds + PG8_SA(b, h) + aoff + m * 2048 + k * 1024); } while (0)
#define PG8_LDB(dst, b, h) do { _Pragma("unroll") for (int n = 0; n < 2; ++n) _Pragma("unroll") for (int k = 0; k < 2; ++k) dst[n][k] = *(const LAS bf16x8*)(lds + PG8_SB(b, h) + boff + n * 2048 + k * 1024); } while (0)
#define PG8_MMA(ai, bj, At, Bt) do { __builtin_amdgcn_s_setprio(1); _Pragma("unroll") for (int m = 0; m < 4; ++m) _Pragma("unroll") for (int n = 0; n < 2; ++n) _Pragma("unroll") for (int k = 0; k < 2; ++k) \
        acc[ai][bj][m][n] = __builtin_amdgcn_mfma_f32_16x16x32_bf16(Bt[n][k], At[m][k], acc[ai][bj][m][n], 0, 0, 0); __builtin_amdgcn_s_setprio(0); } while (0)
#define PG8_WAIT_V(n) asm volatile("s_waitcnt vmcnt(" #n ")" ::: "memory")
#define PG8_WAIT_L(n) asm volatile("s_waitcnt lgkmcnt(" #n ")" ::: "memory")
#define PG8_BAR __builtin_amdgcn_s_barrier()
#define PG8_SCHED __builtin_amdgcn_sched_barrier(0)
    Unit cur, nxt; int ui = 0;
    if (!S.next(0, cur)) return;
    f32x4 acc[2][2][4][2];
#pragma unroll
    for (int a = 0; a < 2; ++a)
#pragma unroll
        for (int b = 0; b < 2; ++b)
#pragma unroll
            for (int m = 0; m < 4; ++m)
#pragma unroll
                for (int n = 0; n < 2; ++n) acc[a][b][m][n] = (f32x4){0.f, 0.f, 0.f, 0.f};
    bf16x8 At[4][2], B0[2][2], B1[2][2];
    const char* cA = (const char*)g.A + (size_t)cur.pm * tstepA; const char* cB = (const char*)g.Bt + (size_t)cur.pn * tstepB;
    PG8_STAGE(PG8_SB(0, 0), cB, offB); PG8_STAGE(PG8_SA(0, 0), cA, offA); PG8_STAGE(PG8_SB(0, 1), cB + hstepB, offB); PG8_STAGE(PG8_SA(0, 1), cA + hstepA, offA);
    if (wr == 1) PG8_BAR;
    PG8_WAIT_V(4); PG8_BAR;
    PG8_STAGE(PG8_SB(1, 0), cB + kstep, offB); PG8_STAGE(PG8_SA(1, 0), cA + kstep, offA); PG8_STAGE(PG8_SB(1, 1), cB + hstepB + kstep, offB);
    PG8_WAIT_V(6); PG8_BAR;
    for (;;) {
        const bool has_next = S.next(ui + 1, nxt);
        const char* nA = has_next ? (const char*)g.A + (size_t)nxt.pm * tstepA : cA; const char* nB = has_next ? (const char*)g.Bt + (size_t)nxt.pn * tstepB : cB;
        for (int t = 0; t < nt; t += 2) {
            const bool last = (t == nt - 2);
            const char* a1 = cA + (size_t)(t + 1) * kstep;
            const char* a2 = last ? nA : cA + (size_t)(t + 2) * kstep; const char* b2 = last ? nB : cB + (size_t)(t + 2) * kstep;
            const char* a3 = a2 + kstep; const char* b3 = b2 + kstep;
            PG8_LDB(B0, 0, 0); PG8_SCHED; PG8_LDA(At, 0, 0); PG8_STAGE(PG8_SA(1, 1), a1 + hstepA, offA);
            PG8_WAIT_L(8); PG8_BAR; PG8_WAIT_L(0); PG8_MMA(0, 0, At, B0); PG8_BAR; PG8_SCHED;
            PG8_LDB(B1, 0, 1); PG8_STAGE(PG8_SB(0, 0), b2, offB);
            PG8_BAR; PG8_WAIT_L(0); PG8_MMA(0, 1, At, B1); PG8_BAR;
            PG8_LDA(At, 0, 1); PG8_STAGE(PG8_SA(0, 0), a2, offA);
            PG8_BAR; PG8_WAIT_L(0); PG8_MMA(1, 0, At, B0); PG8_BAR; PG8_SCHED;
            PG8_STAGE(PG8_SB(0, 1), b2 + hstepB, offB);
            PG8_WAIT_V(6); PG8_BAR; PG8_MMA(1, 1, At, B1); PG8_BAR;
            PG8_LDB(B0, 1, 0); PG8_SCHED; PG8_LDA(At, 1, 0); PG8_STAGE(PG8_SA(0, 1), a2 + hstepA, offA);
            PG8_WAIT_L(8); PG8_BAR; PG8_WAIT_L(0); PG8_MMA(0, 0, At, B0); PG8_BAR; PG8_SCHED;
            PG8_LDB(B1, 1, 1); PG8_STAGE(PG8_SB(1, 0), b3, offB);
            PG8_BAR; PG8_WAIT_L(0); PG8_MMA(0, 1, At, B1); PG8_BAR;
            PG8_LDA(At, 1, 1); PG8_STAGE(PG8_SA(1, 0), a3, offA);
            PG8_BAR; PG8_WAIT_L(0); PG8_MMA(1, 0, At, B0); PG8_BAR; PG8_SCHED;
            PG8_STAGE(PG8_SB(1, 1), b3 + hstepB, offB);
            PG8_WAIT_V(6); PG8_BAR; PG8_MMA(1, 1, At, B1); PG8_BAR;
        }
        E(acc, cur, wr, wc, fr, fq);
        if (!has_next) break;
#pragma unroll
        for (int a = 0; a < 2; ++a)
#pragma unroll
            for (int b = 0; b < 2; ++b)
#pragma unroll
                for (int m = 0; m < 4; ++m)
#pragma unroll
                    for (int n = 0; n < 2; ++n) acc[a][b][m][n] = (f32x4){0.f, 0.f, 0.f, 0.f};
        cur = nxt; cA = nA; cB = nB; ++ui;
    }
    PG8_WAIT_V(0);
    if (wr == 0) PG8_BAR;
    PG8_BAR;
#undef PG8_SA
#undef PG8_SB
#undef PG8_STAGE
#undef PG8_LDA
#undef PG8_LDB
#undef PG8_MMA
#undef PG8_WAIT_V
#undef PG8_WAIT_L
#undef PG8_BAR
#undef PG8_SCHED
}
}

DI int win_srccol(int n) {
    if (n < 384) return n;
    if (n < 448) return 384 + (n - 384);
    if (n < 960) return 512 + (n - 448);
    if (n < 1024) return 1024 + (n - 960);
    if (n < 1792) return 1096 + (n - 1024);
    if (n < 2048) return 1864 + (n - 1792);
    if (n < 2432) return 2376 + (n - 2048);
    if (n < 2816) return 2760 + (n - 2432);
    if (n < 2880) return 448 + (n - 2816);
    if (n < 3136) return 2120 + (n - 2880);
    if (n < 3520) return 3144 + (n - 3136);
    if (n < 3528) return 1088 + (n - 3520);
    return -1;
}
DI void convT(unsigned char* shm, const float* src, int K, int Nsrc, bf16_t* dst, int Ndst, int mode, const int tid) {
    unsigned short* tl = (unsigned short*)shm;
    const int ntk = K / 64, ntiles = (Ndst / 64) * ntk;
    for (int tile = blockIdx.x; tile < ntiles; tile += gridDim.x) {
        const int n0 = (tile / ntk) * 64, k0 = (tile % ntk) * 64;
        const int nx = tid & 63, ky = tid >> 6;
        const int sc = mode ? win_srccol(n0 + nx) : (n0 + nx);
#pragma unroll
        for (int p = 0; p < 8; ++p) { const int k = k0 + ky + 8 * p; const float v = sc >= 0 ? src[(size_t)k * Nsrc + sc] : 0.f; tl[nx * 66 + ky + 8 * p] = f2bf(v); }
        __syncthreads();
#pragma unroll
        for (int p = 0; p < 8; ++p) { const int n = ky + 8 * p; dst[(size_t)(n0 + n) * K + k0 + nx] = tl[n * 66 + nx]; }
        __syncthreads();
    }
}
DI void conv_vec(const float* src, bf16_t* dst, size_t n8, const int tid) {
    for (size_t i = (size_t)blockIdx.x * 512 + tid; i < n8; i += (size_t)gridDim.x * 512) {
        const f32x4 a = *(const f32x4*)(src + i * 8), b = *(const f32x4*)(src + i * 8 + 4);
        u32x4 w; w.x = pk2(a[0], a[1]); w.y = pk2(a[2], a[3]); w.z = pk2(b[0], b[1]); w.w = pk2(b[2], b[3]);
        *(u32x4*)(dst + i * 8) = w;
    }
}
DI int rel_bucket(int n) {
    if (n < 16) return n;
    int large = 16 + (int)(logf((float)n / 16.0f) / 4.852030263919617f * 16.0f);
    return large < 31 ? large : 31;
}
DI void phase_convert(const Args& a, unsigned char* shm, const int tid) {
    bf16_t* wb = (bf16_t*)(a.ws + WS_WB);
    for (int l = 0; l < 2; ++l) {
        bf16_t* w = wb + (size_t)l * W_LAYER;
        convT(shm, a.in[2] + (size_t)l * 1024 * 3528, 1024, 3528, w + WO_IN, NWIN, 1, tid);
        convT(shm, a.in[3] + (size_t)l * 1024 * 3072, 1024, 3072, w + WO_G, 3072, 0, tid);
        convT(shm, a.in[4] + (size_t)l * 384 * 1024, 384, 1024, w + WO_BA, 1024, 0, tid);
        convT(shm, a.in[5] + (size_t)l * 256 * 1024, 256, 1024, w + WO_BB, 1024, 0, tid);
        convT(shm, a.in[6] + (size_t)l * 384 * 1024, 384, 1024, w + WO_BC, 1024, 0, tid);
        convT(shm, a.in[7] + (size_t)l * 1024 * 1024, 1024, 1024, w + WO_OUT, 1024, 0, tid);
        convT(shm, a.in[10] + (size_t)l * 1024 * 4096, 1024, 4096, w + WO_UP, 4096, 0, tid);
        convT(shm, a.in[11] + (size_t)l * 4096 * 1024, 4096, 1024, w + WO_DN, 1024, 0, tid);
        convT(shm, a.in[12] + (size_t)l * 1024 * 1024, 1024, 1024, w + WO_PG, 1024, 0, tid);
        convT(shm, a.in[13] + (size_t)l * 256 * 1024, 256, 1024, w + WO_PL, 1024, 0, tid);
    }
    conv_vec(a.in[0], (bf16_t*)(a.ws + WS_XB), (size_t)MTOK * 1024 / 8, tid);
    conv_vec(a.in[1], (bf16_t*)(a.ws + WS_PB), (size_t)2 * MTOK * 256 / 8, tid);
    float* lut = (float*)(a.ws + WS_LUT);
    const float* rb = a.in[16];
    for (int i = blockIdx.x * 512 + tid; i < 24 * 2048; i += gridDim.x * 512) {
        const int hd = i >> 11, d = i & 2047;
        lut[i] = rb[rel_bucket(d) * 24 + hd] * LOG2E;
    }
}

DI float wave_sum(float v) {
#pragma unroll
    for (int o = 32; o >= 1; o >>= 1) v += __shfl_xor(v, o);
    return v;
}
DI void phase_ln(float* y, bf16_t* xb, const float* g, const float* b, const int tid) {
    const int wid = tid >> 6, lane = tid & 63;
    f32x4 gv[4], bv[4];
#pragma unroll
    for (int k = 0; k < 4; ++k) { gv[k] = *(const f32x4*)(g + k * 256 + lane * 4); bv[k] = *(const f32x4*)(b + k * 256 + lane * 4); }
    for (int row = blockIdx.x * 8 + wid; row < MTOK; row += gridDim.x * 8) {
        float* yp = y + (size_t)row * 1024;
        f32x4 v[4]; float s = 0.f;
#pragma unroll
        for (int k = 0; k < 4; ++k) { v[k] = *(const f32x4*)(yp + k * 256 + lane * 4); s += v[k][0] + v[k][1] + v[k][2] + v[k][3]; }
        const float mean = wave_sum(s) * (1.0f / 1024.0f);
        float q = 0.f;
#pragma unroll
        for (int k = 0; k < 4; ++k) { v[k] = v[k] - mean; q += v[k][0] * v[k][0] + v[k][1] * v[k][1] + v[k][2] * v[k][2] + v[k][3] * v[k][3]; }
        const float var = wave_sum(q) * (1.0f / 1024.0f);
        const float rs = 1.0f / sqrtf(var + 1e-5f);
#pragma unroll
        for (int k = 0; k < 4; ++k) { const f32x4 o = v[k] * rs * gv[k] + bv[k];
            *(f32x4*)(yp + k * 256 + lane * 4) = o;
            u32x2 w; w.x = pk2(o[0], o[1]); w.y = pk2(o[2], o[3]);
            *(u32x2*)(xb + (size_t)row * 1024 + k * 256 + lane * 4) = w; }
    }
}

DI int pi_row(int r) { return (r & 3) | (((r >> 3) & 1) << 2) | (((r >> 2) & 1) << 3) | (r & 16); }
DI void task_rot(int tau, int& b, int& qt) { b = tau >> 6; qt = ((tau & 63) + 8 * (tau >> 8)) & 63; }
DI bool task_map(int k, int& b, int& qt) {
    if (gridDim.x == 256) { if (k >= 8) return false; const int xcd = blockIdx.x & 7, slot = blockIdx.x >> 3; b = xcd + 8 * (k >> 1); qt = (k & 1) ? 63 - slot : slot; return true; }
    const int tau = blockIdx.x + k * gridDim.x; if (tau >= 2048) return false; task_rot(tau, b, qt); return true;
}

DI void a1_task(unsigned char* shm, const bf16_t* prm, const bf16_t* prt, unsigned* mask, int b, int qt, const int tid) {
    const int wid = __builtin_amdgcn_readfirstlane(tid >> 6), lane = tid & 63, r = lane & 31, h = lane >> 5;
    const int t0 = qt * 32, tok0 = b * SEQ;
    unsigned* cnt = (unsigned*)(shm + 33280);
#pragma unroll
    for (int p = 0; p < 4; ++p) { const int c = tid + p * 512, row = c >> 6, ch = c & 63;
        *(u32x4*)(shm + row * 1040 + ch * 16) = *(const u32x4*)(prm + (size_t)(tok0 + t0 + row) * RM_LD + C_IQ + ch * 8); }
    cnt[tid] = 0u; cnt[tid + 512] = 0u;
    float* wqs = (float*)(shm + 33280 + 4096);
    if (tid < 256) wqs[tid] = bf2f(prt[(size_t)(R_IW + (tid >> 5)) * MTOK + tok0 + t0 + (tid & 31)]);
    __syncthreads();
    unsigned key[8][16];
    const bf16_t* kp = prm + (size_t)(tok0 + pi_row(r)) * RM_LD + C_IK + 8 * h;
#pragma unroll
    for (int jt = 0; jt < 8; ++jt) {
        const int kt = wid + 8 * jt;
        if (kt <= qt) {
            const int s0 = kt * 32;
            bf16x8 kf[4];
#pragma unroll
            for (int ks = 0; ks < 4; ++ks) kf[ks] = *(const bf16x8*)(kp + (size_t)s0 * RM_LD + 16 * ks);
            float idx[16];
#pragma unroll
            for (int i = 0; i < 16; ++i) idx[i] = 0.f;
#pragma unroll 1
            for (int hh = 0; hh < 8; ++hh) {
                f32x16 acc;
#pragma unroll
                for (int i = 0; i < 16; ++i) acc[i] = 0.f;
                const unsigned char* qb = shm + r * 1040 + hh * 128 + 16 * h;
#pragma unroll
                for (int ks = 0; ks < 4; ++ks) { const bf16x8 qf = *(const bf16x8*)(qb + 32 * ks); acc = MFMA32(kf[ks], qf, acc); }
                const float wv = wqs[hh * 32 + r];
#pragma unroll
                for (int i = 0; i < 16; ++i) idx[i] = fmaf(wv, fmaxf(acc[i], 0.f), idx[i]);
            }
#pragma unroll
            for (int i = 0; i < 16; ++i) {
                const int s = s0 + 16 * (i >> 3) + 8 * h + (i & 7);
                const unsigned u = __float_as_uint(idx[i] + 0.0f);
                const unsigned k = (u & 0x80000000u) ? ~u : (u | 0x80000000u);
                key[jt][i] = (s <= t0 + r) ? k : 0u;
            }
        } else {
#pragma unroll
            for (int i = 0; i < 16; ++i) key[jt][i] = 0u;
        }
    }
    unsigned T = 0u;
    for (int bit = 31; bit >= 0; --bit) {
        const unsigned cand = T | (1u << bit);
        int c = 0;
#pragma unroll
        for (int jt = 0; jt < 8; ++jt)
#pragma unroll
            for (int i = 0; i < 16; ++i) c += (key[jt][i] >= cand) ? 1 : 0;
        c += __shfl_xor(c, 32);
        if (h == 0 && c) atomicAdd(&cnt[(31 - bit) * 32 + r], (unsigned)c);
        __syncthreads();
        if (cnt[(31 - bit) * 32 + r] >= 256u) T = cand;
    }
    if (T < 1u) T = 1u;
#pragma unroll
    for (int jt = 0; jt < 8; ++jt) {
        const int kt = wid + 8 * jt;
        if (kt <= qt) {
            unsigned part = 0u;
#pragma unroll
            for (int i = 0; i < 16; ++i) part |= (key[jt][i] >= T ? 1u : 0u) << (16 * (i >> 3) + 8 * h + (i & 7));
            part |= (unsigned)__shfl_xor((int)part, 32);
            if (h == 0) mask[(size_t)(tok0 + t0 + r) * 64 + kt] = part;
        }
    }
    __syncthreads();
}
DI void phase_a1(const Args& a, unsigned char* shm, const int tid) {
    const bf16_t* prm = (const bf16_t*)(a.ws + WS_R1);
    const bf16_t* prt = prm + (size_t)MTOK * RM_LD;
    unsigned* mask = (unsigned*)(a.ws + WS_MASK);
    float* kmean = (float*)(a.ws + WS_KMEAN);
    for (int k = 0;; ++k) { int b, qt; if (!task_map(k, b, qt)) break; a1_task(shm, prm, prt, mask, b, qt, tid); }
    for (int j = 2048 + blockIdx.x; j < 2048 + 192; j += gridDim.x) {
        {
            const int id = (j - 2048) * 8 + (tid >> 6), lane = tid & 63;
            const int b = id / 48, hd = (id >> 3) % 6, n = id & 7;
            const bf16_t* p = prm + (size_t)(b * SEQ + n * 256) * RM_LD + C_CK + hd * 64 + lane;
            float s = 0.f;
            for (int t = 0; t < 256; ++t) s += bf2f(p[(size_t)t * RM_LD]);
            kmean[(size_t)((b * 6 + hd) * 8 + n) * 64 + lane] = s * (1.0f / 256.0f);
        }
    }
}

struct AttnSt { float m, l; f32x16 o0, o1; };
struct AttnCtx {
    LAS unsigned char* wl;
    const float* lut;
    const bf16_t* kg;
    const bf16_t* vg;
    unsigned koff[4], voff[4];
    int kfo[4], vfo[2][2];
};
DI void attn_dma(const AttnCtx& c, int kt) {
    const char* kb = (const char*)(c.kg + (size_t)(kt * 32) * RM_LD);
    const char* vb = (const char*)(c.vg + kt * 32);
#pragma unroll
    for (int j = 0; j < 4; ++j) __builtin_amdgcn_global_load_lds((const unsigned*)(kb + c.koff[j]), (LAS unsigned*)(c.wl + 8192 + j * 1024), 16, 0, 0);
#pragma unroll
    for (int j = 0; j < 4; ++j) __builtin_amdgcn_global_load_lds((const unsigned*)(vb + c.voff[j]), (LAS unsigned*)(c.wl + 12288 + j * 1024), 16, 0, 0);
}
template <int MODE, bool UNI>
DI void attn_compute(const bf16x8 (&qf)[4], const bf16x8 (&kf)[4], const bf16x8 (&vf)[2][2], int kt, int d00, const float* lut, float ubias, AttnSt& st,
                     unsigned W, int win, int dmask, bool lane_sel) {
    const int s0 = kt * 32;
    f32x16 sx;
#pragma unroll
    for (int i = 0; i < 16; ++i) sx[i] = 0.f;
#pragma unroll
    for (int ks = 0; ks < 4; ++ks) sx = MFMA32(kf[ks], qf[ks], sx);
    const int d0 = d00 - s0;
    float sv[16]; float mx = NEGF;
#pragma unroll
    for (int i = 0; i < 16; ++i) {
        const int ci = 16 * (i >> 3) + (i & 7);
        const int dist = d0 - ci;
        bool v;
        if (MODE == 0) v = ((W >> ci) & 1u) != 0u;
        else if (MODE == 1) v = ((unsigned)dist <= (unsigned)win) && ((dist & dmask) == 0);
        else if (MODE == 2) v = lane_sel;
        else v = dist >= 0;
        const float bias = UNI ? ubias : lut[dist & 2047];
        float s = fmaf(sx[i], SC2, bias);
        s = v ? s : NEGF;
        sv[i] = s; mx = fmaxf(mx, s);
    }
    mx = fmaxf(mx, __shfl_xor(mx, 32));
    const float mnew = fmaxf(st.m, mx);
    const float msafe = (mnew > -1e29f) ? mnew : 0.f;
    if (__ballot(mnew > st.m) != 0ull) {
        const float alpha = __builtin_amdgcn_exp2f(st.m - msafe);
        st.l *= alpha; st.m = mnew;
#pragma unroll
        for (int i = 0; i < 16; ++i) { st.o0[i] *= alpha; st.o1[i] *= alpha; }
    }
    float ps = 0.f; float p[16];
#pragma unroll
    for (int i = 0; i < 16; ++i) { const float e = __builtin_amdgcn_exp2f(sv[i] - msafe); p[i] = e; ps += e; }
    st.l += ps;
    u32x4 w0, w1;
    w0.x = pk2(p[0], p[1]); w0.y = pk2(p[2], p[3]); w0.z = pk2(p[4], p[5]); w0.w = pk2(p[6], p[7]);
    w1.x = pk2(p[8], p[9]); w1.y = pk2(p[10], p[11]); w1.z = pk2(p[12], p[13]); w1.w = pk2(p[14], p[15]);
    const bf16x8 pf0 = __builtin_bit_cast(bf16x8, w0), pf1 = __builtin_bit_cast(bf16x8, w1);
    st.o0 = MFMA32(vf[0][0], pf0, st.o0); st.o0 = MFMA32(vf[0][1], pf1, st.o0);
    st.o1 = MFMA32(vf[1][0], pf0, st.o1); st.o1 = MFMA32(vf[1][1], pf1, st.o1);
}
template <int MODE>
DI void attn_range(const AttnCtx& c, const bf16x8 (&qf)[4], int lo, int hi, int t0, int d00, AttnSt& st, const unsigned* maskrow, int h8, int win, int dmask, bool lane_sel) {
    if (lo > hi) return;
    attn_dma(c, lo);
    unsigned Wn = 0u;
    if (MODE == 0) Wn = maskrow[lo];
#pragma unroll 1
    for (int kt = lo; kt <= hi; ++kt) {
        asm volatile("s_waitcnt vmcnt(0)" ::: "memory");
        bf16x8 kf[4], vf[2][2];
#pragma unroll
        for (int ks = 0; ks < 4; ++ks) kf[ks] = *(const LAS bf16x8*)(c.wl + 8192 + c.kfo[ks]);
#pragma unroll
        for (int mt = 0; mt < 2; ++mt)
#pragma unroll
            for (int s = 0; s < 2; ++s) vf[mt][s] = *(const LAS bf16x8*)(c.wl + 12288 + c.vfo[mt][s]);
        const unsigned W = Wn >> h8;
        const int dlo = t0 - kt * 32 - 31;
        float ub = 0.f; bool uni = false;
        if (dlo >= 182) { const unsigned ua = __builtin_amdgcn_readfirstlane(__float_as_uint(c.lut[dlo])), ue = __builtin_amdgcn_readfirstlane(__float_as_uint(c.lut[dlo + 62])); uni = (ua == ue); ub = __uint_as_float(ua); }
        asm volatile("s_waitcnt lgkmcnt(0)" ::: "memory");
        if (kt < hi) { attn_dma(c, kt + 1); if (MODE == 0) Wn = maskrow[kt + 1]; }
        if (false) attn_compute<MODE, true>(qf, kf, vf, kt, d00, c.lut, ub, st, W, win, dmask, lane_sel);
        else attn_compute<MODE, false>(qf, kf, vf, kt, d00, c.lut, 0.f, st, W, win, dmask, lane_sel);
    }
}

DI void load_lut(float* lut, const float* glut, int col, int lane) {
    __builtin_amdgcn_fence(__ATOMIC_ACQ_REL, "wavefront");
#pragma unroll
    for (int k = 0; k < 8; ++k) *(f32x4*)(lut + k * 256 + lane * 4) = *(const f32x4*)(glut + (size_t)col * 2048 + k * 256 + lane * 4);
    __builtin_amdgcn_fence(__ATOMIC_ACQ_REL, "wavefront");
    __builtin_amdgcn_wave_barrier();
}

DI void attn_job(const Args& a, unsigned char* wsh, LAS unsigned char* wl, int type, int b, int qt, int hd, const int tid) {
    const int lane = tid & 63, r = lane & 31, h = lane >> 5;
    const bf16_t* prm = (const bf16_t*)(a.ws + WS_R1);
    const bf16_t* prt = prm + (size_t)MTOK * RM_LD;
    const float* glut = (const float*)(a.ws + WS_LUT);
    const unsigned* mask = (const unsigned*)(a.ws + WS_MASK);
    const float* kmean = (const float*)(a.ws + WS_KMEAN);
    bf16_t* oabc = (bf16_t*)(a.ws + WS_OABC);
    float* lut = (float*)wsh;
    const int t0 = qt * 32, tok0 = b * SEQ;
    const int d00 = t0 + r - 8 * h, h8 = 8 * h;
    const unsigned* maskrow = mask + (size_t)(tok0 + t0 + r) * 64;
    AttnCtx c; c.wl = wl; c.lut = lut;
#pragma unroll
    for (int j = 0; j < 4; ++j) {
        const int rk = 8 * j + (lane >> 3), ck = (lane & 7) ^ ((rk >> 1) & 7);
        c.koff[j] = (unsigned)(pi_row(rk) * RM_LD + ck * 8) * 2u;
        const int rv = 16 * j + (lane >> 2), cv = (lane & 3) ^ ((rv >> 2) & 3);
        c.voff[j] = (unsigned)(rv * MTOK + cv * 8) * 2u;
        c.kfo[j] = r * 128 + (((2 * j + h) ^ ((r >> 1) & 7)) * 16);
    }
#pragma unroll
    for (int mt = 0; mt < 2; ++mt)
#pragma unroll
        for (int s = 0; s < 2; ++s) c.vfo[mt][s] = (32 * mt + r) * 64 + (((2 * s + h) ^ ((r >> 2) & 3)) * 16);
    AttnSt st; st.m = NEGF; st.l = 0.f;
#pragma unroll
    for (int i = 0; i < 16; ++i) { st.o0[i] = 0.f; st.o1[i] = 0.f; }
    const int ng = (type == 1) ? 3 : 1;
    int ocol = 0;
    for (int g = 0; g < ng; ++g) {
        int qcol, kcol, vrow, bcol;
        if (type == 0) { qcol = C_AQ + hd * 64; kcol = C_AK; vrow = R_AV; bcol = hd; ocol = hd * 64; }
        else if (type == 1) { qcol = C_BQ + (g * 4 + hd) * 64; kcol = C_BK + hd * 64; vrow = R_BV + hd * 64; bcol = 6 + g * 4 + hd; ocol = 384 + hd * 64; }
        else { qcol = C_CQ + hd * 64; kcol = C_CK + hd * 64; vrow = R_CV + hd * 64; bcol = 18 + hd; ocol = 640 + hd * 64; }
        load_lut(lut, glut, bcol, lane);
        bf16x8 qf[4];
        const bf16_t* qp = prm + (size_t)(tok0 + t0 + r) * RM_LD + qcol + 8 * h;
#pragma unroll
        for (int ks = 0; ks < 4; ++ks) qf[ks] = *(const bf16x8*)(qp + 16 * ks);
        c.kg = prm + (size_t)tok0 * RM_LD + kcol;
        c.vg = prt + (size_t)vrow * MTOK + tok0;
        if (type == 0) {
            attn_range<0>(c, qf, 0, qt, t0, d00, st, maskrow, h8, 0, 0, false);
        } else if (type == 1) {
            const int win = (g == 0) ? 128 : (g == 1 ? 512 : 2048), dmask = (g == 0) ? 0 : (g == 1 ? 3 : 15);
            int lo = t0 - win; if (lo < 0) lo = 0;
            attn_range<1>(c, qf, lo >> 5, qt, t0, d00, st, maskrow, h8, win, dmask, false);
        } else {
            const int cur = qt >> 3;
            float gate[7];
            const float* km = kmean + (size_t)((b * 6 + hd) * 8) * 64 + 8 * h;
#pragma unroll
            for (int n = 0; n < 7; ++n) {
                float s = 0.f;
                if (n < cur) {
#pragma unroll
                    for (int ks = 0; ks < 4; ++ks) {
                        const f32x4 k0 = *(const f32x4*)(km + n * 64 + 16 * ks), k1 = *(const f32x4*)(km + n * 64 + 16 * ks + 4);
                        const u32x4 qw = __builtin_bit_cast(u32x4, qf[ks]);
                        s += bf_lo(qw.x) * k0[0] + bf_hi(qw.x) * k0[1] + bf_lo(qw.y) * k0[2] + bf_hi(qw.y) * k0[3]
                           + bf_lo(qw.z) * k1[0] + bf_hi(qw.z) * k1[1] + bf_lo(qw.w) * k1[2] + bf_hi(qw.w) * k1[3];
                    }
                    s += __shfl_xor(s, 32);
                } else s = -__builtin_inff();
                gate[n] = s;
            }
            unsigned sel = 0u;
#pragma unroll
            for (int rd = 0; rd < 3; ++rd) {
                float bv = -__builtin_inff(); int bi = -1;
#pragma unroll
                for (int n = 0; n < 7; ++n) if (gate[n] > bv) { bv = gate[n]; bi = n; }
                if (bi >= 0) sel |= 1u << bi;
#pragma unroll
                for (int n = 0; n < 7; ++n) if (n == bi) gate[n] = -__builtin_inff();
            }
            for (int n = 0; n < cur; ++n) {
                const bool ls = ((sel >> n) & 1u) != 0u;
                if (__ballot(ls) == 0ull) continue;
                attn_range<2>(c, qf, n * 8, n * 8 + 7, t0, d00, st, maskrow, h8, 0, 0, ls);
            }
            attn_range<3>(c, qf, cur * 8, qt, t0, d00, st, maskrow, h8, 0, 0, false);
        }
    }
    const float lt = st.l + __shfl_xor(st.l, 32);
    const float inv = 1.0f / lt;
    bf16_t* op = oabc + (size_t)(tok0 + t0 + r) * 1024 + ocol + 4 * h;
#pragma unroll
    for (int g4 = 0; g4 < 4; ++g4) {
        u32x2 w;
        w.x = pk2(st.o0[4 * g4] * inv, st.o0[4 * g4 + 1] * inv); w.y = pk2(st.o0[4 * g4 + 2] * inv, st.o0[4 * g4 + 3] * inv);
        *(u32x2*)(op + 8 * g4) = w;
        w.x = pk2(st.o1[4 * g4] * inv, st.o1[4 * g4 + 1] * inv); w.y = pk2(st.o1[4 * g4 + 2] * inv, st.o1[4 * g4 + 3] * inv);
        *(u32x2*)(op + 32 + 8 * g4) = w;
    }
}
DI void phase_attn(const Args& a, unsigned char* shm, const int tid) {
    const int wid = __builtin_amdgcn_readfirstlane(tid >> 6);
    unsigned char* wsh = shm + wid * 16384;
    LAS unsigned char* wl = (LAS unsigned char*)shm + wid * 16384;
    for (int it = 0;; ++it) {
        int b, qt; if (!task_map(it, b, qt)) break;
        const int role = (wid + it) & 7;
        if (role < 6) { attn_job(a, wsh, wl, 0, b, qt, role, tid); attn_job(a, wsh, wl, 2, b, qt, role, tid); }
        else { attn_job(a, wsh, wl, 1, b, qt, role - 6, tid); attn_job(a, wsh, wl, 1, b, qt, role - 4, tid); }
    }
}

#define XB_TMO      128
#define XB_XCNT(j)  (256  + 64 * (j))
#define XB_XSUB(j)  (1280 + 64 * (j))
#define XB_XGEN(j)  (2304 + 64 * (j))
#define XB_TOP      3328
#define XB_TOPGEN   3392
#define XCD_BAR_WORDS 3456
#define XB_SPIN_CAP (1u << 20)
DI unsigned xb_ld(unsigned* p)              { return __hip_atomic_load(p, __ATOMIC_RELAXED, __HIP_MEMORY_SCOPE_AGENT); }
DI unsigned xb_add(unsigned* p, unsigned v) { return __hip_atomic_fetch_add(p, v, __ATOMIC_RELAXED, __HIP_MEMORY_SCOPE_AGENT); }
DI unsigned xb_xcc_id() { return (unsigned)__builtin_amdgcn_s_getreg((3 << 11) | 20) & 0xFu; }
#define XB_SPIN(cond, bar) do { unsigned _sp = 0; while (cond) { __builtin_amdgcn_s_sleep(1); \
    if ((++_sp & 255u) == 0u) { if (xb_ld(&(bar)[XB_TMO])) break; if (_sp > XB_SPIN_CAP) { atomicAdd(&(bar)[XB_TMO], 1u); break; } } } } while (0)
struct XcdBarrier { unsigned* bar; unsigned x; volatile LAS unsigned* st; };
DI void xcd_barrier_complete(unsigned* bar, unsigned x, unsigned& nloc, unsigned& nx) {
    const unsigned G = gridDim.x * gridDim.y * gridDim.z;
    unsigned sum, cnt, mine, sp = 0u;
    for (;;) {
        sum = 0u; cnt = 0u; mine = 0u;
#pragma unroll
        for (unsigned j = 0; j < 16; ++j) { const unsigned c = xb_ld(&bar[XB_XCNT(j)]); sum += c; cnt += (c > 0u) ? 1u : 0u; mine = (j == x) ? c : mine; }
        if (sum == G) break;
        __builtin_amdgcn_s_sleep(1);
        if ((++sp & 255u) == 0u) { if (xb_ld(&bar[XB_TMO])) break; if (sp > XB_SPIN_CAP) { atomicAdd(&bar[XB_TMO], 1u); break; } }
    }
    nloc = mine > 0u ? mine : 1u; nx = cnt > 0u ? cnt : 1u;
}
DI void xcd_barrier(const XcdBarrier& b, const int tid) {
    asm volatile("s_waitcnt vmcnt(0)" ::: "memory");
    __syncthreads();
    if (tid == 0) {
        unsigned* bar = b.bar;
        __builtin_amdgcn_s_waitcnt(0);
        unsigned nloc = b.st[0], nx = b.st[1];
        if (nloc == 0u) { xcd_barrier_complete(bar, b.x, nloc, nx); b.st[0] = nloc; b.st[1] = nx; }
        const unsigned old = xb_add(&bar[XB_XSUB(b.x)], 1u);
        const unsigned gen = old / nloc;
        if (old + 1u == (gen + 1u) * nloc) {
            __builtin_amdgcn_fence(__ATOMIC_RELEASE, "agent");
            asm volatile("s_waitcnt vmcnt(0)" ::: "memory");
            const unsigned og = xb_add(&bar[XB_TOP], 1u);
            const unsigned tg = og / nx;
            if (og + 1u == (tg + 1u) * nx) xb_add(&bar[XB_TOPGEN], 1u);
            else XB_SPIN(xb_ld(&bar[XB_TOPGEN]) == tg, bar);
            __builtin_amdgcn_fence(__ATOMIC_ACQUIRE, "agent");
            xb_add(&bar[XB_XGEN(b.x)], 1u);
            asm volatile("s_waitcnt vmcnt(0)" ::: "memory");
        } else {
            XB_SPIN(xb_ld(&bar[XB_XGEN(b.x)]) == gen, bar);
            __builtin_amdgcn_fence(__ATOMIC_ACQUIRE, "agent");
            asm volatile("s_waitcnt vmcnt(0)" ::: "memory");
        }
    }
    __syncthreads();
}

__global__ void __launch_bounds__(512, 2) mega_fwd(Args a_) {
    extern __shared__ __attribute__((aligned(16))) unsigned char shm[];
    cg::grid_group grid = cg::this_grid();
    LAS unsigned char* lds = (LAS unsigned char*)shm;
    const int G = gridDim.x, c = blockIdx.x;
#ifndef PROBE_REP
#define PROBE_REP -2
#endif
    const int ph_lo = a_.ph_lo, ph_hi = a_.ph_hi;
    const int wave_id = __builtin_amdgcn_readfirstlane(threadIdx.x >> 6);
    XcdBarrier xbar;
    { volatile LAS unsigned* st = (volatile LAS unsigned*)(lds + 131072);
      if (threadIdx.x == 0) { st[0] = 0u; st[1] = 0u; }
      __syncthreads();
      xbar.bar = (unsigned*)(a_.ws + WS_BAR); xbar.x = xb_xcc_id(); xbar.st = st;
      if (threadIdx.x == 0) (void)xb_add(&xbar.bar[XB_XCNT(xbar.x)], 1u); }
    for (int phx = 2 * ph_lo; phx < 2 * ph_hi; ++phx) {
        const int ph = phx >> 1;
        if (phx & 1) { const bool rep = (PROBE_REP == -1) ? (ph == 0) : (ph > 0 && (ph - 1) % 9 == PROBE_REP); if (!rep) continue; }
        const Args& a = a_;
        int tid = wave_id * 64 + (int)__builtin_amdgcn_mbcnt_hi(~0u, __builtin_amdgcn_mbcnt_lo(~0u, 0u)); asm volatile("" : "+v"(tid));
        bf16_t* xb = (bf16_t*)(a.ws + WS_XB);
        bf16_t* r1 = (bf16_t*)(a.ws + WS_R1);
        bf16_t* oabc = (bf16_t*)(a.ws + WS_OABC);
        if (ph == 0) phase_convert(a, shm, tid);
        else {
            const int l = (ph - 1) / 9, sp = (ph - 1) % 9;
            const bf16_t* w = (const bf16_t*)(a.ws + WS_WB) + (size_t)l * W_LAYER;
            const float* xin = (l == 0) ? a.in[0] : a.out;
            if (sp == 0) {
                { pg8::Gemm g{xb, w + WO_IN, 1024, 1024, 1024}; pg8::StaticOrder S; S.init(256, 11, G, c); pg8::EpiBf16<0> E{r1, RM_LD}; pg8::gemm_phase(lds, g, S, E, tid); }
                { pg8::Gemm g{w + WO_IN + (size_t)RM_LD * 1024, xb, 1024, 1024, 1024}; pg8::StaticOrder S; S.init(3, 256, G, c); pg8::EpiBf16<0> E{r1 + (size_t)MTOK * RM_LD, MTOK}; pg8::gemm_phase(lds, g, S, E, tid); }
            } else if (sp == 1) phase_a1(a, shm, tid);
            else if (sp == 2) phase_attn(a, shm, tid);
            else if (sp == 3) {
                pg8::StaticOrder S; S.init(256, 4, G, c);
                { pg8::Gemm g{oabc, w + WO_BA, 1024, 384, 384}; pg8::EpiBf16<0> E{r1, 3072}; pg8::gemm_phase(lds, g, S, E, tid); }
                { pg8::Gemm g{oabc + 384, w + WO_BB, 1024, 256, 256}; pg8::EpiBf16<0> E{r1 + 1024, 3072}; pg8::gemm_phase(lds, g, S, E, tid); }
                { pg8::Gemm g{oabc + 640, w + WO_BC, 1024, 384, 384}; pg8::EpiBf16<0> E{r1 + 2048, 3072}; pg8::gemm_phase(lds, g, S, E, tid); }
                { pg8::Gemm g{xb, w + WO_G, 1024, 1024, 1024}; pg8::Order3 S3; S3.base = S; pg8::EpiGate E{r1, r1 + (size_t)MTOK * 3072}; pg8::gemm_phase(lds, g, S3, E, tid); }
            } else if (sp == 4) {
                pg8::Gemm g{r1 + (size_t)MTOK * 3072, w + WO_OUT, 1024, 1024, 1024}; pg8::StaticOrder S; S.init(256, 4, G, c);
                pg8::EpiRes<false> E{xin, a.out, nullptr}; pg8::gemm_phase(lds, g, S, E, tid);
            } else if (sp == 5) phase_ln(a.out, xb, a.in[8] + l * 1024, a.in[9] + l * 1024, tid);
            else if (sp == 6) {
                { pg8::Gemm g{xb, w + WO_UP, 1024, 1024, 1024}; pg8::StaticOrder S; S.init(256, 16, G, c); pg8::EpiBf16<1> E{r1, 4096}; pg8::gemm_phase(lds, g, S, E, tid); }
                pg8::StaticOrder S; S.init(256, 4, G, c);
                { pg8::Gemm g{(const bf16_t*)(a.ws + WS_PB) + (size_t)l * MTOK * 256, w + WO_PL, 256, 256, 256}; pg8::EpiBf16<0> E{oabc, 1024}; pg8::gemm_phase(lds, g, S, E, tid); }
                { pg8::Gemm g{xb, w + WO_PG, 1024, 1024, 1024}; pg8::EpiT1 E{oabc}; pg8::gemm_phase(lds, g, S, E, tid); }
            } else if (sp == 7) {
                pg8::Gemm g{r1, w + WO_DN, 4096, 4096, 4096}; pg8::StaticOrder S; S.init(256, 4, G, c);
                pg8::EpiRes<true> E{a.out, a.out, oabc}; pg8::gemm_phase(lds, g, S, E, tid);
            } else phase_ln(a.out, xb, a.in[14] + l * 1024, a.in[15] + l * 1024, tid);
        }
        if (phx + 1 < 2 * ph_hi) { if (ph == 0) grid.sync(); else xcd_barrier(xbar, tid); }
    }
}

#ifndef N_LAUNCH_MODE
#define N_LAUNCH_MODE 1
#endif
extern "C" void kernel_launch(void* const* d_in, const int* in_sizes, int n_in, void* d_out, int out_size, void* d_ws, size_t ws_size, hipStream_t stream) {
    static int grid = 0;
    if (grid == 0) {
        if (n_in != 17 || out_size != MTOK * DM || ws_size < WS_END) { fprintf(stderr, "kernel_launch: unexpected shapes (n_in %d out %d ws %zu need %zu)\n", n_in, out_size, ws_size, (size_t)WS_END); grid = -1; return; }
        int dev = 0, cus = 0, per_cu = 0;
        hipGetDevice(&dev);
        hipDeviceGetAttribute(&cus, hipDeviceAttributeMultiprocessorCount, dev);
        if (hipFuncSetAttribute((const void*)mega_fwd, hipFuncAttributeMaxDynamicSharedMemorySize, LDS_BYTES) != hipSuccess) { fprintf(stderr, "kernel_launch: hipFuncSetAttribute failed\n"); grid = -1; return; }
        hipOccupancyMaxActiveBlocksPerMultiprocessor(&per_cu, (const void*)mega_fwd, 512, LDS_BYTES);
        if (per_cu < 1) { fprintf(stderr, "kernel_launch: occupancy query says %d\n", per_cu); per_cu = 1; }
        (void)hipGetLastError();
        grid = cus * per_cu;
    }
    if (grid < 0) return;
    if (hipMemsetAsync((char*)d_ws + WS_BAR, 0, (size_t)3456 * 4, stream) != hipSuccess) { fprintf(stderr, "kernel_launch: memset of the barrier words failed\n"); return; }
    Args a{};
    for (int i = 0; i < 17; ++i) a.in[i] = (const float*)d_in[i];
    a.out = (float*)d_out; a.ws = (unsigned char*)d_ws;
#if N_LAUNCH_MODE == 0
    for (int ph = 0; ph < 19; ++ph) {
        a.ph_lo = ph; a.ph_hi = ph + 1;
        hipLaunchKernelGGL(mega_fwd, dim3(grid), dim3(512), LDS_BYTES, stream, a);
    }
#else
    a.ph_lo = 0; a.ph_hi = 19;
    void* args[] = {&a};
    hipError_t e = hipLaunchCooperativeKernel((const void*)mega_fwd, dim3(grid), dim3(512), args, LDS_BYTES, stream);
    if (e != hipSuccess) fprintf(stderr, "cooperative launch failed: %s (grid %d)\n", hipGetErrorString(e), grid);
#endif
}
```

```cpp
#include <hip/hip_runtime.h>
#include <hip/hip_cooperative_groups.h>
#include <cstdio>
namespace cg = cooperative_groups;

#define LAS __attribute__((address_space(3)))
#define DI __device__ __forceinline__
typedef unsigned short bf16_t;
typedef short bf16x8 __attribute__((ext_vector_type(8)));
typedef float f32x2 __attribute__((ext_vector_type(2)));
typedef float f32x4 __attribute__((ext_vector_type(4)));
typedef float f32x16 __attribute__((ext_vector_type(16)));
typedef unsigned u32x2 __attribute__((ext_vector_type(2)));
typedef unsigned u32x4 __attribute__((ext_vector_type(4)));
typedef __bf16 bf2_t __attribute__((ext_vector_type(2)));

constexpr int MTOK = 65536, SEQ = 2048, DM = 1024, NB = 32, DFF = 4096, PLE = 256;
constexpr int RM_LD = 2816;
constexpr int C_AQ = 0, C_AK = 384, C_IQ = 448, C_IK = 960, C_BQ = 1024, C_BK = 1792, C_CQ = 2048, C_CK = 2432;
constexpr int T_ROWS = 768;
constexpr int R_AV = 0, R_BV = 64, R_CV = 320, R_IW = 704;
constexpr int NWIN = 3584;
constexpr float ALPHA = 1.41421356237309515f;
constexpr float LOG2E = 1.44269504088896341f;
constexpr float SC2 = 0.125f * LOG2E;
constexpr float NEGF = -1e30f;
constexpr int LDS_BYTES = 131072 + 16;

constexpr size_t WO_IN = 0;
constexpr size_t WO_G = WO_IN + (size_t)NWIN * 1024;
constexpr size_t WO_BA = WO_G + (size_t)3072 * 1024;
constexpr size_t WO_BB = WO_BA + (size_t)1024 * 384;
constexpr size_t WO_BC = WO_BB + (size_t)1024 * 256;
constexpr size_t WO_OUT = WO_BC + (size_t)1024 * 384;
constexpr size_t WO_UP = WO_OUT + (size_t)1024 * 1024;
constexpr size_t WO_DN = WO_UP + (size_t)4096 * 1024;
constexpr size_t WO_PG = WO_DN + (size_t)1024 * 4096;
constexpr size_t WO_PL = WO_PG + (size_t)1024 * 1024;
constexpr size_t W_LAYER = WO_PL + (size_t)1024 * 256;

constexpr size_t WS_WB = 0;
constexpr size_t WS_LUT = WS_WB + 2 * W_LAYER * 2;
constexpr size_t WS_KMEAN = WS_LUT + (size_t)24 * 2048 * 4;
constexpr size_t WS_MASK = WS_KMEAN + (size_t)32 * 6 * 8 * 64 * 4;
constexpr size_t WS_XB = WS_MASK + (size_t)MTOK * 64 * 4;
constexpr size_t WS_PB = WS_XB + (size_t)MTOK * 1024 * 2;
constexpr size_t WS_OABC = WS_PB + (size_t)2 * MTOK * 256 * 2;
constexpr size_t WS_R1 = WS_OABC + (size_t)MTOK * 1024 * 2;
constexpr size_t WS_BAR = WS_R1 + (size_t)MTOK * 4096 * 2;
constexpr size_t WS_STATS = WS_BAR + (size_t)4096 * 4;
constexpr size_t WS_END = WS_STATS + (size_t)MTOK * 2 * 4;

struct Args {
    const float* in[17];
    float* out;
    unsigned char* ws;
    int ph_lo, ph_hi;
};

DI unsigned short f2bf(float f) { unsigned u = __float_as_uint(f); u += 0x7FFFu + ((u >> 16) & 1u); return (unsigned short)(u >> 16); }
DI unsigned pk2(float lo, float hi) { f32x2 v = {lo, hi}; bf2_t b = __builtin_convertvector(v, bf2_t); return __builtin_bit_cast(unsigned, b); }
DI float bf_lo(unsigned w) { return __uint_as_float(w << 16); }
DI float bf_hi(unsigned w) { return __uint_as_float(w & 0xFFFF0000u); }
DI float bf2f(bf16_t b) { return __uint_as_float(((unsigned)b) << 16); }
DI float sigmoidf_(float x) { return __builtin_amdgcn_rcpf(1.0f + __expf(-x)); }
#define MFMA32(a, b, c) __builtin_amdgcn_mfma_f32_32x32x16_bf16((a), (b), (c), 0, 0, 0)

namespace pg8 {
constexpr int BM = 256, BK = 64, HALF = 128, HTB = HALF * BK * 2, NXCD = 8, WGM = 8;
DI int lds_byte(int r, int c) { const int st = (r >> 4) * 2 + (c >> 5), rr = r & 15, cc = c & 31, ob = rr * 64 + cc * 2; return st * 1024 + (ob ^ (((ob >> 9) & 1) << 5)); }
DI void stage_rc(int b, int& R, int& C) { const int st = b / 1024, sb = b % 1024, swz = sb ^ (((sb >> 9) & 1) << 5); R = (st >> 1) * 16 + swz / 64; C = (st & 1) * 32 + (swz % 64) / 2; }
DI int perm32(int rho) { const int n = rho >> 4, i = rho & 15; return 8 * (i >> 2) + 4 * n + (i & 3); }

struct Unit { int pm, pn; };
struct Gemm { const bf16_t* A; const bf16_t* Bt; int lda, ldb, K; };

struct StaticOrder {
    int nM, nN, nwg, G, c;
    DI void init(int nM_, int nN_, int G_, int c_) { nM = nM_; nN = nN_; nwg = nM * nN; G = G_; c = c_; }
    DI bool next(int i, Unit& u) const {
        const long L = (long)i * G + c; if (L >= nwg) return false;
        int wgid = (int)L; { const int q = nwg / NXCD, r = nwg % NXCD, xcd = wgid % NXCD, off = wgid / NXCD; wgid = (xcd < r ? xcd * (q + 1) : r * (q + 1) + (xcd - r) * q) + off; }
        const int nig = WGM * nN, gid = wgid / nig, fm = gid * WGM, gsz = (nM - fm) < WGM ? (nM - fm) : WGM;
        u.pm = fm + ((wgid % nig) % gsz); u.pn = (wgid % nig) / gsz; return true;
    }
};
struct Order3 {
    StaticOrder base;
    DI bool next(int i, Unit& u) const { Unit v; if (!base.next(i / 3, v)) return false; u.pm = v.pm; u.pn = (i % 3) * 4 + v.pn; return true; }
};

template <int ACT  > struct EpiBf16 {
    static constexpr bool PERM = true;
    bf16_t* O; int ldc;
    DI void operator()(const f32x4 (&acc)[2][2][4][2], const Unit& u, int wr, int wc, int fr, int fq) const {
        const int row0 = u.pm * BM + wr * 64 + fr, col0 = u.pn * BM + wc * 32 + 8 * fq;
#pragma unroll
        for (int ai = 0; ai < 2; ++ai)
#pragma unroll
            for (int m = 0; m < 4; ++m) { bf16_t* rowp = O + (size_t)(row0 + ai * HALF + m * 16) * ldc + col0;
#pragma unroll
                for (int bj = 0; bj < 2; ++bj) { f32x4 v0 = acc[ai][bj][m][0], v1 = acc[ai][bj][m][1];
                    if (ACT == 1) {
#pragma unroll
                        for (int j = 0; j < 4; ++j) { float a = fmaxf(v0[j], 0.f), b = fmaxf(v1[j], 0.f); v0[j] = a * a; v1[j] = b * b; } }
                    u32x4 w; w.x = pk2(v0[0], v0[1]); w.y = pk2(v0[2], v0[3]); w.z = pk2(v1[0], v1[1]); w.w = pk2(v1[2], v1[3]);
                    *(u32x4*)(rowp + bj * HALF) = w; } }
    }
};
struct EpiGate {
    static constexpr bool PERM = true;
    const bf16_t* obr; bf16_t* mg;
    DI void operator()(const f32x4 (&acc)[2][2][4][2], const Unit& u, int wr, int wc, int fr, int fq) const {
        const int b = u.pn >> 2, colt = (u.pn & 3) * BM;
        const int row0 = u.pm * BM + wr * 64 + fr, col0 = colt + wc * 32 + 8 * fq;
#pragma unroll
        for (int ai = 0; ai < 2; ++ai)
#pragma unroll
            for (int m = 0; m < 4; ++m) { const size_t row = (size_t)(row0 + ai * HALF + m * 16);
#pragma unroll
                for (int bj = 0; bj < 2; ++bj) { const f32x4 v0 = acc[ai][bj][m][0], v1 = acc[ai][bj][m][1];
                    const u32x4 ob = *(const u32x4*)(obr + row * 3072 + b * 1024 + col0 + bj * HALF);
                    bf16_t* mp = mg + row * 1024 + col0 + bj * HALF;
                    float r[8];
                    r[0] = sigmoidf_(v0[0]) * bf_lo(ob.x); r[1] = sigmoidf_(v0[1]) * bf_hi(ob.x); r[2] = sigmoidf_(v0[2]) * bf_lo(ob.y); r[3] = sigmoidf_(v0[3]) * bf_hi(ob.y);
                    r[4] = sigmoidf_(v1[0]) * bf_lo(ob.z); r[5] = sigmoidf_(v1[1]) * bf_hi(ob.z); r[6] = sigmoidf_(v1[2]) * bf_lo(ob.w); r[7] = sigmoidf_(v1[3]) * bf_hi(ob.w);
                    if (b > 0) { const u32x4 pm_ = *(const u32x4*)mp;
                        r[0] += bf_lo(pm_.x); r[1] += bf_hi(pm_.x); r[2] += bf_lo(pm_.y); r[3] += bf_hi(pm_.y); r[4] += bf_lo(pm_.z); r[5] += bf_hi(pm_.z); r[6] += bf_lo(pm_.w); r[7] += bf_hi(pm_.w); }
                    u32x4 w; w.x = pk2(r[0], r[1]); w.y = pk2(r[2], r[3]); w.z = pk2(r[4], r[5]); w.w = pk2(r[6], r[7]);
                    *(u32x4*)mp = w; } }
    }
};
struct EpiT1 {
    static constexpr bool PERM = true;
    bf16_t* T;
    DI void operator()(const f32x4 (&acc)[2][2][4][2], const Unit& u, int wr, int wc, int fr, int fq) const {
        const int row0 = u.pm * BM + wr * 64 + fr, col0 = u.pn * BM + wc * 32 + 8 * fq;
#pragma unroll
        for (int ai = 0; ai < 2; ++ai)
#pragma unroll
            for (int m = 0; m < 4; ++m) { const size_t row = (size_t)(row0 + ai * HALF + m * 16);
#pragma unroll
                for (int bj = 0; bj < 2; ++bj) { const f32x4 v0 = acc[ai][bj][m][0], v1 = acc[ai][bj][m][1];
                    bf16_t* tp = T + row * 1024 + col0 + bj * HALF;
                    const u32x4 ob = *(const u32x4*)tp;
                    float r[8];
                    r[0] = sigmoidf_(v0[0]) * bf_lo(ob.x); r[1] = sigmoidf_(v0[1]) * bf_hi(ob.x); r[2] = sigmoidf_(v0[2]) * bf_lo(ob.y); r[3] = sigmoidf_(v0[3]) * bf_hi(ob.y);
                    r[4] = sigmoidf_(v1[0]) * bf_lo(ob.z); r[5] = sigmoidf_(v1[1]) * bf_hi(ob.z); r[6] = sigmoidf_(v1[2]) * bf_lo(ob.w); r[7] = sigmoidf_(v1[3]) * bf_hi(ob.w);
                    u32x4 w; w.x = pk2(r[0], r[1]); w.y = pk2(r[2], r[3]); w.z = pk2(r[4], r[5]); w.w = pk2(r[6], r[7]);
                    *(u32x4*)tp = w; } }
    }
};
template <bool HAS_T, bool LNX> struct EpiRes {
    static constexpr bool PERM = false;
    const float* xin; float* y; const bf16_t* T; const float* stats; const float* lg; const float* lb;
    DI void operator()(const f32x4 (&acc)[2][2][4][2], const Unit& u, int wr, int wc, int fr, int fq) const {
        const int row0 = u.pm * BM + wr * 64 + fr, col0 = u.pn * BM + wc * 32 + 4 * fq;
#pragma unroll
        for (int bj = 0; bj < 2; ++bj)
#pragma unroll
            for (int n = 0; n < 2; ++n) {
                const int col = col0 + bj * HALF + n * 16;
                f32x4 gv = {1.f, 1.f, 1.f, 1.f}, bv = {0.f, 0.f, 0.f, 0.f};
                if (LNX) { gv = *(const f32x4*)(lg + col); bv = *(const f32x4*)(lb + col); }
#pragma unroll
                for (int ai = 0; ai < 2; ++ai)
#pragma unroll
                    for (int m = 0; m < 4; ++m) {
                        const int row = row0 + ai * HALF + m * 16;
                        const size_t o = (size_t)row * 1024 + col;
                        f32x4 xv = *(const f32x4*)(xin + o);
                        if (LNX) { const f32x2 sm = *(const f32x2*)(stats + 2 * (size_t)row); xv = (xv - sm[0]) * sm[1] * gv + bv; }
                        f32x4 r = acc[ai][bj][m][n] + xv * ALPHA;
                        if (HAS_T) { const u32x2 tv = *(const u32x2*)(T + o); r[0] += bf_lo(tv.x); r[1] += bf_hi(tv.x); r[2] += bf_lo(tv.y); r[3] += bf_hi(tv.y); }
                        *(f32x4*)(y + o) = r; }
            }
    }
};

template <class Epi, class Sched>
DI void gemm_phase(LAS unsigned char* lds, const Gemm g, const Sched& S, const Epi& E, const int tid) {
    const int wid = __builtin_amdgcn_readfirstlane(tid >> 6), lane = tid & 63, wr = wid >> 2, wc = wid & 3, fr = lane & 15, fq = lane >> 4;
    const int K = g.K, nt = K / BK;
    unsigned voffA_, voffB_;
    { int R, C; stage_rc(tid * 16, R, C); const int Rb = Epi::PERM ? ((R & ~31) + perm32(R & 31)) : R;
      voffA_ = (unsigned)(R * g.lda + C) * 2u; voffB_ = (unsigned)(Rb * g.ldb + C) * 2u; }
    const size_t p64offA = (size_t)64 * g.lda * 2, p64offB = (size_t)64 * g.ldb * 2;
    const size_t kstep = (size_t)(BK * 2);
    const size_t hstepA = (size_t)HALF * g.lda * 2, hstepB = (size_t)HALF * g.ldb * 2;
    const size_t tstepA = 2 * hstepA, tstepB = 2 * hstepB;
    const unsigned ldsw = (unsigned)wid * 1024u;
    const int aoff = lds_byte(wr * 64 + fr, fq * 8), boff = lds_byte(wc * 32 + fr, fq * 8);
#define PG8_SA(b, h) (((b) * 2 + (h)) * HTB)
#define PG8_SB(b, h) ((4 + (b) * 2 + (h)) * HTB)
#define PG8_STAGE(bufoff, gbase, voff) do { _Pragma("unroll") for (int _i = 0; _i < 2; ++_i) \
        __builtin_amdgcn_global_load_lds((const unsigned*)((const char*)(gbase) + (size_t)_i * p64##voff + (v##voff##_)), (LAS unsigned*)(lds + (bufoff) + ldsw + _i * 8192), 16, 0, 0); } while (0)
#define PG8_LDA(dst, b, h) do { _Pragma("unroll") for (int m = 0; m < 4; ++m) _Pragma("unroll") for (int k = 0; k < 2; ++k) dst[m][k] = *(const LAS bf16x8*)(lds + PG8_SA(b, h) + aoff + m * 2048 + k * 1024); } while (0)
#define PG8_LDB(dst, b, h) do { _Pragma("unroll") for (int n = 0; n < 2; ++n) _Pragma("unroll") for (int k = 0; k < 2; ++k) dst[n][k] = *(const LAS bf16x8*)(lds + PG8_SB(b, h) + boff + n * 2048 + k * 1024); } while (0)
#define PG8_MMA(ai, bj, At, Bt) do { __builtin_amdgcn_s_setprio(1); _Pragma("unroll") for (int m = 0; m < 4; ++m) _Pragma("unroll") for (int n = 0; n < 2; ++n) _Pragma("unroll") for (int k = 0; k < 2; ++k) \
        acc[ai][bj][m][n] = __builtin_amdgcn_mfma_f32_16x16x32_bf16(Bt[n][k], At[m][k], acc[ai][bj][m][n], 0, 0, 0); __builtin_amdgcn_s_setprio(0); } while (0)
#define PG8_WAIT_V(n) asm volatile("s_waitcnt vmcnt(" #n ")" ::: "memory")
#define PG8_WAIT_L(n) asm volatile("s_waitcnt lgkmcnt(" #n ")" ::: "memory")
#define PG8_BAR __builtin_amdgcn_s_barrier()
#define PG8_SCHED __builtin_amdgcn_sched_barrier(0)
    Unit cur, nxt; int ui = 0;
    if (!S.next(0, cur)) return;
    f32x4 acc[2][2][4][2];
#pragma unroll
    for (int a = 0; a < 2; ++a)
#pragma unroll
        for (int b = 0; b < 2; ++b)
#pragma unroll
            for (int m = 0; m < 4; ++m)
#pragma unroll
                for (int n = 0; n < 2; ++n) acc[a][b][m][n] = (f32x4){0.f, 0.f, 0.f, 0.f};
    bf16x8 At[4][2], B0[2][2], B1[2][2];
    const char* cA = (const char*)g.A + (size_t)cur.pm * tstepA; const char* cB = (const char*)g.Bt + (size_t)cur.pn * tstepB;
    PG8_STAGE(PG8_SB(0, 0), cB, offB); PG8_STAGE(PG8_SA(0, 0), cA, offA); PG8_STAGE(PG8_SB(0, 1), cB + hstepB, offB); PG8_STAGE(PG8_SA(0, 1), cA + hstepA, offA);
    if (wr == 1) PG8_BAR;
    PG8_WAIT_V(4); PG8_BAR;
    PG8_STAGE(PG8_SB(1, 0), cB + kstep, offB); PG8_STAGE(PG8_SA(1, 0), cA + kstep, offA); PG8_STAGE(PG8_SB(1, 1), cB + hstepB + kstep, offB);
    PG8_WAIT_V(6); PG8_BAR;
    for (;;) {
        const bool has_next = S.next(ui + 1, nxt);
        const char* nA = has_next ? (const char*)g.A + (size_t)nxt.pm * tstepA : cA; const char* nB = has_next ? (const char*)g.Bt + (size_t)nxt.pn * tstepB : cB;
        for (int t = 0; t < nt; t += 2) {
            const bool last = (t == nt - 2);
            const char* a1 = cA + (size_t)(t + 1) * kstep;
            const char* a2 = last ? nA : cA + (size_t)(t + 2) * kstep; const char* b2 = last ? nB : cB + (size_t)(t + 2) * kstep;
            const char* a3 = a2 + kstep; const char* b3 = b2 + kstep;
            PG8_LDB(B0, 0, 0); PG8_SCHED; PG8_LDA(At, 0, 0); PG8_STAGE(PG8_SA(1, 1), a1 + hstepA, offA);
            PG8_WAIT_L(8); PG8_BAR; PG8_WAIT_L(0); PG8_MMA(0, 0, At, B0); PG8_BAR; PG8_SCHED;
            PG8_LDB(B1, 0, 1); PG8_STAGE(PG8_SB(0, 0), b2, offB);
            PG8_BAR; PG8_WAIT_L(0); PG8_MMA(0, 1, At, B1); PG8_BAR;
            PG8_LDA(At, 0, 1); PG8_STAGE(PG8_SA(0, 0), a2, offA);
            PG8_BAR; PG8_WAIT_L(0); PG8_MMA(1, 0, At, B0); PG8_BAR; PG8_SCHED;
            PG8_STAGE(PG8_SB(0, 1), b2 + hstepB, offB);
            PG8_WAIT_V(6); PG8_BAR; PG8_MMA(1, 1, At, B1); PG8_BAR;
            PG8_LDB(B0, 1, 0); PG8_SCHED; PG8_LDA(At, 1, 0); PG8_STAGE(PG8_SA(0, 1), a2 + hstepA, offA);
            PG8_WAIT_L(8); PG8_BAR; PG8_WAIT_L(0); PG8_MMA(0, 0, At, B0); PG8_BAR; PG8_SCHED;
            PG8_LDB(B1, 1, 1); PG8_STAGE(PG8_SB(1, 0), b3, offB);
            PG8_BAR; PG8_WAIT_L(0); PG8_MMA(0, 1, At, B1); PG8_BAR;
            PG8_LDA(At, 1, 1); PG8_STAGE(PG8_SA(1, 0), a3, offA);
            PG8_BAR; PG8_WAIT_L(0); PG8_MMA(1, 0, At, B0); PG8_BAR; PG8_SCHED;
            PG8_STAGE(PG8_SB(1, 1), b3 + hstepB, offB);
            PG8_WAIT_V(6); PG8_BAR; PG8_MMA(1, 1, At, B1); PG8_BAR;
        }
        E(acc, cur, wr, wc, fr, fq);
        if (!has_next) break;
#pragma unroll
        for (int a = 0; a < 2; ++a)
#pragma unroll
            for (int b = 0; b < 2; ++b)
#pragma unroll
                for (int m = 0; m < 4; ++m)
#pragma unroll
                    for (int n = 0; n < 2; ++n) acc[a][b][m][n] = (f32x4){0.f, 0.f, 0.f, 0.f};
        cur = nxt; cA = nA; cB = nB; ++ui;
    }
    PG8_WAIT_V(0);
    if (wr == 0) PG8_BAR;
    PG8_BAR;
#undef PG8_SA
#undef PG8_SB
#undef PG8_STAGE
#undef PG8_LDA
#undef PG8_LDB
#undef PG8_MMA
#undef PG8_WAIT_V
#undef PG8_WAIT_L
#undef PG8_BAR
#undef PG8_SCHED
}
}

DI int win_srccol(int n) {
    if (n < 384) return n;
    if (n < 448) return 384 + (n - 384);
    if (n < 960) return 512 + (n - 448);
    if (n < 1024) return 1024 + (n - 960);
    if (n < 1792) return 1096 + (n - 1024);
    if (n < 2048) return 1864 + (n - 1792);
    if (n < 2432) return 2376 + (n - 2048);
    if (n < 2816) return 2760 + (n - 2432);
    if (n < 2880) return 448 + (n - 2816);
    if (n < 3136) return 2120 + (n - 2880);
    if (n < 3520) return 3144 + (n - 3136);
    if (n < 3528) return 1088 + (n - 3520);
    return -1;
}
DI void convT(unsigned char* shm, const float* src, int K, int Nsrc, bf16_t* dst, int Ndst, int mode, const int tid) {
    unsigned short* tl = (unsigned short*)shm;
    const int ntk = K / 64, ntiles = (Ndst / 64) * ntk;
    for (int tile = blockIdx.x; tile < ntiles; tile += gridDim.x) {
        const int n0 = (tile / ntk) * 64, k0 = (tile % ntk) * 64;
        const int nx = tid & 63, ky = tid >> 6;
        const int sc = mode ? win_srccol(n0 + nx) : (n0 + nx);
#pragma unroll
        for (int p = 0; p < 8; ++p) { const int k = k0 + ky + 8 * p; const float v = sc >= 0 ? src[(size_t)k * Nsrc + sc] : 0.f; tl[nx * 66 + ky + 8 * p] = f2bf(v); }
        __syncthreads();
#pragma unroll
        for (int p = 0; p < 8; ++p) { const int n = ky + 8 * p; dst[(size_t)(n0 + n) * K + k0 + nx] = tl[n * 66 + nx]; }
        __syncthreads();
    }
}
DI void conv_vec(const float* src, bf16_t* dst, size_t n8, const int tid) {
    for (size_t i = (size_t)blockIdx.x * 512 + tid; i < n8; i += (size_t)gridDim.x * 512) {
        const f32x4 a = *(const f32x4*)(src + i * 8), b = *(const f32x4*)(src + i * 8 + 4);
        u32x4 w; w.x = pk2(a[0], a[1]); w.y = pk2(a[2], a[3]); w.z = pk2(b[0], b[1]); w.w = pk2(b[2], b[3]);
        *(u32x4*)(dst + i * 8) = w;
    }
}
DI int rel_bucket(int n) {
    if (n < 16) return n;
    int large = 16 + (int)(logf((float)n / 16.0f) / 4.852030263919617f * 16.0f);
    return large < 31 ? large : 31;
}
DI void phase_convert(const Args& a, unsigned char* shm, const int tid) {
    bf16_t* wb = (bf16_t*)(a.ws + WS_WB);
    for (int l = 0; l < 2; ++l) {
        bf16_t* w = wb + (size_t)l * W_LAYER;
        convT(shm, a.in[2] + (size_t)l * 1024 * 3528, 1024, 3528, w + WO_IN, NWIN, 1, tid);
        convT(shm, a.in[3] + (size_t)l * 1024 * 3072, 1024, 3072, w + WO_G, 3072, 0, tid);
        convT(shm, a.in[4] + (size_t)l * 384 * 1024, 384, 1024, w + WO_BA, 1024, 0, tid);
        convT(shm, a.in[5] + (size_t)l * 256 * 1024, 256, 1024, w + WO_BB, 1024, 0, tid);
        convT(shm, a.in[6] + (size_t)l * 384 * 1024, 384, 1024, w + WO_BC, 1024, 0, tid);
        convT(shm, a.in[7] + (size_t)l * 1024 * 1024, 1024, 1024, w + WO_OUT, 1024, 0, tid);
        convT(shm, a.in[10] + (size_t)l * 1024 * 4096, 1024, 4096, w + WO_UP, 4096, 0, tid);
        convT(shm, a.in[11] + (size_t)l * 4096 * 1024, 4096, 1024, w + WO_DN, 1024, 0, tid);
        convT(shm, a.in[12] + (size_t)l * 1024 * 1024, 1024, 1024, w + WO_PG, 1024, 0, tid);
        convT(shm, a.in[13] + (size_t)l * 256 * 1024, 256, 1024, w + WO_PL, 1024, 0, tid);
    }
    conv_vec(a.in[0], (bf16_t*)(a.ws + WS_XB), (size_t)MTOK * 1024 / 8, tid);
    conv_vec(a.in[1], (bf16_t*)(a.ws + WS_PB), (size_t)2 * MTOK * 256 / 8, tid);
    float* lut = (float*)(a.ws + WS_LUT);
    const float* rb = a.in[16];
    for (int i = blockIdx.x * 512 + tid; i < 24 * 2048; i += gridDim.x * 512) {
        const int hd = i >> 11, d = i & 2047;
        lut[i] = rb[rel_bucket(d) * 24 + hd] * LOG2E;
    }
}

DI float wave_sum(float v) {
#pragma unroll
    for (int o = 32; o >= 1; o >>= 1) v += __shfl_xor(v, o);
    return v;
}
template <bool FINAL>
DI void phase_ln(float* y, bf16_t* xb, float* stats, const float* g, const float* b, const int tid) {
    const int wid = tid >> 6, lane = tid & 63;
    f32x4 gv[4], bv[4];
#pragma unroll
    for (int k = 0; k < 4; ++k) { gv[k] = *(const f32x4*)(g + k * 256 + lane * 4); bv[k] = *(const f32x4*)(b + k * 256 + lane * 4); }
    for (int row = blockIdx.x * 8 + wid; row < MTOK; row += gridDim.x * 8) {
        float* yp = y + (size_t)row * 1024;
        f32x4 v[4]; float s = 0.f;
#pragma unroll
        for (int k = 0; k < 4; ++k) { v[k] = *(const f32x4*)(yp + k * 256 + lane * 4); s += v[k][0] + v[k][1] + v[k][2] + v[k][3]; }
        const float mean = wave_sum(s) * (1.0f / 1024.0f);
        float q = 0.f;
#pragma unroll
        for (int k = 0; k < 4; ++k) { v[k] = v[k] - mean; q += v[k][0] * v[k][0] + v[k][1] * v[k][1] + v[k][2] * v[k][2] + v[k][3] * v[k][3]; }
        const float var = wave_sum(q) * (1.0f / 1024.0f);
        const float rs = 1.0f / sqrtf(var + 1e-5f);
        if (!FINAL && lane == 0) { f32x2 sm = {mean, rs}; *(f32x2*)(stats + 2 * (size_t)row) = sm; }
#pragma unroll
        for (int k = 0; k < 4; ++k) { const f32x4 o = v[k] * rs * gv[k] + bv[k];
            if (FINAL) *(f32x4*)(yp + k * 256 + lane * 4) = o;
            else { u32x2 w; w.x = pk2(o[0], o[1]); w.y = pk2(o[2], o[3]); *(u32x2*)(xb + (size_t)row * 1024 + k * 256 + lane * 4) = w; } }
    }
}

DI int pi_row(int r) { return (r & 3) | (((r >> 3) & 1) << 2) | (((r >> 2) & 1) << 3) | (r & 16); }
DI void task_rot(int tau, int& b, int& qt) { b = tau >> 6; qt = ((tau & 63) + 8 * (tau >> 8)) & 63; }
DI bool task_map(int k, int& b, int& qt) {
    if (gridDim.x == 256) { if (k >= 8) return false; const int xcd = blockIdx.x & 7, slot = blockIdx.x >> 3; b = xcd + 8 * (k >> 1); qt = (k & 1) ? 63 - slot : slot; return true; }
    const int tau = blockIdx.x + k * gridDim.x; if (tau >= 2048) return false; task_rot(tau, b, qt); return true;
}

DI void a1_task(unsigned char* shm, const bf16_t* prm, const bf16_t* prt, unsigned* mask, int b, int qt, const int tid) {
    const int wid = __builtin_amdgcn_readfirstlane(tid >> 6), lane = tid & 63, r = lane & 31, h = lane >> 5;
    const int t0 = qt * 32, tok0 = b * SEQ;
    unsigned* cnt = (unsigned*)(shm + 33280);
#pragma unroll
    for (int p = 0; p < 4; ++p) { const int c = tid + p * 512, row = c >> 6, ch = c & 63;
        *(u32x4*)(shm + row * 1040 + ch * 16) = *(const u32x4*)(prm + (size_t)(tok0 + t0 + row) * RM_LD + C_IQ + ch * 8); }
    cnt[tid] = 0u; cnt[tid + 512] = 0u;
    float* wqs = (float*)(shm + 33280 + 4096);
    if (tid < 256) wqs[tid] = bf2f(prt[(size_t)(R_IW + (tid >> 5)) * MTOK + tok0 + t0 + (tid & 31)]);
    __syncthreads();
    unsigned key[8][16];
    const bf16_t* kp = prm + (size_t)(tok0 + pi_row(r)) * RM_LD + C_IK + 8 * h;
    bf16x8 kf[4];
    if (wid <= qt) {
#pragma unroll
        for (int ks = 0; ks < 4; ++ks) kf[ks] = *(const bf16x8*)(kp + (size_t)(wid * 32) * RM_LD + 16 * ks);
    }
#pragma unroll
    for (int jt = 0; jt < 8; ++jt) {
        const int kt = wid + 8 * jt;
        if (kt <= qt) {
            const int s0 = kt * 32;
            bf16x8 kn[4];
            const bool hn = (jt < 7) && (kt + 8 <= qt);
            if (hn) {
#pragma unroll
                for (int ks = 0; ks < 4; ++ks) kn[ks] = *(const bf16x8*)(kp + (size_t)(s0 + 256) * RM_LD + 16 * ks);
            }
            float idx[16];
#pragma unroll
            for (int i = 0; i < 16; ++i) idx[i] = 0.f;
#pragma unroll 1
            for (int hh = 0; hh < 8; ++hh) {
                f32x16 acc;
#pragma unroll
                for (int i = 0; i < 16; ++i) acc[i] = 0.f;
                const unsigned char* qb = shm + r * 1040 + hh * 128 + 16 * h;
#pragma unroll
                for (int ks = 0; ks < 4; ++ks) { const bf16x8 qf = *(const bf16x8*)(qb + 32 * ks); acc = MFMA32(kf[ks], qf, acc); }
                const float wv = wqs[hh * 32 + r];
#pragma unroll
                for (int i = 0; i < 16; ++i) idx[i] = fmaf(wv, fmaxf(acc[i], 0.f), idx[i]);
            }
#pragma unroll
            for (int i = 0; i < 16; ++i) {
                const int s = s0 + 16 * (i >> 3) + 8 * h + (i & 7);
                const unsigned u = __float_as_uint(idx[i] + 0.0f);
                const unsigned k = (u & 0x80000000u) ? ~u : (u | 0x80000000u);
                key[jt][i] = (s <= t0 + r) ? k : 0u;
            }
            if (hn) {
#pragma unroll
                for (int ks = 0; ks < 4; ++ks) kf[ks] = kn[ks];
            }
        } else {
#pragma unroll
            for (int i = 0; i < 16; ++i) key[jt][i] = 0u;
        }
    }
    unsigned T = 0u;
    if (qt >= 8) {
        const int nheld = (qt >= wid) ? ((qt - wid) >> 3) + 1 : 0;
        bool done = false;
        for (int bit = 31; bit >= 0; --bit) {
            const unsigned cand = T | (1u << bit);
            int c = 0;
#pragma unroll
            for (int jt = 0; jt < 8; ++jt) {
                if (jt < nheld) {
#pragma unroll
                    for (int i = 0; i < 16; ++i) c += (key[jt][i] >= cand) ? 1 : 0;
                }
            }
            c += __shfl_xor(c, 32);
            if (h == 0 && c) atomicAdd(&cnt[(31 - bit) * 32 + r], (unsigned)c);
            __syncthreads();
            const unsigned tot = cnt[(31 - bit) * 32 + r];
            if (!done) { if (tot >= 256u) T = cand; if (tot == 256u) done = true; }
            if (__ballot(!done) == 0ull) break;
        }
    }
    if (T < 1u) T = 1u;
#pragma unroll
    for (int jt = 0; jt < 8; ++jt) {
        const int kt = wid + 8 * jt;
        if (kt <= qt) {
            unsigned part = 0u;
#pragma unroll
            for (int i = 0; i < 16; ++i) part |= (key[jt][i] >= T ? 1u : 0u) << (16 * (i >> 3) + 8 * h + (i & 7));
            part |= (unsigned)__shfl_xor((int)part, 32);
            if (h == 0) mask[(size_t)(tok0 + t0 + r) * 64 + kt] = part;
        }
    }
    __syncthreads();
}
DI void phase_a1(const Args& a, unsigned char* shm, const int tid) {
    const bf16_t* prm = (const bf16_t*)(a.ws + WS_R1);
    const bf16_t* prt = prm + (size_t)MTOK * RM_LD;
    unsigned* mask = (unsigned*)(a.ws + WS_MASK);
    float* kmean = (float*)(a.ws + WS_KMEAN);
    for (int k = 0;; ++k) { int b, qt; if (!task_map(k, b, qt)) break; a1_task(shm, prm, prt, mask, b, qt, tid); }
    for (int j = 2048 + blockIdx.x; j < 2048 + 192; j += gridDim.x) {
        {
            const int id = (j - 2048) * 8 + (tid >> 6), lane = tid & 63;
            const int b = id / 48, hd = (id >> 3) % 6, n = id & 7;
            const bf16_t* p = prm + (size_t)(b * SEQ + n * 256) * RM_LD + C_CK + hd * 64 + lane;
            float s = 0.f;
            for (int t = 0; t < 256; ++t) s += bf2f(p[(size_t)t * RM_LD]);
            kmean[(size_t)((b * 6 + hd) * 8 + n) * 64 + lane] = s * (1.0f / 256.0f);
        }
    }
}

struct AttnSt { float m, l; f32x16 o0, o1; };
struct AttnCtx {
    LAS unsigned char* wl;
    const float* lut;
    const bf16_t* kg;
    const bf16_t* vg;
    unsigned koff[4], voff[4];
    int kfo[4], vfo[2][2];
};
DI void attn_dma(const AttnCtx& c, int kt) {
    const char* kb = (const char*)(c.kg + (size_t)(kt * 32) * RM_LD);
    const char* vb = (const char*)(c.vg + kt * 32);
#pragma unroll
    for (int j = 0; j < 4; ++j) __builtin_amdgcn_global_load_lds((const unsigned*)(kb + c.koff[j]), (LAS unsigned*)(c.wl + 8192 + j * 1024), 16, 0, 0);
#pragma unroll
    for (int j = 0; j < 4; ++j) __builtin_amdgcn_global_load_lds((const unsigned*)(vb + c.voff[j]), (LAS unsigned*)(c.wl + 12288 + j * 1024), 16, 0, 0);
}
template <int MODE, bool UNI>
DI void attn_compute(const bf16x8 (&qf)[4], const bf16x8 (&kf)[4], const bf16x8 (&vf)[2][2], int kt, int d00, const float* lut, float ubias, AttnSt& st,
                     unsigned W, int win, int dmask, bool lane_sel) {
    const int s0 = kt * 32;
    f32x16 sx;
#pragma unroll
    for (int i = 0; i < 16; ++i) sx[i] = 0.f;
#pragma unroll
    for (int ks = 0; ks < 4; ++ks) sx = MFMA32(kf[ks], qf[ks], sx);
    const int d0 = d00 - s0;
    float sv[16]; float mx = NEGF;
#pragma unroll
    for (int i = 0; i < 16; ++i) {
        const int ci = 16 * (i >> 3) + (i & 7);
        const int dist = d0 - ci;
        bool v;
        if (MODE == 0) v = ((W >> ci) & 1u) != 0u;
        else if (MODE == 1) v = ((unsigned)dist <= (unsigned)win) && ((dist & dmask) == 0);
        else if (MODE == 2) v = lane_sel;
        else v = dist >= 0;
        const float bias = UNI ? ubias : lut[dist & 2047];
        float s = fmaf(sx[i], SC2, bias);
        s = v ? s : NEGF;
        sv[i] = s; mx = fmaxf(mx, s);
    }
    mx = fmaxf(mx, __shfl_xor(mx, 32));
    const float mnew = fmaxf(st.m, mx);
    const float msafe = (mnew > -1e29f) ? mnew : 0.f;
    if (__ballot(mnew > st.m) != 0ull) {
        const float alpha = __builtin_amdgcn_exp2f(st.m - msafe);
        st.l *= alpha; st.m = mnew;
#pragma unroll
        for (int i = 0; i < 16; ++i) { st.o0[i] *= alpha; st.o1[i] *= alpha; }
    }
    float ps = 0.f; float p[16];
#pragma unroll
    for (int i = 0; i < 16; ++i) { const float e = __builtin_amdgcn_exp2f(sv[i] - msafe); p[i] = e; ps += e; }
    st.l += ps;
    u32x4 w0, w1;
    w0.x = pk2(p[0], p[1]); w0.y = pk2(p[2], p[3]); w0.z = pk2(p[4], p[5]); w0.w = pk2(p[6], p[7]);
    w1.x = pk2(p[8], p[9]); w1.y = pk2(p[10], p[11]); w1.z = pk2(p[12], p[13]); w1.w = pk2(p[14], p[15]);
    const bf16x8 pf0 = __builtin_bit_cast(bf16x8, w0), pf1 = __builtin_bit_cast(bf16x8, w1);
    st.o0 = MFMA32(vf[0][0], pf0, st.o0); st.o0 = MFMA32(vf[0][1], pf1, st.o0);
    st.o1 = MFMA32(vf[1][0], pf0, st.o1); st.o1 = MFMA32(vf[1][1], pf1, st.o1);
}
DI void attn_compute_sp4(const bf16x8 (&qf)[4], const bf16x8 (&kf)[4], const bf16x8 (&vf)[2][2], int kt, int d00, const float* lut, AttnSt& st, int win, int dmask) {
    const int s0 = kt * 32;
    f32x16 sx;
#pragma unroll
    for (int i = 0; i < 16; ++i) sx[i] = 0.f;
#pragma unroll
    for (int ks = 0; ks < 4; ++ks) sx = MFMA32(kf[ks], qf[ks], sx);
    const int d0 = d00 - s0, e = d0 & 3;
    const bool e0 = (e == 0), e1 = (e == 1), e2 = (e == 2);
    float sv[4]; float mx = NEGF;
#pragma unroll
    for (int g = 0; g < 4; ++g) {
        const float x = e0 ? sx[4 * g] : (e1 ? sx[4 * g + 1] : (e2 ? sx[4 * g + 2] : sx[4 * g + 3]));
        const int dist = d0 - (16 * (g >> 1) + 4 * (g & 1)) - e;
        const bool v = ((unsigned)dist <= (unsigned)win) && ((dist & dmask) == 0);
        const float bias = lut[dist & 2047];
        float sc = fmaf(x, SC2, bias);
        sc = v ? sc : NEGF;
        sv[g] = sc; mx = fmaxf(mx, sc);
    }
    mx = fmaxf(mx, __shfl_xor(mx, 32));
    const float mnew = fmaxf(st.m, mx);
    const float msafe = (mnew > -1e29f) ? mnew : 0.f;
    if (__ballot(mnew > st.m) != 0ull) {
        const float alpha = __builtin_amdgcn_exp2f(st.m - msafe);
        st.l *= alpha; st.m = mnew;
#pragma unroll
        for (int i = 0; i < 16; ++i) { st.o0[i] *= alpha; st.o1[i] *= alpha; }
    }
    float ps = 0.f; float p[16];
#pragma unroll
    for (int g = 0; g < 4; ++g) {
        const float pe = __builtin_amdgcn_exp2f(sv[g] - msafe); ps += pe;
        p[4 * g] = e0 ? pe : 0.f; p[4 * g + 1] = e1 ? pe : 0.f; p[4 * g + 2] = e2 ? pe : 0.f; p[4 * g + 3] = (e == 3) ? pe : 0.f;
    }
    st.l += ps;
    u32x4 w0, w1;
    w0.x = pk2(p[0], p[1]); w0.y = pk2(p[2], p[3]); w0.z = pk2(p[4], p[5]); w0.w = pk2(p[6], p[7]);
    w1.x = pk2(p[8], p[9]); w1.y = pk2(p[10], p[11]); w1.z = pk2(p[12], p[13]); w1.w = pk2(p[14], p[15]);
    const bf16x8 pf0 = __builtin_bit_cast(bf16x8, w0), pf1 = __builtin_bit_cast(bf16x8, w1);
    st.o0 = MFMA32(vf[0][0], pf0, st.o0); st.o0 = MFMA32(vf[0][1], pf1, st.o0);
    st.o1 = MFMA32(vf[1][0], pf0, st.o1); st.o1 = MFMA32(vf[1][1], pf1, st.o1);
}
template <int MODE>
DI void attn_range(const AttnCtx& c, const bf16x8 (&qf)[4], int lo, int hi, int t0, int d00, AttnSt& st, const unsigned* maskrow, int h8, int win, int dmask, bool lane_sel) {
    if (lo > hi) return;
    attn_dma(c, lo);
    unsigned Wn = 0u;
    if (MODE == 0) Wn = maskrow[lo];
#pragma unroll 1
    for (int kt = lo; kt <= hi; ++kt) {
        asm volatile("s_waitcnt vmcnt(0)" ::: "memory");
        bf16x8 kf[4], vf[2][2];
#pragma unroll
        for (int ks = 0; ks < 4; ++ks) kf[ks] = *(const LAS bf16x8*)(c.wl + 8192 + c.kfo[ks]);
#pragma unroll
        for (int mt = 0; mt < 2; ++mt)
#pragma unroll
            for (int s = 0; s < 2; ++s) vf[mt][s] = *(const LAS bf16x8*)(c.wl + 12288 + c.vfo[mt][s]);
        const unsigned W = Wn >> h8;
        const int dlo = t0 - kt * 32 - 31;
        float ub = 0.f; bool uni = false;
        if (dlo >= 182) { const unsigned ua = __builtin_amdgcn_readfirstlane(__float_as_uint(c.lut[dlo])), ue = __builtin_amdgcn_readfirstlane(__float_as_uint(c.lut[dlo + 62])); uni = (ua == ue); ub = __uint_as_float(ua); }
        asm volatile("s_waitcnt lgkmcnt(0)" ::: "memory");
        if (kt < hi) { attn_dma(c, kt + 1); if (MODE == 0) Wn = maskrow[kt + 1]; }
        if (MODE == 1 && dmask != 0) attn_compute_sp4(qf, kf, vf, kt, d00, c.lut, st, win, dmask);
        else attn_compute<MODE, false>(qf, kf, vf, kt, d00, c.lut, 0.f, st, W, win, dmask, lane_sel);
    }
}

DI void load_lut(float* lut, const float* glut, int col, int lane) {
    __builtin_amdgcn_fence(__ATOMIC_ACQ_REL, "wavefront");
#pragma unroll
    for (int k = 0; k < 8; ++k) *(f32x4*)(lut + k * 256 + lane * 4) = *(const f32x4*)(glut + (size_t)col * 2048 + k * 256 + lane * 4);
    __builtin_amdgcn_fence(__ATOMIC_ACQ_REL, "wavefront");
    __builtin_amdgcn_wave_barrier();
}

DI void attn_job(const Args& a, unsigned char* wsh, LAS unsigned char* wl, int type, int b, int qt, int hd, const int tid) {
    const int lane = tid & 63, r = lane & 31, h = lane >> 5;
    const bf16_t* prm = (const bf16_t*)(a.ws + WS_R1);
    const bf16_t* prt = prm + (size_t)MTOK * RM_LD;
    const float* glut = (const float*)(a.ws + WS_LUT);
    const unsigned* mask = (const unsigned*)(a.ws + WS_MASK);
    const float* kmean = (const float*)(a.ws + WS_KMEAN);
    bf16_t* oabc = (bf16_t*)(a.ws + WS_OABC);
    float* lut = (float*)wsh;
    const int t0 = qt * 32, tok0 = b * SEQ;
    const int d00 = t0 + r - 8 * h, h8 = 8 * h;
    const unsigned* maskrow = mask + (size_t)(tok0 + t0 + r) * 64;
    AttnCtx c; c.wl = wl; c.lut = lut;
#pragma unroll
    for (int j = 0; j < 4; ++j) {
        const int rk = 8 * j + (lane >> 3), ck = (lane & 7) ^ ((rk >> 1) & 7);
        c.koff[j] = (unsigned)(pi_row(rk) * RM_LD + ck * 8) * 2u;
        const int rv = 16 * j + (lane >> 2), cv = (lane & 3) ^ ((rv >> 2) & 3);
        c.voff[j] = (unsigned)(rv * MTOK + cv * 8) * 2u;
        c.kfo[j] = r * 128 + (((2 * j + h) ^ ((r >> 1) & 7)) * 16);
    }
#pragma unroll
    for (int mt = 0; mt < 2; ++mt)
#pragma unroll
        for (int s = 0; s < 2; ++s) c.vfo[mt][s] = (32 * mt + r) * 64 + (((2 * s + h) ^ ((r >> 2) & 3)) * 16);
    AttnSt st; st.m = NEGF; st.l = 0.f;
#pragma unroll
    for (int i = 0; i < 16; ++i) { st.o0[i] = 0.f; st.o1[i] = 0.f; }
    const int ng = (type == 1) ? 3 : 1;
    int ocol = 0;
    for (int g = 0; g < ng; ++g) {
        int qcol, kcol, vrow, bcol;
        if (type == 0) { qcol = C_AQ + hd * 64; kcol = C_AK; vrow = R_AV; bcol = hd; ocol = hd * 64; }
        else if (type == 1) { qcol = C_BQ + (g * 4 + hd) * 64; kcol = C_BK + hd * 64; vrow = R_BV + hd * 64; bcol = 6 + g * 4 + hd; ocol = 384 + hd * 64; }
        else { qcol = C_CQ + hd * 64; kcol = C_CK + hd * 64; vrow = R_CV + hd * 64; bcol = 18 + hd; ocol = 640 + hd * 64; }
        load_lut(lut, glut, bcol, lane);
        bf16x8 qf[4];
        const bf16_t* qp = prm + (size_t)(tok0 + t0 + r) * RM_LD + qcol + 8 * h;
#pragma unroll
        for (int ks = 0; ks < 4; ++ks) qf[ks] = *(const bf16x8*)(qp + 16 * ks);
        c.kg = prm + (size_t)tok0 * RM_LD + kcol;
        c.vg = prt + (size_t)vrow * MTOK + tok0;
        if (type == 0) {
            attn_range<0>(c, qf, 0, qt, t0, d00, st, maskrow, h8, 0, 0, false);
        } else if (type == 1) {
            const int win = (g == 0) ? 128 : (g == 1 ? 512 : 2048), dmask = (g == 0) ? 0 : (g == 1 ? 3 : 15);
            int lo = t0 - win; if (lo < 0) lo = 0;
            attn_range<1>(c, qf, lo >> 5, qt, t0, d00, st, maskrow, h8, win, dmask, false);
        } else {
            const int cur = qt >> 3;
            float gate[7];
            const float* km = kmean + (size_t)((b * 6 + hd) * 8) * 64 + 8 * h;
#pragma unroll
            for (int n = 0; n < 7; ++n) {
                float s = 0.f;
                if (n < cur) {
#pragma unroll
                    for (int ks = 0; ks < 4; ++ks) {
                        const f32x4 k0 = *(const f32x4*)(km + n * 64 + 16 * ks), k1 = *(const f32x4*)(km + n * 64 + 16 * ks + 4);
                        const u32x4 qw = __builtin_bit_cast(u32x4, qf[ks]);
                        s += bf_lo(qw.x) * k0[0] + bf_hi(qw.x) * k0[1] + bf_lo(qw.y) * k0[2] + bf_hi(qw.y) * k0[3]
                           + bf_lo(qw.z) * k1[0] + bf_hi(qw.z) * k1[1] + bf_lo(qw.w) * k1[2] + bf_hi(qw.w) * k1[3];
                    }
                    s += __shfl_xor(s, 32);
                } else s = -__builtin_inff();
                gate[n] = s;
            }
            unsigned sel = 0u;
#pragma unroll
            for (int rd = 0; rd < 3; ++rd) {
                float bv = -__builtin_inff(); int bi = -1;
#pragma unroll
                for (int n = 0; n < 7; ++n) if (gate[n] > bv) { bv = gate[n]; bi = n; }
                if (bi >= 0) sel |= 1u << bi;
#pragma unroll
                for (int n = 0; n < 7; ++n) if (n == bi) gate[n] = -__builtin_inff();
            }
            for (int n = 0; n < cur; ++n) {
                const bool ls = ((sel >> n) & 1u) != 0u;
                if (__ballot(ls) == 0ull) continue;
                attn_range<2>(c, qf, n * 8, n * 8 + 7, t0, d00, st, maskrow, h8, 0, 0, ls);
            }
            attn_range<3>(c, qf, cur * 8, qt, t0, d00, st, maskrow, h8, 0, 0, false);
        }
    }
    const float lt = st.l + __shfl_xor(st.l, 32);
    const float inv = 1.0f / lt;
    bf16_t* op = oabc + (size_t)(tok0 + t0 + r) * 1024 + ocol + 4 * h;
#pragma unroll
    for (int g4 = 0; g4 < 4; ++g4) {
        u32x2 w;
        w.x = pk2(st.o0[4 * g4] * inv, st.o0[4 * g4 + 1] * inv); w.y = pk2(st.o0[4 * g4 + 2] * inv, st.o0[4 * g4 + 3] * inv);
        *(u32x2*)(op + 8 * g4) = w;
        w.x = pk2(st.o1[4 * g4] * inv, st.o1[4 * g4 + 1] * inv); w.y = pk2(st.o1[4 * g4 + 2] * inv, st.o1[4 * g4 + 3] * inv);
        *(u32x2*)(op + 32 + 8 * g4) = w;
    }
}
DI void phase_attn(const Args& a, unsigned char* shm, const int tid) {
    const int wid = __builtin_amdgcn_readfirstlane(tid >> 6);
    unsigned char* wsh = shm + wid * 16384;
    LAS unsigned char* wl = (LAS unsigned char*)shm + wid * 16384;
    for (int it = 0;; ++it) {
        int b, qt; if (!task_map(it, b, qt)) break;
        const int role = (wid + it) & 7;
        if (role < 6) { attn_job(a, wsh, wl, 0, b, qt, role, tid); attn_job(a, wsh, wl, 2, b, qt, role, tid); }
        else { attn_job(a, wsh, wl, 1, b, qt, role - 6, tid); attn_job(a, wsh, wl, 1, b, qt, role - 4, tid); }
    }
}

#define XB_TMO      128
#define XB_XCNT(j)  (256  + 64 * (j))
#define XB_XSUB(j)  (1280 + 64 * (j))
#define XB_XGEN(j)  (2304 + 64 * (j))
#define XB_TOP      3328
#define XB_TOPGEN   3392
#define XCD_BAR_WORDS 3456
#define XB_SPIN_CAP (1u << 20)
DI unsigned xb_ld(unsigned* p)              { return __hip_atomic_load(p, __ATOMIC_RELAXED, __HIP_MEMORY_SCOPE_AGENT); }
DI unsigned xb_add(unsigned* p, unsigned v) { return __hip_atomic_fetch_add(p, v, __ATOMIC_RELAXED, __HIP_MEMORY_SCOPE_AGENT); }
DI unsigned xb_xcc_id() { return (unsigned)__builtin_amdgcn_s_getreg((3 << 11) | 20) & 0xFu; }
#define XB_SPIN(cond, bar) do { unsigned _sp = 0; while (cond) { __builtin_amdgcn_s_sleep(1); \
    if ((++_sp & 255u) == 0u) { if (xb_ld(&(bar)[XB_TMO])) break; if (_sp > XB_SPIN_CAP) { atomicAdd(&(bar)[XB_TMO], 1u); break; } } } } while (0)
struct XcdBarrier { unsigned* bar; unsigned x; volatile LAS unsigned* st; };
DI void xcd_barrier_complete(unsigned* bar, unsigned x, unsigned& nloc, unsigned& nx) {
    const unsigned G = gridDim.x * gridDim.y * gridDim.z;
    unsigned sum, cnt, mine, sp = 0u;
    for (;;) {
        sum = 0u; cnt = 0u; mine = 0u;
#pragma unroll
        for (unsigned j = 0; j < 16; ++j) { const unsigned c = xb_ld(&bar[XB_XCNT(j)]); sum += c; cnt += (c > 0u) ? 1u : 0u; mine = (j == x) ? c : mine; }
        if (sum == G) break;
        __builtin_amdgcn_s_sleep(1);
        if ((++sp & 255u) == 0u) { if (xb_ld(&bar[XB_TMO])) break; if (sp > XB_SPIN_CAP) { atomicAdd(&bar[XB_TMO], 1u); break; } }
    }
    nloc = mine > 0u ? mine : 1u; nx = cnt > 0u ? cnt : 1u;
}
DI void xcd_barrier(const XcdBarrier& b, const int tid) {
    asm volatile("s_waitcnt vmcnt(0)" ::: "memory");
    __syncthreads();
    if (tid == 0) {
        unsigned* bar = b.bar;
        __builtin_amdgcn_s_waitcnt(0);
        unsigned nloc = b.st[0], nx = b.st[1];
        if (nloc == 0u) { xcd_barrier_complete(bar, b.x, nloc, nx); b.st[0] = nloc; b.st[1] = nx; }
        const unsigned old = xb_add(&bar[XB_XSUB(b.x)], 1u);
        const unsigned gen = old / nloc;
        if (old + 1u == (gen + 1u) * nloc) {
            __builtin_amdgcn_fence(__ATOMIC_RELEASE, "agent");
            asm volatile("s_waitcnt vmcnt(0)" ::: "memory");
            const unsigned og = xb_add(&bar[XB_TOP], 1u);
            const unsigned tg = og / nx;
            if (og + 1u == (tg + 1u) * nx) xb_add(&bar[XB_TOPGEN], 1u);
            else XB_SPIN(xb_ld(&bar[XB_TOPGEN]) == tg, bar);
            __builtin_amdgcn_fence(__ATOMIC_ACQUIRE, "agent");
            xb_add(&bar[XB_XGEN(b.x)], 1u);
            asm volatile("s_waitcnt vmcnt(0)" ::: "memory");
        } else {
            XB_SPIN(xb_ld(&bar[XB_XGEN(b.x)]) == gen, bar);
            __builtin_amdgcn_fence(__ATOMIC_ACQUIRE, "agent");
            asm volatile("s_waitcnt vmcnt(0)" ::: "memory");
        }
    }
    __syncthreads();
}

__global__ void __launch_bounds__(512, 2) mega_fwd(Args a_) {
    extern __shared__ __attribute__((aligned(16))) unsigned char shm[];
    cg::grid_group grid = cg::this_grid();
    LAS unsigned char* lds = (LAS unsigned char*)shm;
    const int G = gridDim.x, c = blockIdx.x;
#ifndef PROBE_REP
#define PROBE_REP -2
#endif
    const int ph_lo = a_.ph_lo, ph_hi = a_.ph_hi;
    const int wave_id = __builtin_amdgcn_readfirstlane(threadIdx.x >> 6);
    XcdBarrier xbar;
    { volatile LAS unsigned* st = (volatile LAS unsigned*)(lds + 131072);
      if (threadIdx.x == 0) { st[0] = 0u; st[1] = 0u; }
      __syncthreads();
      xbar.bar = (unsigned*)(a_.ws + WS_BAR); xbar.x = xb_xcc_id(); xbar.st = st;
      if (threadIdx.x == 0) (void)xb_add(&xbar.bar[XB_XCNT(xbar.x)], 1u); }
    for (int phx = 2 * ph_lo; phx < 2 * ph_hi; ++phx) {
        const int ph = phx >> 1;
        if (phx & 1) { const bool rep = (PROBE_REP == -1) ? (ph == 0) : (ph > 0 && (ph - 1) % 9 == PROBE_REP); if (!rep) continue; }
        const Args& a = a_;
        int tid = wave_id * 64 + (int)__builtin_amdgcn_mbcnt_hi(~0u, __builtin_amdgcn_mbcnt_lo(~0u, 0u)); asm volatile("" : "+v"(tid));
        bf16_t* xb = (bf16_t*)(a.ws + WS_XB);
        bf16_t* r1 = (bf16_t*)(a.ws + WS_R1);
        bf16_t* oabc = (bf16_t*)(a.ws + WS_OABC);
        float* stats = (float*)(a.ws + WS_STATS);
        if (ph == 0) phase_convert(a, shm, tid);
        else {
            const int l = (ph - 1) / 9, sp = (ph - 1) % 9;
            const bf16_t* w = (const bf16_t*)(a.ws + WS_WB) + (size_t)l * W_LAYER;
            const float* xin = (l == 0) ? a.in[0] : a.out;
            if (sp == 0) {
                { pg8::Gemm g{xb, w + WO_IN, 1024, 1024, 1024}; pg8::StaticOrder S; S.init(256, 11, G, c); pg8::EpiBf16<0> E{r1, RM_LD}; pg8::gemm_phase(lds, g, S, E, tid); }
                { pg8::Gemm g{w + WO_IN + (size_t)RM_LD * 1024, xb, 1024, 1024, 1024}; pg8::StaticOrder S; S.init(3, 256, G, c); pg8::EpiBf16<0> E{r1 + (size_t)MTOK * RM_LD, MTOK}; pg8::gemm_phase(lds, g, S, E, tid); }
            } else if (sp == 1) phase_a1(a, shm, tid);
            else if (sp == 2) phase_attn(a, shm, tid);
            else if (sp == 3) {
                pg8::StaticOrder S; S.init(256, 4, G, c);
                { pg8::Gemm g{oabc, w + WO_BA, 1024, 384, 384}; pg8::EpiBf16<0> E{r1, 3072}; pg8::gemm_phase(lds, g, S, E, tid); }
                { pg8::Gemm g{oabc + 384, w + WO_BB, 1024, 256, 256}; pg8::EpiBf16<0> E{r1 + 1024, 3072}; pg8::gemm_phase(lds, g, S, E, tid); }
                { pg8::Gemm g{oabc + 640, w + WO_BC, 1024, 384, 384}; pg8::EpiBf16<0> E{r1 + 2048, 3072}; pg8::gemm_phase(lds, g, S, E, tid); }
                { pg8::Gemm g{xb, w + WO_G, 1024, 1024, 1024}; pg8::Order3 S3; S3.base = S; pg8::EpiGate E{r1, r1 + (size_t)MTOK * 3072}; pg8::gemm_phase(lds, g, S3, E, tid); }
            } else if (sp == 4) {
                pg8::Gemm g{r1 + (size_t)MTOK * 3072, w + WO_OUT, 1024, 1024, 1024}; pg8::StaticOrder S; S.init(256, 4, G, c);
                if (l == 0) { pg8::EpiRes<false, false> E{xin, a.out, nullptr, nullptr, nullptr, nullptr}; pg8::gemm_phase(lds, g, S, E, tid); }
                else { pg8::EpiRes<false, true> E{xin, a.out, nullptr, stats, a.in[14], a.in[15]}; pg8::gemm_phase(lds, g, S, E, tid); }
            } else if (sp == 5) phase_ln<false>(a.out, xb, stats, a.in[8] + l * 1024, a.in[9] + l * 1024, tid);
            else if (sp == 6) {
                { pg8::Gemm g{xb, w + WO_UP, 1024, 1024, 1024}; pg8::StaticOrder S; S.init(256, 16, G, c); pg8::EpiBf16<1> E{r1, 4096}; pg8::gemm_phase(lds, g, S, E, tid); }
                pg8::StaticOrder S; S.init(256, 4, G, c);
                { pg8::Gemm g{(const bf16_t*)(a.ws + WS_PB) + (size_t)l * MTOK * 256, w + WO_PL, 256, 256, 256}; pg8::EpiBf16<0> E{oabc, 1024}; pg8::gemm_phase(lds, g, S, E, tid); }
                { pg8::Gemm g{xb, w + WO_PG, 1024, 1024, 1024}; pg8::EpiT1 E{oabc}; pg8::gemm_phase(lds, g, S, E, tid); }
            } else if (sp == 7) {
                pg8::Gemm g{r1, w + WO_DN, 4096, 4096, 4096}; pg8::StaticOrder S; S.init(256, 4, G, c);
                pg8::EpiRes<true, true> E{a.out, a.out, oabc, stats, a.in[8] + l * 1024, a.in[9] + l * 1024}; pg8::gemm_phase(lds, g, S, E, tid);
            } else { if (l == 0) phase_ln<false>(a.out, xb, stats, a.in[14], a.in[15], tid); else phase_ln<true>(a.out, xb, stats, a.in[14] + 1024, a.in[15] + 1024, tid); }
        }
        if (phx + 1 < 2 * ph_hi) { if (ph == 0) grid.sync(); else xcd_barrier(xbar, tid); }
    }
}

#ifndef N_LAUNCH_MODE
#define N_LAUNCH_MODE 1
#endif
extern "C" void kernel_launch(void* const* d_in, const int* in_sizes, int n_in, void* d_out, int out_size, void* d_ws, size_t ws_size, hipStream_t stream) {
    static int grid = 0;
    if (grid == 0) {
        if (n_in != 17 || out_size != MTOK * DM || ws_size < WS_END) { fprintf(stderr, "kernel_launch: unexpected shapes (n_in %d out %d ws %zu need %zu)\n", n_in, out_size, ws_size, (size_t)WS_END); grid = -1; return; }
        int dev = 0, cus = 0, per_cu = 0;
        hipGetDevice(&dev);
        hipDeviceGetAttribute(&cus, hipDeviceAttributeMultiprocessorCount, dev);
        if (hipFuncSetAttribute((const void*)mega_fwd, hipFuncAttributeMaxDynamicSharedMemorySize, LDS_BYTES) != hipSuccess) { fprintf(stderr, "kernel_launch: hipFuncSetAttribute failed\n"); grid = -1; return; }
        hipOccupancyMaxActiveBlocksPerMultiprocessor(&per_cu, (const void*)mega_fwd, 512, LDS_BYTES);
        if (per_cu < 1) { fprintf(stderr, "kernel_launch: occupancy query says %d\n", per_cu); per_cu = 1; }
        (void)hipGetLastError();
        grid = cus * per_cu;
    }
    if (grid < 0) return;
    if (hipMemsetAsync((char*)d_ws + WS_BAR, 0, (size_t)3456 * 4, stream) != hipSuccess) { fprintf(stderr, "kernel_launch: memset of the barrier words failed\n"); return; }
    Args a{};
    for (int i = 0; i < 17; ++i) a.in[i] = (const float*)d_in[i];
    a.out = (float*)d_out; a.ws = (unsigned char*)d_ws;
#if N_LAUNCH_MODE == 0
    for (int ph = 0; ph < 19; ++ph) {
        a.ph_lo = ph; a.ph_hi = ph + 1;
        hipLaunchKernelGGL(mega_fwd, dim3(grid), dim3(512), LDS_BYTES, stream, a);
    }
#else
    a.ph_lo = 0; a.ph_hi = 19;
    void* args[] = {&a};
    hipError_t e = hipLaunchCooperativeKernel((const void*)mega_fwd, dim3(grid), dim3(512), args, LDS_BYTES, stream);
    if (e != hipSuccess) fprintf(stderr, "cooperative launch failed: %s (grid %d)\n", hipGetErrorString(e), grid);
#endif
}
```

```cpp
#include <hip/hip_runtime.h>
#include <hip/hip_cooperative_groups.h>
#include <cstdio>
namespace cg = cooperative_groups;

#define LAS __attribute__((address_space(3)))
#define DI __device__ __forceinline__
typedef unsigned short bf16_t;
typedef short bf16x8 __attribute__((ext_vector_type(8)));
typedef float f32x2 __attribute__((ext_vector_type(2)));
typedef float f32x4 __attribute__((ext_vector_type(4)));
typedef float f32x16 __attribute__((ext_vector_type(16)));
typedef unsigned u32x2 __attribute__((ext_vector_type(2)));
typedef unsigned u32x4 __attribute__((ext_vector_type(4)));
typedef __bf16 bf2_t __attribute__((ext_vector_type(2)));

constexpr int MTOK = 65536, SEQ = 2048, DM = 1024, NB = 32, DFF = 4096, PLE = 256;
constexpr int RM_LD = 2816;
constexpr int C_AQ = 0, C_AK = 384, C_IQ = 448, C_IK = 960, C_BQ = 1024, C_BK = 1792, C_CQ = 2048, C_CK = 2432;
constexpr int T_ROWS = 768;
constexpr int R_AV = 0, R_BV = 64, R_CV = 320, R_IW = 704;
constexpr int NWIN = 3584;
constexpr float ALPHA = 1.41421356237309515f;
constexpr float LOG2E = 1.44269504088896341f;
constexpr float SC2 = 0.125f * LOG2E;
constexpr float NEGF = -1e30f;
constexpr int LDS_BYTES = 131072 + 16;

constexpr size_t WO_IN = 0;
constexpr size_t WO_G = WO_IN + (size_t)NWIN * 1024;
constexpr size_t WO_BA = WO_G + (size_t)3072 * 1024;
constexpr size_t WO_BB = WO_BA + (size_t)1024 * 384;
constexpr size_t WO_BC = WO_BB + (size_t)1024 * 256;
constexpr size_t WO_OUT = WO_BC + (size_t)1024 * 384;
constexpr size_t WO_UP = WO_OUT + (size_t)1024 * 1024;
constexpr size_t WO_DN = WO_UP + (size_t)4096 * 1024;
constexpr size_t WO_PG = WO_DN + (size_t)1024 * 4096;
constexpr size_t WO_PL = WO_PG + (size_t)1024 * 1024;
constexpr size_t W_LAYER = WO_PL + (size_t)1024 * 256;

constexpr size_t WS_WB = 0;
constexpr size_t WS_LUT = WS_WB + 2 * W_LAYER * 2;
constexpr size_t WS_KMEAN = WS_LUT + (size_t)24 * 2048 * 4;
constexpr size_t WS_MASK = WS_KMEAN + (size_t)32 * 6 * 8 * 64 * 4;
constexpr size_t WS_XB = WS_MASK + (size_t)MTOK * 64 * 4;
constexpr size_t WS_PB = WS_XB + (size_t)MTOK * 1024 * 2;
constexpr size_t WS_OABC = WS_PB + (size_t)2 * MTOK * 256 * 2;
constexpr size_t WS_R1 = WS_OABC + (size_t)MTOK * 1024 * 2;
constexpr size_t WS_BAR = WS_R1 + (size_t)MTOK * 4096 * 2;
constexpr size_t WS_STATS = WS_BAR + (size_t)4096 * 4;
constexpr size_t WS_G2 = WS_STATS + (size_t)MTOK * 2 * 4;
constexpr size_t WS_END = WS_G2 + (size_t)MTOK * 4 * 68 * 4;
constexpr size_t WS_VT16 = WS_R1 + ((size_t)MTOK * RM_LD + (size_t)T_ROWS * MTOK) * 2;

struct Args {
    const float* in[17];
    float* out;
    unsigned char* ws;
    int ph_lo, ph_hi;
};

DI unsigned short f2bf(float f) { unsigned u = __float_as_uint(f); u += 0x7FFFu + ((u >> 16) & 1u); return (unsigned short)(u >> 16); }
DI unsigned pk2(float lo, float hi) { f32x2 v = {lo, hi}; bf2_t b = __builtin_convertvector(v, bf2_t); return __builtin_bit_cast(unsigned, b); }
DI float bf_lo(unsigned w) { return __uint_as_float(w << 16); }
DI float bf_hi(unsigned w) { return __uint_as_float(w & 0xFFFF0000u); }
DI float bf2f(bf16_t b) { return __uint_as_float(((unsigned)b) << 16); }
DI float sigmoidf_(float x) { return __builtin_amdgcn_rcpf(1.0f + __expf(-x)); }
#define MFMA32(a, b, c) __builtin_amdgcn_mfma_f32_32x32x16_bf16((a), (b), (c), 0, 0, 0)

namespace pg8 {
constexpr int BM = 256, BK = 64, HALF = 128, HTB = HALF * BK * 2, NXCD = 8, WGM = 8;
DI int lds_byte(int r, int c) { const int st = (r >> 4) * 2 + (c >> 5), rr = r & 15, cc = c & 31, ob = rr * 64 + cc * 2; return st * 1024 + (ob ^ (((ob >> 9) & 1) << 5)); }
DI void stage_rc(int b, int& R, int& C) { const int st = b / 1024, sb = b % 1024, swz = sb ^ (((sb >> 9) & 1) << 5); R = (st >> 1) * 16 + swz / 64; C = (st & 1) * 32 + (swz % 64) / 2; }
DI int perm32(int rho) { const int n = rho >> 4, i = rho & 15; return 8 * (i >> 2) + 4 * n + (i & 3); }

struct Unit { int pm, pn; long bofs; };
struct Gemm { const bf16_t* A; const bf16_t* Bt; int lda, ldb, K; long hsB; };

struct StaticOrder {
    int nM, nN, nwg, G, c;
    DI void init(int nM_, int nN_, int G_, int c_) { nM = nM_; nN = nN_; nwg = nM * nN; G = G_; c = c_; }
    DI bool next(int i, Unit& u) const {
        const long L = (long)i * G + c; if (L >= nwg) return false;
        int wgid = (int)L; { const int q = nwg / NXCD, r = nwg % NXCD, xcd = wgid % NXCD, off = wgid / NXCD; wgid = (xcd < r ? xcd * (q + 1) : r * (q + 1) + (xcd - r) * q) + off; }
        const int nig = WGM * nN, gid = wgid / nig, fm = gid * WGM, gsz = (nM - fm) < WGM ? (nM - fm) : WGM;
        u.pm = fm + ((wgid % nig) % gsz); u.pn = (wgid % nig) / gsz; u.bofs = -1; return true;
    }
};
struct OrderVT16 {
    int G, c;
    DI bool next(int i, Unit& u) const { const int L = i * G + c; if (L >= 256) return false; u.pm = 0; u.pn = L; u.bofs = ((long)((L >> 3) * 2048 + 2 * (L & 7)) * 1024) * 2; return true; }
};
struct Order3 {
    StaticOrder base;
    DI bool next(int i, Unit& u) const { Unit v; if (!base.next(i / 3, v)) return false; u.pm = v.pm; u.pn = (i % 3) * 4 + v.pn; u.bofs = -1; return true; }
};

template <int ACT  > struct EpiBf16 {
    static constexpr bool PERM = true;
    bf16_t* O; int ldc;
    DI void operator()(const f32x4 (&acc)[2][2][4][2], const Unit& u, int wr, int wc, int fr, int fq) const {
        const int row0 = u.pm * BM + wr * 64 + fr, col0 = u.pn * BM + wc * 32 + 8 * fq;
#pragma unroll
        for (int ai = 0; ai < 2; ++ai)
#pragma unroll
            for (int m = 0; m < 4; ++m) { bf16_t* rowp = O + (size_t)(row0 + ai * HALF + m * 16) * ldc + col0;
#pragma unroll
                for (int bj = 0; bj < 2; ++bj) { f32x4 v0 = acc[ai][bj][m][0], v1 = acc[ai][bj][m][1];
                    if (ACT == 1) {
#pragma unroll
                        for (int j = 0; j < 4; ++j) { float a = fmaxf(v0[j], 0.f), b = fmaxf(v1[j], 0.f); v0[j] = a * a; v1[j] = b * b; } }
                    u32x4 w; w.x = pk2(v0[0], v0[1]); w.y = pk2(v0[2], v0[3]); w.z = pk2(v1[0], v1[1]); w.w = pk2(v1[2], v1[3]);
                    *(u32x4*)(rowp + bj * HALF) = w; } }
    }
};
struct EpiGate {
    static constexpr bool PERM = true;
    const bf16_t* obr; bf16_t* mg;
    DI void operator()(const f32x4 (&acc)[2][2][4][2], const Unit& u, int wr, int wc, int fr, int fq) const {
        const int b = u.pn >> 2, colt = (u.pn & 3) * BM;
        const int row0 = u.pm * BM + wr * 64 + fr, col0 = colt + wc * 32 + 8 * fq;
#pragma unroll
        for (int ai = 0; ai < 2; ++ai)
#pragma unroll
            for (int m = 0; m < 4; ++m) { const size_t row = (size_t)(row0 + ai * HALF + m * 16);
#pragma unroll
                for (int bj = 0; bj < 2; ++bj) { const f32x4 v0 = acc[ai][bj][m][0], v1 = acc[ai][bj][m][1];
                    const u32x4 ob = *(const u32x4*)(obr + row * 3072 + b * 1024 + col0 + bj * HALF);
                    bf16_t* mp = mg + row * 1024 + col0 + bj * HALF;
                    float r[8];
                    r[0] = sigmoidf_(v0[0]) * bf_lo(ob.x); r[1] = sigmoidf_(v0[1]) * bf_hi(ob.x); r[2] = sigmoidf_(v0[2]) * bf_lo(ob.y); r[3] = sigmoidf_(v0[3]) * bf_hi(ob.y);
                    r[4] = sigmoidf_(v1[0]) * bf_lo(ob.z); r[5] = sigmoidf_(v1[1]) * bf_hi(ob.z); r[6] = sigmoidf_(v1[2]) * bf_lo(ob.w); r[7] = sigmoidf_(v1[3]) * bf_hi(ob.w);
                    if (b > 0) { const u32x4 pm_ = *(const u32x4*)mp;
                        r[0] += bf_lo(pm_.x); r[1] += bf_hi(pm_.x); r[2] += bf_lo(pm_.y); r[3] += bf_hi(pm_.y); r[4] += bf_lo(pm_.z); r[5] += bf_hi(pm_.z); r[6] += bf_lo(pm_.w); r[7] += bf_hi(pm_.w); }
                    u32x4 w; w.x = pk2(r[0], r[1]); w.y = pk2(r[2], r[3]); w.z = pk2(r[4], r[5]); w.w = pk2(r[6], r[7]);
                    *(u32x4*)mp = w; } }
    }
};
struct EpiT1 {
    static constexpr bool PERM = true;
    bf16_t* T;
    DI void operator()(const f32x4 (&acc)[2][2][4][2], const Unit& u, int wr, int wc, int fr, int fq) const {
        const int row0 = u.pm * BM + wr * 64 + fr, col0 = u.pn * BM + wc * 32 + 8 * fq;
#pragma unroll
        for (int ai = 0; ai < 2; ++ai)
#pragma unroll
            for (int m = 0; m < 4; ++m) { const size_t row = (size_t)(row0 + ai * HALF + m * 16);
#pragma unroll
                for (int bj = 0; bj < 2; ++bj) { const f32x4 v0 = acc[ai][bj][m][0], v1 = acc[ai][bj][m][1];
                    bf16_t* tp = T + row * 1024 + col0 + bj * HALF;
                    const u32x4 ob = *(const u32x4*)tp;
                    float r[8];
                    r[0] = sigmoidf_(v0[0]) * bf_lo(ob.x); r[1] = sigmoidf_(v0[1]) * bf_hi(ob.x); r[2] = sigmoidf_(v0[2]) * bf_lo(ob.y); r[3] = sigmoidf_(v0[3]) * bf_hi(ob.y);
                    r[4] = sigmoidf_(v1[0]) * bf_lo(ob.z); r[5] = sigmoidf_(v1[1]) * bf_hi(ob.z); r[6] = sigmoidf_(v1[2]) * bf_lo(ob.w); r[7] = sigmoidf_(v1[3]) * bf_hi(ob.w);
                    u32x4 w; w.x = pk2(r[0], r[1]); w.y = pk2(r[2], r[3]); w.z = pk2(r[4], r[5]); w.w = pk2(r[6], r[7]);
                    *(u32x4*)tp = w; } }
    }
};
template <bool HAS_T, bool LNX> struct EpiRes {
    static constexpr bool PERM = false;
    const float* xin; float* y; const bf16_t* T; const float* stats; const float* lg; const float* lb;
    DI void operator()(const f32x4 (&acc)[2][2][4][2], const Unit& u, int wr, int wc, int fr, int fq) const {
        const int row0 = u.pm * BM + wr * 64 + fr, col0 = u.pn * BM + wc * 32 + 4 * fq;
#pragma unroll
        for (int bj = 0; bj < 2; ++bj)
#pragma unroll
            for (int n = 0; n < 2; ++n) {
                const int col = col0 + bj * HALF + n * 16;
                f32x4 gv = {1.f, 1.f, 1.f, 1.f}, bv = {0.f, 0.f, 0.f, 0.f};
                if (LNX) { gv = *(const f32x4*)(lg + col); bv = *(const f32x4*)(lb + col); }
#pragma unroll
                for (int ai = 0; ai < 2; ++ai)
#pragma unroll
                    for (int m = 0; m < 4; ++m) {
                        const int row = row0 + ai * HALF + m * 16;
                        const size_t o = (size_t)row * 1024 + col;
                        f32x4 xv = *(const f32x4*)(xin + o);
                        if (LNX) { const f32x2 sm = *(const f32x2*)(stats + 2 * (size_t)row); xv = (xv - sm[0]) * sm[1] * gv + bv; }
                        f32x4 r = acc[ai][bj][m][n] + xv * ALPHA;
                        if (HAS_T) { const u32x2 tv = *(const u32x2*)(T + o); r[0] += bf_lo(tv.x); r[1] += bf_hi(tv.x); r[2] += bf_lo(tv.y); r[3] += bf_hi(tv.y); }
                        *(f32x4*)(y + o) = r; }
            }
    }
};

template <class Epi, class Sched>
DI void gemm_phase(LAS unsigned char* lds, const Gemm g, const Sched& S, const Epi& E, const int tid) {
    const int wid = __builtin_amdgcn_readfirstlane(tid >> 6), lane = tid & 63, wr = wid >> 2, wc = wid & 3, fr = lane & 15, fq = lane >> 4;
    const int K = g.K, nt = K / BK;
    unsigned voffA_, voffB_;
    { int R, C; stage_rc(tid * 16, R, C); const int Rb = Epi::PERM ? ((R & ~31) + perm32(R & 31)) : R;
      voffA_ = (unsigned)(R * g.lda + C) * 2u; voffB_ = (unsigned)(Rb * g.ldb + C) * 2u; }
    const size_t p64offA = (size_t)64 * g.lda * 2, p64offB = (size_t)64 * g.ldb * 2;
    const size_t kstep = (size_t)(BK * 2);
    const size_t hstepA = (size_t)HALF * g.lda * 2, hstepB = g.hsB > 0 ? (size_t)g.hsB : (size_t)HALF * g.ldb * 2;
    const size_t tstepA = 2 * hstepA, tstepB = 2 * hstepB;
    const unsigned ldsw = (unsigned)wid * 1024u;
    const int aoff = lds_byte(wr * 64 + fr, fq * 8), boff = lds_byte(wc * 32 + fr, fq * 8);
#define PG8_SA(b, h) (((b) * 2 + (h)) * HTB)
#define PG8_SB(b, h) ((4 + (b) * 2 + (h)) * HTB)
#define PG8_STAGE(bufoff, gbase, voff) do { _Pragma("unroll") for (int _i = 0; _i < 2; ++_i) \
        __builtin_amdgcn_global_load_lds((const unsigned*)((const char*)(gbase) + (size_t)_i * p64##voff + (v##voff##_)), (LAS unsigned*)(lds + (bufoff) + ldsw + _i * 8192), 16, 0, 0); } while (0)
#define PG8_LDA(dst, b, h) do { _Pragma("unroll") for (int m = 0; m < 4; ++m) _Pragma("unroll") for (int k = 0; k < 2; ++k) dst[m][k] = *(const LAS bf16x8*)(lds + PG8_SA(b, h) + aoff + m * 2048 + k * 1024); } while (0)
#define PG8_LDB(dst, b, h) do { _Pragma("unroll") for (int n = 0; n < 2; ++n) _Pragma("unroll") for (int k = 0; k < 2; ++k) dst[n][k] = *(const LAS bf16x8*)(lds + PG8_SB(b, h) + boff + n * 2048 + k * 1024); } while (0)
#define PG8_MMA(ai, bj, At, Bt) do { __builtin_amdgcn_s_setprio(1); _Pragma("unroll") for (int m = 0; m < 4; ++m) _Pragma("unroll") for (int n = 0; n < 2; ++n) _Pragma("unroll") for (int k = 0; k < 2; ++k) \
        acc[ai][bj][m][n] = __builtin_amdgcn_mfma_f32_16x16x32_bf16(Bt[n][k], At[m][k], acc[ai][bj][m][n], 0, 0, 0); __builtin_amdgcn_s_setprio(0); } while (0)
#define PG8_WAIT_V(n) asm volatile("s_waitcnt vmcnt(" #n ")" ::: "memory")
#define PG8_WAIT_L(n) asm volatile("s_waitcnt lgkmcnt(" #n ")" ::: "memory")
#define PG8_BAR __builtin_amdgcn_s_barrier()
#define PG8_SCHED __builtin_amdgcn_sched_barrier(0)
    Unit cur, nxt; int ui = 0;
    if (!S.next(0, cur)) return;
    f32x4 acc[2][2][4][2];
#pragma unroll
    for (int a = 0; a < 2; ++a)
#pragma unroll
        for (int b = 0; b < 2; ++b)
#pragma unroll
            for (int m = 0; m < 4; ++m)
#pragma unroll
                for (int n = 0; n < 2; ++n) acc[a][b][m][n] = (f32x4){0.f, 0.f, 0.f, 0.f};
    bf16x8 At[4][2], B0[2][2], B1[2][2];
    const char* cA = (const char*)g.A + (size_t)cur.pm * tstepA; const char* cB = (const char*)g.Bt + (cur.bofs >= 0 ? (size_t)cur.bofs : (size_t)cur.pn * tstepB);
    PG8_STAGE(PG8_SB(0, 0), cB, offB); PG8_STAGE(PG8_SA(0, 0), cA, offA); PG8_STAGE(PG8_SB(0, 1), cB + hstepB, offB); PG8_STAGE(PG8_SA(0, 1), cA + hstepA, offA);
    if (wr == 1) PG8_BAR;
    PG8_WAIT_V(4); PG8_BAR;
    PG8_STAGE(PG8_SB(1, 0), cB + kstep, offB); PG8_STAGE(PG8_SA(1, 0), cA + kstep, offA); PG8_STAGE(PG8_SB(1, 1), cB + hstepB + kstep, offB);
    PG8_WAIT_V(6); PG8_BAR;
    for (;;) {
        const bool has_next = S.next(ui + 1, nxt);
        const char* nA = has_next ? (const char*)g.A + (size_t)nxt.pm * tstepA : cA; const char* nB = has_next ? (const char*)g.Bt + (nxt.bofs >= 0 ? (size_t)nxt.bofs : (size_t)nxt.pn * tstepB) : cB;
        for (int t = 0; t < nt; t += 2) {
            const bool last = (t == nt - 2);
            const char* a1 = cA + (size_t)(t + 1) * kstep;
            const char* a2 = last ? nA : cA + (size_t)(t + 2) * kstep; const char* b2 = last ? nB : cB + (size_t)(t + 2) * kstep;
            const char* a3 = a2 + kstep; const char* b3 = b2 + kstep;
            PG8_LDB(B0, 0, 0); PG8_SCHED; PG8_LDA(At, 0, 0); PG8_STAGE(PG8_SA(1, 1), a1 + hstepA, offA);
            PG8_WAIT_L(8); PG8_BAR; PG8_WAIT_L(0); PG8_MMA(0, 0, At, B0); PG8_BAR; PG8_SCHED;
            PG8_LDB(B1, 0, 1); PG8_STAGE(PG8_SB(0, 0), b2, offB);
            PG8_BAR; PG8_WAIT_L(0); PG8_MMA(0, 1, At, B1); PG8_BAR;
            PG8_LDA(At, 0, 1); PG8_STAGE(PG8_SA(0, 0), a2, offA);
            PG8_BAR; PG8_WAIT_L(0); PG8_MMA(1, 0, At, B0); PG8_BAR; PG8_SCHED;
            PG8_STAGE(PG8_SB(0, 1), b2 + hstepB, offB);
            PG8_WAIT_V(6); PG8_BAR; PG8_MMA(1, 1, At, B1); PG8_BAR;
            PG8_LDB(B0, 1, 0); PG8_SCHED; PG8_LDA(At, 1, 0); PG8_STAGE(PG8_SA(0, 1), a2 + hstepA, offA);
            PG8_WAIT_L(8); PG8_BAR; PG8_WAIT_L(0); PG8_MMA(0, 0, At, B0); PG8_BAR; PG8_SCHED;
            PG8_LDB(B1, 1, 1); PG8_STAGE(PG8_SB(1, 0), b3, offB);
            PG8_BAR; PG8_WAIT_L(0); PG8_MMA(0, 1, At, B1); PG8_BAR;
            PG8_LDA(At, 1, 1); PG8_STAGE(PG8_SA(1, 0), a3, offA);
            PG8_BAR; PG8_WAIT_L(0); PG8_MMA(1, 0, At, B0); PG8_BAR; PG8_SCHED;
            PG8_STAGE(PG8_SB(1, 1), b3 + hstepB, offB);
            PG8_WAIT_V(6); PG8_BAR; PG8_MMA(1, 1, At, B1); PG8_BAR;
        }
        E(acc, cur, wr, wc, fr, fq);
        if (!has_next) break;
#pragma unroll
        for (int a = 0; a < 2; ++a)
#pragma unroll
            for (int b = 0; b < 2; ++b)
#pragma unroll
                for (int m = 0; m < 4; ++m)
#pragma unroll
                    for (int n = 0; n < 2; ++n) acc[a][b][m][n] = (f32x4){0.f, 0.f, 0.f, 0.f};
        cur = nxt; cA = nA; cB = nB; ++ui;
    }
    PG8_WAIT_V(0);
    if (wr == 0) PG8_BAR;
    PG8_BAR;
#undef PG8_SA
#undef PG8_SB
#undef PG8_STAGE
#undef PG8_LDA
#undef PG8_LDB
#undef PG8_MMA
#undef PG8_WAIT_V
#undef PG8_WAIT_L
#undef PG8_BAR
#undef PG8_SCHED
}
}

DI int win_srccol(int n) {
    if (n < 384) return n;
    if (n < 448) return 384 + (n - 384);
    if (n < 960) return 512 + (n - 448);
    if (n < 1024) return 1024 + (n - 960);
    if (n < 1792) return 1096 + (n - 1024);
    if (n < 2048) return 1864 + (n - 1792);
    if (n < 2432) return 2376 + (n - 2048);
    if (n < 2816) return 2760 + (n - 2432);
    if (n < 2880) return 448 + (n - 2816);
    if (n < 3136) return 2120 + (n - 2880);
    if (n < 3520) return 3144 + (n - 3136);
    if (n < 3528) return 1088 + (n - 3520);
    return -1;
}
DI void convT(unsigned char* shm, const float* src, int K, int Nsrc, bf16_t* dst, int Ndst, int mode, const int tid) {
    unsigned short* tl = (unsigned short*)shm;
    const int ntk = K / 64, ntiles = (Ndst / 64) * ntk;
    for (int tile = blockIdx.x; tile < ntiles; tile += gridDim.x) {
        const int n0 = (tile / ntk) * 64, k0 = (tile % ntk) * 64;
        const int nx = tid & 63, ky = tid >> 6;
        const int sc = mode ? win_srccol(n0 + nx) : (n0 + nx);
#pragma unroll
        for (int p = 0; p < 8; ++p) { const int k = k0 + ky + 8 * p; const float v = sc >= 0 ? src[(size_t)k * Nsrc + sc] : 0.f; tl[nx * 66 + ky + 8 * p] = f2bf(v); }
        __syncthreads();
#pragma unroll
        for (int p = 0; p < 8; ++p) { const int n = ky + 8 * p; dst[(size_t)(n0 + n) * K + k0 + nx] = tl[n * 66 + nx]; }
        __syncthreads();
    }
}
DI void conv_vec(const float* src, bf16_t* dst, size_t n8, const int tid) {
    for (size_t i = (size_t)blockIdx.x * 512 + tid; i < n8; i += (size_t)gridDim.x * 512) {
        const f32x4 a = *(const f32x4*)(src + i * 8), b = *(const f32x4*)(src + i * 8 + 4);
        u32x4 w; w.x = pk2(a[0], a[1]); w.y = pk2(a[2], a[3]); w.z = pk2(b[0], b[1]); w.w = pk2(b[2], b[3]);
        *(u32x4*)(dst + i * 8) = w;
    }
}
DI int rel_bucket(int n) {
    if (n < 16) return n;
    int large = 16 + (int)(logf((float)n / 16.0f) / 4.852030263919617f * 16.0f);
    return large < 31 ? large : 31;
}
DI void phase_convert(const Args& a, unsigned char* shm, const int tid) {
    bf16_t* wb = (bf16_t*)(a.ws + WS_WB);
    for (int l = 0; l < 2; ++l) {
        bf16_t* w = wb + (size_t)l * W_LAYER;
        convT(shm, a.in[2] + (size_t)l * 1024 * 3528, 1024, 3528, w + WO_IN, NWIN, 1, tid);
        convT(shm, a.in[3] + (size_t)l * 1024 * 3072, 1024, 3072, w + WO_G, 3072, 0, tid);
        convT(shm, a.in[4] + (size_t)l * 384 * 1024, 384, 1024, w + WO_BA, 1024, 0, tid);
        convT(shm, a.in[5] + (size_t)l * 256 * 1024, 256, 1024, w + WO_BB, 1024, 0, tid);
        convT(shm, a.in[6] + (size_t)l * 384 * 1024, 384, 1024, w + WO_BC, 1024, 0, tid);
        convT(shm, a.in[7] + (size_t)l * 1024 * 1024, 1024, 1024, w + WO_OUT, 1024, 0, tid);
        convT(shm, a.in[10] + (size_t)l * 1024 * 4096, 1024, 4096, w + WO_UP, 4096, 0, tid);
        convT(shm, a.in[11] + (size_t)l * 4096 * 1024, 4096, 1024, w + WO_DN, 1024, 0, tid);
        convT(shm, a.in[12] + (size_t)l * 1024 * 1024, 1024, 1024, w + WO_PG, 1024, 0, tid);
        convT(shm, a.in[13] + (size_t)l * 256 * 1024, 256, 1024, w + WO_PL, 1024, 0, tid);
    }
    conv_vec(a.in[0], (bf16_t*)(a.ws + WS_XB), (size_t)MTOK * 1024 / 8, tid);
    conv_vec(a.in[1], (bf16_t*)(a.ws + WS_PB), (size_t)2 * MTOK * 256 / 8, tid);
    float* lut = (float*)(a.ws + WS_LUT);
    const float* rb = a.in[16];
    for (int i = blockIdx.x * 512 + tid; i < 24 * 2048; i += gridDim.x * 512) {
        const int hd = i >> 11, d = i & 2047;
        lut[i] = rb[rel_bucket(d) * 24 + hd] * LOG2E;
    }
}

DI float wave_sum(float v) {
#pragma unroll
    for (int o = 32; o >= 1; o >>= 1) v += __shfl_xor(v, o);
    return v;
}
template <bool FINAL>
DI void phase_ln(float* y, bf16_t* xb, float* stats, const float* g, const float* b, const int tid) {
    const int wid = tid >> 6, lane = tid & 63;
    f32x4 gv[4], bv[4];
#pragma unroll
    for (int k = 0; k < 4; ++k) { gv[k] = *(const f32x4*)(g + k * 256 + lane * 4); bv[k] = *(const f32x4*)(b + k * 256 + lane * 4); }
    for (int row = blockIdx.x * 8 + wid; row < MTOK; row += gridDim.x * 8) {
        float* yp = y + (size_t)row * 1024;
        f32x4 v[4]; float s = 0.f;
#pragma unroll
        for (int k = 0; k < 4; ++k) { v[k] = *(const f32x4*)(yp + k * 256 + lane * 4); s += v[k][0] + v[k][1] + v[k][2] + v[k][3]; }
        const float mean = wave_sum(s) * (1.0f / 1024.0f);
        float q = 0.f;
#pragma unroll
        for (int k = 0; k < 4; ++k) { v[k] = v[k] - mean; q += v[k][0] * v[k][0] + v[k][1] * v[k][1] + v[k][2] * v[k][2] + v[k][3] * v[k][3]; }
        const float var = wave_sum(q) * (1.0f / 1024.0f);
        const float rs = 1.0f / sqrtf(var + 1e-5f);
        if (!FINAL && lane == 0) { f32x2 sm = {mean, rs}; *(f32x2*)(stats + 2 * (size_t)row) = sm; }
#pragma unroll
        for (int k = 0; k < 4; ++k) { const f32x4 o = v[k] * rs * gv[k] + bv[k];
            if (FINAL) *(f32x4*)(yp + k * 256 + lane * 4) = o;
            else { u32x2 w; w.x = pk2(o[0], o[1]); w.y = pk2(o[2], o[3]); *(u32x2*)(xb + (size_t)row * 1024 + k * 256 + lane * 4) = w; } }
    }
}

DI int pi_row(int r) { return (r & 3) | (((r >> 3) & 1) << 2) | (((r >> 2) & 1) << 3) | (r & 16); }
DI void task_rot(int tau, int& b, int& qt) { b = tau >> 6; qt = ((tau & 63) + 8 * (tau >> 8)) & 63; }
DI bool task_map(int k, int& b, int& qt) {
    if (gridDim.x == 256) { if (k >= 8) return false; const int xcd = blockIdx.x & 7, slot = blockIdx.x >> 3; b = xcd + 8 * (k >> 1); qt = (k & 1) ? 63 - slot : slot; return true; }
    const int tau = blockIdx.x + k * gridDim.x; if (tau >= 2048) return false; task_rot(tau, b, qt); return true;
}

DI void a1_task(unsigned char* shm, const bf16_t* prm, const bf16_t* prt, unsigned* mask, int b, int qt, const int tid) {
    const int wid = __builtin_amdgcn_readfirstlane(tid >> 6), lane = tid & 63, r = lane & 31, h = lane >> 5;
    const int t0 = qt * 32, tok0 = b * SEQ;
    unsigned* cnt = (unsigned*)(shm + 33280);
#pragma unroll
    for (int p = 0; p < 4; ++p) { const int c = tid + p * 512, row = c >> 6, ch = c & 63;
        *(u32x4*)(shm + row * 1040 + ch * 16) = *(const u32x4*)(prm + (size_t)(tok0 + t0 + row) * RM_LD + C_IQ + ch * 8); }
    cnt[tid] = 0u; cnt[tid + 512] = 0u;
    float* wqs = (float*)(shm + 33280 + 4096);
    if (tid < 256) wqs[tid] = bf2f(prt[(size_t)(R_IW + (tid >> 5)) * MTOK + tok0 + t0 + (tid & 31)]);
    __syncthreads();
    unsigned key[8][16];
    const bf16_t* kp = prm + (size_t)(tok0 + pi_row(r)) * RM_LD + C_IK + 8 * h;
    bf16x8 kf[4];
    if (wid <= qt) {
#pragma unroll
        for (int ks = 0; ks < 4; ++ks) kf[ks] = *(const bf16x8*)(kp + (size_t)(wid * 32) * RM_LD + 16 * ks);
    }
#pragma unroll
    for (int jt = 0; jt < 8; ++jt) {
        const int kt = wid + 8 * jt;
        if (kt <= qt) {
            const int s0 = kt * 32;
            bf16x8 kn[4];
            const bool hn = (jt < 7) && (kt + 8 <= qt);
            if (hn) {
#pragma unroll
                for (int ks = 0; ks < 4; ++ks) kn[ks] = *(const bf16x8*)(kp + (size_t)(s0 + 256) * RM_LD + 16 * ks);
            }
            float idx[16];
#pragma unroll
            for (int i = 0; i < 16; ++i) idx[i] = 0.f;
#pragma unroll 1
            for (int hh = 0; hh < 8; ++hh) {
                f32x16 acc;
#pragma unroll
                for (int i = 0; i < 16; ++i) acc[i] = 0.f;
                const unsigned char* qb = shm + r * 1040 + hh * 128 + 16 * h;
#pragma unroll
                for (int ks = 0; ks < 4; ++ks) { const bf16x8 qf = *(const bf16x8*)(qb + 32 * ks); acc = MFMA32(kf[ks], qf, acc); }
                const float wv = wqs[hh * 32 + r];
#pragma unroll
                for (int i = 0; i < 16; ++i) idx[i] = fmaf(wv, fmaxf(acc[i], 0.f), idx[i]);
            }
#pragma unroll
            for (int i = 0; i < 16; ++i) {
                const int s = s0 + 16 * (i >> 3) + 8 * h + (i & 7);
                const unsigned u = __float_as_uint(idx[i] + 0.0f);
                const unsigned k = (u & 0x80000000u) ? ~u : (u | 0x80000000u);
                key[jt][i] = (s <= t0 + r) ? k : 0u;
            }
            if (hn) {
#pragma unroll
                for (int ks = 0; ks < 4; ++ks) kf[ks] = kn[ks];
            }
        } else {
#pragma unroll
            for (int i = 0; i < 16; ++i) key[jt][i] = 0u;
        }
    }
    unsigned T = 0u;
    if (qt >= 8) {
        const int nheld = (qt >= wid) ? ((qt - wid) >> 3) + 1 : 0;
        bool done = false;
        for (int bit = 31; bit >= 0; --bit) {
            const unsigned cand = T | (1u << bit);
            int c = 0;
#pragma unroll
            for (int jt = 0; jt < 8; ++jt) {
                if (jt < nheld) {
#pragma unroll
                    for (int i = 0; i < 16; ++i) c += (key[jt][i] >= cand) ? 1 : 0;
                }
            }
            c += __shfl_xor(c, 32);
            if (h == 0 && c) atomicAdd(&cnt[(31 - bit) * 32 + r], (unsigned)c);
            __syncthreads();
            const unsigned tot = cnt[(31 - bit) * 32 + r];
            if (!done) { if (tot >= 256u) T = cand; if (tot == 256u) done = true; }
            if (__ballot(!done) == 0ull) break;
        }
    }
    if (T < 1u) T = 1u;
#pragma unroll
    for (int jt = 0; jt < 8; ++jt) {
        const int kt = wid + 8 * jt;
        if (kt <= qt) {
            unsigned part = 0u;
#pragma unroll
            for (int i = 0; i < 16; ++i) part |= (key[jt][i] >= T ? 1u : 0u) << (16 * (i >> 3) + 8 * h + (i & 7));
            part |= (unsigned)__shfl_xor((int)part, 32);
            if (h == 0) mask[(size_t)(tok0 + t0 + r) * 64 + kt] = part;
        }
    }
    __syncthreads();
}
DI void g2_job(const Args& a, unsigned char* wsh, LAS unsigned char* wl, int b, int slot, int cls, int it, const int tid);
DI void phase_a1(const Args& a, unsigned char* shm, const int tid) {
    const bf16_t* prm = (const bf16_t*)(a.ws + WS_R1);
    const bf16_t* prt = prm + (size_t)MTOK * RM_LD;
    unsigned* mask = (unsigned*)(a.ws + WS_MASK);
    float* kmean = (float*)(a.ws + WS_KMEAN);
    for (int k = 0;; ++k) { int b, qt; if (!task_map(k, b, qt)) break; a1_task(shm, prm, prt, mask, b, qt, tid); }
    for (int j = 2048 + blockIdx.x; j < 2048 + 192; j += gridDim.x) {
        {
            const int id = (j - 2048) * 8 + (tid >> 6), lane = tid & 63;
            const int b = id / 48, hd = (id >> 3) % 6, n = id & 7;
            const bf16_t* p = prm + (size_t)(b * SEQ + n * 256) * RM_LD + C_CK + hd * 64 + lane;
            float s = 0.f;
            for (int t = 0; t < 256; ++t) s += bf2f(p[(size_t)t * RM_LD]);
            kmean[(size_t)((b * 6 + hd) * 8 + n) * 64 + lane] = s * (1.0f / 256.0f);
        }
    }
    __syncthreads();
    {
        const int wid = __builtin_amdgcn_readfirstlane(tid >> 6);
        unsigned char* wsh = shm + wid * 16384;
        LAS unsigned char* wl = (LAS unsigned char*)shm + wid * 16384;
        for (int j = blockIdx.x; j < 1024; j += gridDim.x) {
            const int id = j * 8 + wid;
            g2_job(a, wsh, wl, id >> 8, (id >> 6) & 3, (id >> 2) & 15, id & 3, tid);
        }
    }
    __syncthreads();
}


struct AttnSt { float m, l; f32x16 o0, o1; };
struct AttnCtx {
    LAS unsigned char* wl;
    const float* lut;
    const bf16_t* kg;
    const bf16_t* vg;
    unsigned koff[4], voff[4];
    int kfo[4], vfo[2][2];
    int krs;
};
DI void attn_dma(const AttnCtx& c, int kt) {
    const char* kb = (const char*)(c.kg + (size_t)(kt * 32 * c.krs) * RM_LD);
    const char* vb = (const char*)(c.vg + kt * 32);
#pragma unroll
    for (int j = 0; j < 4; ++j) __builtin_amdgcn_global_load_lds((const unsigned*)(kb + c.koff[j]), (LAS unsigned*)(c.wl + 8192 + j * 1024), 16, 0, 0);
#pragma unroll
    for (int j = 0; j < 4; ++j) __builtin_amdgcn_global_load_lds((const unsigned*)(vb + c.voff[j]), (LAS unsigned*)(c.wl + 12288 + j * 1024), 16, 0, 0);
}
template <int MODE, bool UNI>
DI void attn_compute(const bf16x8 (&qf)[4], const bf16x8 (&kf)[4], const bf16x8 (&vf)[2][2], int kt, int d00, const float* lut, float ubias, AttnSt& st,
                     unsigned W, int win, int dmask, bool lane_sel) {
    const int s0 = kt * 32;
    f32x16 sx;
#pragma unroll
    for (int i = 0; i < 16; ++i) sx[i] = 0.f;
#pragma unroll
    for (int ks = 0; ks < 4; ++ks) sx = MFMA32(kf[ks], qf[ks], sx);
    const int d0 = d00 - s0;
    float sv[16]; float mx = NEGF;
#pragma unroll
    for (int i = 0; i < 16; ++i) {
        const int ci = 16 * (i >> 3) + (i & 7);
        const int dist = d0 - ci;
        bool v;
        if (MODE == 0) v = ((W >> ci) & 1u) != 0u;
        else if (MODE == 1) v = ((unsigned)dist <= (unsigned)win) && ((dist & dmask) == 0);
        else if (MODE == 2) v = lane_sel;
        else v = dist >= 0;
        const float bias = UNI ? ubias : lut[((MODE == 4) ? dist * 16 : dist) & 2047];
        float s = fmaf(sx[i], SC2, bias);
        s = v ? s : NEGF;
        sv[i] = s; mx = fmaxf(mx, s);
    }
    mx = fmaxf(mx, __shfl_xor(mx, 32));
    const float mnew = fmaxf(st.m, mx);
    const float msafe = (mnew > -1e29f) ? mnew : 0.f;
    if (__ballot(mnew > st.m) != 0ull) {
        const float alpha = __builtin_amdgcn_exp2f(st.m - msafe);
        st.l *= alpha; st.m = mnew;
#pragma unroll
        for (int i = 0; i < 16; ++i) { st.o0[i] *= alpha; st.o1[i] *= alpha; }
    }
    float ps = 0.f; float p[16];
#pragma unroll
    for (int i = 0; i < 16; ++i) { const float e = __builtin_amdgcn_exp2f(sv[i] - msafe); p[i] = e; ps += e; }
    st.l += ps;
    u32x4 w0, w1;
    w0.x = pk2(p[0], p[1]); w0.y = pk2(p[2], p[3]); w0.z = pk2(p[4], p[5]); w0.w = pk2(p[6], p[7]);
    w1.x = pk2(p[8], p[9]); w1.y = pk2(p[10], p[11]); w1.z = pk2(p[12], p[13]); w1.w = pk2(p[14], p[15]);
    const bf16x8 pf0 = __builtin_bit_cast(bf16x8, w0), pf1 = __builtin_bit_cast(bf16x8, w1);
    st.o0 = MFMA32(vf[0][0], pf0, st.o0); st.o0 = MFMA32(vf[0][1], pf1, st.o0);
    st.o1 = MFMA32(vf[1][0], pf0, st.o1); st.o1 = MFMA32(vf[1][1], pf1, st.o1);
}
DI void attn_compute_sp4(const bf16x8 (&qf)[4], const bf16x8 (&kf)[4], const bf16x8 (&vf)[2][2], int kt, int d00, const float* lut, AttnSt& st, int win, int dmask) {
    const int s0 = kt * 32;
    f32x16 sx;
#pragma unroll
    for (int i = 0; i < 16; ++i) sx[i] = 0.f;
#pragma unroll
    for (int ks = 0; ks < 4; ++ks) sx = MFMA32(kf[ks], qf[ks], sx);
    const int d0 = d00 - s0, e = d0 & 3;
    const bool e0 = (e == 0), e1 = (e == 1), e2 = (e == 2);
    float sv[4]; float mx = NEGF;
#pragma unroll
    for (int g = 0; g < 4; ++g) {
        const float x = e0 ? sx[4 * g] : (e1 ? sx[4 * g + 1] : (e2 ? sx[4 * g + 2] : sx[4 * g + 3]));
        const int dist = d0 - (16 * (g >> 1) + 4 * (g & 1)) - e;
        const bool v = ((unsigned)dist <= (unsigned)win) && ((dist & dmask) == 0);
        const float bias = lut[dist & 2047];
        float sc = fmaf(x, SC2, bias);
        sc = v ? sc : NEGF;
        sv[g] = sc; mx = fmaxf(mx, sc);
    }
    mx = fmaxf(mx, __shfl_xor(mx, 32));
    const float mnew = fmaxf(st.m, mx);
    const float msafe = (mnew > -1e29f) ? mnew : 0.f;
    if (__ballot(mnew > st.m) != 0ull) {
        const float alpha = __builtin_amdgcn_exp2f(st.m - msafe);
        st.l *= alpha; st.m = mnew;
#pragma unroll
        for (int i = 0; i < 16; ++i) { st.o0[i] *= alpha; st.o1[i] *= alpha; }
    }
    float ps = 0.f; float p[16];
#pragma unroll
    for (int g = 0; g < 4; ++g) {
        const float pe = __builtin_amdgcn_exp2f(sv[g] - msafe); ps += pe;
        p[4 * g] = e0 ? pe : 0.f; p[4 * g + 1] = e1 ? pe : 0.f; p[4 * g + 2] = e2 ? pe : 0.f; p[4 * g + 3] = (e == 3) ? pe : 0.f;
    }
    st.l += ps;
    u32x4 w0, w1;
    w0.x = pk2(p[0], p[1]); w0.y = pk2(p[2], p[3]); w0.z = pk2(p[4], p[5]); w0.w = pk2(p[6], p[7]);
    w1.x = pk2(p[8], p[9]); w1.y = pk2(p[10], p[11]); w1.z = pk2(p[12], p[13]); w1.w = pk2(p[14], p[15]);
    const bf16x8 pf0 = __builtin_bit_cast(bf16x8, w0), pf1 = __builtin_bit_cast(bf16x8, w1);
    st.o0 = MFMA32(vf[0][0], pf0, st.o0); st.o0 = MFMA32(vf[0][1], pf1, st.o0);
    st.o1 = MFMA32(vf[1][0], pf0, st.o1); st.o1 = MFMA32(vf[1][1], pf1, st.o1);
}
template <int MODE>
DI void attn_range(const AttnCtx& c, const bf16x8 (&qf)[4], int lo, int hi, int t0, int d00, AttnSt& st, const unsigned* maskrow, int h8, int win, int dmask, bool lane_sel) {
    if (lo > hi) return;
    attn_dma(c, lo);
    unsigned Wn = 0u;
    if (MODE == 0) Wn = maskrow[lo];
#pragma unroll 1
    for (int kt = lo; kt <= hi; ++kt) {
        asm volatile("s_waitcnt vmcnt(0)" ::: "memory");
        bf16x8 kf[4], vf[2][2];
#pragma unroll
        for (int ks = 0; ks < 4; ++ks) kf[ks] = *(const LAS bf16x8*)(c.wl + 8192 + c.kfo[ks]);
#pragma unroll
        for (int mt = 0; mt < 2; ++mt)
#pragma unroll
            for (int s = 0; s < 2; ++s) vf[mt][s] = *(const LAS bf16x8*)(c.wl + 12288 + c.vfo[mt][s]);
        const unsigned W = Wn >> h8;
        const int dlo = t0 - kt * 32 - 31;
        float ub = 0.f; bool uni = false;
        if (dlo >= 182) { const unsigned ua = __builtin_amdgcn_readfirstlane(__float_as_uint(c.lut[dlo])), ue = __builtin_amdgcn_readfirstlane(__float_as_uint(c.lut[dlo + 62])); uni = (ua == ue); ub = __uint_as_float(ua); }
        asm volatile("s_waitcnt lgkmcnt(0)" ::: "memory");
        if (kt < hi) { attn_dma(c, kt + 1); if (MODE == 0) Wn = maskrow[kt + 1]; }
        if (MODE == 1 && dmask != 0) attn_compute_sp4(qf, kf, vf, kt, d00, c.lut, st, win, dmask);
        else attn_compute<MODE, false>(qf, kf, vf, kt, d00, c.lut, 0.f, st, W, win, dmask, lane_sel);
    }
}

DI void load_lut(float* lut, const float* glut, int col, int lane) {
    __builtin_amdgcn_fence(__ATOMIC_ACQ_REL, "wavefront");
#pragma unroll
    for (int k = 0; k < 8; ++k) *(f32x4*)(lut + k * 256 + lane * 4) = *(const f32x4*)(glut + (size_t)col * 2048 + k * 256 + lane * 4);
    __builtin_amdgcn_fence(__ATOMIC_ACQ_REL, "wavefront");
    __builtin_amdgcn_wave_barrier();
}

DI void attn_job(const Args& a, unsigned char* wsh, LAS unsigned char* wl, int type, int b, int qt, int hd, const int tid) {
    const int lane = tid & 63, r = lane & 31, h = lane >> 5;
    const bf16_t* prm = (const bf16_t*)(a.ws + WS_R1);
    const bf16_t* prt = prm + (size_t)MTOK * RM_LD;
    const float* glut = (const float*)(a.ws + WS_LUT);
    const unsigned* mask = (const unsigned*)(a.ws + WS_MASK);
    const float* kmean = (const float*)(a.ws + WS_KMEAN);
    bf16_t* oabc = (bf16_t*)(a.ws + WS_OABC);
    float* lut = (float*)wsh;
    const int t0 = qt * 32, tok0 = b * SEQ;
    const int d00 = t0 + r - 8 * h, h8 = 8 * h;
    const unsigned* maskrow = mask + (size_t)(tok0 + t0 + r) * 64;
    AttnCtx c; c.wl = wl; c.lut = lut; c.krs = 1;
#pragma unroll
    for (int j = 0; j < 4; ++j) {
        const int rk = 8 * j + (lane >> 3), ck = (lane & 7) ^ ((rk >> 1) & 7);
        c.koff[j] = (unsigned)(pi_row(rk) * RM_LD + ck * 8) * 2u;
        const int rv = 16 * j + (lane >> 2), cv = (lane & 3) ^ ((rv >> 2) & 3);
        c.voff[j] = (unsigned)(rv * MTOK + cv * 8) * 2u;
        c.kfo[j] = r * 128 + (((2 * j + h) ^ ((r >> 1) & 7)) * 16);
    }
#pragma unroll
    for (int mt = 0; mt < 2; ++mt)
#pragma unroll
        for (int s = 0; s < 2; ++s) c.vfo[mt][s] = (32 * mt + r) * 64 + (((2 * s + h) ^ ((r >> 2) & 3)) * 16);
    AttnSt st; st.m = NEGF; st.l = 0.f;
#pragma unroll
    for (int i = 0; i < 16; ++i) { st.o0[i] = 0.f; st.o1[i] = 0.f; }
    const int ng = (type == 1) ? 2 : 1;
    int ocol = 0;
    for (int g = 0; g < ng; ++g) {
        int qcol, kcol, vrow, bcol;
        if (type == 0) { qcol = C_AQ + hd * 64; kcol = C_AK; vrow = R_AV; bcol = hd; ocol = hd * 64; }
        else if (type == 1) { qcol = C_BQ + (g * 4 + hd) * 64; kcol = C_BK + hd * 64; vrow = R_BV + hd * 64; bcol = 6 + g * 4 + hd; ocol = 384 + hd * 64; }
        else { qcol = C_CQ + hd * 64; kcol = C_CK + hd * 64; vrow = R_CV + hd * 64; bcol = 18 + hd; ocol = 640 + hd * 64; }
        load_lut(lut, glut, bcol, lane);
        bf16x8 qf[4];
        const bf16_t* qp = prm + (size_t)(tok0 + t0 + r) * RM_LD + qcol + 8 * h;
#pragma unroll
        for (int ks = 0; ks < 4; ++ks) qf[ks] = *(const bf16x8*)(qp + 16 * ks);
        c.kg = prm + (size_t)tok0 * RM_LD + kcol;
        c.vg = prt + (size_t)vrow * MTOK + tok0;
        if (type == 0) {
            attn_range<0>(c, qf, 0, qt, t0, d00, st, maskrow, h8, 0, 0, false);
        } else if (type == 1) {
            const int win = (g == 0) ? 128 : (g == 1 ? 512 : 2048), dmask = (g == 0) ? 0 : (g == 1 ? 3 : 15);
            int lo = t0 - win; if (lo < 0) lo = 0;
            attn_range<1>(c, qf, lo >> 5, qt, t0, d00, st, maskrow, h8, win, dmask, false);
        } else {
            const int cur = qt >> 3;
            float gate[7];
            const float* km = kmean + (size_t)((b * 6 + hd) * 8) * 64 + 8 * h;
#pragma unroll
            for (int n = 0; n < 7; ++n) {
                float s = 0.f;
                if (n < cur) {
#pragma unroll
                    for (int ks = 0; ks < 4; ++ks) {
                        const f32x4 k0 = *(const f32x4*)(km + n * 64 + 16 * ks), k1 = *(const f32x4*)(km + n * 64 + 16 * ks + 4);
                        const u32x4 qw = __builtin_bit_cast(u32x4, qf[ks]);
                        s += bf_lo(qw.x) * k0[0] + bf_hi(qw.x) * k0[1] + bf_lo(qw.y) * k0[2] + bf_hi(qw.y) * k0[3]
                           + bf_lo(qw.z) * k1[0] + bf_hi(qw.z) * k1[1] + bf_lo(qw.w) * k1[2] + bf_hi(qw.w) * k1[3];
                    }
                    s += __shfl_xor(s, 32);
                } else s = -__builtin_inff();
                gate[n] = s;
            }
            unsigned sel = 0u;
#pragma unroll
            for (int rd = 0; rd < 3; ++rd) {
                float bv = -__builtin_inff(); int bi = -1;
#pragma unroll
                for (int n = 0; n < 7; ++n) if (gate[n] > bv) { bv = gate[n]; bi = n; }
                if (bi >= 0) sel |= 1u << bi;
#pragma unroll
                for (int n = 0; n < 7; ++n) if (n == bi) gate[n] = -__builtin_inff();
            }
            for (int n = 0; n < cur; ++n) {
                const bool ls = ((sel >> n) & 1u) != 0u;
                if (__ballot(ls) == 0ull) continue;
                attn_range<2>(c, qf, n * 8, n * 8 + 7, t0, d00, st, maskrow, h8, 0, 0, ls);
            }
            attn_range<3>(c, qf, cur * 8, qt, t0, d00, st, maskrow, h8, 0, 0, false);
        }
    }
    float lt = st.l + __shfl_xor(st.l, 32);
    if (type == 1) {
        const float* pp = (const float*)(a.ws + WS_G2) + ((size_t)(tok0 + t0 + r) * 4 + hd) * 68;
        const f32x2 ml = *(const f32x2*)(pp + 64);
        const float mn = fmaxf(st.m, ml[0]);
        const float a1 = __builtin_amdgcn_exp2f(st.m - mn), a2 = __builtin_amdgcn_exp2f(ml[0] - mn);
        lt = lt * a1 + ml[1] * a2;
#pragma unroll
        for (int g4 = 0; g4 < 4; ++g4) {
            const f32x4 p0 = *(const f32x4*)(pp + 8 * g4 + 4 * h), p1 = *(const f32x4*)(pp + 32 + 8 * g4 + 4 * h);
#pragma unroll
            for (int e = 0; e < 4; ++e) { st.o0[4 * g4 + e] = st.o0[4 * g4 + e] * a1 + p0[e] * a2; st.o1[4 * g4 + e] = st.o1[4 * g4 + e] * a1 + p1[e] * a2; }
        }
    }
    const float inv = 1.0f / lt;
    bf16_t* op = oabc + (size_t)(tok0 + t0 + r) * 1024 + ocol + 4 * h;
#pragma unroll
    for (int g4 = 0; g4 < 4; ++g4) {
        u32x2 w;
        w.x = pk2(st.o0[4 * g4] * inv, st.o0[4 * g4 + 1] * inv); w.y = pk2(st.o0[4 * g4 + 2] * inv, st.o0[4 * g4 + 3] * inv);
        *(u32x2*)(op + 8 * g4) = w;
        w.x = pk2(st.o1[4 * g4] * inv, st.o1[4 * g4 + 1] * inv); w.y = pk2(st.o1[4 * g4 + 2] * inv, st.o1[4 * g4 + 3] * inv);
        *(u32x2*)(op + 32 + 8 * g4) = w;
    }
}
DI void g2_job(const Args& a, unsigned char* wsh, LAS unsigned char* wl, int b, int slot, int cls, int it, const int tid) {
    const int lane = tid & 63, r = lane & 31, h = lane >> 5;
    const bf16_t* prm = (const bf16_t*)(a.ws + WS_R1);
    const bf16_t* vt16 = (const bf16_t*)(a.ws + WS_VT16);
    const float* glut = (const float*)(a.ws + WS_LUT);
    float* lut = (float*)wsh;
    const int tok0 = b * SEQ;
    const int d00 = 32 * it + r - 8 * h;
    AttnCtx c; c.wl = wl; c.lut = lut; c.krs = 16;
#pragma unroll
    for (int j = 0; j < 4; ++j) {
        const int rk = 8 * j + (lane >> 3), ck = (lane & 7) ^ ((rk >> 1) & 7);
        c.koff[j] = (unsigned)(pi_row(rk) * 16 * RM_LD + ck * 8) * 2u;
        const int rv = 16 * j + (lane >> 2), cv = (lane & 3) ^ ((rv >> 2) & 3);
        c.voff[j] = (unsigned)(rv * MTOK + cv * 8) * 2u;
        c.kfo[j] = r * 128 + (((2 * j + h) ^ ((r >> 1) & 7)) * 16);
    }
#pragma unroll
    for (int mt = 0; mt < 2; ++mt)
#pragma unroll
        for (int s = 0; s < 2; ++s) c.vfo[mt][s] = (32 * mt + r) * 64 + (((2 * s + h) ^ ((r >> 2) & 3)) * 16);
    AttnSt st; st.m = NEGF; st.l = 0.f;
#pragma unroll
    for (int i = 0; i < 16; ++i) { st.o0[i] = 0.f; st.o1[i] = 0.f; }
    load_lut(lut, glut, 6 + 2 * 4 + slot, lane);
    const int tq = tok0 + cls + 16 * (32 * it + r);
    bf16x8 qf[4];
    const bf16_t* qp = prm + (size_t)tq * RM_LD + C_BQ + (2 * 4 + slot) * 64 + 8 * h;
#pragma unroll
    for (int ks = 0; ks < 4; ++ks) qf[ks] = *(const bf16x8*)(qp + 16 * ks);
    c.kg = prm + (size_t)(tok0 + cls) * RM_LD + C_BK + slot * 64;
    c.vg = vt16 + (size_t)(slot * 64) * MTOK + tok0 + cls * 128;
    attn_range<4>(c, qf, 0, it, 0, d00, st, nullptr, 0, 0, 0, false);
    const float lt = st.l + __shfl_xor(st.l, 32);
    float* pp = (float*)(a.ws + WS_G2) + ((size_t)tq * 4 + slot) * 68;
#pragma unroll
    for (int g4 = 0; g4 < 4; ++g4) {
        f32x4 p0, p1;
#pragma unroll
        for (int e = 0; e < 4; ++e) { p0[e] = st.o0[4 * g4 + e]; p1[e] = st.o1[4 * g4 + e]; }
        *(f32x4*)(pp + 8 * g4 + 4 * h) = p0; *(f32x4*)(pp + 32 + 8 * g4 + 4 * h) = p1;
    }
    if (h == 0) { f32x2 ml = {st.m, lt}; *(f32x2*)(pp + 64) = ml; }
}
DI void phase_attn(const Args& a, unsigned char* shm, const int tid) {
    const int wid = __builtin_amdgcn_readfirstlane(tid >> 6);
    unsigned char* wsh = shm + wid * 16384;
    LAS unsigned char* wl = (LAS unsigned char*)shm + wid * 16384;
    for (int it = 0;; ++it) {
        int b, qt; if (!task_map(it, b, qt)) break;
        const int role = (wid + it) & 7;
        if (role < 6) { attn_job(a, wsh, wl, 0, b, qt, role, tid); attn_job(a, wsh, wl, 2, b, qt, role, tid); }
        else { attn_job(a, wsh, wl, 1, b, qt, role - 6, tid); attn_job(a, wsh, wl, 1, b, qt, role - 4, tid); }
    }
}

#define XB_TMO      128
#define XB_XCNT(j)  (256  + 64 * (j))
#define XB_XSUB(j)  (1280 + 64 * (j))
#define XB_XGEN(j)  (2304 + 64 * (j))
#define XB_TOP      3328
#define XB_TOPGEN   3392
#define XCD_BAR_WORDS 3456
#define XB_SPIN_CAP (1u << 20)
DI unsigned xb_ld(unsigned* p)              { return __hip_atomic_load(p, __ATOMIC_RELAXED, __HIP_MEMORY_SCOPE_AGENT); }
DI unsigned xb_add(unsigned* p, unsigned v) { return __hip_atomic_fetch_add(p, v, __ATOMIC_RELAXED, __HIP_MEMORY_SCOPE_AGENT); }
DI unsigned xb_xcc_id() { return (unsigned)__builtin_amdgcn_s_getreg((3 << 11) | 20) & 0xFu; }
#define XB_SPIN(cond, bar) do { unsigned _sp = 0; while (cond) { __builtin_amdgcn_s_sleep(1); \
    if ((++_sp & 255u) == 0u) { if (xb_ld(&(bar)[XB_TMO])) break; if (_sp > XB_SPIN_CAP) { atomicAdd(&(bar)[XB_TMO], 1u); break; } } } } while (0)
struct XcdBarrier { unsigned* bar; unsigned x; volatile LAS unsigned* st; };
DI void xcd_barrier_complete(unsigned* bar, unsigned x, unsigned& nloc, unsigned& nx) {
    const unsigned G = gridDim.x * gridDim.y * gridDim.z;
    unsigned sum, cnt, mine, sp = 0u;
    for (;;) {
        sum = 0u; cnt = 0u; mine = 0u;
#pragma unroll
        for (unsigned j = 0; j < 16; ++j) { const unsigned c = xb_ld(&bar[XB_XCNT(j)]); sum += c; cnt += (c > 0u) ? 1u : 0u; mine = (j == x) ? c : mine; }
        if (sum == G) break;
        __builtin_amdgcn_s_sleep(1);
        if ((++sp & 255u) == 0u) { if (xb_ld(&bar[XB_TMO])) break; if (sp > XB_SPIN_CAP) { atomicAdd(&bar[XB_TMO], 1u); break; } }
    }
    nloc = mine > 0u ? mine : 1u; nx = cnt > 0u ? cnt : 1u;
}
DI void xcd_barrier(const XcdBarrier& b, const int tid) {
    asm volatile("s_waitcnt vmcnt(0)" ::: "memory");
    __syncthreads();
    if (tid == 0) {
        unsigned* bar = b.bar;
        __builtin_amdgcn_s_waitcnt(0);
        unsigned nloc = b.st[0], nx = b.st[1];
        if (nloc == 0u) { xcd_barrier_complete(bar, b.x, nloc, nx); b.st[0] = nloc; b.st[1] = nx; }
        const unsigned old = xb_add(&bar[XB_XSUB(b.x)], 1u);
        const unsigned gen = old / nloc;
        if (old + 1u == (gen + 1u) * nloc) {
            __builtin_amdgcn_fence(__ATOMIC_RELEASE, "agent");
            asm volatile("s_waitcnt vmcnt(0)" ::: "memory");
            const unsigned og = xb_add(&bar[XB_TOP], 1u);
            const unsigned tg = og / nx;
            if (og + 1u == (tg + 1u) * nx) xb_add(&bar[XB_TOPGEN], 1u);
            else XB_SPIN(xb_ld(&bar[XB_TOPGEN]) == tg, bar);
            __builtin_amdgcn_fence(__ATOMIC_ACQUIRE, "agent");
            xb_add(&bar[XB_XGEN(b.x)], 1u);
            asm volatile("s_waitcnt vmcnt(0)" ::: "memory");
        } else {
            XB_SPIN(xb_ld(&bar[XB_XGEN(b.x)]) == gen, bar);
            __builtin_amdgcn_fence(__ATOMIC_ACQUIRE, "agent");
            asm volatile("s_waitcnt vmcnt(0)" ::: "memory");
        }
    }
    __syncthreads();
}

__global__ void __launch_bounds__(512, 2) mega_fwd(Args a_) {
    extern __shared__ __attribute__((aligned(16))) unsigned char shm[];
    cg::grid_group grid = cg::this_grid();
    LAS unsigned char* lds = (LAS unsigned char*)shm;
    const int G = gridDim.x, c = blockIdx.x;
#ifndef PROBE_REP
#define PROBE_REP -2
#endif
    const int ph_lo = a_.ph_lo, ph_hi = a_.ph_hi;
    const int wave_id = __builtin_amdgcn_readfirstlane(threadIdx.x >> 6);
    XcdBarrier xbar;
    { volatile LAS unsigned* st = (volatile LAS unsigned*)(lds + 131072);
      if (threadIdx.x == 0) { st[0] = 0u; st[1] = 0u; }
      __syncthreads();
      xbar.bar = (unsigned*)(a_.ws + WS_BAR); xbar.x = xb_xcc_id(); xbar.st = st;
      if (threadIdx.x == 0) (void)xb_add(&xbar.bar[XB_XCNT(xbar.x)], 1u); }
    for (int phx = 2 * ph_lo; phx < 2 * ph_hi; ++phx) {
        const int ph = phx >> 1;
        if (phx & 1) { const bool rep = (PROBE_REP == -1) ? (ph == 0) : (ph > 0 && (ph - 1) % 9 == PROBE_REP); if (!rep) continue; }
        const Args& a = a_;
        int tid = wave_id * 64 + (int)__builtin_amdgcn_mbcnt_hi(~0u, __builtin_amdgcn_mbcnt_lo(~0u, 0u)); asm volatile("" : "+v"(tid));
        bf16_t* xb = (bf16_t*)(a.ws + WS_XB);
        bf16_t* r1 = (bf16_t*)(a.ws + WS_R1);
        bf16_t* oabc = (bf16_t*)(a.ws + WS_OABC);
        float* stats = (float*)(a.ws + WS_STATS);
        if (ph == 0) phase_convert(a, shm, tid);
        else {
            const int l = (ph - 1) / 9, sp = (ph - 1) % 9;
            const bf16_t* w = (const bf16_t*)(a.ws + WS_WB) + (size_t)l * W_LAYER;
            const float* xin = (l == 0) ? a.in[0] : a.out;
            if (sp == 0) {
                { pg8::Gemm g{xb, w + WO_IN, 1024, 1024, 1024, 0}; pg8::StaticOrder S; S.init(256, 11, G, c); pg8::EpiBf16<0> E{r1, RM_LD}; pg8::gemm_phase(lds, g, S, E, tid); }
                { pg8::Gemm g{w + WO_IN + (size_t)RM_LD * 1024, xb, 1024, 1024, 1024, 0}; pg8::StaticOrder S; S.init(3, 256, G, c); pg8::EpiBf16<0> E{r1 + (size_t)MTOK * RM_LD, MTOK}; pg8::gemm_phase(lds, g, S, E, tid); }
                { pg8::Gemm g{w + WO_IN + (size_t)2880 * 1024, xb, 1024, 16 * 1024, 1024, 2048}; pg8::OrderVT16 S{G, c}; pg8::EpiBf16<0> E{(bf16_t*)(a.ws + WS_VT16), MTOK}; pg8::gemm_phase(lds, g, S, E, tid); }
            } else if (sp == 1) phase_a1(a, shm, tid);
            else if (sp == 2) phase_attn(a, shm, tid);
            else if (sp == 3) {
                pg8::StaticOrder S; S.init(256, 4, G, c);
                { pg8::Gemm g{oabc, w + WO_BA, 1024, 384, 384, 0}; pg8::EpiBf16<0> E{r1, 3072}; pg8::gemm_phase(lds, g, S, E, tid); }
                { pg8::Gemm g{oabc + 384, w + WO_BB, 1024, 256, 256, 0}; pg8::EpiBf16<0> E{r1 + 1024, 3072}; pg8::gemm_phase(lds, g, S, E, tid); }
                { pg8::Gemm g{oabc + 640, w + WO_BC, 1024, 384, 384, 0}; pg8::EpiBf16<0> E{r1 + 2048, 3072}; pg8::gemm_phase(lds, g, S, E, tid); }
                { pg8::Gemm g{xb, w + WO_G, 1024, 1024, 1024, 0}; pg8::Order3 S3; S3.base = S; pg8::EpiGate E{r1, r1 + (size_t)MTOK * 3072}; pg8::gemm_phase(lds, g, S3, E, tid); }
            } else if (sp == 4) {
                pg8::Gemm g{r1 + (size_t)MTOK * 3072, w + WO_OUT, 1024, 1024, 1024, 0}; pg8::StaticOrder S; S.init(256, 4, G, c);
                if (l == 0) { pg8::EpiRes<false, false> E{xin, a.out, nullptr, nullptr, nullptr, nullptr}; pg8::gemm_phase(lds, g, S, E, tid); }
                else { pg8::EpiRes<false, true> E{xin, a.out, nullptr, stats, a.in[14], a.in[15]}; pg8::gemm_phase(lds, g, S, E, tid); }
            } else if (sp == 5) phase_ln<false>(a.out, xb, stats, a.in[8] + l * 1024, a.in[9] + l * 1024, tid);
            else if (sp == 6) {
                { pg8::Gemm g{xb, w + WO_UP, 1024, 1024, 1024, 0}; pg8::StaticOrder S; S.init(256, 16, G, c); pg8::EpiBf16<1> E{r1, 4096}; pg8::gemm_phase(lds, g, S, E, tid); }
                pg8::StaticOrder S; S.init(256, 4, G, c);
                { pg8::Gemm g{(const bf16_t*)(a.ws + WS_PB) + (size_t)l * MTOK * 256, w + WO_PL, 256, 256, 256, 0}; pg8::EpiBf16<0> E{oabc, 1024}; pg8::gemm_phase(lds, g, S, E, tid); }
                { pg8::Gemm g{xb, w + WO_PG, 1024, 1024, 1024, 0}; pg8::EpiT1 E{oabc}; pg8::gemm_phase(lds, g, S, E, tid); }
            } else if (sp == 7) {
                pg8::Gemm g{r1, w + WO_DN, 4096, 4096, 4096, 0}; pg8::StaticOrder S; S.init(256, 4, G, c);
                pg8::EpiRes<true, true> E{a.out, a.out, oabc, stats, a.in[8] + l * 1024, a.in[9] + l * 1024}; pg8::gemm_phase(lds, g, S, E, tid);
            } else { if (l == 0) phase_ln<false>(a.out, xb, stats, a.in[14], a.in[15], tid); else phase_ln<true>(a.out, xb, stats, a.in[14] + 1024, a.in[15] + 1024, tid); }
        }
        if (phx + 1 < 2 * ph_hi) { if (ph == 0) grid.sync(); else xcd_barrier(xbar, tid); }
    }
}

#ifndef N_LAUNCH_MODE
#define N_LAUNCH_MODE 1
#endif
extern "C" void kernel_launch(void* const* d_in, const int* in_sizes, int n_in, void* d_out, int out_size, void* d_ws, size_t ws_size, hipStream_t stream) {
    static int grid = 0;
    if (grid == 0) {
        if (n_in != 17 || out_size != MTOK * DM || ws_size < WS_END) { fprintf(stderr, "kernel_launch: unexpected shapes (n_in %d out %d ws %zu need %zu)\n", n_in, out_size, ws_size, (size_t)WS_END); grid = -1; return; }
        int dev = 0, cus = 0, per_cu = 0;
        hipGetDevice(&dev);
        hipDeviceGetAttribute(&cus, hipDeviceAttributeMultiprocessorCount, dev);
        if (hipFuncSetAttribute((const void*)mega_fwd, hipFuncAttributeMaxDynamicSharedMemorySize, LDS_BYTES) != hipSuccess) { fprintf(stderr, "kernel_launch: hipFuncSetAttribute failed\n"); grid = -1; return; }
        hipOccupancyMaxActiveBlocksPerMultiprocessor(&per_cu, (const void*)mega_fwd, 512, LDS_BYTES);
        if (per_cu < 1) { fprintf(stderr, "kernel_launch: occupancy query says %d\n", per_cu); per_cu = 1; }
        (void)hipGetLastError();
        grid = cus * per_cu;
    }
    if (grid < 0) return;
    if (hipMemsetAsync((char*)d_ws + WS_BAR, 0, (size_t)3456 * 4, stream) != hipSuccess) { fprintf(stderr, "kernel_launch: memset of the barrier words failed\n"); return; }
    Args a{};
    for (int i = 0; i < 17; ++i) a.in[i] = (const float*)d_in[i];
    a.out = (float*)d_out; a.ws = (unsigned char*)d_ws;
#if N_LAUNCH_MODE == 0
    for (int ph = 0; ph < 19; ++ph) {
        a.ph_lo = ph; a.ph_hi = ph + 1;
        hipLaunchKernelGGL(mega_fwd, dim3(grid), dim3(512), LDS_BYTES, stream, a);
    }
#else
    a.ph_lo = 0; a.ph_hi = 19;
    void* args[] = {&a};
    hipError_t e = hipLaunchCooperativeKernel((const void*)mega_fwd, dim3(grid), dim3(512), args, LDS_BYTES, stream);
    if (e != hipSuccess) fprintf(stderr, "cooperative launch failed: %s (grid %d)\n", hipGetErrorString(e), grid);
#endif
}
```

```cpp
#include <hip/hip_runtime.h>
#include <hip/hip_cooperative_groups.h>
#include <cstdio>
namespace cg = cooperative_groups;

#define LAS __attribute__((address_space(3)))
#define DI __device__ __forceinline__
typedef unsigned short bf16_t;
typedef short bf16x8 __attribute__((ext_vector_type(8)));
typedef float f32x2 __attribute__((ext_vector_type(2)));
typedef float f32x4 __attribute__((ext_vector_type(4)));
typedef float f32x16 __attribute__((ext_vector_type(16)));
typedef unsigned u32x2 __attribute__((ext_vector_type(2)));
typedef unsigned u32x4 __attribute__((ext_vector_type(4)));
typedef __bf16 bf2_t __attribute__((ext_vector_type(2)));

constexpr int MTOK = 65536, SEQ = 2048, DM = 1024, NB = 32, DFF = 4096, PLE = 256;
constexpr int RM_LD = 2816;
constexpr int C_AQ = 0, C_AK = 384, C_IQ = 448, C_IK = 960, C_BQ = 1024, C_BK = 1792, C_CQ = 2048, C_CK = 2432;
constexpr int T_ROWS = 768;
constexpr int R_AV = 0, R_BV = 64, R_CV = 320, R_IW = 704;
constexpr int NWIN = 3584;
constexpr float ALPHA = 1.41421356237309515f;
constexpr float LOG2E = 1.44269504088896341f;
constexpr float SC2 = 0.125f * LOG2E;
constexpr float NEGF = -1e30f;
constexpr int LDS_BYTES = 131072 + 16;

constexpr size_t WO_IN = 0;
constexpr size_t WO_G = WO_IN + (size_t)NWIN * 1024;
constexpr size_t WO_BA = WO_G + (size_t)3072 * 1024;
constexpr size_t WO_BB = WO_BA + (size_t)1024 * 384;
constexpr size_t WO_BC = WO_BB + (size_t)1024 * 256;
constexpr size_t WO_OUT = WO_BC + (size_t)1024 * 384;
constexpr size_t WO_UP = WO_OUT + (size_t)1024 * 1024;
constexpr size_t WO_DN = WO_UP + (size_t)4096 * 1024;
constexpr size_t WO_PG = WO_DN + (size_t)1024 * 4096;
constexpr size_t WO_PL = WO_PG + (size_t)1024 * 1024;
constexpr size_t W_LAYER = WO_PL + (size_t)1024 * 256;

constexpr size_t WS_WB = 0;
constexpr size_t WS_LUT = WS_WB + 2 * W_LAYER * 2;
constexpr size_t WS_KMEAN = WS_LUT + (size_t)24 * 2048 * 4;
constexpr size_t WS_MASK = WS_KMEAN + (size_t)32 * 6 * 8 * 64 * 4;
constexpr size_t WS_XB = WS_MASK + (size_t)MTOK * 64 * 4;
constexpr size_t WS_PB = WS_XB + (size_t)MTOK * 1024 * 2;
constexpr size_t WS_OABC = WS_PB + (size_t)2 * MTOK * 256 * 2;
constexpr size_t WS_R1 = WS_OABC + (size_t)MTOK * 1024 * 2;
constexpr size_t WS_BAR = WS_R1 + (size_t)MTOK * 4096 * 2;
constexpr size_t WS_STATS = WS_BAR + (size_t)4096 * 4;
constexpr size_t WS_G2 = WS_STATS + (size_t)MTOK * 2 * 4;
constexpr size_t WS_END = WS_G2 + (size_t)MTOK * 4 * 68 * 4;
constexpr size_t WS_VT16 = WS_R1 + ((size_t)MTOK * RM_LD + (size_t)T_ROWS * MTOK) * 2;

struct Args {
    const float* in[17];
    float* out;
    unsigned char* ws;
    int ph_lo, ph_hi;
};

DI unsigned short f2bf(float f) { unsigned u = __float_as_uint(f); u += 0x7FFFu + ((u >> 16) & 1u); return (unsigned short)(u >> 16); }
DI unsigned pk2(float lo, float hi) { f32x2 v = {lo, hi}; bf2_t b = __builtin_convertvector(v, bf2_t); return __builtin_bit_cast(unsigned, b); }
DI float bf_lo(unsigned w) { return __uint_as_float(w << 16); }
DI float bf_hi(unsigned w) { return __uint_as_float(w & 0xFFFF0000u); }
DI float bf2f(bf16_t b) { return __uint_as_float(((unsigned)b) << 16); }
DI float sigmoidf_(float x) { return __builtin_amdgcn_rcpf(1.0f + __expf(-x)); }
#define MFMA32(a, b, c) __builtin_amdgcn_mfma_f32_32x32x16_bf16((a), (b), (c), 0, 0, 0)

namespace pg8 {
constexpr int BM = 256, BK = 64, HALF = 128, HTB = HALF * BK * 2, NXCD = 8, WGM = 8;
DI int lds_byte(int r, int c) { const int st = (r >> 4) * 2 + (c >> 5), rr = r & 15, cc = c & 31, ob = rr * 64 + cc * 2; return st * 1024 + (ob ^ (((ob >> 9) & 1) << 5)); }
DI void stage_rc(int b, int& R, int& C) { const int st = b / 1024, sb = b % 1024, swz = sb ^ (((sb >> 9) & 1) << 5); R = (st >> 1) * 16 + swz / 64; C = (st & 1) * 32 + (swz % 64) / 2; }
DI int perm32(int rho) { const int n = rho >> 4, i = rho & 15; return 8 * (i >> 2) + 4 * n + (i & 3); }

struct Unit { int pm, pn; long bofs; };
struct Gemm { const bf16_t* A; const bf16_t* Bt; int lda, ldb, K; long hsB; };

struct StaticOrder {
    int nM, nN, nwg, G, c;
    DI void init(int nM_, int nN_, int G_, int c_) { nM = nM_; nN = nN_; nwg = nM * nN; G = G_; c = c_; }
    DI bool next(int i, Unit& u) const {
        const long L = (long)i * G + c; if (L >= nwg) return false;
        int wgid = (int)L; { const int q = nwg / NXCD, r = nwg % NXCD, xcd = wgid % NXCD, off = wgid / NXCD; wgid = (xcd < r ? xcd * (q + 1) : r * (q + 1) + (xcd - r) * q) + off; }
        const int nig = WGM * nN, gid = wgid / nig, fm = gid * WGM, gsz = (nM - fm) < WGM ? (nM - fm) : WGM;
        u.pm = fm + ((wgid % nig) % gsz); u.pn = (wgid % nig) / gsz; u.bofs = -1; return true;
    }
};
struct OrderVT16 {
    int G, c;
    DI bool next(int i, Unit& u) const { const int L = i * G + c; if (L >= 256) return false; u.pm = 0; u.pn = L; u.bofs = ((long)((L >> 3) * 2048 + 2 * (L & 7)) * 1024) * 2; return true; }
};
struct Order3 {
    StaticOrder base;
    DI bool next(int i, Unit& u) const { Unit v; if (!base.next(i / 3, v)) return false; u.pm = v.pm; u.pn = (i % 3) * 4 + v.pn; u.bofs = -1; return true; }
};

template <int ACT  > struct EpiBf16 {
    static constexpr bool PERM = true;
    bf16_t* O; int ldc;
    DI void operator()(const f32x4 (&acc)[2][2][4][2], const Unit& u, int wr, int wc, int fr, int fq) const {
        const int row0 = u.pm * BM + wr * 64 + fr, col0 = u.pn * BM + wc * 32 + 8 * fq;
#pragma unroll
        for (int ai = 0; ai < 2; ++ai)
#pragma unroll
            for (int m = 0; m < 4; ++m) { bf16_t* rowp = O + (size_t)(row0 + ai * HALF + m * 16) * ldc + col0;
#pragma unroll
                for (int bj = 0; bj < 2; ++bj) { f32x4 v0 = acc[ai][bj][m][0], v1 = acc[ai][bj][m][1];
                    if (ACT == 1) {
#pragma unroll
                        for (int j = 0; j < 4; ++j) { float a = fmaxf(v0[j], 0.f), b = fmaxf(v1[j], 0.f); v0[j] = a * a; v1[j] = b * b; } }
                    u32x4 w; w.x = pk2(v0[0], v0[1]); w.y = pk2(v0[2], v0[3]); w.z = pk2(v1[0], v1[1]); w.w = pk2(v1[2], v1[3]);
                    *(u32x4*)(rowp + bj * HALF) = w; } }
    }
};
struct EpiGate {
    static constexpr bool PERM = true;
    const bf16_t* obr; bf16_t* mg;
    DI void operator()(const f32x4 (&acc)[2][2][4][2], const Unit& u, int wr, int wc, int fr, int fq) const {
        const int b = u.pn >> 2, colt = (u.pn & 3) * BM;
        const int row0 = u.pm * BM + wr * 64 + fr, col0 = colt + wc * 32 + 8 * fq;
#pragma unroll
        for (int ai = 0; ai < 2; ++ai)
#pragma unroll
            for (int m = 0; m < 4; ++m) { const size_t row = (size_t)(row0 + ai * HALF + m * 16);
#pragma unroll
                for (int bj = 0; bj < 2; ++bj) { const f32x4 v0 = acc[ai][bj][m][0], v1 = acc[ai][bj][m][1];
                    const u32x4 ob = *(const u32x4*)(obr + row * 3072 + b * 1024 + col0 + bj * HALF);
                    bf16_t* mp = mg + row * 1024 + col0 + bj * HALF;
                    float r[8];
                    r[0] = sigmoidf_(v0[0]) * bf_lo(ob.x); r[1] = sigmoidf_(v0[1]) * bf_hi(ob.x); r[2] = sigmoidf_(v0[2]) * bf_lo(ob.y); r[3] = sigmoidf_(v0[3]) * bf_hi(ob.y);
                    r[4] = sigmoidf_(v1[0]) * bf_lo(ob.z); r[5] = sigmoidf_(v1[1]) * bf_hi(ob.z); r[6] = sigmoidf_(v1[2]) * bf_lo(ob.w); r[7] = sigmoidf_(v1[3]) * bf_hi(ob.w);
                    if (b > 0) { const u32x4 pm_ = *(const u32x4*)mp;
                        r[0] += bf_lo(pm_.x); r[1] += bf_hi(pm_.x); r[2] += bf_lo(pm_.y); r[3] += bf_hi(pm_.y); r[4] += bf_lo(pm_.z); r[5] += bf_hi(pm_.z); r[6] += bf_lo(pm_.w); r[7] += bf_hi(pm_.w); }
                    u32x4 w; w.x = pk2(r[0], r[1]); w.y = pk2(r[2], r[3]); w.z = pk2(r[4], r[5]); w.w = pk2(r[6], r[7]);
                    *(u32x4*)mp = w; } }
    }
};
struct EpiT1 {
    static constexpr bool PERM = true;
    bf16_t* T;
    DI void operator()(const f32x4 (&acc)[2][2][4][2], const Unit& u, int wr, int wc, int fr, int fq) const {
        const int row0 = u.pm * BM + wr * 64 + fr, col0 = u.pn * BM + wc * 32 + 8 * fq;
#pragma unroll
        for (int ai = 0; ai < 2; ++ai)
#pragma unroll
            for (int m = 0; m < 4; ++m) { const size_t row = (size_t)(row0 + ai * HALF + m * 16);
#pragma unroll
                for (int bj = 0; bj < 2; ++bj) { const f32x4 v0 = acc[ai][bj][m][0], v1 = acc[ai][bj][m][1];
                    bf16_t* tp = T + row * 1024 + col0 + bj * HALF;
                    const u32x4 ob = *(const u32x4*)tp;
                    float r[8];
                    r[0] = sigmoidf_(v0[0]) * bf_lo(ob.x); r[1] = sigmoidf_(v0[1]) * bf_hi(ob.x); r[2] = sigmoidf_(v0[2]) * bf_lo(ob.y); r[3] = sigmoidf_(v0[3]) * bf_hi(ob.y);
                    r[4] = sigmoidf_(v1[0]) * bf_lo(ob.z); r[5] = sigmoidf_(v1[1]) * bf_hi(ob.z); r[6] = sigmoidf_(v1[2]) * bf_lo(ob.w); r[7] = sigmoidf_(v1[3]) * bf_hi(ob.w);
                    u32x4 w; w.x = pk2(r[0], r[1]); w.y = pk2(r[2], r[3]); w.z = pk2(r[4], r[5]); w.w = pk2(r[6], r[7]);
                    *(u32x4*)tp = w; } }
    }
};
template <bool HAS_T, bool LNX> struct EpiRes {
    static constexpr bool PERM = false;
    const float* xin; float* y; const bf16_t* T; const float* stats; const float* lg; const float* lb;
    DI void operator()(const f32x4 (&acc)[2][2][4][2], const Unit& u, int wr, int wc, int fr, int fq) const {
        const int row0 = u.pm * BM + wr * 64 + fr, col0 = u.pn * BM + wc * 32 + 4 * fq;
#pragma unroll
        for (int bj = 0; bj < 2; ++bj)
#pragma unroll
            for (int n = 0; n < 2; ++n) {
                const int col = col0 + bj * HALF + n * 16;
                f32x4 gv = {1.f, 1.f, 1.f, 1.f}, bv = {0.f, 0.f, 0.f, 0.f};
                if (LNX) { gv = *(const f32x4*)(lg + col); bv = *(const f32x4*)(lb + col); }
#pragma unroll
                for (int ai = 0; ai < 2; ++ai)
#pragma unroll
                    for (int m = 0; m < 4; ++m) {
                        const int row = row0 + ai * HALF + m * 16;
                        const size_t o = (size_t)row * 1024 + col;
                        f32x4 xv = *(const f32x4*)(xin + o);
                        if (LNX) { const f32x2 sm = *(const f32x2*)(stats + 2 * (size_t)row); xv = (xv - sm[0]) * sm[1] * gv + bv; }
                        f32x4 r = acc[ai][bj][m][n] + xv * ALPHA;
                        if (HAS_T) { const u32x2 tv = *(const u32x2*)(T + o); r[0] += bf_lo(tv.x); r[1] += bf_hi(tv.x); r[2] += bf_lo(tv.y); r[3] += bf_hi(tv.y); }
                        *(f32x4*)(y + o) = r; }
            }
    }
};

template <class Epi, class Sched>
DI void gemm_phase(LAS unsigned char* lds, const Gemm g, const Sched& S, const Epi& E, const int tid) {
    const int wid = __builtin_amdgcn_readfirstlane(tid >> 6), lane = tid & 63, wr = wid >> 2, wc = wid & 3, fr = lane & 15, fq = lane >> 4;
    const int K = g.K, nt = K / BK;
    unsigned voffA_, voffB_;
    { int R, C; stage_rc(tid * 16, R, C); const int Rb = Epi::PERM ? ((R & ~31) + perm32(R & 31)) : R;
      voffA_ = (unsigned)(R * g.lda + C) * 2u; voffB_ = (unsigned)(Rb * g.ldb + C) * 2u; }
    const size_t p64offA = (size_t)64 * g.lda * 2, p64offB = (size_t)64 * g.ldb * 2;
    const size_t kstep = (size_t)(BK * 2);
    const size_t hstepA = (size_t)HALF * g.lda * 2, hstepB = g.hsB > 0 ? (size_t)g.hsB : (size_t)HALF * g.ldb * 2;
    const size_t tstepA = 2 * hstepA, tstepB = 2 * hstepB;
    const unsigned ldsw = (unsigned)wid * 1024u;
    const int aoff = lds_byte(wr * 64 + fr, fq * 8), boff = lds_byte(wc * 32 + fr, fq * 8);
#define PG8_SA(b, h) (((b) * 2 + (h)) * HTB)
#define PG8_SB(b, h) ((4 + (b) * 2 + (h)) * HTB)
#define PG8_STAGE(bufoff, gbase, voff) do { _Pragma("unroll") for (int _i = 0; _i < 2; ++_i) \
        __builtin_amdgcn_global_load_lds((const unsigned*)((const char*)(gbase) + (size_t)_i * p64##voff + (v##voff##_)), (LAS unsigned*)(lds + (bufoff) + ldsw + _i * 8192), 16, 0, 0); } while (0)
#define PG8_LDA(dst, b, h) do { _Pragma("unroll") for (int m = 0; m < 4; ++m) _Pragma("unroll") for (int k = 0; k < 2; ++k) dst[m][k] = *(const LAS bf16x8*)(lds + PG8_SA(b, h) + aoff + m * 2048 + k * 1024); } while (0)
#define PG8_LDB(dst, b, h) do { _Pragma("unroll") for (int n = 0; n < 2; ++n) _Pragma("unroll") for (int k = 0; k < 2; ++k) dst[n][k] = *(const LAS bf16x8*)(lds + PG8_SB(b, h) + boff + n * 2048 + k * 1024); } while (0)
#define PG8_MMA(ai, bj, At, Bt) do { __builtin_amdgcn_s_setprio(1); _Pragma("unroll") for (int m = 0; m < 4; ++m) _Pragma("unroll") for (int n = 0; n < 2; ++n) _Pragma("unroll") for (int k = 0; k < 2; ++k) \
        acc[ai][bj][m][n] = __builtin_amdgcn_mfma_f32_16x16x32_bf16(Bt[n][k], At[m][k], acc[ai][bj][m][n], 0, 0, 0); __builtin_amdgcn_s_setprio(0); } while (0)
#define PG8_WAIT_V(n) asm volatile("s_waitcnt vmcnt(" #n ")" ::: "memory")
#define PG8_WAIT_L(n) asm volatile("s_waitcnt lgkmcnt(" #n ")" ::: "memory")
#define PG8_BAR __builtin_amdgcn_s_barrier()
#define PG8_SCHED __builtin_amdgcn_sched_barrier(0)
    Unit cur, nxt; int ui = 0;
    if (!S.next(0, cur)) return;
    f32x4 acc[2][2][4][2];
#pragma unroll
    for (int a = 0; a < 2; ++a)
#pragma unroll
        for (int b = 0; b < 2; ++b)
#pragma unroll
            for (int m = 0; m < 4; ++m)
#pragma unroll
                for (int n = 0; n < 2; ++n) acc[a][b][m][n] = (f32x4){0.f, 0.f, 0.f, 0.f};
    bf16x8 At[4][2], B0[2][2], B1[2][2];
    const char* cA = (const char*)g.A + (size_t)cur.pm * tstepA; const char* cB = (const char*)g.Bt + (cur.bofs >= 0 ? (size_t)cur.bofs : (size_t)cur.pn * tstepB);
    PG8_STAGE(PG8_SB(0, 0), cB, offB); PG8_STAGE(PG8_SA(0, 0), cA, offA); PG8_STAGE(PG8_SB(0, 1), cB + hstepB, offB); PG8_STAGE(PG8_SA(0, 1), cA + hstepA, offA);
    if (wr == 1) PG8_BAR;
    PG8_WAIT_V(4); PG8_BAR;
    PG8_STAGE(PG8_SB(1, 0), cB + kstep, offB); PG8_STAGE(PG8_SA(1, 0), cA + kstep, offA); PG8_STAGE(PG8_SB(1, 1), cB + hstepB + kstep, offB);
    PG8_WAIT_V(6); PG8_BAR;
    for (;;) {
        const bool has_next = S.next(ui + 1, nxt);
        const char* nA = has_next ? (const char*)g.A + (size_t)nxt.pm * tstepA : cA; const char* nB = has_next ? (const char*)g.Bt + (nxt.bofs >= 0 ? (size_t)nxt.bofs : (size_t)nxt.pn * tstepB) : cB;
        for (int t = 0; t < nt; t += 2) {
            const bool last = (t == nt - 2);
            const char* a1 = cA + (size_t)(t + 1) * kstep;
            const char* a2 = last ? nA : cA + (size_t)(t + 2) * kstep; const char* b2 = last ? nB : cB + (size_t)(t + 2) * kstep;
            const char* a3 = a2 + kstep; const char* b3 = b2 + kstep;
            PG8_LDB(B0, 0, 0); PG8_SCHED; PG8_LDA(At, 0, 0); PG8_STAGE(PG8_SA(1, 1), a1 + hstepA, offA);
            PG8_WAIT_L(8); PG8_BAR; PG8_WAIT_L(0); PG8_MMA(0, 0, At, B0); PG8_BAR; PG8_SCHED;
            PG8_LDB(B1, 0, 1); PG8_STAGE(PG8_SB(0, 0), b2, offB);
            PG8_BAR; PG8_WAIT_L(0); PG8_MMA(0, 1, At, B1); PG8_BAR;
            PG8_LDA(At, 0, 1); PG8_STAGE(PG8_SA(0, 0), a2, offA);
            PG8_BAR; PG8_WAIT_L(0); PG8_MMA(1, 0, At, B0); PG8_BAR; PG8_SCHED;
            PG8_STAGE(PG8_SB(0, 1), b2 + hstepB, offB);
            PG8_WAIT_V(6); PG8_BAR; PG8_MMA(1, 1, At, B1); PG8_BAR;
            PG8_LDB(B0, 1, 0); PG8_SCHED; PG8_LDA(At, 1, 0); PG8_STAGE(PG8_SA(0, 1), a2 + hstepA, offA);
            PG8_WAIT_L(8); PG8_BAR; PG8_WAIT_L(0); PG8_MMA(0, 0, At, B0); PG8_BAR; PG8_SCHED;
            PG8_LDB(B1, 1, 1); PG8_STAGE(PG8_SB(1, 0), b3, offB);
            PG8_BAR; PG8_WAIT_L(0); PG8_MMA(0, 1, At, B1); PG8_BAR;
            PG8_LDA(At, 1, 1); PG8_STAGE(PG8_SA(1, 0), a3, offA);
            PG8_BAR; PG8_WAIT_L(0); PG8_MMA(1, 0, At, B0); PG8_BAR; PG8_SCHED;
            PG8_STAGE(PG8_SB(1, 1), b3 + hstepB, offB);
            PG8_WAIT_V(6); PG8_BAR; PG8_MMA(1, 1, At, B1); PG8_BAR;
        }
        E(acc, cur, wr, wc, fr, fq);
        if (!has_next) break;
#pragma unroll
        for (int a = 0; a < 2; ++a)
#pragma unroll
            for (int b = 0; b < 2; ++b)
#pragma unroll
                for (int m = 0; m < 4; ++m)
#pragma unroll
                    for (int n = 0; n < 2; ++n) acc[a][b][m][n] = (f32x4){0.f, 0.f, 0.f, 0.f};
        cur = nxt; cA = nA; cB = nB; ++ui;
    }
    PG8_WAIT_V(0);
    if (wr == 0) PG8_BAR;
    PG8_BAR;
#undef PG8_SA
#undef PG8_SB
#undef PG8_STAGE
#undef PG8_LDA
#undef PG8_LDB
#undef PG8_MMA
#undef PG8_WAIT_V
#undef PG8_WAIT_L
#undef PG8_BAR
#undef PG8_SCHED
}
}

DI int win_srccol(int n) {
    if (n < 384) return n;
    if (n < 448) return 384 + (n - 384);
    if (n < 960) return 512 + (n - 448);
    if (n < 1024) return 1024 + (n - 960);
    if (n < 1792) return 1096 + (n - 1024);
    if (n < 2048) return 1864 + (n - 1792);
    if (n < 2432) return 2376 + (n - 2048);
    if (n < 2816) return 2760 + (n - 2432);
    if (n < 2880) return 448 + (n - 2816);
    if (n < 3136) return 2120 + (n - 2880);
    if (n < 3520) return 3144 + (n - 3136);
    if (n < 3528) return 1088 + (n - 3520);
    return -1;
}
DI void convT(unsigned char* shm, const float* src, int K, int Nsrc, bf16_t* dst, int Ndst, int mode, const int tid) {
    unsigned short* tl = (unsigned short*)shm;
    const int ntk = K / 64, ntiles = (Ndst / 64) * ntk;
    for (int tile = blockIdx.x; tile < ntiles; tile += gridDim.x) {
        const int n0 = (tile / ntk) * 64, k0 = (tile % ntk) * 64;
        const int nx = tid & 63, ky = tid >> 6;
        const int sc = mode ? win_srccol(n0 + nx) : (n0 + nx);
#pragma unroll
        for (int p = 0; p < 8; ++p) { const int k = k0 + ky + 8 * p; const float v = sc >= 0 ? src[(size_t)k * Nsrc + sc] : 0.f; tl[nx * 66 + ky + 8 * p] = f2bf(v); }
        __syncthreads();
#pragma unroll
        for (int p = 0; p < 8; ++p) { const int n = ky + 8 * p; dst[(size_t)(n0 + n) * K + k0 + nx] = tl[n * 66 + nx]; }
        __syncthreads();
    }
}
DI void conv_vec(const float* src, bf16_t* dst, size_t n8, const int tid) {
    for (size_t i = (size_t)blockIdx.x * 512 + tid; i < n8; i += (size_t)gridDim.x * 512) {
        const f32x4 a = *(const f32x4*)(src + i * 8), b = *(const f32x4*)(src + i * 8 + 4);
        u32x4 w; w.x = pk2(a[0], a[1]); w.y = pk2(a[2], a[3]); w.z = pk2(b[0], b[1]); w.w = pk2(b[2], b[3]);
        *(u32x4*)(dst + i * 8) = w;
    }
}
DI int rel_bucket(int n) {
    if (n < 16) return n;
    int large = 16 + (int)(logf((float)n / 16.0f) / 4.852030263919617f * 16.0f);
    return large < 31 ? large : 31;
}
DI void phase_convert(const Args& a, unsigned char* shm, const int tid) {
    bf16_t* wb = (bf16_t*)(a.ws + WS_WB);
    for (int l = 0; l < 2; ++l) {
        bf16_t* w = wb + (size_t)l * W_LAYER;
        convT(shm, a.in[2] + (size_t)l * 1024 * 3528, 1024, 3528, w + WO_IN, NWIN, 1, tid);
        convT(shm, a.in[3] + (size_t)l * 1024 * 3072, 1024, 3072, w + WO_G, 3072, 0, tid);
        convT(shm, a.in[4] + (size_t)l * 384 * 1024, 384, 1024, w + WO_BA, 1024, 0, tid);
        convT(shm, a.in[5] + (size_t)l * 256 * 1024, 256, 1024, w + WO_BB, 1024, 0, tid);
        convT(shm, a.in[6] + (size_t)l * 384 * 1024, 384, 1024, w + WO_BC, 1024, 0, tid);
        convT(shm, a.in[7] + (size_t)l * 1024 * 1024, 1024, 1024, w + WO_OUT, 1024, 0, tid);
        convT(shm, a.in[10] + (size_t)l * 1024 * 4096, 1024, 4096, w + WO_UP, 4096, 0, tid);
        convT(shm, a.in[11] + (size_t)l * 4096 * 1024, 4096, 1024, w + WO_DN, 1024, 0, tid);
        convT(shm, a.in[12] + (size_t)l * 1024 * 1024, 1024, 1024, w + WO_PG, 1024, 0, tid);
        convT(shm, a.in[13] + (size_t)l * 256 * 1024, 256, 1024, w + WO_PL, 1024, 0, tid);
    }
    conv_vec(a.in[0], (bf16_t*)(a.ws + WS_XB), (size_t)MTOK * 1024 / 8, tid);
    conv_vec(a.in[1], (bf16_t*)(a.ws + WS_PB), (size_t)2 * MTOK * 256 / 8, tid);
    float* lut = (float*)(a.ws + WS_LUT);
    const float* rb = a.in[16];
    for (int i = blockIdx.x * 512 + tid; i < 24 * 2048; i += gridDim.x * 512) {
        const int hd = i >> 11, d = i & 2047;
        lut[i] = rb[rel_bucket(d) * 24 + hd] * LOG2E;
    }
}

DI float wave_sum(float v) {
#pragma unroll
    for (int o = 32; o >= 1; o >>= 1) v += __shfl_xor(v, o);
    return v;
}
template <bool FINAL>
DI void phase_ln(float* y, bf16_t* xb, float* stats, const float* g, const float* b, const int tid) {
    const int wid = tid >> 6, lane = tid & 63;
    f32x4 gv[4], bv[4];
#pragma unroll
    for (int k = 0; k < 4; ++k) { gv[k] = *(const f32x4*)(g + k * 256 + lane * 4); bv[k] = *(const f32x4*)(b + k * 256 + lane * 4); }
    for (int row = blockIdx.x * 8 + wid; row < MTOK; row += gridDim.x * 8) {
        float* yp = y + (size_t)row * 1024;
        f32x4 v[4]; float s = 0.f;
#pragma unroll
        for (int k = 0; k < 4; ++k) { v[k] = *(const f32x4*)(yp + k * 256 + lane * 4); s += v[k][0] + v[k][1] + v[k][2] + v[k][3]; }
        const float mean = wave_sum(s) * (1.0f / 1024.0f);
        float q = 0.f;
#pragma unroll
        for (int k = 0; k < 4; ++k) { v[k] = v[k] - mean; q += v[k][0] * v[k][0] + v[k][1] * v[k][1] + v[k][2] * v[k][2] + v[k][3] * v[k][3]; }
        const float var = wave_sum(q) * (1.0f / 1024.0f);
        const float rs = 1.0f / sqrtf(var + 1e-5f);
        if (!FINAL && lane == 0) { f32x2 sm = {mean, rs}; *(f32x2*)(stats + 2 * (size_t)row) = sm; }
#pragma unroll
        for (int k = 0; k < 4; ++k) { const f32x4 o = v[k] * rs * gv[k] + bv[k];
            if (FINAL) *(f32x4*)(yp + k * 256 + lane * 4) = o;
            else { u32x2 w; w.x = pk2(o[0], o[1]); w.y = pk2(o[2], o[3]); *(u32x2*)(xb + (size_t)row * 1024 + k * 256 + lane * 4) = w; } }
    }
}

DI int pi_row(int r) { return (r & 3) | (((r >> 3) & 1) << 2) | (((r >> 2) & 1) << 3) | (r & 16); }
DI void task_rot(int tau, int& b, int& qt) { b = tau >> 6; qt = ((tau & 63) + 8 * (tau >> 8)) & 63; }
DI bool task_map(int k, int& b, int& qt) {
    if (gridDim.x == 256) { if (k >= 8) return false; const int xcd = blockIdx.x & 7, slot = blockIdx.x >> 3; b = xcd + 8 * (k >> 1); qt = (k & 1) ? 63 - slot : slot; return true; }
    const int tau = blockIdx.x + k * gridDim.x; if (tau >= 2048) return false; task_rot(tau, b, qt); return true;
}

DI void a1_task(unsigned char* shm, const bf16_t* prm, const bf16_t* prt, unsigned* mask, int b, int qt, const int tid) {
    const int wid = __builtin_amdgcn_readfirstlane(tid >> 6), lane = tid & 63, r = lane & 31, h = lane >> 5;
    const int t0 = qt * 32, tok0 = b * SEQ;
    unsigned* cnt = (unsigned*)(shm + 33280);
#pragma unroll
    for (int p = 0; p < 4; ++p) { const int c = tid + p * 512, row = c >> 6, ch = c & 63;
        *(u32x4*)(shm + row * 1040 + ch * 16) = *(const u32x4*)(prm + (size_t)(tok0 + t0 + row) * RM_LD + C_IQ + ch * 8); }
    cnt[tid] = 0u; cnt[tid + 512] = 0u;
    float* wqs = (float*)(shm + 33280 + 4096);
    if (tid < 256) wqs[tid] = bf2f(prt[(size_t)(R_IW + (tid >> 5)) * MTOK + tok0 + t0 + (tid & 31)]);
    __syncthreads();
    unsigned key[8][16];
    const bf16_t* kp = prm + (size_t)(tok0 + pi_row(r)) * RM_LD + C_IK + 8 * h;
    bf16x8 kf[4];
    if (wid <= qt) {
#pragma unroll
        for (int ks = 0; ks < 4; ++ks) kf[ks] = *(const bf16x8*)(kp + (size_t)(wid * 32) * RM_LD + 16 * ks);
    }
#pragma unroll
    for (int jt = 0; jt < 8; ++jt) {
        const int kt = wid + 8 * jt;
        if (kt <= qt) {
            const int s0 = kt * 32;
            bf16x8 kn[4];
            const bool hn = (jt < 7) && (kt + 8 <= qt);
            if (hn) {
#pragma unroll
                for (int ks = 0; ks < 4; ++ks) kn[ks] = *(const bf16x8*)(kp + (size_t)(s0 + 256) * RM_LD + 16 * ks);
            }
            float idx[16];
#pragma unroll
            for (int i = 0; i < 16; ++i) idx[i] = 0.f;
#pragma unroll 1
            for (int hh = 0; hh < 8; ++hh) {
                f32x16 acc;
#pragma unroll
                for (int i = 0; i < 16; ++i) acc[i] = 0.f;
                const unsigned char* qb = shm + r * 1040 + hh * 128 + 16 * h;
#pragma unroll
                for (int ks = 0; ks < 4; ++ks) { const bf16x8 qf = *(const bf16x8*)(qb + 32 * ks); acc = MFMA32(kf[ks], qf, acc); }
                const float wv = wqs[hh * 32 + r];
#pragma unroll
                for (int i = 0; i < 16; ++i) idx[i] = fmaf(wv, fmaxf(acc[i], 0.f), idx[i]);
            }
#pragma unroll
            for (int i = 0; i < 16; ++i) {
                const int s = s0 + 16 * (i >> 3) + 8 * h + (i & 7);
                const unsigned u = __float_as_uint(idx[i] + 0.0f);
                const unsigned k = (u & 0x80000000u) ? ~u : (u | 0x80000000u);
                key[jt][i] = (s <= t0 + r) ? k : 0u;
            }
            if (hn) {
#pragma unroll
                for (int ks = 0; ks < 4; ++ks) kf[ks] = kn[ks];
            }
        } else {
#pragma unroll
            for (int i = 0; i < 16; ++i) key[jt][i] = 0u;
        }
    }
    unsigned T = 0u;
    if (qt >= 8) {
        const int nheld = (qt >= wid) ? ((qt - wid) >> 3) + 1 : 0;
        bool done = false;
        for (int bit = 31; bit >= 0; --bit) {
            const unsigned cand = T | (1u << bit);
            int c = 0;
#pragma unroll
            for (int jt = 0; jt < 8; ++jt) {
                if (jt < nheld) {
#pragma unroll
                    for (int i = 0; i < 16; ++i) c += (key[jt][i] >= cand) ? 1 : 0;
                }
            }
            c += __shfl_xor(c, 32);
            if (h == 0 && c) atomicAdd(&cnt[(31 - bit) * 32 + r], (unsigned)c);
            __syncthreads();
            const unsigned tot = cnt[(31 - bit) * 32 + r];
            if (!done) { if (tot >= 256u) T = cand; if (tot == 256u) done = true; }
            if (__ballot(!done) == 0ull) break;
        }
    }
    if (T < 1u) T = 1u;
#pragma unroll
    for (int jt = 0; jt < 8; ++jt) {
        const int kt = wid + 8 * jt;
        if (kt <= qt) {
            unsigned part = 0u;
#pragma unroll
            for (int i = 0; i < 16; ++i) part |= (key[jt][i] >= T ? 1u : 0u) << (16 * (i >> 3) + 8 * h + (i & 7));
            part |= (unsigned)__shfl_xor((int)part, 32);
            if (h == 0) mask[(size_t)(tok0 + t0 + r) * 64 + kt] = part;
        }
    }
    __syncthreads();
}
DI void g2_job(const Args& a, unsigned char* wsh, LAS unsigned char* wl, int b, int slot, int cls, int it, const int tid);
DI void phase_a1(const Args& a, unsigned char* shm, const int tid) {
    const bf16_t* prm = (const bf16_t*)(a.ws + WS_R1);
    const bf16_t* prt = prm + (size_t)MTOK * RM_LD;
    unsigned* mask = (unsigned*)(a.ws + WS_MASK);
    float* kmean = (float*)(a.ws + WS_KMEAN);
    for (int k = 0;; ++k) { int b, qt; if (!task_map(k, b, qt)) break; a1_task(shm, prm, prt, mask, b, qt, tid); }
    for (int j = 2048 + blockIdx.x; j < 2048 + 192; j += gridDim.x) {
        {
            const int id = (j - 2048) * 8 + (tid >> 6), lane = tid & 63;
            const int b = id / 48, hd = (id >> 3) % 6, n = id & 7;
            const bf16_t* p = prm + (size_t)(b * SEQ + n * 256) * RM_LD + C_CK + hd * 64 + lane;
            float s = 0.f;
            for (int t = 0; t < 256; ++t) s += bf2f(p[(size_t)t * RM_LD]);
            kmean[(size_t)((b * 6 + hd) * 8 + n) * 64 + lane] = s * (1.0f / 256.0f);
        }
    }
    __syncthreads();
    {
        const int wid = __builtin_amdgcn_readfirstlane(tid >> 6);
        unsigned char* wsh = shm + wid * 16384;
        LAS unsigned char* wl = (LAS unsigned char*)shm + wid * 16384;
        for (int j = blockIdx.x; j < 1024; j += gridDim.x) {
            const int id = j * 8 + wid;
            g2_job(a, wsh, wl, id >> 8, (id >> 6) & 3, (id >> 2) & 15, id & 3, tid);
        }
    }
    __syncthreads();
}


struct AttnSt { float m, l; f32x16 o0, o1; };
struct AttnCtx {
    LAS unsigned char* wl;
    const float* lut;
    const bf16_t* kg;
    const bf16_t* vg;
    unsigned koff[4], voff[4];
    int kfo[4], vfo[2][2];
    int krs;
};
DI void attn_dma(const AttnCtx& c, int kt) {
    const char* kb = (const char*)(c.kg + (size_t)(kt * 32 * c.krs) * RM_LD);
    const char* vb = (const char*)(c.vg + kt * 32);
#pragma unroll
    for (int j = 0; j < 4; ++j) __builtin_amdgcn_global_load_lds((const unsigned*)(kb + c.koff[j]), (LAS unsigned*)(c.wl + j * 1024), 16, 0, 0);
#pragma unroll
    for (int j = 0; j < 4; ++j) __builtin_amdgcn_global_load_lds((const unsigned*)(vb + c.voff[j]), (LAS unsigned*)(c.wl + 4096 + j * 1024), 16, 0, 0);
}
template <int MODE, bool UNI>
DI void attn_compute(const bf16x8 (&qf)[4], const bf16x8 (&kf)[4], const bf16x8 (&vf)[2][2], int kt, int d00, const float* lut, float ubias, AttnSt& st,
                     unsigned W, int win, int dmask, bool lane_sel) {
    const int s0 = kt * 32;
    f32x16 sx;
#pragma unroll
    for (int i = 0; i < 16; ++i) sx[i] = 0.f;
#pragma unroll
    for (int ks = 0; ks < 4; ++ks) sx = MFMA32(kf[ks], qf[ks], sx);
    const int d0 = d00 - s0;
    const LAS float* lb = (const LAS float*)lut + ((MODE == 4) ? 16 * (d0 - 23) : (d0 - 23));
    float sv[16]; float mx = NEGF;
#pragma unroll
    for (int i = 0; i < 16; ++i) {
        const int ci = 16 * (i >> 3) + (i & 7);
        const int dist = d0 - ci;
        bool v;
        if (MODE == 0) v = ((W >> ci) & 1u) != 0u;
        else if (MODE == 1) v = ((unsigned)dist <= (unsigned)win) && ((dist & dmask) == 0);
        else if (MODE == 2) v = lane_sel;
        else v = dist >= 0;
        const float bias = UNI ? ubias : ((MODE == 4) ? lb[16 * (23 - ci)] : lb[23 - ci]);
        float s = fmaf(sx[i], SC2, bias);
        s = v ? s : NEGF;
        sv[i] = s; mx = fmaxf(mx, s);
    }
    mx = fmaxf(mx, __shfl_xor(mx, 32));
    const float mnew = fmaxf(st.m, mx);
    const float msafe = (mnew > -1e29f) ? mnew : 0.f;
    if (__ballot(mnew > st.m) != 0ull) {
        const float alpha = __builtin_amdgcn_exp2f(st.m - msafe);
        st.l *= alpha; st.m = mnew;
#pragma unroll
        for (int i = 0; i < 16; ++i) { st.o0[i] *= alpha; st.o1[i] *= alpha; }
    }
    float ps = 0.f; float p[16];
#pragma unroll
    for (int i = 0; i < 16; ++i) { const float e = __builtin_amdgcn_exp2f(sv[i] - msafe); p[i] = e; ps += e; }
    st.l += ps;
    u32x4 w0, w1;
    w0.x = pk2(p[0], p[1]); w0.y = pk2(p[2], p[3]); w0.z = pk2(p[4], p[5]); w0.w = pk2(p[6], p[7]);
    w1.x = pk2(p[8], p[9]); w1.y = pk2(p[10], p[11]); w1.z = pk2(p[12], p[13]); w1.w = pk2(p[14], p[15]);
    const bf16x8 pf0 = __builtin_bit_cast(bf16x8, w0), pf1 = __builtin_bit_cast(bf16x8, w1);
    st.o0 = MFMA32(vf[0][0], pf0, st.o0); st.o0 = MFMA32(vf[0][1], pf1, st.o0);
    st.o1 = MFMA32(vf[1][0], pf0, st.o1); st.o1 = MFMA32(vf[1][1], pf1, st.o1);
}
DI void attn_compute_sp4(const bf16x8 (&qf)[4], const bf16x8 (&kf)[4], const bf16x8 (&vf)[2][2], int kt, int d00, const float* lut, AttnSt& st, int win, int dmask) {
    const int s0 = kt * 32;
    f32x16 sx;
#pragma unroll
    for (int i = 0; i < 16; ++i) sx[i] = 0.f;
#pragma unroll
    for (int ks = 0; ks < 4; ++ks) sx = MFMA32(kf[ks], qf[ks], sx);
    const int d0 = d00 - s0, e = d0 & 3;
    const bool e0 = (e == 0), e1 = (e == 1), e2 = (e == 2);
    const LAS float* lb = (const LAS float*)lut + (d0 - e - 20);
    float sv[4]; float mx = NEGF;
#pragma unroll
    for (int g = 0; g < 4; ++g) {
        const float x = e0 ? sx[4 * g] : (e1 ? sx[4 * g + 1] : (e2 ? sx[4 * g + 2] : sx[4 * g + 3]));
        const int dist = d0 - (16 * (g >> 1) + 4 * (g & 1)) - e;
        const bool v = ((unsigned)dist <= (unsigned)win) && ((dist & dmask) == 0);
        const float bias = lb[20 - (16 * (g >> 1) + 4 * (g & 1))];
        float sc = fmaf(x, SC2, bias);
        sc = v ? sc : NEGF;
        sv[g] = sc; mx = fmaxf(mx, sc);
    }
    mx = fmaxf(mx, __shfl_xor(mx, 32));
    const float mnew = fmaxf(st.m, mx);
    const float msafe = (mnew > -1e29f) ? mnew : 0.f;
    if (__ballot(mnew > st.m) != 0ull) {
        const float alpha = __builtin_amdgcn_exp2f(st.m - msafe);
        st.l *= alpha; st.m = mnew;
#pragma unroll
        for (int i = 0; i < 16; ++i) { st.o0[i] *= alpha; st.o1[i] *= alpha; }
    }
    float ps = 0.f; float p[16];
#pragma unroll
    for (int g = 0; g < 4; ++g) {
        const float pe = __builtin_amdgcn_exp2f(sv[g] - msafe); ps += pe;
        p[4 * g] = e0 ? pe : 0.f; p[4 * g + 1] = e1 ? pe : 0.f; p[4 * g + 2] = e2 ? pe : 0.f; p[4 * g + 3] = (e == 3) ? pe : 0.f;
    }
    st.l += ps;
    u32x4 w0, w1;
    w0.x = pk2(p[0], p[1]); w0.y = pk2(p[2], p[3]); w0.z = pk2(p[4], p[5]); w0.w = pk2(p[6], p[7]);
    w1.x = pk2(p[8], p[9]); w1.y = pk2(p[10], p[11]); w1.z = pk2(p[12], p[13]); w1.w = pk2(p[14], p[15]);
    const bf16x8 pf0 = __builtin_bit_cast(bf16x8, w0), pf1 = __builtin_bit_cast(bf16x8, w1);
    st.o0 = MFMA32(vf[0][0], pf0, st.o0); st.o0 = MFMA32(vf[0][1], pf1, st.o0);
    st.o1 = MFMA32(vf[1][0], pf0, st.o1); st.o1 = MFMA32(vf[1][1], pf1, st.o1);
}
template <int MODE>
DI void attn_range(const AttnCtx& c, const bf16x8 (&qf)[4], int lo, int hi, int t0, int d00, AttnSt& st, const unsigned* maskrow, int h8, int win, int dmask, bool lane_sel) {
    if (lo > hi) return;
    attn_dma(c, lo);
    unsigned Wn = 0u;
    if (MODE == 0) Wn = maskrow[lo];
#pragma unroll 1
    for (int kt = lo; kt <= hi; ++kt) {
        asm volatile("s_waitcnt vmcnt(0)" ::: "memory");
        bf16x8 kf[4], vf[2][2];
#pragma unroll
        for (int ks = 0; ks < 4; ++ks) kf[ks] = *(const LAS bf16x8*)(c.wl + c.kfo[ks]);
#pragma unroll
        for (int mt = 0; mt < 2; ++mt)
#pragma unroll
            for (int s = 0; s < 2; ++s) vf[mt][s] = *(const LAS bf16x8*)(c.wl + 4096 + c.vfo[mt][s]);
        const unsigned W = Wn >> h8;
        const int dlo = t0 - kt * 32 - 31;
        float ub = 0.f; bool uni = false;
        if (dlo >= 182) { const unsigned ua = __builtin_amdgcn_readfirstlane(__float_as_uint(c.lut[dlo])), ue = __builtin_amdgcn_readfirstlane(__float_as_uint(c.lut[dlo + 62])); uni = (ua == ue); ub = __uint_as_float(ua); }
        asm volatile("s_waitcnt lgkmcnt(0)" ::: "memory");
        if (kt < hi) { attn_dma(c, kt + 1); if (MODE == 0) Wn = maskrow[kt + 1]; }
        if (MODE == 1 && dmask != 0) attn_compute_sp4(qf, kf, vf, kt, d00, c.lut, st, win, dmask);
        else attn_compute<MODE, false>(qf, kf, vf, kt, d00, c.lut, 0.f, st, W, win, dmask, lane_sel);
    }
}

DI void load_lut(float* lut, const float* glut, int col, int lane) {
    __builtin_amdgcn_fence(__ATOMIC_ACQ_REL, "wavefront");
#pragma unroll
    for (int k = 0; k < 8; ++k) *(f32x4*)(lut + k * 256 + lane * 4) = *(const f32x4*)(glut + (size_t)col * 2048 + k * 256 + lane * 4);
    __builtin_amdgcn_fence(__ATOMIC_ACQ_REL, "wavefront");
    __builtin_amdgcn_wave_barrier();
}

DI void attn_job(const Args& a, unsigned char* wsh, LAS unsigned char* wl, int type, int b, int qt, int hd, const int tid) {
    const int lane = tid & 63, r = lane & 31, h = lane >> 5;
    const bf16_t* prm = (const bf16_t*)(a.ws + WS_R1);
    const bf16_t* prt = prm + (size_t)MTOK * RM_LD;
    const float* glut = (const float*)(a.ws + WS_LUT);
    const unsigned* mask = (const unsigned*)(a.ws + WS_MASK);
    const float* kmean = (const float*)(a.ws + WS_KMEAN);
    bf16_t* oabc = (bf16_t*)(a.ws + WS_OABC);
    float* lut = (float*)(wsh + 8192);
    const int t0 = qt * 32, tok0 = b * SEQ;
    const int d00 = t0 + r - 8 * h, h8 = 8 * h;
    const unsigned* maskrow = mask + (size_t)(tok0 + t0 + r) * 64;
    AttnCtx c; c.wl = wl; c.lut = lut; c.krs = 1;
#pragma unroll
    for (int j = 0; j < 4; ++j) {
        const int rk = 8 * j + (lane >> 3), ck = (lane & 7) ^ ((rk >> 1) & 7);
        c.koff[j] = (unsigned)(pi_row(rk) * RM_LD + ck * 8) * 2u;
        const int rv = 16 * j + (lane >> 2), cv = (lane & 3) ^ ((rv >> 2) & 3);
        c.voff[j] = (unsigned)(rv * MTOK + cv * 8) * 2u;
        c.kfo[j] = r * 128 + (((2 * j + h) ^ ((r >> 1) & 7)) * 16);
    }
#pragma unroll
    for (int mt = 0; mt < 2; ++mt)
#pragma unroll
        for (int s = 0; s < 2; ++s) c.vfo[mt][s] = (32 * mt + r) * 64 + (((2 * s + h) ^ ((r >> 2) & 3)) * 16);
    AttnSt st; st.m = NEGF; st.l = 0.f;
#pragma unroll
    for (int i = 0; i < 16; ++i) { st.o0[i] = 0.f; st.o1[i] = 0.f; }
    const int ng = (type == 1) ? 2 : 1;
    int ocol = 0;
    for (int g = 0; g < ng; ++g) {
        int qcol, kcol, vrow, bcol;
        if (type == 0) { qcol = C_AQ + hd * 64; kcol = C_AK; vrow = R_AV; bcol = hd; ocol = hd * 64; }
        else if (type == 1) { qcol = C_BQ + (g * 4 + hd) * 64; kcol = C_BK + hd * 64; vrow = R_BV + hd * 64; bcol = 6 + g * 4 + hd; ocol = 384 + hd * 64; }
        else { qcol = C_CQ + hd * 64; kcol = C_CK + hd * 64; vrow = R_CV + hd * 64; bcol = 18 + hd; ocol = 640 + hd * 64; }
        load_lut(lut, glut, bcol, lane);
        bf16x8 qf[4];
        const bf16_t* qp = prm + (size_t)(tok0 + t0 + r) * RM_LD + qcol + 8 * h;
#pragma unroll
        for (int ks = 0; ks < 4; ++ks) qf[ks] = *(const bf16x8*)(qp + 16 * ks);
        c.kg = prm + (size_t)tok0 * RM_LD + kcol;
        c.vg = prt + (size_t)vrow * MTOK + tok0;
        if (type == 0) {
            attn_range<0>(c, qf, 0, qt, t0, d00, st, maskrow, h8, 0, 0, false);
        } else if (type == 1) {
            const int win = (g == 0) ? 128 : (g == 1 ? 512 : 2048), dmask = (g == 0) ? 0 : (g == 1 ? 3 : 15);
            int lo = t0 - win; if (lo < 0) lo = 0;
            attn_range<1>(c, qf, lo >> 5, qt, t0, d00, st, maskrow, h8, win, dmask, false);
        } else {
            const int cur = qt >> 3;
            float gate[7];
            const float* km = kmean + (size_t)((b * 6 + hd) * 8) * 64 + 8 * h;
#pragma unroll
            for (int n = 0; n < 7; ++n) {
                float s = 0.f;
                if (n < cur) {
#pragma unroll
                    for (int ks = 0; ks < 4; ++ks) {
                        const f32x4 k0 = *(const f32x4*)(km + n * 64 + 16 * ks), k1 = *(const f32x4*)(km + n * 64 + 16 * ks + 4);
                        const u32x4 qw = __builtin_bit_cast(u32x4, qf[ks]);
                        s += bf_lo(qw.x) * k0[0] + bf_hi(qw.x) * k0[1] + bf_lo(qw.y) * k0[2] + bf_hi(qw.y) * k0[3]
                           + bf_lo(qw.z) * k1[0] + bf_hi(qw.z) * k1[1] + bf_lo(qw.w) * k1[2] + bf_hi(qw.w) * k1[3];
                    }
                    s += __shfl_xor(s, 32);
                } else s = -__builtin_inff();
                gate[n] = s;
            }
            unsigned sel = 0u;
#pragma unroll
            for (int rd = 0; rd < 3; ++rd) {
                float bv = -__builtin_inff(); int bi = -1;
#pragma unroll
                for (int n = 0; n < 7; ++n) if (gate[n] > bv) { bv = gate[n]; bi = n; }
                if (bi >= 0) sel |= 1u << bi;
#pragma unroll
                for (int n = 0; n < 7; ++n) if (n == bi) gate[n] = -__builtin_inff();
            }
            for (int n = 0; n < cur; ++n) {
                const bool ls = ((sel >> n) & 1u) != 0u;
                if (__ballot(ls) == 0ull) continue;
                attn_range<2>(c, qf, n * 8, n * 8 + 7, t0, d00, st, maskrow, h8, 0, 0, ls);
            }
            attn_range<3>(c, qf, cur * 8, qt, t0, d00, st, maskrow, h8, 0, 0, false);
        }
    }
    float lt = st.l + __shfl_xor(st.l, 32);
    if (type == 1) {
        const float* pp = (const float*)(a.ws + WS_G2) + ((size_t)(tok0 + t0 + r) * 4 + hd) * 68;
        const f32x2 ml = *(const f32x2*)(pp + 64);
        const float mn = fmaxf(st.m, ml[0]);
        const float a1 = __builtin_amdgcn_exp2f(st.m - mn), a2 = __builtin_amdgcn_exp2f(ml[0] - mn);
        lt = lt * a1 + ml[1] * a2;
#pragma unroll
        for (int g4 = 0; g4 < 4; ++g4) {
            const f32x4 p0 = *(const f32x4*)(pp + 8 * g4 + 4 * h), p1 = *(const f32x4*)(pp + 32 + 8 * g4 + 4 * h);
#pragma unroll
            for (int e = 0; e < 4; ++e) { st.o0[4 * g4 + e] = st.o0[4 * g4 + e] * a1 + p0[e] * a2; st.o1[4 * g4 + e] = st.o1[4 * g4 + e] * a1 + p1[e] * a2; }
        }
    }
    const float inv = 1.0f / lt;
    bf16_t* op = oabc + (size_t)(tok0 + t0 + r) * 1024 + ocol + 4 * h;
#pragma unroll
    for (int g4 = 0; g4 < 4; ++g4) {
        u32x2 w;
        w.x = pk2(st.o0[4 * g4] * inv, st.o0[4 * g4 + 1] * inv); w.y = pk2(st.o0[4 * g4 + 2] * inv, st.o0[4 * g4 + 3] * inv);
        *(u32x2*)(op + 8 * g4) = w;
        w.x = pk2(st.o1[4 * g4] * inv, st.o1[4 * g4 + 1] * inv); w.y = pk2(st.o1[4 * g4 + 2] * inv, st.o1[4 * g4 + 3] * inv);
        *(u32x2*)(op + 32 + 8 * g4) = w;
    }
}
DI void g2_job(const Args& a, unsigned char* wsh, LAS unsigned char* wl, int b, int slot, int cls, int it, const int tid) {
    const int lane = tid & 63, r = lane & 31, h = lane >> 5;
    const bf16_t* prm = (const bf16_t*)(a.ws + WS_R1);
    const bf16_t* vt16 = (const bf16_t*)(a.ws + WS_VT16);
    const float* glut = (const float*)(a.ws + WS_LUT);
    float* lut = (float*)(wsh + 8192);
    const int tok0 = b * SEQ;
    const int d00 = 32 * it + r - 8 * h;
    AttnCtx c; c.wl = wl; c.lut = lut; c.krs = 16;
#pragma unroll
    for (int j = 0; j < 4; ++j) {
        const int rk = 8 * j + (lane >> 3), ck = (lane & 7) ^ ((rk >> 1) & 7);
        c.koff[j] = (unsigned)(pi_row(rk) * 16 * RM_LD + ck * 8) * 2u;
        const int rv = 16 * j + (lane >> 2), cv = (lane & 3) ^ ((rv >> 2) & 3);
        c.voff[j] = (unsigned)(rv * MTOK + cv * 8) * 2u;
        c.kfo[j] = r * 128 + (((2 * j + h) ^ ((r >> 1) & 7)) * 16);
    }
#pragma unroll
    for (int mt = 0; mt < 2; ++mt)
#pragma unroll
        for (int s = 0; s < 2; ++s) c.vfo[mt][s] = (32 * mt + r) * 64 + (((2 * s + h) ^ ((r >> 2) & 3)) * 16);
    AttnSt st; st.m = NEGF; st.l = 0.f;
#pragma unroll
    for (int i = 0; i < 16; ++i) { st.o0[i] = 0.f; st.o1[i] = 0.f; }
    load_lut(lut, glut, 6 + 2 * 4 + slot, lane);
    const int tq = tok0 + cls + 16 * (32 * it + r);
    bf16x8 qf[4];
    const bf16_t* qp = prm + (size_t)tq * RM_LD + C_BQ + (2 * 4 + slot) * 64 + 8 * h;
#pragma unroll
    for (int ks = 0; ks < 4; ++ks) qf[ks] = *(const bf16x8*)(qp + 16 * ks);
    c.kg = prm + (size_t)(tok0 + cls) * RM_LD + C_BK + slot * 64;
    c.vg = vt16 + (size_t)(slot * 64) * MTOK + tok0 + cls * 128;
    attn_range<4>(c, qf, 0, it, 0, d00, st, nullptr, 0, 0, 0, false);
    const float lt = st.l + __shfl_xor(st.l, 32);
    float* pp = (float*)(a.ws + WS_G2) + ((size_t)tq * 4 + slot) * 68;
#pragma unroll
    for (int g4 = 0; g4 < 4; ++g4) {
        f32x4 p0, p1;
#pragma unroll
        for (int e = 0; e < 4; ++e) { p0[e] = st.o0[4 * g4 + e]; p1[e] = st.o1[4 * g4 + e]; }
        *(f32x4*)(pp + 8 * g4 + 4 * h) = p0; *(f32x4*)(pp + 32 + 8 * g4 + 4 * h) = p1;
    }
    if (h == 0) { f32x2 ml = {st.m, lt}; *(f32x2*)(pp + 64) = ml; }
}
DI void phase_attn(const Args& a, unsigned char* shm, const int tid) {
    const int wid = __builtin_amdgcn_readfirstlane(tid >> 6);
    unsigned char* wsh = shm + wid * 16384;
    LAS unsigned char* wl = (LAS unsigned char*)shm + wid * 16384;
    for (int it = 0;; ++it) {
        int b, qt; if (!task_map(it, b, qt)) break;
        const int role = (wid + it) & 7;
        if (role < 6) { attn_job(a, wsh, wl, 0, b, qt, role, tid); attn_job(a, wsh, wl, 2, b, qt, role, tid); }
        else { attn_job(a, wsh, wl, 1, b, qt, role - 6, tid); attn_job(a, wsh, wl, 1, b, qt, role - 4, tid); }
    }
}

#define XB_TMO      128
#define XB_XCNT(j)  (256  + 64 * (j))
#define XB_XSUB(j)  (1280 + 64 * (j))
#define XB_XGEN(j)  (2304 + 64 * (j))
#define XB_TOP      3328
#define XB_TOPGEN   3392
#define XCD_BAR_WORDS 3456
#define XB_SPIN_CAP (1u << 20)
DI unsigned xb_ld(unsigned* p)              { return __hip_atomic_load(p, __ATOMIC_RELAXED, __HIP_MEMORY_SCOPE_AGENT); }
DI unsigned xb_add(unsigned* p, unsigned v) { return __hip_atomic_fetch_add(p, v, __ATOMIC_RELAXED, __HIP_MEMORY_SCOPE_AGENT); }
DI unsigned xb_xcc_id() { return (unsigned)__builtin_amdgcn_s_getreg((3 << 11) | 20) & 0xFu; }
#define XB_SPIN(cond, bar) do { unsigned _sp = 0; while (cond) { __builtin_amdgcn_s_sleep(1); \
    if ((++_sp & 255u) == 0u) { if (xb_ld(&(bar)[XB_TMO])) break; if (_sp > XB_SPIN_CAP) { atomicAdd(&(bar)[XB_TMO], 1u); break; } } } } while (0)
struct XcdBarrier { unsigned* bar; unsigned x; volatile LAS unsigned* st; };
DI void xcd_barrier_complete(unsigned* bar, unsigned x, unsigned& nloc, unsigned& nx) {
    const unsigned G = gridDim.x * gridDim.y * gridDim.z;
    unsigned sum, cnt, mine, sp = 0u;
    for (;;) {
        sum = 0u; cnt = 0u; mine = 0u;
#pragma unroll
        for (unsigned j = 0; j < 16; ++j) { const unsigned c = xb_ld(&bar[XB_XCNT(j)]); sum += c; cnt += (c > 0u) ? 1u : 0u; mine = (j == x) ? c : mine; }
        if (sum == G) break;
        __builtin_amdgcn_s_sleep(1);
        if ((++sp & 255u) == 0u) { if (xb_ld(&bar[XB_TMO])) break; if (sp > XB_SPIN_CAP) { atomicAdd(&bar[XB_TMO], 1u); break; } }
    }
    nloc = mine > 0u ? mine : 1u; nx = cnt > 0u ? cnt : 1u;
}
DI void xcd_barrier(const XcdBarrier& b, const int tid) {
    asm volatile("s_waitcnt vmcnt(0)" ::: "memory");
    __syncthreads();
    if (tid == 0) {
        unsigned* bar = b.bar;
        __builtin_amdgcn_s_waitcnt(0);
        unsigned nloc = b.st[0], nx = b.st[1];
        if (nloc == 0u) { xcd_barrier_complete(bar, b.x, nloc, nx); b.st[0] = nloc; b.st[1] = nx; }
        const unsigned old = xb_add(&bar[XB_XSUB(b.x)], 1u);
        const unsigned gen = old / nloc;
        if (old + 1u == (gen + 1u) * nloc) {
            __builtin_amdgcn_fence(__ATOMIC_RELEASE, "agent");
            asm volatile("s_waitcnt vmcnt(0)" ::: "memory");
            const unsigned og = xb_add(&bar[XB_TOP], 1u);
            const unsigned tg = og / nx;
            if (og + 1u == (tg + 1u) * nx) xb_add(&bar[XB_TOPGEN], 1u);
            else XB_SPIN(xb_ld(&bar[XB_TOPGEN]) == tg, bar);
            __builtin_amdgcn_fence(__ATOMIC_ACQUIRE, "agent");
            xb_add(&bar[XB_XGEN(b.x)], 1u);
            asm volatile("s_waitcnt vmcnt(0)" ::: "memory");
        } else {
            XB_SPIN(xb_ld(&bar[XB_XGEN(b.x)]) == gen, bar);
            __builtin_amdgcn_fence(__ATOMIC_ACQUIRE, "agent");
            asm volatile("s_waitcnt vmcnt(0)" ::: "memory");
        }
    }
    __syncthreads();
}

__global__ void __launch_bounds__(512, 2) mega_fwd(Args a_) {
    extern __shared__ __attribute__((aligned(16))) unsigned char shm[];
    cg::grid_group grid = cg::this_grid();
    LAS unsigned char* lds = (LAS unsigned char*)shm;
    const int G = gridDim.x, c = blockIdx.x;
#ifndef PROBE_REP
#define PROBE_REP -2
#endif
    const int ph_lo = a_.ph_lo, ph_hi = a_.ph_hi;
    const int wave_id = __builtin_amdgcn_readfirstlane(threadIdx.x >> 6);
    XcdBarrier xbar;
    { volatile LAS unsigned* st = (volatile LAS unsigned*)(lds + 131072);
      if (threadIdx.x == 0) { st[0] = 0u; st[1] = 0u; }
      __syncthreads();
      xbar.bar = (unsigned*)(a_.ws + WS_BAR); xbar.x = xb_xcc_id(); xbar.st = st;
      if (threadIdx.x == 0) (void)xb_add(&xbar.bar[XB_XCNT(xbar.x)], 1u); }
    for (int phx = 2 * ph_lo; phx < 2 * ph_hi; ++phx) {
        const int ph = phx >> 1;
        if (phx & 1) { const bool rep = (PROBE_REP == -1) ? (ph == 0) : (ph > 0 && (ph - 1) % 9 == PROBE_REP); if (!rep) continue; }
        const Args& a = a_;
        int tid = wave_id * 64 + (int)__builtin_amdgcn_mbcnt_hi(~0u, __builtin_amdgcn_mbcnt_lo(~0u, 0u)); asm volatile("" : "+v"(tid));
        bf16_t* xb = (bf16_t*)(a.ws + WS_XB);
        bf16_t* r1 = (bf16_t*)(a.ws + WS_R1);
        bf16_t* oabc = (bf16_t*)(a.ws + WS_OABC);
        float* stats = (float*)(a.ws + WS_STATS);
        if (ph == 0) phase_convert(a, shm, tid);
        else {
            const int l = (ph - 1) / 9, sp = (ph - 1) % 9;
            const bf16_t* w = (const bf16_t*)(a.ws + WS_WB) + (size_t)l * W_LAYER;
            const float* xin = (l == 0) ? a.in[0] : a.out;
            if (sp == 0) {
                { pg8::Gemm g{xb, w + WO_IN, 1024, 1024, 1024, 0}; pg8::StaticOrder S; S.init(256, 11, G, c); pg8::EpiBf16<0> E{r1, RM_LD}; pg8::gemm_phase(lds, g, S, E, tid); }
                { pg8::Gemm g{w + WO_IN + (size_t)RM_LD * 1024, xb, 1024, 1024, 1024, 0}; pg8::StaticOrder S; S.init(3, 256, G, c); pg8::EpiBf16<0> E{r1 + (size_t)MTOK * RM_LD, MTOK}; pg8::gemm_phase(lds, g, S, E, tid); }
                { pg8::Gemm g{w + WO_IN + (size_t)2880 * 1024, xb, 1024, 16 * 1024, 1024, 2048}; pg8::OrderVT16 S{G, c}; pg8::EpiBf16<0> E{(bf16_t*)(a.ws + WS_VT16), MTOK}; pg8::gemm_phase(lds, g, S, E, tid); }
            } else if (sp == 1) phase_a1(a, shm, tid);
            else if (sp == 2) phase_attn(a, shm, tid);
            else if (sp == 3) {
                pg8::StaticOrder S; S.init(256, 4, G, c);
                { pg8::Gemm g{oabc, w + WO_BA, 1024, 384, 384, 0}; pg8::EpiBf16<0> E{r1, 3072}; pg8::gemm_phase(lds, g, S, E, tid); }
                { pg8::Gemm g{oabc + 384, w + WO_BB, 1024, 256, 256, 0}; pg8::EpiBf16<0> E{r1 + 1024, 3072}; pg8::gemm_phase(lds, g, S, E, tid); }
                { pg8::Gemm g{oabc + 640, w + WO_BC, 1024, 384, 384, 0}; pg8::EpiBf16<0> E{r1 + 2048, 3072}; pg8::gemm_phase(lds, g, S, E, tid); }
                { pg8::Gemm g{xb, w + WO_G, 1024, 1024, 1024, 0}; pg8::Order3 S3; S3.base = S; pg8::EpiGate E{r1, r1 + (size_t)MTOK * 3072}; pg8::gemm_phase(lds, g, S3, E, tid); }
            } else if (sp == 4) {
                pg8::Gemm g{r1 + (size_t)MTOK * 3072, w + WO_OUT, 1024, 1024, 1024, 0}; pg8::StaticOrder S; S.init(256, 4, G, c);
                if (l == 0) { pg8::EpiRes<false, false> E{xin, a.out, nullptr, nullptr, nullptr, nullptr}; pg8::gemm_phase(lds, g, S, E, tid); }
                else { pg8::EpiRes<false, true> E{xin, a.out, nullptr, stats, a.in[14], a.in[15]}; pg8::gemm_phase(lds, g, S, E, tid); }
            } else if (sp == 5) phase_ln<false>(a.out, xb, stats, a.in[8] + l * 1024, a.in[9] + l * 1024, tid);
            else if (sp == 6) {
                { pg8::Gemm g{xb, w + WO_UP, 1024, 1024, 1024, 0}; pg8::StaticOrder S; S.init(256, 16, G, c); pg8::EpiBf16<1> E{r1, 4096}; pg8::gemm_phase(lds, g, S, E, tid); }
                pg8::StaticOrder S; S.init(256, 4, G, c);
                { pg8::Gemm g{(const bf16_t*)(a.ws + WS_PB) + (size_t)l * MTOK * 256, w + WO_PL, 256, 256, 256, 0}; pg8::EpiBf16<0> E{oabc, 1024}; pg8::gemm_phase(lds, g, S, E, tid); }
                { pg8::Gemm g{xb, w + WO_PG, 1024, 1024, 1024, 0}; pg8::EpiT1 E{oabc}; pg8::gemm_phase(lds, g, S, E, tid); }
            } else if (sp == 7) {
                pg8::Gemm g{r1, w + WO_DN, 4096, 4096, 4096, 0}; pg8::StaticOrder S; S.init(256, 4, G, c);
                pg8::EpiRes<true, true> E{a.out, a.out, oabc, stats, a.in[8] + l * 1024, a.in[9] + l * 1024}; pg8::gemm_phase(lds, g, S, E, tid);
            } else { if (l == 0) phase_ln<false>(a.out, xb, stats, a.in[14], a.in[15], tid); else phase_ln<true>(a.out, xb, stats, a.in[14] + 1024, a.in[15] + 1024, tid); }
        }
        if (phx + 1 < 2 * ph_hi) { if (ph == 0) grid.sync(); else xcd_barrier(xbar, tid); }
    }
}

#ifndef N_LAUNCH_MODE
#define N_LAUNCH_MODE 1
#endif
extern "C" void kernel_launch(void* const* d_in, const int* in_sizes, int n_in, void* d_out, int out_size, void* d_ws, size_t ws_size, hipStream_t stream) {
    static int grid = 0;
    if (grid == 0) {
        if (n_in != 17 || out_size != MTOK * DM || ws_size < WS_END) { fprintf(stderr, "kernel_launch: unexpected shapes (n_in %d out %d ws %zu need %zu)\n", n_in, out_size, ws_size, (size_t)WS_END); grid = -1; return; }
        int dev = 0, cus = 0, per_cu = 0;
        hipGetDevice(&dev);
        hipDeviceGetAttribute(&cus, hipDeviceAttributeMultiprocessorCount, dev);
        if (hipFuncSetAttribute((const void*)mega_fwd, hipFuncAttributeMaxDynamicSharedMemorySize, LDS_BYTES) != hipSuccess) { fprintf(stderr, "kernel_launch: hipFuncSetAttribute failed\n"); grid = -1; return; }
        hipOccupancyMaxActiveBlocksPerMultiprocessor(&per_cu, (const void*)mega_fwd, 512, LDS_BYTES);
        if (per_cu < 1) { fprintf(stderr, "kernel_launch: occupancy query says %d\n", per_cu); per_cu = 1; }
        (void)hipGetLastError();
        grid = cus * per_cu;
    }
    if (grid < 0) return;
    if (hipMemsetAsync((char*)d_ws + WS_BAR, 0, (size_t)3456 * 4, stream) != hipSuccess) { fprintf(stderr, "kernel_launch: memset of the barrier words failed\n"); return; }
    Args a{};
    for (int i = 0; i < 17; ++i) a.in[i] = (const float*)d_in[i];
    a.out = (float*)d_out; a.ws = (unsigned char*)d_ws;
#if N_LAUNCH_MODE == 0
    for (int ph = 0; ph < 19; ++ph) {
        a.ph_lo = ph; a.ph_hi = ph + 1;
        hipLaunchKernelGGL(mega_fwd, dim3(grid), dim3(512), LDS_BYTES, stream, a);
    }
#else
    a.ph_lo = 0; a.ph_hi = 19;
    void* args[] = {&a};
    hipError_t e = hipLaunchCooperativeKernel((const void*)mega_fwd, dim3(grid), dim3(512), args, LDS_BYTES, stream);
    if (e != hipSuccess) fprintf(stderr, "cooperative launch failed: %s (grid %d)\n", hipGetErrorString(e), grid);
#endif
}
```

```cpp
#include <hip/hip_runtime.h>
#include <hip/hip_cooperative_groups.h>
#include <cstdio>
namespace cg = cooperative_groups;

#define LAS __attribute__((address_space(3)))
#define DI __device__ __forceinline__
typedef unsigned short bf16_t;
typedef short bf16x8 __attribute__((ext_vector_type(8)));
typedef float f32x2 __attribute__((ext_vector_type(2)));
typedef float f32x4 __attribute__((ext_vector_type(4)));
typedef float f32x16 __attribute__((ext_vector_type(16)));
typedef unsigned u32x2 __attribute__((ext_vector_type(2)));
typedef unsigned u32x4 __attribute__((ext_vector_type(4)));
typedef __bf16 bf2_t __attribute__((ext_vector_type(2)));

constexpr int MTOK = 65536, SEQ = 2048, DM = 1024, NB = 32, DFF = 4096, PLE = 256;
constexpr int RM_LD = 2816;
constexpr int C_AQ = 0, C_AK = 384, C_IQ = 448, C_IK = 960, C_BQ = 1024, C_BK = 1792, C_CQ = 2048, C_CK = 2432;
constexpr int T_ROWS = 768;
constexpr int R_AV = 0, R_BV = 64, R_CV = 320, R_IW = 704;
constexpr int NWIN = 3584;
constexpr float ALPHA = 1.41421356237309515f;
constexpr float LOG2E = 1.44269504088896341f;
constexpr float SC2 = 0.125f * LOG2E;
constexpr float NEGF = -1e30f;
constexpr int LDS_BYTES = 131072 + 16;

constexpr size_t WO_IN = 0;
constexpr size_t WO_G = WO_IN + (size_t)NWIN * 1024;
constexpr size_t WO_BA = WO_G + (size_t)3072 * 1024;
constexpr size_t WO_BB = WO_BA + (size_t)1024 * 384;
constexpr size_t WO_BC = WO_BB + (size_t)1024 * 256;
constexpr size_t WO_OUT = WO_BC + (size_t)1024 * 384;
constexpr size_t WO_UP = WO_OUT + (size_t)1024 * 1024;
constexpr size_t WO_DN = WO_UP + (size_t)4096 * 1024;
constexpr size_t WO_PG = WO_DN + (size_t)1024 * 4096;
constexpr size_t WO_PL = WO_PG + (size_t)1024 * 1024;
constexpr size_t W_LAYER = WO_PL + (size_t)1024 * 256;

constexpr size_t WS_WB = 0;
constexpr size_t WS_LUT = WS_WB + 2 * W_LAYER * 2;
constexpr size_t WS_KMEAN = WS_LUT + (size_t)24 * 2048 * 4;
constexpr size_t WS_MASK = WS_KMEAN + (size_t)32 * 6 * 8 * 64 * 4;
constexpr size_t WS_XB = WS_MASK + (size_t)MTOK * 64 * 4;
constexpr size_t WS_PB = WS_XB + (size_t)MTOK * 1024 * 2;
constexpr size_t WS_OABC = WS_PB + (size_t)2 * MTOK * 256 * 2;
constexpr size_t WS_R1 = WS_OABC + (size_t)MTOK * 1024 * 2;
constexpr size_t WS_BAR = WS_R1 + (size_t)MTOK * 4096 * 2;
constexpr size_t WS_STATS = WS_BAR + (size_t)4096 * 4;
constexpr size_t WS_G2 = WS_STATS + (size_t)MTOK * 2 * 4;
constexpr size_t WS_END = WS_G2 + (size_t)MTOK * 4 * 68 * 4;
constexpr size_t WS_VT16 = WS_R1 + ((size_t)MTOK * RM_LD + (size_t)T_ROWS * MTOK) * 2;

struct Args {
    const float* in[17];
    float* out;
    unsigned char* ws;
    int ph_lo, ph_hi;
};

DI unsigned short f2bf(float f) { unsigned u = __float_as_uint(f); u += 0x7FFFu + ((u >> 16) & 1u); return (unsigned short)(u >> 16); }
DI unsigned pk2(float lo, float hi) { f32x2 v = {lo, hi}; bf2_t b = __builtin_convertvector(v, bf2_t); return __builtin_bit_cast(unsigned, b); }
DI float bf_lo(unsigned w) { return __uint_as_float(w << 16); }
DI float bf_hi(unsigned w) { return __uint_as_float(w & 0xFFFF0000u); }
DI float bf2f(bf16_t b) { return __uint_as_float(((unsigned)b) << 16); }
DI float sigmoidf_(float x) { return __builtin_amdgcn_rcpf(1.0f + __expf(-x)); }
#define MFMA32(a, b, c) __builtin_amdgcn_mfma_f32_32x32x16_bf16((a), (b), (c), 0, 0, 0)

namespace pg8 {
constexpr int BM = 256, BK = 64, HALF = 128, HTB = HALF * BK * 2, NXCD = 8, WGM = 8;
DI int lds_byte(int r, int c) { const int st = (r >> 4) * 2 + (c >> 5), rr = r & 15, cc = c & 31, ob = rr * 64 + cc * 2; return st * 1024 + (ob ^ (((ob >> 9) & 1) << 5)); }
DI void stage_rc(int b, int& R, int& C) { const int st = b / 1024, sb = b % 1024, swz = sb ^ (((sb >> 9) & 1) << 5); R = (st >> 1) * 16 + swz / 64; C = (st & 1) * 32 + (swz % 64) / 2; }
DI int perm32(int rho) { const int n = rho >> 4, i = rho & 15; return 8 * (i >> 2) + 4 * n + (i & 3); }

struct Unit { int pm, pn; long bofs; };
struct Gemm { const bf16_t* A; const bf16_t* Bt; int lda, ldb, K; long hsB; };

struct StaticOrder {
    int nM, nN, nwg, G, c;
    DI void init(int nM_, int nN_, int G_, int c_) { nM = nM_; nN = nN_; nwg = nM * nN; G = G_; c = c_; }
    DI bool next(int i, Unit& u) const {
        const long L = (long)i * G + c; if (L >= nwg) return false;
        int wgid = (int)L; { const int q = nwg / NXCD, r = nwg % NXCD, xcd = wgid % NXCD, off = wgid / NXCD; wgid = (xcd < r ? xcd * (q + 1) : r * (q + 1) + (xcd - r) * q) + off; }
        const int nig = WGM * nN, gid = wgid / nig, fm = gid * WGM, gsz = (nM - fm) < WGM ? (nM - fm) : WGM;
        u.pm = fm + ((wgid % nig) % gsz); u.pn = (wgid % nig) / gsz; u.bofs = -1; return true;
    }
};
struct OrderVT16 {
    int G, c;
    DI bool next(int i, Unit& u) const { const int L = i * G + c; if (L >= 256) return false; u.pm = 0; u.pn = L; u.bofs = ((long)((L >> 3) * 2048 + 2 * (L & 7)) * 1024) * 2; return true; }
};
struct Order3 {
    StaticOrder base;
    DI bool next(int i, Unit& u) const { Unit v; if (!base.next(i / 3, v)) return false; u.pm = v.pm; u.pn = (i % 3) * 4 + v.pn; u.bofs = -1; return true; }
};

template <int ACT  > struct EpiBf16 {
    static constexpr bool PERM = true;
    bf16_t* O; int ldc;
    DI void operator()(const f32x4 (&acc)[2][2][4][2], const Unit& u, int wr, int wc, int fr, int fq) const {
        const int row0 = u.pm * BM + wr * 64 + fr, col0 = u.pn * BM + wc * 32 + 8 * fq;
#pragma unroll
        for (int ai = 0; ai < 2; ++ai)
#pragma unroll
            for (int m = 0; m < 4; ++m) { bf16_t* rowp = O + (size_t)(row0 + ai * HALF + m * 16) * ldc + col0;
#pragma unroll
                for (int bj = 0; bj < 2; ++bj) { f32x4 v0 = acc[ai][bj][m][0], v1 = acc[ai][bj][m][1];
                    if (ACT == 1) {
#pragma unroll
                        for (int j = 0; j < 4; ++j) { float a = fmaxf(v0[j], 0.f), b = fmaxf(v1[j], 0.f); v0[j] = a * a; v1[j] = b * b; } }
                    u32x4 w; w.x = pk2(v0[0], v0[1]); w.y = pk2(v0[2], v0[3]); w.z = pk2(v1[0], v1[1]); w.w = pk2(v1[2], v1[3]);
                    *(u32x4*)(rowp + bj * HALF) = w; } }
    }
};
struct EpiGate {
    static constexpr bool PERM = true;
    const bf16_t* obr; bf16_t* mg;
    DI void operator()(const f32x4 (&acc)[2][2][4][2], const Unit& u, int wr, int wc, int fr, int fq) const {
        const int b = u.pn >> 2, colt = (u.pn & 3) * BM;
        const int row0 = u.pm * BM + wr * 64 + fr, col0 = colt + wc * 32 + 8 * fq;
#pragma unroll
        for (int ai = 0; ai < 2; ++ai)
#pragma unroll
            for (int m = 0; m < 4; ++m) { const size_t row = (size_t)(row0 + ai * HALF + m * 16);
#pragma unroll
                for (int bj = 0; bj < 2; ++bj) { const f32x4 v0 = acc[ai][bj][m][0], v1 = acc[ai][bj][m][1];
                    const u32x4 ob = *(const u32x4*)(obr + row * 3072 + b * 1024 + col0 + bj * HALF);
                    bf16_t* mp = mg + row * 1024 + col0 + bj * HALF;
                    float r[8];
                    r[0] = sigmoidf_(v0[0]) * bf_lo(ob.x); r[1] = sigmoidf_(v0[1]) * bf_hi(ob.x); r[2] = sigmoidf_(v0[2]) * bf_lo(ob.y); r[3] = sigmoidf_(v0[3]) * bf_hi(ob.y);
                    r[4] = sigmoidf_(v1[0]) * bf_lo(ob.z); r[5] = sigmoidf_(v1[1]) * bf_hi(ob.z); r[6] = sigmoidf_(v1[2]) * bf_lo(ob.w); r[7] = sigmoidf_(v1[3]) * bf_hi(ob.w);
                    if (b > 0) { const u32x4 pm_ = *(const u32x4*)mp;
                        r[0] += bf_lo(pm_.x); r[1] += bf_hi(pm_.x); r[2] += bf_lo(pm_.y); r[3] += bf_hi(pm_.y); r[4] += bf_lo(pm_.z); r[5] += bf_hi(pm_.z); r[6] += bf_lo(pm_.w); r[7] += bf_hi(pm_.w); }
                    u32x4 w; w.x = pk2(r[0], r[1]); w.y = pk2(r[2], r[3]); w.z = pk2(r[4], r[5]); w.w = pk2(r[6], r[7]);
                    *(u32x4*)mp = w; } }
    }
};
struct EpiT1 {
    static constexpr bool PERM = true;
    bf16_t* T;
    DI void operator()(const f32x4 (&acc)[2][2][4][2], const Unit& u, int wr, int wc, int fr, int fq) const {
        const int row0 = u.pm * BM + wr * 64 + fr, col0 = u.pn * BM + wc * 32 + 8 * fq;
#pragma unroll
        for (int ai = 0; ai < 2; ++ai)
#pragma unroll
            for (int m = 0; m < 4; ++m) { const size_t row = (size_t)(row0 + ai * HALF + m * 16);
#pragma unroll
                for (int bj = 0; bj < 2; ++bj) { const f32x4 v0 = acc[ai][bj][m][0], v1 = acc[ai][bj][m][1];
                    bf16_t* tp = T + row * 1024 + col0 + bj * HALF;
                    const u32x4 ob = *(const u32x4*)tp;
                    float r[8];
                    r[0] = sigmoidf_(v0[0]) * bf_lo(ob.x); r[1] = sigmoidf_(v0[1]) * bf_hi(ob.x); r[2] = sigmoidf_(v0[2]) * bf_lo(ob.y); r[3] = sigmoidf_(v0[3]) * bf_hi(ob.y);
                    r[4] = sigmoidf_(v1[0]) * bf_lo(ob.z); r[5] = sigmoidf_(v1[1]) * bf_hi(ob.z); r[6] = sigmoidf_(v1[2]) * bf_lo(ob.w); r[7] = sigmoidf_(v1[3]) * bf_hi(ob.w);
                    u32x4 w; w.x = pk2(r[0], r[1]); w.y = pk2(r[2], r[3]); w.z = pk2(r[4], r[5]); w.w = pk2(r[6], r[7]);
                    *(u32x4*)tp = w; } }
    }
};
template <bool HAS_T, bool LNX> struct EpiRes {
    static constexpr bool PERM = false;
    const float* xin; float* y; const bf16_t* T; const float* stats; const float* lg; const float* lb;
    DI void operator()(const f32x4 (&acc)[2][2][4][2], const Unit& u, int wr, int wc, int fr, int fq) const {
        const int row0 = u.pm * BM + wr * 64 + fr, col0 = u.pn * BM + wc * 32 + 4 * fq;
#pragma unroll
        for (int bj = 0; bj < 2; ++bj)
#pragma unroll
            for (int n = 0; n < 2; ++n) {
                const int col = col0 + bj * HALF + n * 16;
                f32x4 gv = {1.f, 1.f, 1.f, 1.f}, bv = {0.f, 0.f, 0.f, 0.f};
                if (LNX) { gv = *(const f32x4*)(lg + col); bv = *(const f32x4*)(lb + col); }
#pragma unroll
                for (int ai = 0; ai < 2; ++ai)
#pragma unroll
                    for (int m = 0; m < 4; ++m) {
                        const int row = row0 + ai * HALF + m * 16;
                        const size_t o = (size_t)row * 1024 + col;
                        f32x4 xv = *(const f32x4*)(xin + o);
                        if (LNX) { const f32x2 sm = *(const f32x2*)(stats + 2 * (size_t)row); xv = (xv - sm[0]) * sm[1] * gv + bv; }
                        f32x4 r = acc[ai][bj][m][n] + xv * ALPHA;
                        if (HAS_T) { const u32x2 tv = *(const u32x2*)(T + o); r[0] += bf_lo(tv.x); r[1] += bf_hi(tv.x); r[2] += bf_lo(tv.y); r[3] += bf_hi(tv.y); }
                        *(f32x4*)(y + o) = r; }
            }
    }
};

template <class Epi, class Sched>
DI void gemm_phase(LAS unsigned char* lds, const Gemm g, const Sched& S, const Epi& E, const int tid) {
    const int wid = __builtin_amdgcn_readfirstlane(tid >> 6), lane = tid & 63, wr = wid >> 2, wc = wid & 3, fr = lane & 15, fq = lane >> 4;
    const int K = g.K, nt = K / BK;
    unsigned voffA_, voffB_;
    { int R, C; stage_rc(tid * 16, R, C); const int Rb = Epi::PERM ? ((R & ~31) + perm32(R & 31)) : R;
      voffA_ = (unsigned)(R * g.lda + C) * 2u; voffB_ = (unsigned)(Rb * g.ldb + C) * 2u; }
    const size_t p64offA = (size_t)64 * g.lda * 2, p64offB = (size_t)64 * g.ldb * 2;
    const size_t kstep = (size_t)(BK * 2);
    const size_t hstepA = (size_t)HALF * g.lda * 2, hstepB = g.hsB > 0 ? (size_t)g.hsB : (size_t)HALF * g.ldb * 2;
    const size_t tstepA = 2 * hstepA, tstepB = 2 * hstepB;
    const unsigned ldsw = (unsigned)wid * 1024u;
    const int aoff = lds_byte(wr * 64 + fr, fq * 8), boff = lds_byte(wc * 32 + fr, fq * 8);
#define PG8_SA(b, h) (((b) * 2 + (h)) * HTB)
#define PG8_SB(b, h) ((4 + (b) * 2 + (h)) * HTB)
#define PG8_STAGE(bufoff, gbase, voff) do { _Pragma("unroll") for (int _i = 0; _i < 2; ++_i) \
        __builtin_amdgcn_global_load_lds((const unsigned*)((const char*)(gbase) + (size_t)_i * p64##voff + (v##voff##_)), (LAS unsigned*)(lds + (bufoff) + ldsw + _i * 8192), 16, 0, 0); } while (0)
#define PG8_LDA(dst, b, h) do { _Pragma("unroll") for (int m = 0; m < 4; ++m) _Pragma("unroll") for (int k = 0; k < 2; ++k) dst[m][k] = *(const LAS bf16x8*)(lds + PG8_SA(b, h) + aoff + m * 2048 + k * 1024); } while (0)
#define PG8_LDB(dst, b, h) do { _Pragma("unroll") for (int n = 0; n < 2; ++n) _Pragma("unroll") for (int k = 0; k < 2; ++k) dst[n][k] = *(const LAS bf16x8*)(lds + PG8_SB(b, h) + boff + n * 2048 + k * 1024); } while (0)
#define PG8_MMA(ai, bj, At, Bt) do { __builtin_amdgcn_s_setprio(1); _Pragma("unroll") for (int m = 0; m < 4; ++m) _Pragma("unroll") for (int n = 0; n < 2; ++n) _Pragma("unroll") for (int k = 0; k < 2; ++k) \
        acc[ai][bj][m][n] = __builtin_amdgcn_mfma_f32_16x16x32_bf16(Bt[n][k], At[m][k], acc[ai][bj][m][n], 0, 0, 0); __builtin_amdgcn_s_setprio(0); } while (0)
#define PG8_WAIT_V(n) asm volatile("s_waitcnt vmcnt(" #n ")" ::: "memory")
#define PG8_WAIT_L(n) asm volatile("s_waitcnt lgkmcnt(" #n ")" ::: "memory")
#define PG8_BAR __builtin_amdgcn_s_barrier()
#define PG8_SCHED __builtin_amdgcn_sched_barrier(0)
    Unit cur, nxt; int ui = 0;
    if (!S.next(0, cur)) return;
    f32x4 acc[2][2][4][2];
#pragma unroll
    for (int a = 0; a < 2; ++a)
#pragma unroll
        for (int b = 0; b < 2; ++b)
#pragma unroll
            for (int m = 0; m < 4; ++m)
#pragma unroll
                for (int n = 0; n < 2; ++n) acc[a][b][m][n] = (f32x4){0.f, 0.f, 0.f, 0.f};
    bf16x8 At[4][2], B0[2][2], B1[2][2];
    const char* cA = (const char*)g.A + (size_t)cur.pm * tstepA; const char* cB = (const char*)g.Bt + (cur.bofs >= 0 ? (size_t)cur.bofs : (size_t)cur.pn * tstepB);
    PG8_STAGE(PG8_SB(0, 0), cB, offB); PG8_STAGE(PG8_SA(0, 0), cA, offA); PG8_STAGE(PG8_SB(0, 1), cB + hstepB, offB); PG8_STAGE(PG8_SA(0, 1), cA + hstepA, offA);
    if (wr == 1) PG8_BAR;
    PG8_WAIT_V(4); PG8_BAR;
    PG8_STAGE(PG8_SB(1, 0), cB + kstep, offB); PG8_STAGE(PG8_SA(1, 0), cA + kstep, offA); PG8_STAGE(PG8_SB(1, 1), cB + hstepB + kstep, offB);
    PG8_WAIT_V(6); PG8_BAR;
    for (;;) {
        const bool has_next = S.next(ui + 1, nxt);
        const char* nA = has_next ? (const char*)g.A + (size_t)nxt.pm * tstepA : cA; const char* nB = has_next ? (const char*)g.Bt + (nxt.bofs >= 0 ? (size_t)nxt.bofs : (size_t)nxt.pn * tstepB) : cB;
        for (int t = 0; t < nt; t += 2) {
            const bool last = (t == nt - 2);
            const char* a1 = cA + (size_t)(t + 1) * kstep;
            const char* a2 = last ? nA : cA + (size_t)(t + 2) * kstep; const char* b2 = last ? nB : cB + (size_t)(t + 2) * kstep;
            const char* a3 = a2 + kstep; const char* b3 = b2 + kstep;
            PG8_LDB(B0, 0, 0); PG8_SCHED; PG8_LDA(At, 0, 0); PG8_STAGE(PG8_SA(1, 1), a1 + hstepA, offA);
            PG8_WAIT_L(8); PG8_BAR; PG8_WAIT_L(0); PG8_MMA(0, 0, At, B0); PG8_BAR; PG8_SCHED;
            PG8_LDB(B1, 0, 1); PG8_STAGE(PG8_SB(0, 0), b2, offB);
            PG8_BAR; PG8_WAIT_L(0); PG8_MMA(0, 1, At, B1); PG8_BAR;
            PG8_LDA(At, 0, 1); PG8_STAGE(PG8_SA(0, 0), a2, offA);
            PG8_BAR; PG8_WAIT_L(0); PG8_MMA(1, 0, At, B0); PG8_BAR; PG8_SCHED;
            PG8_STAGE(PG8_SB(0, 1), b2 + hstepB, offB);
            PG8_WAIT_V(6); PG8_BAR; PG8_MMA(1, 1, At, B1); PG8_BAR;
            PG8_LDB(B0, 1, 0); PG8_SCHED; PG8_LDA(At, 1, 0); PG8_STAGE(PG8_SA(0, 1), a2 + hstepA, offA);
            PG8_WAIT_L(8); PG8_BAR; PG8_WAIT_L(0); PG8_MMA(0, 0, At, B0); PG8_BAR; PG8_SCHED;
            PG8_LDB(B1, 1, 1); PG8_STAGE(PG8_SB(1, 0), b3, offB);
            PG8_BAR; PG8_WAIT_L(0); PG8_MMA(0, 1, At, B1); PG8_BAR;
            PG8_LDA(At, 1, 1); PG8_STAGE(PG8_SA(1, 0), a3, offA);
            PG8_BAR; PG8_WAIT_L(0); PG8_MMA(1, 0, At, B0); PG8_BAR; PG8_SCHED;
            PG8_STAGE(PG8_SB(1, 1), b3 + hstepB, offB);
            PG8_WAIT_V(6); PG8_BAR; PG8_MMA(1, 1, At, B1); PG8_BAR;
        }
        E(acc, cur, wr, wc, fr, fq);
        if (!has_next) break;
#pragma unroll
        for (int a = 0; a < 2; ++a)
#pragma unroll
            for (int b = 0; b < 2; ++b)
#pragma unroll
                for (int m = 0; m < 4; ++m)
#pragma unroll
                    for (int n = 0; n < 2; ++n) acc[a][b][m][n] = (f32x4){0.f, 0.f, 0.f, 0.f};
        cur = nxt; cA = nA; cB = nB; ++ui;
    }
    PG8_WAIT_V(0);
    if (wr == 0) PG8_BAR;
    PG8_BAR;
#undef PG8_SA
#undef PG8_SB
#undef PG8_STAGE
#undef PG8_LDA
#undef PG8_LDB
#undef PG8_MMA
#undef PG8_WAIT_V
#undef PG8_WAIT_L
#undef PG8_BAR
#undef PG8_SCHED
}
}

DI int win_srccol(int n) {
    if (n < 384) return n;
    if (n < 448) return 384 + (n - 384);
    if (n < 960) return 512 + (n - 448);
    if (n < 1024) return 1024 + (n - 960);
    if (n < 1792) return 1096 + (n - 1024);
    if (n < 2048) return 1864 + (n - 1792);
    if (n < 2432) return 2376 + (n - 2048);
    if (n < 2816) return 2760 + (n - 2432);
    if (n < 2880) return 448 + (n - 2816);
    if (n < 3136) return 2120 + (n - 2880);
    if (n < 3520) return 3144 + (n - 3136);
    if (n < 3528) return 1088 + (n - 3520);
    return -1;
}
DI void convT(unsigned char* shm, const float* src, int K, int Nsrc, bf16_t* dst, int Ndst, int mode, const int tid) {
    unsigned short* tl = (unsigned short*)shm;
    const int ntk = K / 64, ntiles = (Ndst / 64) * ntk;
    for (int tile = blockIdx.x; tile < ntiles; tile += gridDim.x) {
        const int n0 = (tile / ntk) * 64, k0 = (tile % ntk) * 64;
        const int nx = tid & 63, ky = tid >> 6;
        const int sc = mode ? win_srccol(n0 + nx) : (n0 + nx);
#pragma unroll
        for (int p = 0; p < 8; ++p) { const int k = k0 + ky + 8 * p; const float v = sc >= 0 ? src[(size_t)k * Nsrc + sc] : 0.f; tl[nx * 66 + ky + 8 * p] = f2bf(v); }
        __syncthreads();
#pragma unroll
        for (int p = 0; p < 8; ++p) { const int n = ky + 8 * p; dst[(size_t)(n0 + n) * K + k0 + nx] = tl[n * 66 + nx]; }
        __syncthreads();
    }
}
DI void conv_vec(const float* src, bf16_t* dst, size_t n8, const int tid) {
    for (size_t i = (size_t)blockIdx.x * 512 + tid; i < n8; i += (size_t)gridDim.x * 512) {
        const f32x4 a = *(const f32x4*)(src + i * 8), b = *(const f32x4*)(src + i * 8 + 4);
        u32x4 w; w.x = pk2(a[0], a[1]); w.y = pk2(a[2], a[3]); w.z = pk2(b[0], b[1]); w.w = pk2(b[2], b[3]);
        *(u32x4*)(dst + i * 8) = w;
    }
}
DI int rel_bucket(int n) {
    if (n < 16) return n;
    int large = 16 + (int)(logf((float)n / 16.0f) / 4.852030263919617f * 16.0f);
    return large < 31 ? large : 31;
}
DI void phase_convert(const Args& a, unsigned char* shm, const int tid) {
    bf16_t* wb = (bf16_t*)(a.ws + WS_WB);
    for (int l = 0; l < 2; ++l) {
        bf16_t* w = wb + (size_t)l * W_LAYER;
        convT(shm, a.in[2] + (size_t)l * 1024 * 3528, 1024, 3528, w + WO_IN, NWIN, 1, tid);
        convT(shm, a.in[3] + (size_t)l * 1024 * 3072, 1024, 3072, w + WO_G, 3072, 0, tid);
        convT(shm, a.in[4] + (size_t)l * 384 * 1024, 384, 1024, w + WO_BA, 1024, 0, tid);
        convT(shm, a.in[5] + (size_t)l * 256 * 1024, 256, 1024, w + WO_BB, 1024, 0, tid);
        convT(shm, a.in[6] + (size_t)l * 384 * 1024, 384, 1024, w + WO_BC, 1024, 0, tid);
        convT(shm, a.in[7] + (size_t)l * 1024 * 1024, 1024, 1024, w + WO_OUT, 1024, 0, tid);
        convT(shm, a.in[10] + (size_t)l * 1024 * 4096, 1024, 4096, w + WO_UP, 4096, 0, tid);
        convT(shm, a.in[11] + (size_t)l * 4096 * 1024, 4096, 1024, w + WO_DN, 1024, 0, tid);
        convT(shm, a.in[12] + (size_t)l * 1024 * 1024, 1024, 1024, w + WO_PG, 1024, 0, tid);
        convT(shm, a.in[13] + (size_t)l * 256 * 1024, 256, 1024, w + WO_PL, 1024, 0, tid);
    }
    conv_vec(a.in[0], (bf16_t*)(a.ws + WS_XB), (size_t)MTOK * 1024 / 8, tid);
    conv_vec(a.in[1], (bf16_t*)(a.ws + WS_PB), (size_t)2 * MTOK * 256 / 8, tid);
    float* lut = (float*)(a.ws + WS_LUT);
    const float* rb = a.in[16];
    for (int i = blockIdx.x * 512 + tid; i < 24 * 2048; i += gridDim.x * 512) {
        const int hd = i >> 11, d = i & 2047;
        lut[i] = rb[rel_bucket(d) * 24 + hd] * LOG2E;
    }
}

DI float wave_sum(float v) {
#pragma unroll
    for (int o = 32; o >= 1; o >>= 1) v += __shfl_xor(v, o);
    return v;
}
template <bool FINAL>
DI void phase_ln(float* y, bf16_t* xb, float* stats, const float* g, const float* b, const int tid) {
    const int wid = tid >> 6, lane = tid & 63;
    f32x4 gv[4], bv[4];
#pragma unroll
    for (int k = 0; k < 4; ++k) { gv[k] = *(const f32x4*)(g + k * 256 + lane * 4); bv[k] = *(const f32x4*)(b + k * 256 + lane * 4); }
    for (int row = blockIdx.x * 8 + wid; row < MTOK; row += gridDim.x * 8) {
        float* yp = y + (size_t)row * 1024;
        f32x4 v[4]; float s = 0.f;
#pragma unroll
        for (int k = 0; k < 4; ++k) { v[k] = *(const f32x4*)(yp + k * 256 + lane * 4); s += v[k][0] + v[k][1] + v[k][2] + v[k][3]; }
        const float mean = wave_sum(s) * (1.0f / 1024.0f);
        float q = 0.f;
#pragma unroll
        for (int k = 0; k < 4; ++k) { v[k] = v[k] - mean; q += v[k][0] * v[k][0] + v[k][1] * v[k][1] + v[k][2] * v[k][2] + v[k][3] * v[k][3]; }
        const float var = wave_sum(q) * (1.0f / 1024.0f);
        const float rs = 1.0f / sqrtf(var + 1e-5f);
        if (!FINAL && lane == 0) { f32x2 sm = {mean, rs}; *(f32x2*)(stats + 2 * (size_t)row) = sm; }
#pragma unroll
        for (int k = 0; k < 4; ++k) { const f32x4 o = v[k] * rs * gv[k] + bv[k];
            if (FINAL) *(f32x4*)(yp + k * 256 + lane * 4) = o;
            else { u32x2 w; w.x = pk2(o[0], o[1]); w.y = pk2(o[2], o[3]); *(u32x2*)(xb + (size_t)row * 1024 + k * 256 + lane * 4) = w; } }
    }
}

DI int pi_row(int r) { return (r & 3) | (((r >> 3) & 1) << 2) | (((r >> 2) & 1) << 3) | (r & 16); }
DI void task_rot(int tau, int& b, int& qt) { b = tau >> 6; qt = ((tau & 63) + 8 * (tau >> 8)) & 63; }
DI bool task_map(int k, int& b, int& qt) {
    if (gridDim.x == 256) { if (k >= 8) return false; const int xcd = blockIdx.x & 7, slot = blockIdx.x >> 3; b = xcd + 8 * (k >> 1); qt = (k & 1) ? 63 - slot : slot; return true; }
    const int tau = blockIdx.x + k * gridDim.x; if (tau >= 2048) return false; task_rot(tau, b, qt); return true;
}

DI void a1_task(unsigned char* shm, const bf16_t* prm, const bf16_t* prt, unsigned* mask, int b, int qt, const int tid) {
    const int wid = __builtin_amdgcn_readfirstlane(tid >> 6), lane = tid & 63, r = lane & 31, h = lane >> 5;
    const int t0 = qt * 32, tok0 = b * SEQ;
    unsigned* cnt = (unsigned*)(shm + 33280);
#pragma unroll
    for (int p = 0; p < 4; ++p) { const int c = tid + p * 512, row = c >> 6, ch = c & 63;
        *(u32x4*)(shm + row * 1040 + ch * 16) = *(const u32x4*)(prm + (size_t)(tok0 + t0 + row) * RM_LD + C_IQ + ch * 8); }
    cnt[tid] = 0u; cnt[tid + 512] = 0u;
    float* wqs = (float*)(shm + 33280 + 4096);
    if (tid < 256) wqs[tid] = bf2f(prt[(size_t)(R_IW + (tid >> 5)) * MTOK + tok0 + t0 + (tid & 31)]);
    __syncthreads();
    unsigned key[8][16];
    const bf16_t* kp = prm + (size_t)(tok0 + pi_row(r)) * RM_LD + C_IK + 8 * h;
    bf16x8 kf[4];
    if (wid <= qt) {
#pragma unroll
        for (int ks = 0; ks < 4; ++ks) kf[ks] = *(const bf16x8*)(kp + (size_t)(wid * 32) * RM_LD + 16 * ks);
    }
#pragma unroll
    for (int jt = 0; jt < 8; ++jt) {
        const int kt = wid + 8 * jt;
        if (kt <= qt) {
            const int s0 = kt * 32;
            bf16x8 kn[4];
            const bool hn = (jt < 7) && (kt + 8 <= qt);
            if (hn) {
#pragma unroll
                for (int ks = 0; ks < 4; ++ks) kn[ks] = *(const bf16x8*)(kp + (size_t)(s0 + 256) * RM_LD + 16 * ks);
            }
            float idx[16];
#pragma unroll
            for (int i = 0; i < 16; ++i) idx[i] = 0.f;
#pragma unroll 1
            for (int hh = 0; hh < 8; ++hh) {
                f32x16 acc;
#pragma unroll
                for (int i = 0; i < 16; ++i) acc[i] = 0.f;
                const unsigned char* qb = shm + r * 1040 + hh * 128 + 16 * h;
#pragma unroll
                for (int ks = 0; ks < 4; ++ks) { const bf16x8 qf = *(const bf16x8*)(qb + 32 * ks); acc = MFMA32(kf[ks], qf, acc); }
                const float wv = wqs[hh * 32 + r];
#pragma unroll
                for (int i = 0; i < 16; ++i) idx[i] = fmaf(wv, fmaxf(acc[i], 0.f), idx[i]);
            }
#pragma unroll
            for (int i = 0; i < 16; ++i) {
                const int s = s0 + 16 * (i >> 3) + 8 * h + (i & 7);
                const unsigned u = __float_as_uint(idx[i] + 0.0f);
                const unsigned k = (u & 0x80000000u) ? ~u : (u | 0x80000000u);
                key[jt][i] = (s <= t0 + r) ? k : 0u;
            }
            if (hn) {
#pragma unroll
                for (int ks = 0; ks < 4; ++ks) kf[ks] = kn[ks];
            }
        } else {
#pragma unroll
            for (int i = 0; i < 16; ++i) key[jt][i] = 0u;
        }
    }
    unsigned T = 0u;
    if (qt >= 8) {
        const int nheld = (qt >= wid) ? ((qt - wid) >> 3) + 1 : 0;
        bool done = false;
        for (int bit = 31; bit >= 0; --bit) {
            const unsigned cand = T | (1u << bit);
            int c = 0;
#pragma unroll
            for (int jt = 0; jt < 8; ++jt) {
                if (jt < nheld) {
#pragma unroll
                    for (int i = 0; i < 16; ++i) c += (key[jt][i] >= cand) ? 1 : 0;
                }
            }
            c += __shfl_xor(c, 32);
            if (h == 0 && c) atomicAdd(&cnt[(31 - bit) * 32 + r], (unsigned)c);
            __syncthreads();
            const unsigned tot = cnt[(31 - bit) * 32 + r];
            if (!done) { if (tot >= 256u) T = cand; if (tot == 256u) done = true; }
            if (__ballot(!done) == 0ull) break;
        }
    }
    if (T < 1u) T = 1u;
#pragma unroll
    for (int jt = 0; jt < 8; ++jt) {
        const int kt = wid + 8 * jt;
        if (kt <= qt) {
            unsigned part = 0u;
#pragma unroll
            for (int i = 0; i < 16; ++i) part |= (key[jt][i] >= T ? 1u : 0u) << (16 * (i >> 3) + 8 * h + (i & 7));
            part |= (unsigned)__shfl_xor((int)part, 32);
            if (h == 0) mask[(size_t)(tok0 + t0 + r) * 64 + kt] = part;
        }
    }
    __syncthreads();
}
DI void g2_job(const Args& a, unsigned char* wsh, LAS unsigned char* wl, int b, int slot, int cls, int it, const int tid);
DI void phase_a1(const Args& a, unsigned char* shm, const int tid) {
    const bf16_t* prm = (const bf16_t*)(a.ws + WS_R1);
    const bf16_t* prt = prm + (size_t)MTOK * RM_LD;
    unsigned* mask = (unsigned*)(a.ws + WS_MASK);
    float* kmean = (float*)(a.ws + WS_KMEAN);
    for (int k = 0;; ++k) { int b, qt; if (!task_map(k, b, qt)) break; a1_task(shm, prm, prt, mask, b, qt, tid); }
    for (int j = 2048 + blockIdx.x; j < 2048 + 192; j += gridDim.x) {
        {
            const int id = (j - 2048) * 8 + (tid >> 6), lane = tid & 63;
            const int b = id / 48, hd = (id >> 3) % 6, n = id & 7;
            const bf16_t* p = prm + (size_t)(b * SEQ + n * 256) * RM_LD + C_CK + hd * 64 + lane;
            float s = 0.f;
            for (int t = 0; t < 256; ++t) s += bf2f(p[(size_t)t * RM_LD]);
            kmean[(size_t)((b * 6 + hd) * 8 + n) * 64 + lane] = s * (1.0f / 256.0f);
        }
    }
    __syncthreads();
    {
        const int wid = __builtin_amdgcn_readfirstlane(tid >> 6);
        unsigned char* wsh = shm + wid * 16384;
        LAS unsigned char* wl = (LAS unsigned char*)shm + wid * 16384;
        for (int j = blockIdx.x; j < 1024; j += gridDim.x) {
            const int id = j * 8 + wid;
            g2_job(a, wsh, wl, id >> 8, (id >> 6) & 3, (id >> 2) & 15, id & 3, tid);
        }
    }
    __syncthreads();
}


struct AttnSt { float m, l; f32x16 o0, o1; };
struct AttnCtx {
    LAS unsigned char* wl;
    const float* lut;
    const bf16_t* kg;
    const bf16_t* vg;
    unsigned koff[4], voff[4];
    int kfo[4], vfo[2][2];
    int krs;
};
DI void attn_dma(const AttnCtx& c, int kt) {
    const char* kb = (const char*)(c.kg + (size_t)(kt * 32 * c.krs) * RM_LD);
    const char* vb = (const char*)(c.vg + kt * 32);
#pragma unroll
    for (int j = 0; j < 4; ++j) __builtin_amdgcn_global_load_lds((const unsigned*)(kb + c.koff[j]), (LAS unsigned*)(c.wl + j * 1024), 16, 0, 0);
#pragma unroll
    for (int j = 0; j < 4; ++j) __builtin_amdgcn_global_load_lds((const unsigned*)(vb + c.voff[j]), (LAS unsigned*)(c.wl + 4096 + j * 1024), 16, 0, 0);
}
template <int MODE, bool UNI>
DI void attn_compute(const bf16x8 (&qf)[4], const bf16x8 (&kf)[4], const bf16x8 (&vf)[2][2], int kt, int d00, const float* lut, float ubias, AttnSt& st,
                     unsigned W, int win, int dmask, bool lane_sel) {
    const int s0 = kt * 32;
    f32x16 sx;
#pragma unroll
    for (int i = 0; i < 16; ++i) sx[i] = 0.f;
#pragma unroll
    for (int ks = 0; ks < 4; ++ks) sx = MFMA32(kf[ks], qf[ks], sx);
    const int d0 = d00 - s0;
    const LAS float* lb = (const LAS float*)lut + ((MODE == 4) ? 16 * (d0 - 23) : (d0 - 23));
    float sv[16]; float mx = NEGF;
#pragma unroll
    for (int i = 0; i < 16; ++i) {
        const int ci = 16 * (i >> 3) + (i & 7);
        const int dist = d0 - ci;
        bool v;
        if (MODE == 0) v = ((W >> ci) & 1u) != 0u;
        else if (MODE == 1) v = ((unsigned)dist <= (unsigned)win) && ((dist & dmask) == 0);
        else if (MODE == 2) v = lane_sel;
        else v = dist >= 0;
        const float bias = UNI ? ubias : ((MODE == 4) ? lb[16 * (23 - ci)] : lb[23 - ci]);
        float s = fmaf(sx[i], SC2, bias);
        if (MODE == 0) { const unsigned t = (unsigned)__builtin_amdgcn_sbfe((int)W, ci, 1);
            s = __uint_as_float((__float_as_uint(s) & t) | (__float_as_uint(NEGF) & ~t)); }
        else s = v ? s : NEGF;
        sv[i] = s; mx = fmaxf(mx, s);
    }
    mx = fmaxf(mx, __shfl_xor(mx, 32));
    const float mnew = fmaxf(st.m, mx);
    const float msafe = (mnew > -1e29f) ? mnew : 0.f;
    if (__ballot(mnew > st.m) != 0ull) {
        const float alpha = __builtin_amdgcn_exp2f(st.m - msafe);
        st.l *= alpha; st.m = mnew;
#pragma unroll
        for (int i = 0; i < 16; ++i) { st.o0[i] *= alpha; st.o1[i] *= alpha; }
    }
    float ps = 0.f; float p[16];
#pragma unroll
    for (int i = 0; i < 16; ++i) { const float e = __builtin_amdgcn_exp2f(sv[i] - msafe); p[i] = e; ps += e; }
    st.l += ps;
    u32x4 w0, w1;
    w0.x = pk2(p[0], p[1]); w0.y = pk2(p[2], p[3]); w0.z = pk2(p[4], p[5]); w0.w = pk2(p[6], p[7]);
    w1.x = pk2(p[8], p[9]); w1.y = pk2(p[10], p[11]); w1.z = pk2(p[12], p[13]); w1.w = pk2(p[14], p[15]);
    const bf16x8 pf0 = __builtin_bit_cast(bf16x8, w0), pf1 = __builtin_bit_cast(bf16x8, w1);
    st.o0 = MFMA32(vf[0][0], pf0, st.o0); st.o0 = MFMA32(vf[0][1], pf1, st.o0);
    st.o1 = MFMA32(vf[1][0], pf0, st.o1); st.o1 = MFMA32(vf[1][1], pf1, st.o1);
}
DI void attn_compute_sp4(const bf16x8 (&qf)[4], const bf16x8 (&kf)[4], const bf16x8 (&vf)[2][2], int kt, int d00, const float* lut, AttnSt& st, int win, int dmask) {
    const int s0 = kt * 32;
    f32x16 sx;
#pragma unroll
    for (int i = 0; i < 16; ++i) sx[i] = 0.f;
#pragma unroll
    for (int ks = 0; ks < 4; ++ks) sx = MFMA32(kf[ks], qf[ks], sx);
    const int d0 = d00 - s0, e = d0 & 3;
    const bool e0 = (e == 0), e1 = (e == 1), e2 = (e == 2);
    const LAS float* lb = (const LAS float*)lut + (d0 - e - 20);
    float sv[4]; float mx = NEGF;
#pragma unroll
    for (int g = 0; g < 4; ++g) {
        const float x = e0 ? sx[4 * g] : (e1 ? sx[4 * g + 1] : (e2 ? sx[4 * g + 2] : sx[4 * g + 3]));
        const int dist = d0 - (16 * (g >> 1) + 4 * (g & 1)) - e;
        const bool v = ((unsigned)dist <= (unsigned)win) && ((dist & dmask) == 0);
        const float bias = lb[20 - (16 * (g >> 1) + 4 * (g & 1))];
        float sc = fmaf(x, SC2, bias);
        sc = v ? sc : NEGF;
        sv[g] = sc; mx = fmaxf(mx, sc);
    }
    mx = fmaxf(mx, __shfl_xor(mx, 32));
    const float mnew = fmaxf(st.m, mx);
    const float msafe = (mnew > -1e29f) ? mnew : 0.f;
    if (__ballot(mnew > st.m) != 0ull) {
        const float alpha = __builtin_amdgcn_exp2f(st.m - msafe);
        st.l *= alpha; st.m = mnew;
#pragma unroll
        for (int i = 0; i < 16; ++i) { st.o0[i] *= alpha; st.o1[i] *= alpha; }
    }
    float ps = 0.f; float p[16];
#pragma unroll
    for (int g = 0; g < 4; ++g) {
        const float pe = __builtin_amdgcn_exp2f(sv[g] - msafe); ps += pe;
        p[4 * g] = e0 ? pe : 0.f; p[4 * g + 1] = e1 ? pe : 0.f; p[4 * g + 2] = e2 ? pe : 0.f; p[4 * g + 3] = (e == 3) ? pe : 0.f;
    }
    st.l += ps;
    u32x4 w0, w1;
    w0.x = pk2(p[0], p[1]); w0.y = pk2(p[2], p[3]); w0.z = pk2(p[4], p[5]); w0.w = pk2(p[6], p[7]);
    w1.x = pk2(p[8], p[9]); w1.y = pk2(p[10], p[11]); w1.z = pk2(p[12], p[13]); w1.w = pk2(p[14], p[15]);
    const bf16x8 pf0 = __builtin_bit_cast(bf16x8, w0), pf1 = __builtin_bit_cast(bf16x8, w1);
    st.o0 = MFMA32(vf[0][0], pf0, st.o0); st.o0 = MFMA32(vf[0][1], pf1, st.o0);
    st.o1 = MFMA32(vf[1][0], pf0, st.o1); st.o1 = MFMA32(vf[1][1], pf1, st.o1);
}
template <int MODE>
DI void attn_range(const AttnCtx& c, const bf16x8 (&qf)[4], int lo, int hi, int t0, int d00, AttnSt& st, const unsigned* maskrow, int h8, int win, int dmask, bool lane_sel) {
    if (lo > hi) return;
    attn_dma(c, lo);
    unsigned Wn = 0u;
    if (MODE == 0) Wn = maskrow[lo];
#pragma unroll 1
    for (int kt = lo; kt <= hi; ++kt) {
        asm volatile("s_waitcnt vmcnt(0)" ::: "memory");
        bf16x8 kf[4], vf[2][2];
#pragma unroll
        for (int ks = 0; ks < 4; ++ks) kf[ks] = *(const LAS bf16x8*)(c.wl + c.kfo[ks]);
#pragma unroll
        for (int mt = 0; mt < 2; ++mt)
#pragma unroll
            for (int s = 0; s < 2; ++s) vf[mt][s] = *(const LAS bf16x8*)(c.wl + 4096 + c.vfo[mt][s]);
        const unsigned W = Wn >> h8;
        const int dlo = t0 - kt * 32 - 31;
        float ub = 0.f; bool uni = false;
        if (dlo >= 182) { const unsigned ua = __builtin_amdgcn_readfirstlane(__float_as_uint(c.lut[dlo])), ue = __builtin_amdgcn_readfirstlane(__float_as_uint(c.lut[dlo + 62])); uni = (ua == ue); ub = __uint_as_float(ua); }
        asm volatile("s_waitcnt lgkmcnt(0)" ::: "memory");
        if (kt < hi) { attn_dma(c, kt + 1); if (MODE == 0) Wn = maskrow[kt + 1]; }
        if (MODE == 1 && dmask != 0) attn_compute_sp4(qf, kf, vf, kt, d00, c.lut, st, win, dmask);
        else attn_compute<MODE, false>(qf, kf, vf, kt, d00, c.lut, 0.f, st, W, win, dmask, lane_sel);
    }
}

DI void load_lut(float* lut, const float* glut, int col, int lane) {
    __builtin_amdgcn_fence(__ATOMIC_ACQ_REL, "wavefront");
#pragma unroll
    for (int k = 0; k < 8; ++k) *(f32x4*)(lut + k * 256 + lane * 4) = *(const f32x4*)(glut + (size_t)col * 2048 + k * 256 + lane * 4);
    __builtin_amdgcn_fence(__ATOMIC_ACQ_REL, "wavefront");
    __builtin_amdgcn_wave_barrier();
}

DI void attn_job(const Args& a, unsigned char* wsh, LAS unsigned char* wl, int type, int b, int qt, int hd, const int tid) {
    const int lane = tid & 63, r = lane & 31, h = lane >> 5;
    const bf16_t* prm = (const bf16_t*)(a.ws + WS_R1);
    const bf16_t* prt = prm + (size_t)MTOK * RM_LD;
    const float* glut = (const float*)(a.ws + WS_LUT);
    const unsigned* mask = (const unsigned*)(a.ws + WS_MASK);
    const float* kmean = (const float*)(a.ws + WS_KMEAN);
    bf16_t* oabc = (bf16_t*)(a.ws + WS_OABC);
    float* lut = (float*)(wsh + 8192);
    const int t0 = qt * 32, tok0 = b * SEQ;
    const int d00 = t0 + r - 8 * h, h8 = 8 * h;
    const unsigned* maskrow = mask + (size_t)(tok0 + t0 + r) * 64;
    AttnCtx c; c.wl = wl; c.lut = lut; c.krs = 1;
#pragma unroll
    for (int j = 0; j < 4; ++j) {
        const int rk = 8 * j + (lane >> 3), ck = (lane & 7) ^ ((rk >> 1) & 7);
        c.koff[j] = (unsigned)(pi_row(rk) * RM_LD + ck * 8) * 2u;
        const int rv = 16 * j + (lane >> 2), cv = (lane & 3) ^ ((rv >> 2) & 3);
        c.voff[j] = (unsigned)(rv * MTOK + cv * 8) * 2u;
        c.kfo[j] = r * 128 + (((2 * j + h) ^ ((r >> 1) & 7)) * 16);
    }
#pragma unroll
    for (int mt = 0; mt < 2; ++mt)
#pragma unroll
        for (int s = 0; s < 2; ++s) c.vfo[mt][s] = (32 * mt + r) * 64 + (((2 * s + h) ^ ((r >> 2) & 3)) * 16);
    AttnSt st; st.m = NEGF; st.l = 0.f;
#pragma unroll
    for (int i = 0; i < 16; ++i) { st.o0[i] = 0.f; st.o1[i] = 0.f; }
    const int ng = (type == 1) ? 2 : 1;
    int ocol = 0;
    for (int g = 0; g < ng; ++g) {
        int qcol, kcol, vrow, bcol;
        if (type == 0) { qcol = C_AQ + hd * 64; kcol = C_AK; vrow = R_AV; bcol = hd; ocol = hd * 64; }
        else if (type == 1) { qcol = C_BQ + (g * 4 + hd) * 64; kcol = C_BK + hd * 64; vrow = R_BV + hd * 64; bcol = 6 + g * 4 + hd; ocol = 384 + hd * 64; }
        else { qcol = C_CQ + hd * 64; kcol = C_CK + hd * 64; vrow = R_CV + hd * 64; bcol = 18 + hd; ocol = 640 + hd * 64; }
        load_lut(lut, glut, bcol, lane);
        bf16x8 qf[4];
        const bf16_t* qp = prm + (size_t)(tok0 + t0 + r) * RM_LD + qcol + 8 * h;
#pragma unroll
        for (int ks = 0; ks < 4; ++ks) qf[ks] = *(const bf16x8*)(qp + 16 * ks);
        c.kg = prm + (size_t)tok0 * RM_LD + kcol;
        c.vg = prt + (size_t)vrow * MTOK + tok0;
        if (type == 0) {
            attn_range<0>(c, qf, 0, qt, t0, d00, st, maskrow, h8, 0, 0, false);
        } else if (type == 1) {
            const int win = (g == 0) ? 128 : (g == 1 ? 512 : 2048), dmask = (g == 0) ? 0 : (g == 1 ? 3 : 15);
            int lo = t0 - win; if (lo < 0) lo = 0;
            attn_range<1>(c, qf, lo >> 5, qt, t0, d00, st, maskrow, h8, win, dmask, false);
        } else {
            const int cur = qt >> 3;
            float gate[7];
            const float* km = kmean + (size_t)((b * 6 + hd) * 8) * 64 + 8 * h;
#pragma unroll
            for (int n = 0; n < 7; ++n) {
                float s = 0.f;
                if (n < cur) {
#pragma unroll
                    for (int ks = 0; ks < 4; ++ks) {
                        const f32x4 k0 = *(const f32x4*)(km + n * 64 + 16 * ks), k1 = *(const f32x4*)(km + n * 64 + 16 * ks + 4);
                        const u32x4 qw = __builtin_bit_cast(u32x4, qf[ks]);
                        s += bf_lo(qw.x) * k0[0] + bf_hi(qw.x) * k0[1] + bf_lo(qw.y) * k0[2] + bf_hi(qw.y) * k0[3]
                           + bf_lo(qw.z) * k1[0] + bf_hi(qw.z) * k1[1] + bf_lo(qw.w) * k1[2] + bf_hi(qw.w) * k1[3];
                    }
                    s += __shfl_xor(s, 32);
                } else s = -__builtin_inff();
                gate[n] = s;
            }
            unsigned sel = 0u;
#pragma unroll
            for (int rd = 0; rd < 3; ++rd) {
                float bv = -__builtin_inff(); int bi = -1;
#pragma unroll
                for (int n = 0; n < 7; ++n) if (gate[n] > bv) { bv = gate[n]; bi = n; }
                if (bi >= 0) sel |= 1u << bi;
#pragma unroll
                for (int n = 0; n < 7; ++n) if (n == bi) gate[n] = -__builtin_inff();
            }
            for (int n = 0; n < cur; ++n) {
                const bool ls = ((sel >> n) & 1u) != 0u;
                if (__ballot(ls) == 0ull) continue;
                attn_range<2>(c, qf, n * 8, n * 8 + 7, t0, d00, st, maskrow, h8, 0, 0, ls);
            }
            attn_range<3>(c, qf, cur * 8, qt, t0, d00, st, maskrow, h8, 0, 0, false);
        }
    }
    float lt = st.l + __shfl_xor(st.l, 32);
    if (type == 1) {
        const float* pp = (const float*)(a.ws + WS_G2) + ((size_t)(tok0 + t0 + r) * 4 + hd) * 68;
        const f32x2 ml = *(const f32x2*)(pp + 64);
        const float mn = fmaxf(st.m, ml[0]);
        const float a1 = __builtin_amdgcn_exp2f(st.m - mn), a2 = __builtin_amdgcn_exp2f(ml[0] - mn);
        lt = lt * a1 + ml[1] * a2;
#pragma unroll
        for (int g4 = 0; g4 < 4; ++g4) {
            const f32x4 p0 = *(const f32x4*)(pp + 8 * g4 + 4 * h), p1 = *(const f32x4*)(pp + 32 + 8 * g4 + 4 * h);
#pragma unroll
            for (int e = 0; e < 4; ++e) { st.o0[4 * g4 + e] = st.o0[4 * g4 + e] * a1 + p0[e] * a2; st.o1[4 * g4 + e] = st.o1[4 * g4 + e] * a1 + p1[e] * a2; }
        }
    }
    const float inv = 1.0f / lt;
    bf16_t* op = oabc + (size_t)(tok0 + t0 + r) * 1024 + ocol + 4 * h;
#pragma unroll
    for (int g4 = 0; g4 < 4; ++g4) {
        u32x2 w;
        w.x = pk2(st.o0[4 * g4] * inv, st.o0[4 * g4 + 1] * inv); w.y = pk2(st.o0[4 * g4 + 2] * inv, st.o0[4 * g4 + 3] * inv);
        *(u32x2*)(op + 8 * g4) = w;
        w.x = pk2(st.o1[4 * g4] * inv, st.o1[4 * g4 + 1] * inv); w.y = pk2(st.o1[4 * g4 + 2] * inv, st.o1[4 * g4 + 3] * inv);
        *(u32x2*)(op + 32 + 8 * g4) = w;
    }
}
DI void g2_job(const Args& a, unsigned char* wsh, LAS unsigned char* wl, int b, int slot, int cls, int it, const int tid) {
    const int lane = tid & 63, r = lane & 31, h = lane >> 5;
    const bf16_t* prm = (const bf16_t*)(a.ws + WS_R1);
    const bf16_t* vt16 = (const bf16_t*)(a.ws + WS_VT16);
    const float* glut = (const float*)(a.ws + WS_LUT);
    float* lut = (float*)(wsh + 8192);
    const int tok0 = b * SEQ;
    const int d00 = 32 * it + r - 8 * h;
    AttnCtx c; c.wl = wl; c.lut = lut; c.krs = 16;
#pragma unroll
    for (int j = 0; j < 4; ++j) {
        const int rk = 8 * j + (lane >> 3), ck = (lane & 7) ^ ((rk >> 1) & 7);
        c.koff[j] = (unsigned)(pi_row(rk) * 16 * RM_LD + ck * 8) * 2u;
        const int rv = 16 * j + (lane >> 2), cv = (lane & 3) ^ ((rv >> 2) & 3);
        c.voff[j] = (unsigned)(rv * MTOK + cv * 8) * 2u;
        c.kfo[j] = r * 128 + (((2 * j + h) ^ ((r >> 1) & 7)) * 16);
    }
#pragma unroll
    for (int mt = 0; mt < 2; ++mt)
#pragma unroll
        for (int s = 0; s < 2; ++s) c.vfo[mt][s] = (32 * mt + r) * 64 + (((2 * s + h) ^ ((r >> 2) & 3)) * 16);
    AttnSt st; st.m = NEGF; st.l = 0.f;
#pragma unroll
    for (int i = 0; i < 16; ++i) { st.o0[i] = 0.f; st.o1[i] = 0.f; }
    load_lut(lut, glut, 6 + 2 * 4 + slot, lane);
    const int tq = tok0 + cls + 16 * (32 * it + r);
    bf16x8 qf[4];
    const bf16_t* qp = prm + (size_t)tq * RM_LD + C_BQ + (2 * 4 + slot) * 64 + 8 * h;
#pragma unroll
    for (int ks = 0; ks < 4; ++ks) qf[ks] = *(const bf16x8*)(qp + 16 * ks);
    c.kg = prm + (size_t)(tok0 + cls) * RM_LD + C_BK + slot * 64;
    c.vg = vt16 + (size_t)(slot * 64) * MTOK + tok0 + cls * 128;
    attn_range<4>(c, qf, 0, it, 0, d00, st, nullptr, 0, 0, 0, false);
    const float lt = st.l + __shfl_xor(st.l, 32);
    float* pp = (float*)(a.ws + WS_G2) + ((size_t)tq * 4 + slot) * 68;
#pragma unroll
    for (int g4 = 0; g4 < 4; ++g4) {
        f32x4 p0, p1;
#pragma unroll
        for (int e = 0; e < 4; ++e) { p0[e] = st.o0[4 * g4 + e]; p1[e] = st.o1[4 * g4 + e]; }
        *(f32x4*)(pp + 8 * g4 + 4 * h) = p0; *(f32x4*)(pp + 32 + 8 * g4 + 4 * h) = p1;
    }
    if (h == 0) { f32x2 ml = {st.m, lt}; *(f32x2*)(pp + 64) = ml; }
}
DI void phase_attn(const Args& a, unsigned char* shm, const int tid) {
    const int wid = __builtin_amdgcn_readfirstlane(tid >> 6);
    unsigned char* wsh = shm + wid * 16384;
    LAS unsigned char* wl = (LAS unsigned char*)shm + wid * 16384;
    for (int it = 0;; ++it) {
        int b, qt; if (!task_map(it, b, qt)) break;
        const int role = (wid + it) & 7;
        if (role < 6) { attn_job(a, wsh, wl, 0, b, qt, role, tid); attn_job(a, wsh, wl, 2, b, qt, role, tid); }
        else { attn_job(a, wsh, wl, 1, b, qt, role - 6, tid); attn_job(a, wsh, wl, 1, b, qt, role - 4, tid); }
    }
}

#define XB_TMO      128
#define XB_XCNT(j)  (256  + 64 * (j))
#define XB_XSUB(j)  (1280 + 64 * (j))
#define XB_XGEN(j)  (2304 + 64 * (j))
#define XB_TOP      3328
#define XB_TOPGEN   3392
#define XCD_BAR_WORDS 3456
#define XB_SPIN_CAP (1u << 20)
DI unsigned xb_ld(unsigned* p)              { return __hip_atomic_load(p, __ATOMIC_RELAXED, __HIP_MEMORY_SCOPE_AGENT); }
DI unsigned xb_add(unsigned* p, unsigned v) { return __hip_atomic_fetch_add(p, v, __ATOMIC_RELAXED, __HIP_MEMORY_SCOPE_AGENT); }
DI unsigned xb_xcc_id() { return (unsigned)__builtin_amdgcn_s_getreg((3 << 11) | 20) & 0xFu; }
#define XB_SPIN(cond, bar) do { unsigned _sp = 0; while (cond) { __builtin_amdgcn_s_sleep(1); \
    if ((++_sp & 255u) == 0u) { if (xb_ld(&(bar)[XB_TMO])) break; if (_sp > XB_SPIN_CAP) { atomicAdd(&(bar)[XB_TMO], 1u); break; } } } } while (0)
struct XcdBarrier { unsigned* bar; unsigned x; volatile LAS unsigned* st; };
DI void xcd_barrier_complete(unsigned* bar, unsigned x, unsigned& nloc, unsigned& nx) {
    const unsigned G = gridDim.x * gridDim.y * gridDim.z;
    unsigned sum, cnt, mine, sp = 0u;
    for (;;) {
        sum = 0u; cnt = 0u; mine = 0u;
#pragma unroll
        for (unsigned j = 0; j < 16; ++j) { const unsigned c = xb_ld(&bar[XB_XCNT(j)]); sum += c; cnt += (c > 0u) ? 1u : 0u; mine = (j == x) ? c : mine; }
        if (sum == G) break;
        __builtin_amdgcn_s_sleep(1);
        if ((++sp & 255u) == 0u) { if (xb_ld(&bar[XB_TMO])) break; if (sp > XB_SPIN_CAP) { atomicAdd(&bar[XB_TMO], 1u); break; } }
    }
    nloc = mine > 0u ? mine : 1u; nx = cnt > 0u ? cnt : 1u;
}
DI void xcd_barrier(const XcdBarrier& b, const int tid) {
    asm volatile("s_waitcnt vmcnt(0)" ::: "memory");
    __syncthreads();
    if (tid == 0) {
        unsigned* bar = b.bar;
        __builtin_amdgcn_s_waitcnt(0);
        unsigned nloc = b.st[0], nx = b.st[1];
        if (nloc == 0u) { xcd_barrier_complete(bar, b.x, nloc, nx); b.st[0] = nloc; b.st[1] = nx; }
        const unsigned old = xb_add(&bar[XB_XSUB(b.x)], 1u);
        const unsigned gen = old / nloc;
        if (old + 1u == (gen + 1u) * nloc) {
            __builtin_amdgcn_fence(__ATOMIC_RELEASE, "agent");
            asm volatile("s_waitcnt vmcnt(0)" ::: "memory");
            const unsigned og = xb_add(&bar[XB_TOP], 1u);
            const unsigned tg = og / nx;
            if (og + 1u == (tg + 1u) * nx) xb_add(&bar[XB_TOPGEN], 1u);
            else XB_SPIN(xb_ld(&bar[XB_TOPGEN]) == tg, bar);
            __builtin_amdgcn_fence(__ATOMIC_ACQUIRE, "agent");
            xb_add(&bar[XB_XGEN(b.x)], 1u);
            asm volatile("s_waitcnt vmcnt(0)" ::: "memory");
        } else {
            XB_SPIN(xb_ld(&bar[XB_XGEN(b.x)]) == gen, bar);
            __builtin_amdgcn_fence(__ATOMIC_ACQUIRE, "agent");
            asm volatile("s_waitcnt vmcnt(0)" ::: "memory");
        }
    }
    __syncthreads();
}

__global__ void __launch_bounds__(512, 2) mega_fwd(Args a_) {
    extern __shared__ __attribute__((aligned(16))) unsigned char shm[];
    cg::grid_group grid = cg::this_grid();
    LAS unsigned char* lds = (LAS unsigned char*)shm;
    const int G = gridDim.x, c = blockIdx.x;
#ifndef PROBE_REP
#define PROBE_REP -2
#endif
    const int ph_lo = a_.ph_lo, ph_hi = a_.ph_hi;
    const int wave_id = __builtin_amdgcn_readfirstlane(threadIdx.x >> 6);
    XcdBarrier xbar;
    { volatile LAS unsigned* st = (volatile LAS unsigned*)(lds + 131072);
      if (threadIdx.x == 0) { st[0] = 0u; st[1] = 0u; }
      __syncthreads();
      xbar.bar = (unsigned*)(a_.ws + WS_BAR); xbar.x = xb_xcc_id(); xbar.st = st;
      if (threadIdx.x == 0) (void)xb_add(&xbar.bar[XB_XCNT(xbar.x)], 1u); }
    for (int phx = 2 * ph_lo; phx < 2 * ph_hi; ++phx) {
        const int ph = phx >> 1;
        if (phx & 1) { const bool rep = (PROBE_REP == -1) ? (ph == 0) : (ph > 0 && (ph - 1) % 9 == PROBE_REP); if (!rep) continue; }
        const Args& a = a_;
        int tid = wave_id * 64 + (int)__builtin_amdgcn_mbcnt_hi(~0u, __builtin_amdgcn_mbcnt_lo(~0u, 0u)); asm volatile("" : "+v"(tid));
        bf16_t* xb = (bf16_t*)(a.ws + WS_XB);
        bf16_t* r1 = (bf16_t*)(a.ws + WS_R1);
        bf16_t* oabc = (bf16_t*)(a.ws + WS_OABC);
        float* stats = (float*)(a.ws + WS_STATS);
        if (ph == 0) phase_convert(a, shm, tid);
        else {
            const int l = (ph - 1) / 9, sp = (ph - 1) % 9;
            const bf16_t* w = (const bf16_t*)(a.ws + WS_WB) + (size_t)l * W_LAYER;
            const float* xin = (l == 0) ? a.in[0] : a.out;
            if (sp == 0) {
                { pg8::Gemm g{xb, w + WO_IN, 1024, 1024, 1024, 0}; pg8::StaticOrder S; S.init(256, 11, G, c); pg8::EpiBf16<0> E{r1, RM_LD}; pg8::gemm_phase(lds, g, S, E, tid); }
                { pg8::Gemm g{w + WO_IN + (size_t)RM_LD * 1024, xb, 1024, 1024, 1024, 0}; pg8::StaticOrder S; S.init(3, 256, G, c); pg8::EpiBf16<0> E{r1 + (size_t)MTOK * RM_LD, MTOK}; pg8::gemm_phase(lds, g, S, E, tid); }
                { pg8::Gemm g{w + WO_IN + (size_t)2880 * 1024, xb, 1024, 16 * 1024, 1024, 2048}; pg8::OrderVT16 S{G, c}; pg8::EpiBf16<0> E{(bf16_t*)(a.ws + WS_VT16), MTOK}; pg8::gemm_phase(lds, g, S, E, tid); }
            } else if (sp == 1) phase_a1(a, shm, tid);
            else if (sp == 2) phase_attn(a, shm, tid);
            else if (sp == 3) {
                pg8::StaticOrder S; S.init(256, 4, G, c);
                { pg8::Gemm g{oabc, w + WO_BA, 1024, 384, 384, 0}; pg8::EpiBf16<0> E{r1, 3072}; pg8::gemm_phase(lds, g, S, E, tid); }
                { pg8::Gemm g{oabc + 384, w + WO_BB, 1024, 256, 256, 0}; pg8::EpiBf16<0> E{r1 + 1024, 3072}; pg8::gemm_phase(lds, g, S, E, tid); }
                { pg8::Gemm g{oabc + 640, w + WO_BC, 1024, 384, 384, 0}; pg8::EpiBf16<0> E{r1 + 2048, 3072}; pg8::gemm_phase(lds, g, S, E, tid); }
                { pg8::Gemm g{xb, w + WO_G, 1024, 1024, 1024, 0}; pg8::Order3 S3; S3.base = S; pg8::EpiGate E{r1, r1 + (size_t)MTOK * 3072}; pg8::gemm_phase(lds, g, S3, E, tid); }
            } else if (sp == 4) {
                pg8::Gemm g{r1 + (size_t)MTOK * 3072, w + WO_OUT, 1024, 1024, 1024, 0}; pg8::StaticOrder S; S.init(256, 4, G, c);
                if (l == 0) { pg8::EpiRes<false, false> E{xin, a.out, nullptr, nullptr, nullptr, nullptr}; pg8::gemm_phase(lds, g, S, E, tid); }
                else { pg8::EpiRes<false, true> E{xin, a.out, nullptr, stats, a.in[14], a.in[15]}; pg8::gemm_phase(lds, g, S, E, tid); }
            } else if (sp == 5) phase_ln<false>(a.out, xb, stats, a.in[8] + l * 1024, a.in[9] + l * 1024, tid);
            else if (sp == 6) {
                { pg8::Gemm g{xb, w + WO_UP, 1024, 1024, 1024, 0}; pg8::StaticOrder S; S.init(256, 16, G, c); pg8::EpiBf16<1> E{r1, 4096}; pg8::gemm_phase(lds, g, S, E, tid); }
                pg8::StaticOrder S; S.init(256, 4, G, c);
                { pg8::Gemm g{(const bf16_t*)(a.ws + WS_PB) + (size_t)l * MTOK * 256, w + WO_PL, 256, 256, 256, 0}; pg8::EpiBf16<0> E{oabc, 1024}; pg8::gemm_phase(lds, g, S, E, tid); }
                { pg8::Gemm g{xb, w + WO_PG, 1024, 1024, 1024, 0}; pg8::EpiT1 E{oabc}; pg8::gemm_phase(lds, g, S, E, tid); }
            } else if (sp == 7) {
                pg8::Gemm g{r1, w + WO_DN, 4096, 4096, 4096, 0}; pg8::StaticOrder S; S.init(256, 4, G, c);
                pg8::EpiRes<true, true> E{a.out, a.out, oabc, stats, a.in[8] + l * 1024, a.in[9] + l * 1024}; pg8::gemm_phase(lds, g, S, E, tid);
            } else { if (l == 0) phase_ln<false>(a.out, xb, stats, a.in[14], a.in[15], tid); else phase_ln<true>(a.out, xb, stats, a.in[14] + 1024, a.in[15] + 1024, tid); }
        }
        if (phx + 1 < 2 * ph_hi) { if (ph == 0) grid.sync(); else xcd_barrier(xbar, tid); }
    }
}

#ifndef N_LAUNCH_MODE
#define N_LAUNCH_MODE 1
#endif
extern "C" void kernel_launch(void* const* d_in, const int* in_sizes, int n_in, void* d_out, int out_size, void* d_ws, size_t ws_size, hipStream_t stream) {
    static int grid = 0;
    if (grid == 0) {
        if (n_in != 17 || out_size != MTOK * DM || ws_size < WS_END) { fprintf(stderr, "kernel_launch: unexpected shapes (n_in %d out %d ws %zu need %zu)\n", n_in, out_size, ws_size, (size_t)WS_END); grid = -1; return; }
        int dev = 0, cus = 0, per_cu = 0;
        hipGetDevice(&dev);
        hipDeviceGetAttribute(&cus, hipDeviceAttributeMultiprocessorCount, dev);
        if (hipFuncSetAttribute((const void*)mega_fwd, hipFuncAttributeMaxDynamicSharedMemorySize, LDS_BYTES) != hipSuccess) { fprintf(stderr, "kernel_launch: hipFuncSetAttribute failed\n"); grid = -1; return; }
        hipOccupancyMaxActiveBlocksPerMultiprocessor(&per_cu, (const void*)mega_fwd, 512, LDS_BYTES);
        if (per_cu < 1) { fprintf(stderr, "kernel_launch: occupancy query says %d\n", per_cu); per_cu = 1; }
        (void)hipGetLastError();
        grid = cus * per_cu;
    }
    if (grid < 0) return;
    if (hipMemsetAsync((char*)d_ws + WS_BAR, 0, (size_t)3456 * 4, stream) != hipSuccess) { fprintf(stderr, "kernel_launch: memset of the barrier words failed\n"); return; }
    Args a{};
    for (int i = 0; i < 17; ++i) a.in[i] = (const float*)d_in[i];
    a.out = (float*)d_out; a.ws = (unsigned char*)d_ws;
#if N_LAUNCH_MODE == 0
    for (int ph = 0; ph < 19; ++ph) {
        a.ph_lo = ph; a.ph_hi = ph + 1;
        hipLaunchKernelGGL(mega_fwd, dim3(grid), dim3(512), LDS_BYTES, stream, a);
    }
#else
    a.ph_lo = 0; a.ph_hi = 19;
    void* args[] = {&a};
    hipError_t e = hipLaunchCooperativeKernel((const void*)mega_fwd, dim3(grid), dim3(512), args, LDS_BYTES, stream);
    if (e != hipSuccess) fprintf(stderr, "cooperative launch failed: %s (grid %d)\n", hipGetErrorString(e), grid);
#endif
}
```

```cpp
#include <hip/hip_runtime.h>
#include <hip/hip_cooperative_groups.h>
#include <cstdio>
namespace cg = cooperative_groups;

#define LAS __attribute__((address_space(3)))
#define DI __device__ __forceinline__
typedef unsigned short bf16_t;
typedef short bf16x8 __attribute__((ext_vector_type(8)));
typedef float f32x2 __attribute__((ext_vector_type(2)));
typedef float f32x4 __attribute__((ext_vector_type(4)));
typedef float f32x16 __attribute__((ext_vector_type(16)));
typedef unsigned u32x2 __attribute__((ext_vector_type(2)));
typedef unsigned u32x4 __attribute__((ext_vector_type(4)));
typedef __bf16 bf2_t __attribute__((ext_vector_type(2)));

constexpr int MTOK = 65536, SEQ = 2048, DM = 1024, NB = 32, DFF = 4096, PLE = 256;
constexpr int RM_LD = 2816;
constexpr int C_AQ = 0, C_AK = 384, C_IQ = 448, C_IK = 960, C_BQ = 1024, C_BK = 1792, C_CQ = 2048, C_CK = 2432;
constexpr int T_ROWS = 768;
constexpr int R_AV = 0, R_BV = 64, R_CV = 320, R_IW = 704;
constexpr int NWIN = 3584;
constexpr float ALPHA = 1.41421356237309515f;
constexpr float LOG2E = 1.44269504088896341f;
constexpr float SC2 = 0.125f * LOG2E;
constexpr float NEGF = -1e30f;
constexpr int LDS_BYTES = 131072 + 16;

constexpr size_t WO_IN = 0;
constexpr size_t WO_G = WO_IN + (size_t)NWIN * 1024;
constexpr size_t WO_BA = WO_G + (size_t)3072 * 1024;
constexpr size_t WO_BB = WO_BA + (size_t)1024 * 384;
constexpr size_t WO_BC = WO_BB + (size_t)1024 * 256;
constexpr size_t WO_OUT = WO_BC + (size_t)1024 * 384;
constexpr size_t WO_UP = WO_OUT + (size_t)1024 * 1024;
constexpr size_t WO_DN = WO_UP + (size_t)4096 * 1024;
constexpr size_t WO_PG = WO_DN + (size_t)1024 * 4096;
constexpr size_t WO_PL = WO_PG + (size_t)1024 * 1024;
constexpr size_t W_LAYER = WO_PL + (size_t)1024 * 256;

constexpr size_t WS_WB = 0;
constexpr size_t WS_LUT = WS_WB + 2 * W_LAYER * 2;
constexpr size_t WS_KMEAN = WS_LUT + (size_t)24 * 2048 * 4;
constexpr size_t WS_MASK = WS_KMEAN + (size_t)32 * 6 * 8 * 64 * 4;
constexpr size_t WS_XB = WS_MASK + (size_t)MTOK * 64 * 4;
constexpr size_t WS_PB = WS_XB + (size_t)MTOK * 1024 * 2;
constexpr size_t WS_OABC = WS_PB + (size_t)2 * MTOK * 256 * 2;
constexpr size_t WS_R1 = WS_OABC + (size_t)MTOK * 1024 * 2;
constexpr size_t WS_BAR = WS_R1 + (size_t)MTOK * 4096 * 2;
constexpr size_t WS_STATS = WS_BAR + (size_t)4096 * 4;
constexpr size_t WS_G2 = WS_STATS + (size_t)MTOK * 2 * 4;
constexpr size_t WS_END = WS_G2 + (size_t)MTOK * 4 * 68 * 4;
constexpr size_t WS_VT16 = WS_R1 + ((size_t)MTOK * RM_LD + (size_t)T_ROWS * MTOK) * 2;

struct Args {
    const float* in[17];
    float* out;
    unsigned char* ws;
    int ph_lo, ph_hi;
};

DI unsigned short f2bf(float f) { unsigned u = __float_as_uint(f); u += 0x7FFFu + ((u >> 16) & 1u); return (unsigned short)(u >> 16); }
DI unsigned pk2(float lo, float hi) { f32x2 v = {lo, hi}; bf2_t b = __builtin_convertvector(v, bf2_t); return __builtin_bit_cast(unsigned, b); }
DI float bf_lo(unsigned w) { return __uint_as_float(w << 16); }
DI float bf_hi(unsigned w) { return __uint_as_float(w & 0xFFFF0000u); }
DI float bf2f(bf16_t b) { return __uint_as_float(((unsigned)b) << 16); }
DI float sigmoidf_(float x) { return __builtin_amdgcn_rcpf(1.0f + __expf(-x)); }
#define MFMA32(a, b, c) __builtin_amdgcn_mfma_f32_32x32x16_bf16((a), (b), (c), 0, 0, 0)

namespace pg8 {
constexpr int BM = 256, BK = 64, HALF = 128, HTB = HALF * BK * 2, NXCD = 8, WGM = 8;
DI int lds_byte(int r, int c) { const int st = (r >> 4) * 2 + (c >> 5), rr = r & 15, cc = c & 31, ob = rr * 64 + cc * 2; return st * 1024 + (ob ^ (((ob >> 9) & 1) << 5)); }
DI void stage_rc(int b, int& R, int& C) { const int st = b / 1024, sb = b % 1024, swz = sb ^ (((sb >> 9) & 1) << 5); R = (st >> 1) * 16 + swz / 64; C = (st & 1) * 32 + (swz % 64) / 2; }
DI int perm32(int rho) { const int n = rho >> 4, i = rho & 15; return 8 * (i >> 2) + 4 * n + (i & 3); }

struct Unit { int pm, pn; long bofs; };
struct Gemm { const bf16_t* A; const bf16_t* Bt; int lda, ldb, K; long hsB; };

struct StaticOrder {
    int nM, nN, nwg, G, c;
    DI void init(int nM_, int nN_, int G_, int c_) { nM = nM_; nN = nN_; nwg = nM * nN; G = G_; c = c_; }
    DI bool next(int i, Unit& u) const {
        const long L = (long)i * G + c; if (L >= nwg) return false;
        int wgid = (int)L; { const int q = nwg / NXCD, r = nwg % NXCD, xcd = wgid % NXCD, off = wgid / NXCD; wgid = (xcd < r ? xcd * (q + 1) : r * (q + 1) + (xcd - r) * q) + off; }
        const int nig = WGM * nN, gid = wgid / nig, fm = gid * WGM, gsz = (nM - fm) < WGM ? (nM - fm) : WGM;
        u.pm = fm + ((wgid % nig) % gsz); u.pn = (wgid % nig) / gsz; u.bofs = -1; return true;
    }
};
struct OrderVT16 {
    int G, c;
    DI bool next(int i, Unit& u) const { const int L = i * G + c; if (L >= 256) return false; u.pm = 0; u.pn = L; u.bofs = ((long)((L >> 3) * 2048 + 2 * (L & 7)) * 1024) * 2; return true; }
};
struct Order3 {
    StaticOrder base;
    DI bool next(int i, Unit& u) const { Unit v; if (!base.next(i / 3, v)) return false; u.pm = v.pm; u.pn = (i % 3) * 4 + v.pn; u.bofs = -1; return true; }
};

template <int ACT  > struct EpiBf16 {
    static constexpr bool PERM = true;
    bf16_t* O; int ldc;
    DI void operator()(const f32x4 (&acc)[2][2][4][2], const Unit& u, int wr, int wc, int fr, int fq) const {
        const int row0 = u.pm * BM + wr * 64 + fr, col0 = u.pn * BM + wc * 32 + 8 * fq;
#pragma unroll
        for (int ai = 0; ai < 2; ++ai)
#pragma unroll
            for (int m = 0; m < 4; ++m) { bf16_t* rowp = O + (size_t)(row0 + ai * HALF + m * 16) * ldc + col0;
#pragma unroll
                for (int bj = 0; bj < 2; ++bj) { f32x4 v0 = acc[ai][bj][m][0], v1 = acc[ai][bj][m][1];
                    if (ACT == 1) {
#pragma unroll
                        for (int j = 0; j < 4; ++j) { float a = fmaxf(v0[j], 0.f), b = fmaxf(v1[j], 0.f); v0[j] = a * a; v1[j] = b * b; } }
                    u32x4 w; w.x = pk2(v0[0], v0[1]); w.y = pk2(v0[2], v0[3]); w.z = pk2(v1[0], v1[1]); w.w = pk2(v1[2], v1[3]);
                    *(u32x4*)(rowp + bj * HALF) = w; } }
    }
};
struct EpiGate {
    static constexpr bool PERM = true;
    const bf16_t* obr; bf16_t* mg;
    DI void operator()(const f32x4 (&acc)[2][2][4][2], const Unit& u, int wr, int wc, int fr, int fq) const {
        const int b = u.pn >> 2, colt = (u.pn & 3) * BM;
        const int row0 = u.pm * BM + wr * 64 + fr, col0 = colt + wc * 32 + 8 * fq;
        const bf16_t* ob0 = obr + (size_t)row0 * 3072 + b * 1024 + col0;
        bf16_t* mp0 = mg + (size_t)row0 * 1024 + col0;
        u32x4 ob[2][4], pm[2][4];
#define GATE_LOAD(k, s) do { _Pragma("unroll") for (int q = 0; q < 4; ++q) { const int ai = (k) >> 1, m = 2 * ((k) & 1) + (q >> 1), bj = q & 1; const size_t ro = (size_t)(ai * HALF + m * 16); \
            ob[s][q] = *(const u32x4*)(ob0 + ro * 3072 + bj * HALF); if (b > 0) pm[s][q] = *(const u32x4*)(mp0 + ro * 1024 + bj * HALF); } } while (0)
        GATE_LOAD(0, 0);
#pragma unroll
        for (int k = 0; k < 4; ++k) {
            if (k + 1 < 4) GATE_LOAD(k + 1, (k + 1) & 1);
#pragma unroll
            for (int q = 0; q < 4; ++q) {
                const int ai = k >> 1, m = 2 * (k & 1) + (q >> 1), bj = q & 1;
                const f32x4 v0 = acc[ai][bj][m][0], v1 = acc[ai][bj][m][1];
                const u32x4 o = ob[k & 1][q];
                float r[8];
                r[0] = sigmoidf_(v0[0]) * bf_lo(o.x); r[1] = sigmoidf_(v0[1]) * bf_hi(o.x); r[2] = sigmoidf_(v0[2]) * bf_lo(o.y); r[3] = sigmoidf_(v0[3]) * bf_hi(o.y);
                r[4] = sigmoidf_(v1[0]) * bf_lo(o.z); r[5] = sigmoidf_(v1[1]) * bf_hi(o.z); r[6] = sigmoidf_(v1[2]) * bf_lo(o.w); r[7] = sigmoidf_(v1[3]) * bf_hi(o.w);
                if (b > 0) { const u32x4 pv = pm[k & 1][q];
                    r[0] += bf_lo(pv.x); r[1] += bf_hi(pv.x); r[2] += bf_lo(pv.y); r[3] += bf_hi(pv.y); r[4] += bf_lo(pv.z); r[5] += bf_hi(pv.z); r[6] += bf_lo(pv.w); r[7] += bf_hi(pv.w); }
                u32x4 w; w.x = pk2(r[0], r[1]); w.y = pk2(r[2], r[3]); w.z = pk2(r[4], r[5]); w.w = pk2(r[6], r[7]);
                *(u32x4*)(mp0 + (size_t)(ai * HALF + m * 16) * 1024 + bj * HALF) = w;
            }
        }
#undef GATE_LOAD
    }
};
struct EpiT1 {
    static constexpr bool PERM = true;
    bf16_t* T;
    DI void operator()(const f32x4 (&acc)[2][2][4][2], const Unit& u, int wr, int wc, int fr, int fq) const {
        const int row0 = u.pm * BM + wr * 64 + fr, col0 = u.pn * BM + wc * 32 + 8 * fq;
        bf16_t* tp0 = T + (size_t)row0 * 1024 + col0;
        u32x4 ob[2][8];
#pragma unroll
        for (int ai = 0; ai < 2; ++ai)
#pragma unroll
            for (int q = 0; q < 8; ++q) ob[ai][q] = *(const u32x4*)(tp0 + (size_t)(ai * HALF + (q >> 1) * 16) * 1024 + (q & 1) * HALF);
#pragma unroll
        for (int ai = 0; ai < 2; ++ai)
#pragma unroll
            for (int q = 0; q < 8; ++q) {
                const int m = q >> 1, bj = q & 1;
                const f32x4 v0 = acc[ai][bj][m][0], v1 = acc[ai][bj][m][1];
                const u32x4 o = ob[ai][q];
                float r[8];
                r[0] = sigmoidf_(v0[0]) * bf_lo(o.x); r[1] = sigmoidf_(v0[1]) * bf_hi(o.x); r[2] = sigmoidf_(v0[2]) * bf_lo(o.y); r[3] = sigmoidf_(v0[3]) * bf_hi(o.y);
                r[4] = sigmoidf_(v1[0]) * bf_lo(o.z); r[5] = sigmoidf_(v1[1]) * bf_hi(o.z); r[6] = sigmoidf_(v1[2]) * bf_lo(o.w); r[7] = sigmoidf_(v1[3]) * bf_hi(o.w);
                u32x4 w; w.x = pk2(r[0], r[1]); w.y = pk2(r[2], r[3]); w.z = pk2(r[4], r[5]); w.w = pk2(r[6], r[7]);
                *(u32x4*)(tp0 + (size_t)(ai * HALF + m * 16) * 1024 + bj * HALF) = w;
            }
    }
};
template <bool HAS_T, bool LNX> struct EpiRes {
    static constexpr bool PERM = false;
    const float* xin; float* y; const bf16_t* T; const float* stats; const float* lg; const float* lb;
    DI void operator()(const f32x4 (&acc)[2][2][4][2], const Unit& u, int wr, int wc, int fr, int fq) const {
        const int row0 = u.pm * BM + wr * 64 + fr, col0 = u.pn * BM + wc * 32 + 4 * fq;
        const size_t o0 = (size_t)row0 * 1024 + col0;
        f32x4 xv[2][4]; u32x2 tv[2][4]; f32x2 sm[2][4];
#define RES_LOAD(k, s) do { _Pragma("unroll") for (int m = 0; m < 4; ++m) { const int row = row0 + ((k) >> 2) * HALF + m * 16; const size_t o = (size_t)row * 1024 + col0 + (((k) >> 1) & 1) * HALF + ((k) & 1) * 16; \
            xv[s][m] = *(const f32x4*)(xin + o); if (HAS_T) tv[s][m] = *(const u32x2*)(T + o); if (LNX) sm[s][m] = *(const f32x2*)(stats + 2 * (size_t)row); } } while (0)
#pragma unroll
        for (int k = 0; k < 8; ++k) {
            RES_LOAD(k, k & 1);
            const int ai = k >> 2, bj = (k >> 1) & 1, n = k & 1;
            f32x4 gv = {1.f, 1.f, 1.f, 1.f}, bv = {0.f, 0.f, 0.f, 0.f};
            if (LNX) { gv = *(const f32x4*)(lg + col0 + bj * HALF + n * 16); bv = *(const f32x4*)(lb + col0 + bj * HALF + n * 16); }
#pragma unroll
            for (int m = 0; m < 4; ++m) {
                const size_t o = o0 + (size_t)(ai * HALF + m * 16) * 1024 + bj * HALF + n * 16;
                f32x4 x = xv[k & 1][m];
                if (LNX) x = (x - sm[k & 1][m][0]) * sm[k & 1][m][1] * gv + bv;
                f32x4 r = acc[ai][bj][m][n] + x * ALPHA;
                if (HAS_T) { const u32x2 t = tv[k & 1][m]; r[0] += bf_lo(t.x); r[1] += bf_hi(t.x); r[2] += bf_lo(t.y); r[3] += bf_hi(t.y); }
                *(f32x4*)(y + o) = r;
            }
        }
#undef RES_LOAD
    }
};

template <class Epi, class Sched>
DI void gemm_phase(LAS unsigned char* lds, const Gemm g, const Sched& S, const Epi& E, const int tid) {
    const int wid = __builtin_amdgcn_readfirstlane(tid >> 6), lane = tid & 63, wr = wid >> 2, wc = wid & 3, fr = lane & 15, fq = lane >> 4;
    const int K = g.K, nt = K / BK;
    unsigned voffA_, voffB_;
    { int R, C; stage_rc(tid * 16, R, C); const int Rb = Epi::PERM ? ((R & ~31) + perm32(R & 31)) : R;
      voffA_ = (unsigned)(R * g.lda + C) * 2u; voffB_ = (unsigned)(Rb * g.ldb + C) * 2u; }
    const size_t p64offA = (size_t)64 * g.lda * 2, p64offB = (size_t)64 * g.ldb * 2;
    const size_t kstep = (size_t)(BK * 2);
    const size_t hstepA = (size_t)HALF * g.lda * 2, hstepB = g.hsB > 0 ? (size_t)g.hsB : (size_t)HALF * g.ldb * 2;
    const size_t tstepA = 2 * hstepA, tstepB = 2 * hstepB;
    const unsigned ldsw = (unsigned)wid * 1024u;
    const int aoff = lds_byte(wr * 64 + fr, fq * 8), boff = lds_byte(wc * 32 + fr, fq * 8);
#define PG8_SA(b, h) (((b) * 2 + (h)) * HTB)
#define PG8_SB(b, h) ((4 + (b) * 2 + (h)) * HTB)
#define PG8_STAGE(bufoff, gbase, voff) do { _Pragma("unroll") for (int _i = 0; _i < 2; ++_i) \
        __builtin_amdgcn_global_load_lds((const unsigned*)((const char*)(gbase) + (size_t)_i * p64##voff + (v##voff##_)), (LAS unsigned*)(lds + (bufoff) + ldsw + _i * 8192), 16, 0, 0); } while (0)
#define PG8_LDA(dst, b, h) do { _Pragma("unroll") for (int m = 0; m < 4; ++m) _Pragma("unroll") for (int k = 0; k < 2; ++k) dst[m][k] = *(const LAS bf16x8*)(lds + PG8_SA(b, h) + aoff + m * 2048 + k * 1024); } while (0)
#define PG8_LDB(dst, b, h) do { _Pragma("unroll") for (int n = 0; n < 2; ++n) _Pragma("unroll") for (int k = 0; k < 2; ++k) dst[n][k] = *(const LAS bf16x8*)(lds + PG8_SB(b, h) + boff + n * 2048 + k * 1024); } while (0)
#define PG8_MMA(ai, bj, At, Bt) do { __builtin_amdgcn_s_setprio(1); _Pragma("unroll") for (int m = 0; m < 4; ++m) _Pragma("unroll") for (int n = 0; n < 2; ++n) _Pragma("unroll") for (int k = 0; k < 2; ++k) \
        acc[ai][bj][m][n] = __builtin_amdgcn_mfma_f32_16x16x32_bf16(Bt[n][k], At[m][k], acc[ai][bj][m][n], 0, 0, 0); __builtin_amdgcn_s_setprio(0); } while (0)
#define PG8_WAIT_V(n) asm volatile("s_waitcnt vmcnt(" #n ")" ::: "memory")
#define PG8_WAIT_L(n) asm volatile("s_waitcnt lgkmcnt(" #n ")" ::: "memory")
#define PG8_BAR __builtin_amdgcn_s_barrier()
#define PG8_SCHED __builtin_amdgcn_sched_barrier(0)
    Unit cur, nxt; int ui = 0;
    if (!S.next(0, cur)) return;
    f32x4 acc[2][2][4][2];
#pragma unroll
    for (int a = 0; a < 2; ++a)
#pragma unroll
        for (int b = 0; b < 2; ++b)
#pragma unroll
            for (int m = 0; m < 4; ++m)
#pragma unroll
                for (int n = 0; n < 2; ++n) acc[a][b][m][n] = (f32x4){0.f, 0.f, 0.f, 0.f};
    bf16x8 At[4][2], B0[2][2], B1[2][2];
    const char* cA = (const char*)g.A + (size_t)cur.pm * tstepA; const char* cB = (const char*)g.Bt + (cur.bofs >= 0 ? (size_t)cur.bofs : (size_t)cur.pn * tstepB);
    PG8_STAGE(PG8_SB(0, 0), cB, offB); PG8_STAGE(PG8_SA(0, 0), cA, offA); PG8_STAGE(PG8_SB(0, 1), cB + hstepB, offB); PG8_STAGE(PG8_SA(0, 1), cA + hstepA, offA);
    if (wr == 1) PG8_BAR;
    PG8_WAIT_V(4); PG8_BAR;
    PG8_STAGE(PG8_SB(1, 0), cB + kstep, offB); PG8_STAGE(PG8_SA(1, 0), cA + kstep, offA); PG8_STAGE(PG8_SB(1, 1), cB + hstepB + kstep, offB);
    PG8_WAIT_V(6); PG8_BAR;
    for (;;) {
        const bool has_next = S.next(ui + 1, nxt);
        const char* nA = has_next ? (const char*)g.A + (size_t)nxt.pm * tstepA : cA; const char* nB = has_next ? (const char*)g.Bt + (nxt.bofs >= 0 ? (size_t)nxt.bofs : (size_t)nxt.pn * tstepB) : cB;
        for (int t = 0; t < nt; t += 2) {
            const bool last = (t == nt - 2);
            const char* a1 = cA + (size_t)(t + 1) * kstep;
            const char* a2 = last ? nA : cA + (size_t)(t + 2) * kstep; const char* b2 = last ? nB : cB + (size_t)(t + 2) * kstep;
            const char* a3 = a2 + kstep; const char* b3 = b2 + kstep;
            PG8_LDB(B0, 0, 0); PG8_SCHED; PG8_LDA(At, 0, 0); PG8_STAGE(PG8_SA(1, 1), a1 + hstepA, offA);
            PG8_WAIT_L(8); PG8_BAR; PG8_WAIT_L(0); PG8_MMA(0, 0, At, B0); PG8_BAR; PG8_SCHED;
            PG8_LDB(B1, 0, 1); PG8_STAGE(PG8_SB(0, 0), b2, offB);
            PG8_BAR; PG8_WAIT_L(0); PG8_MMA(0, 1, At, B1); PG8_BAR;
            PG8_LDA(At, 0, 1); PG8_STAGE(PG8_SA(0, 0), a2, offA);
            PG8_BAR; PG8_WAIT_L(0); PG8_MMA(1, 0, At, B0); PG8_BAR; PG8_SCHED;
            PG8_STAGE(PG8_SB(0, 1), b2 + hstepB, offB);
            PG8_WAIT_V(6); PG8_BAR; PG8_MMA(1, 1, At, B1); PG8_BAR;
            PG8_LDB(B0, 1, 0); PG8_SCHED; PG8_LDA(At, 1, 0); PG8_STAGE(PG8_SA(0, 1), a2 + hstepA, offA);
            PG8_WAIT_L(8); PG8_BAR; PG8_WAIT_L(0); PG8_MMA(0, 0, At, B0); PG8_BAR; PG8_SCHED;
            PG8_LDB(B1, 1, 1); PG8_STAGE(PG8_SB(1, 0), b3, offB);
            PG8_BAR; PG8_WAIT_L(0); PG8_MMA(0, 1, At, B1); PG8_BAR;
            PG8_LDA(At, 1, 1); PG8_STAGE(PG8_SA(1, 0), a3, offA);
            PG8_BAR; PG8_WAIT_L(0); PG8_MMA(1, 0, At, B0); PG8_BAR; PG8_SCHED;
            PG8_STAGE(PG8_SB(1, 1), b3 + hstepB, offB);
            PG8_WAIT_V(6); PG8_BAR; PG8_MMA(1, 1, At, B1); PG8_BAR;
        }
        E(acc, cur, wr, wc, fr, fq);
        if (!has_next) break;
#pragma unroll
        for (int a = 0; a < 2; ++a)
#pragma unroll
            for (int b = 0; b < 2; ++b)
#pragma unroll
                for (int m = 0; m < 4; ++m)
#pragma unroll
                    for (int n = 0; n < 2; ++n) acc[a][b][m][n] = (f32x4){0.f, 0.f, 0.f, 0.f};
        cur = nxt; cA = nA; cB = nB; ++ui;
    }
    PG8_WAIT_V(0);
    if (wr == 0) PG8_BAR;
    PG8_BAR;
#undef PG8_SA
#undef PG8_SB
#undef PG8_STAGE
#undef PG8_LDA
#undef PG8_LDB
#undef PG8_MMA
#undef PG8_WAIT_V
#undef PG8_WAIT_L
#undef PG8_BAR
#undef PG8_SCHED
}
}

DI int win_srccol(int n) {
    if (n < 384) return n;
    if (n < 448) return 384 + (n - 384);
    if (n < 960) return 512 + (n - 448);
    if (n < 1024) return 1024 + (n - 960);
    if (n < 1792) return 1096 + (n - 1024);
    if (n < 2048) return 1864 + (n - 1792);
    if (n < 2432) return 2376 + (n - 2048);
    if (n < 2816) return 2760 + (n - 2432);
    if (n < 2880) return 448 + (n - 2816);
    if (n < 3136) return 2120 + (n - 2880);
    if (n < 3520) return 3144 + (n - 3136);
    if (n < 3528) return 1088 + (n - 3520);
    return -1;
}
DI void convT(unsigned char* shm, const float* src, int K, int Nsrc, bf16_t* dst, int Ndst, int mode, const int tid) {
    unsigned short* tl = (unsigned short*)shm;
    const int ntk = K / 64, ntiles = (Ndst / 64) * ntk;
    for (int tile = blockIdx.x; tile < ntiles; tile += gridDim.x) {
        const int n0 = (tile / ntk) * 64, k0 = (tile % ntk) * 64;
        const int nx = tid & 63, ky = tid >> 6;
        const int sc = mode ? win_srccol(n0 + nx) : (n0 + nx);
#pragma unroll
        for (int p = 0; p < 8; ++p) { const int k = k0 + ky + 8 * p; const float v = sc >= 0 ? src[(size_t)k * Nsrc + sc] : 0.f; tl[nx * 66 + ky + 8 * p] = f2bf(v); }
        __syncthreads();
#pragma unroll
        for (int p = 0; p < 8; ++p) { const int n = ky + 8 * p; dst[(size_t)(n0 + n) * K + k0 + nx] = tl[n * 66 + nx]; }
        __syncthreads();
    }
}
DI void conv_vec(const float* src, bf16_t* dst, size_t n8, const int tid) {
    for (size_t i = (size_t)blockIdx.x * 512 + tid; i < n8; i += (size_t)gridDim.x * 512) {
        const f32x4 a = *(const f32x4*)(src + i * 8), b = *(const f32x4*)(src + i * 8 + 4);
        u32x4 w; w.x = pk2(a[0], a[1]); w.y = pk2(a[2], a[3]); w.z = pk2(b[0], b[1]); w.w = pk2(b[2], b[3]);
        *(u32x4*)(dst + i * 8) = w;
    }
}
DI int rel_bucket(int n) {
    if (n < 16) return n;
    int large = 16 + (int)(logf((float)n / 16.0f) / 4.852030263919617f * 16.0f);
    return large < 31 ? large : 31;
}
DI void phase_convert(const Args& a, unsigned char* shm, const int tid) {
    bf16_t* wb = (bf16_t*)(a.ws + WS_WB);
    for (int l = 0; l < 2; ++l) {
        bf16_t* w = wb + (size_t)l * W_LAYER;
        convT(shm, a.in[2] + (size_t)l * 1024 * 3528, 1024, 3528, w + WO_IN, NWIN, 1, tid);
        convT(shm, a.in[3] + (size_t)l * 1024 * 3072, 1024, 3072, w + WO_G, 3072, 0, tid);
        convT(shm, a.in[4] + (size_t)l * 384 * 1024, 384, 1024, w + WO_BA, 1024, 0, tid);
        convT(shm, a.in[5] + (size_t)l * 256 * 1024, 256, 1024, w + WO_BB, 1024, 0, tid);
        convT(shm, a.in[6] + (size_t)l * 384 * 1024, 384, 1024, w + WO_BC, 1024, 0, tid);
        convT(shm, a.in[7] + (size_t)l * 1024 * 1024, 1024, 1024, w + WO_OUT, 1024, 0, tid);
        convT(shm, a.in[10] + (size_t)l * 1024 * 4096, 1024, 4096, w + WO_UP, 4096, 0, tid);
        convT(shm, a.in[11] + (size_t)l * 4096 * 1024, 4096, 1024, w + WO_DN, 1024, 0, tid);
        convT(shm, a.in[12] + (size_t)l * 1024 * 1024, 1024, 1024, w + WO_PG, 1024, 0, tid);
        convT(shm, a.in[13] + (size_t)l * 256 * 1024, 256, 1024, w + WO_PL, 1024, 0, tid);
    }
    conv_vec(a.in[0], (bf16_t*)(a.ws + WS_XB), (size_t)MTOK * 1024 / 8, tid);
    conv_vec(a.in[1], (bf16_t*)(a.ws + WS_PB), (size_t)2 * MTOK * 256 / 8, tid);
    float* lut = (float*)(a.ws + WS_LUT);
    const float* rb = a.in[16];
    for (int i = blockIdx.x * 512 + tid; i < 24 * 2048; i += gridDim.x * 512) {
        const int hd = i >> 11, d = i & 2047;
        lut[i] = rb[rel_bucket(d) * 24 + hd] * LOG2E;
    }
}

DI float wave_sum(float v) {
#pragma unroll
    for (int o = 32; o >= 1; o >>= 1) v += __shfl_xor(v, o);
    return v;
}
template <bool FINAL>
DI void phase_ln(float* y, bf16_t* xb, float* stats, const float* g, const float* b, const int tid) {
    const int wid = tid >> 6, lane = tid & 63;
    f32x4 gv[4], bv[4];
#pragma unroll
    for (int k = 0; k < 4; ++k) { gv[k] = *(const f32x4*)(g + k * 256 + lane * 4); bv[k] = *(const f32x4*)(b + k * 256 + lane * 4); }
    for (int row = blockIdx.x * 8 + wid; row < MTOK; row += gridDim.x * 8) {
        float* yp = y + (size_t)row * 1024;
        f32x4 v[4]; float s = 0.f;
#pragma unroll
        for (int k = 0; k < 4; ++k) { v[k] = *(const f32x4*)(yp + k * 256 + lane * 4); s += v[k][0] + v[k][1] + v[k][2] + v[k][3]; }
        const float mean = wave_sum(s) * (1.0f / 1024.0f);
        float q = 0.f;
#pragma unroll
        for (int k = 0; k < 4; ++k) { v[k] = v[k] - mean; q += v[k][0] * v[k][0] + v[k][1] * v[k][1] + v[k][2] * v[k][2] + v[k][3] * v[k][3]; }
        const float var = wave_sum(q) * (1.0f / 1024.0f);
        const float rs = 1.0f / sqrtf(var + 1e-5f);
        if (!FINAL && lane == 0) { f32x2 sm = {mean, rs}; *(f32x2*)(stats + 2 * (size_t)row) = sm; }
#pragma unroll
        for (int k = 0; k < 4; ++k) { const f32x4 o = v[k] * rs * gv[k] + bv[k];
            if (FINAL) *(f32x4*)(yp + k * 256 + lane * 4) = o;
            else { u32x2 w; w.x = pk2(o[0], o[1]); w.y = pk2(o[2], o[3]); *(u32x2*)(xb + (size_t)row * 1024 + k * 256 + lane * 4) = w; } }
    }
}

DI int pi_row(int r) { return (r & 3) | (((r >> 3) & 1) << 2) | (((r >> 2) & 1) << 3) | (r & 16); }
DI void task_rot(int tau, int& b, int& qt) { b = tau >> 6; qt = ((tau & 63) + 8 * (tau >> 8)) & 63; }
DI bool task_map(int k, int& b, int& qt) {
    if (gridDim.x == 256) { if (k >= 8) return false; const int xcd = blockIdx.x & 7, slot = blockIdx.x >> 3; b = xcd + 8 * (k >> 1); qt = (k & 1) ? 63 - slot : slot; return true; }
    const int tau = blockIdx.x + k * gridDim.x; if (tau >= 2048) return false; task_rot(tau, b, qt); return true;
}

DI void a1_task(unsigned char* shm, const bf16_t* prm, const bf16_t* prt, unsigned* mask, int b, int qt, const int tid) {
    const int wid = __builtin_amdgcn_readfirstlane(tid >> 6), lane = tid & 63, r = lane & 31, h = lane >> 5;
    const int t0 = qt * 32, tok0 = b * SEQ;
    unsigned* cnt = (unsigned*)(shm + 33280);
#pragma unroll
    for (int p = 0; p < 4; ++p) { const int c = tid + p * 512, row = c >> 6, ch = c & 63;
        *(u32x4*)(shm + row * 1040 + ch * 16) = *(const u32x4*)(prm + (size_t)(tok0 + t0 + row) * RM_LD + C_IQ + ch * 8); }
    cnt[tid] = 0u; cnt[tid + 512] = 0u;
    float* wqs = (float*)(shm + 33280 + 4096);
    if (tid < 256) wqs[tid] = bf2f(prt[(size_t)(R_IW + (tid >> 5)) * MTOK + tok0 + t0 + (tid & 31)]);
    __syncthreads();
    unsigned key[8][16];
    const bf16_t* kp = prm + (size_t)(tok0 + pi_row(r)) * RM_LD + C_IK + 8 * h;
    bf16x8 kf[4];
    if (wid <= qt) {
#pragma unroll
        for (int ks = 0; ks < 4; ++ks) kf[ks] = *(const bf16x8*)(kp + (size_t)(wid * 32) * RM_LD + 16 * ks);
    }
#pragma unroll
    for (int jt = 0; jt < 8; ++jt) {
        const int kt = wid + 8 * jt;
        if (kt <= qt) {
            const int s0 = kt * 32;
            bf16x8 kn[4];
            const bool hn = (jt < 7) && (kt + 8 <= qt);
            if (hn) {
#pragma unroll
                for (int ks = 0; ks < 4; ++ks) kn[ks] = *(const bf16x8*)(kp + (size_t)(s0 + 256) * RM_LD + 16 * ks);
            }
            float idx[16];
#pragma unroll
            for (int i = 0; i < 16; ++i) idx[i] = 0.f;
#pragma unroll 1
            for (int hh = 0; hh < 8; ++hh) {
                f32x16 acc;
#pragma unroll
                for (int i = 0; i < 16; ++i) acc[i] = 0.f;
                const unsigned char* qb = shm + r * 1040 + hh * 128 + 16 * h;
#pragma unroll
                for (int ks = 0; ks < 4; ++ks) { const bf16x8 qf = *(const bf16x8*)(qb + 32 * ks); acc = MFMA32(kf[ks], qf, acc); }
                const float wv = wqs[hh * 32 + r];
#pragma unroll
                for (int i = 0; i < 16; ++i) idx[i] = fmaf(wv, fmaxf(acc[i], 0.f), idx[i]);
            }
#pragma unroll
            for (int i = 0; i < 16; ++i) {
                const int s = s0 + 16 * (i >> 3) + 8 * h + (i & 7);
                const unsigned u = __float_as_uint(idx[i] + 0.0f);
                const unsigned k = (u & 0x80000000u) ? ~u : (u | 0x80000000u);
                key[jt][i] = (s <= t0 + r) ? k : 0u;
            }
            if (hn) {
#pragma unroll
                for (int ks = 0; ks < 4; ++ks) kf[ks] = kn[ks];
            }
        } else {
#pragma unroll
            for (int i = 0; i < 16; ++i) key[jt][i] = 0u;
        }
    }
    unsigned T = 0u;
    if (qt >= 8) {
        const int nheld = (qt >= wid) ? ((qt - wid) >> 3) + 1 : 0;
        bool done = false;
        for (int bit = 31; bit >= 0; --bit) {
            const unsigned cand = T | (1u << bit);
            int c = 0;
#pragma unroll
            for (int jt = 0; jt < 8; ++jt) {
                if (jt < nheld) {
#pragma unroll
                    for (int i = 0; i < 16; ++i) c += (key[jt][i] >= cand) ? 1 : 0;
                }
            }
            c += __shfl_xor(c, 32);
            if (h == 0 && c) atomicAdd(&cnt[(31 - bit) * 32 + r], (unsigned)c);
            __syncthreads();
            const unsigned tot = cnt[(31 - bit) * 32 + r];
            if (!done) { if (tot >= 256u) T = cand; if (tot == 256u) done = true; }
            if (__ballot(!done) == 0ull) break;
        }
    }
    if (T < 1u) T = 1u;
#pragma unroll
    for (int jt = 0; jt < 8; ++jt) {
        const int kt = wid + 8 * jt;
        if (kt <= qt) {
            unsigned part = 0u;
#pragma unroll
            for (int i = 0; i < 16; ++i) part |= (key[jt][i] >= T ? 1u : 0u) << (16 * (i >> 3) + 8 * h + (i & 7));
            part |= (unsigned)__shfl_xor((int)part, 32);
            if (h == 0) mask[(size_t)(tok0 + t0 + r) * 64 + kt] = part;
        }
    }
    __syncthreads();
}
DI void g2_job(const Args& a, unsigned char* wsh, LAS unsigned char* wl, int b, int slot, int cls, int it, const int tid);
DI void phase_a1(const Args& a, unsigned char* shm, const int tid) {
    const bf16_t* prm = (const bf16_t*)(a.ws + WS_R1);
    const bf16_t* prt = prm + (size_t)MTOK * RM_LD;
    unsigned* mask = (unsigned*)(a.ws + WS_MASK);
    float* kmean = (float*)(a.ws + WS_KMEAN);
    for (int k = 0;; ++k) { int b, qt; if (!task_map(k, b, qt)) break; a1_task(shm, prm, prt, mask, b, qt, tid); }
    for (int j = 2048 + blockIdx.x; j < 2048 + 192; j += gridDim.x) {
        {
            const int id = (j - 2048) * 8 + (tid >> 6), lane = tid & 63;
            const int b = id / 48, hd = (id >> 3) % 6, n = id & 7;
            const bf16_t* p = prm + (size_t)(b * SEQ + n * 256) * RM_LD + C_CK + hd * 64 + lane;
            float s = 0.f;
            for (int t = 0; t < 256; ++t) s += bf2f(p[(size_t)t * RM_LD]);
            kmean[(size_t)((b * 6 + hd) * 8 + n) * 64 + lane] = s * (1.0f / 256.0f);
        }
    }
    __syncthreads();
    {
        const int wid = __builtin_amdgcn_readfirstlane(tid >> 6);
        unsigned char* wsh = shm + wid * 16384;
        LAS unsigned char* wl = (LAS unsigned char*)shm + wid * 16384;
        for (int j = blockIdx.x; j < 1024; j += gridDim.x) {
            const int id = j * 8 + wid;
            g2_job(a, wsh, wl, id >> 8, (id >> 6) & 3, (id >> 2) & 15, id & 3, tid);
        }
    }
    __syncthreads();
}


struct AttnSt { float m, l; f32x16 o0, o1; };
struct AttnCtx {
    LAS unsigned char* wl;
    const float* lut;
    const bf16_t* kg;
    const bf16_t* vg;
    unsigned koff[4], voff[4];
    int kfo[4], vfo[2][2];
    int krs;
};
DI void attn_dma(const AttnCtx& c, int kt) {
    const char* kb = (const char*)(c.kg + (size_t)(kt * 32 * c.krs) * RM_LD);
    const char* vb = (const char*)(c.vg + kt * 32);
#pragma unroll
    for (int j = 0; j < 4; ++j) __builtin_amdgcn_global_load_lds((const unsigned*)(kb + c.koff[j]), (LAS unsigned*)(c.wl + j * 1024), 16, 0, 0);
#pragma unroll
    for (int j = 0; j < 4; ++j) __builtin_amdgcn_global_load_lds((const unsigned*)(vb + c.voff[j]), (LAS unsigned*)(c.wl + 4096 + j * 1024), 16, 0, 0);
}
template <int MODE, bool UNI>
DI void attn_compute(const bf16x8 (&qf)[4], const bf16x8 (&kf)[4], const bf16x8 (&vf)[2][2], int kt, int d00, const float* lut, float ubias, AttnSt& st,
                     unsigned W, int win, int dmask, bool lane_sel) {
    const int s0 = kt * 32;
    f32x16 sx;
#pragma unroll
    for (int i = 0; i < 16; ++i) sx[i] = 0.f;
#pragma unroll
    for (int ks = 0; ks < 4; ++ks) sx = MFMA32(kf[ks], qf[ks], sx);
    const int d0 = d00 - s0;
    const LAS float* lb = (const LAS float*)lut + ((MODE == 4) ? 16 * (d0 - 23) : (d0 - 23));
    float sv[16]; float mx = NEGF;
#pragma unroll
    for (int i = 0; i < 16; ++i) {
        const int ci = 16 * (i >> 3) + (i & 7);
        const int dist = d0 - ci;
        bool v;
        if (MODE == 0) v = ((W >> ci) & 1u) != 0u;
        else if (MODE == 1) v = ((unsigned)dist <= (unsigned)win) && ((dist & dmask) == 0);
        else if (MODE == 2) v = lane_sel;
        else v = dist >= 0;
        const float bias = UNI ? ubias : ((MODE == 4) ? lb[16 * (23 - ci)] : lb[23 - ci]);
        float s = fmaf(sx[i], SC2, bias);
        if (MODE == 0) { const unsigned t = (unsigned)__builtin_amdgcn_sbfe((int)W, ci, 1);
            s = __uint_as_float((__float_as_uint(s) & t) | (__float_as_uint(NEGF) & ~t)); }
        else s = v ? s : NEGF;
        sv[i] = s; mx = fmaxf(mx, s);
    }
    mx = fmaxf(mx, __shfl_xor(mx, 32));
    const float mnew = fmaxf(st.m, mx);
    const float msafe = (mnew > -1e29f) ? mnew : 0.f;
    if (__ballot(mnew > st.m) != 0ull) {
        const float alpha = __builtin_amdgcn_exp2f(st.m - msafe);
        st.l *= alpha; st.m = mnew;
#pragma unroll
        for (int i = 0; i < 16; ++i) { st.o0[i] *= alpha; st.o1[i] *= alpha; }
    }
    float ps = 0.f; float p[16];
#pragma unroll
    for (int i = 0; i < 16; ++i) { const float e = __builtin_amdgcn_exp2f(sv[i] - msafe); p[i] = e; ps += e; }
    st.l += ps;
    u32x4 w0, w1;
    w0.x = pk2(p[0], p[1]); w0.y = pk2(p[2], p[3]); w0.z = pk2(p[4], p[5]); w0.w = pk2(p[6], p[7]);
    w1.x = pk2(p[8], p[9]); w1.y = pk2(p[10], p[11]); w1.z = pk2(p[12], p[13]); w1.w = pk2(p[14], p[15]);
    const bf16x8 pf0 = __builtin_bit_cast(bf16x8, w0), pf1 = __builtin_bit_cast(bf16x8, w1);
    st.o0 = MFMA32(vf[0][0], pf0, st.o0); st.o0 = MFMA32(vf[0][1], pf1, st.o0);
    st.o1 = MFMA32(vf[1][0], pf0, st.o1); st.o1 = MFMA32(vf[1][1], pf1, st.o1);
}
DI void attn_compute_sp4(const bf16x8 (&qf)[4], const bf16x8 (&kf)[4], const bf16x8 (&vf)[2][2], int kt, int d00, const float* lut, AttnSt& st, int win, int dmask) {
    const int s0 = kt * 32;
    f32x16 sx;
#pragma unroll
    for (int i = 0; i < 16; ++i) sx[i] = 0.f;
#pragma unroll
    for (int ks = 0; ks < 4; ++ks) sx = MFMA32(kf[ks], qf[ks], sx);
    const int d0 = d00 - s0, e = d0 & 3;
    const bool e0 = (e == 0), e1 = (e == 1), e2 = (e == 2);
    const LAS float* lb = (const LAS float*)lut + (d0 - e - 20);
    float sv[4]; float mx = NEGF;
#pragma unroll
    for (int g = 0; g < 4; ++g) {
        const float x = e0 ? sx[4 * g] : (e1 ? sx[4 * g + 1] : (e2 ? sx[4 * g + 2] : sx[4 * g + 3]));
        const int dist = d0 - (16 * (g >> 1) + 4 * (g & 1)) - e;
        const bool v = ((unsigned)dist <= (unsigned)win) && ((dist & dmask) == 0);
        const float bias = lb[20 - (16 * (g >> 1) + 4 * (g & 1))];
        float sc = fmaf(x, SC2, bias);
        sc = v ? sc : NEGF;
        sv[g] = sc; mx = fmaxf(mx, sc);
    }
    mx = fmaxf(mx, __shfl_xor(mx, 32));
    const float mnew = fmaxf(st.m, mx);
    const float msafe = (mnew > -1e29f) ? mnew : 0.f;
    if (__ballot(mnew > st.m) != 0ull) {
        const float alpha = __builtin_amdgcn_exp2f(st.m - msafe);
        st.l *= alpha; st.m = mnew;
#pragma unroll
        for (int i = 0; i < 16; ++i) { st.o0[i] *= alpha; st.o1[i] *= alpha; }
    }
    float ps = 0.f; float p[16];
#pragma unroll
    for (int g = 0; g < 4; ++g) {
        const float pe = __builtin_amdgcn_exp2f(sv[g] - msafe); ps += pe;
        p[4 * g] = e0 ? pe : 0.f; p[4 * g + 1] = e1 ? pe : 0.f; p[4 * g + 2] = e2 ? pe : 0.f; p[4 * g + 3] = (e == 3) ? pe : 0.f;
    }
    st.l += ps;
    u32x4 w0, w1;
    w0.x = pk2(p[0], p[1]); w0.y = pk2(p[2], p[3]); w0.z = pk2(p[4], p[5]); w0.w = pk2(p[6], p[7]);
    w1.x = pk2(p[8], p[9]); w1.y = pk2(p[10], p[11]); w1.z = pk2(p[12], p[13]); w1.w = pk2(p[14], p[15]);
    const bf16x8 pf0 = __builtin_bit_cast(bf16x8, w0), pf1 = __builtin_bit_cast(bf16x8, w1);
    st.o0 = MFMA32(vf[0][0], pf0, st.o0); st.o0 = MFMA32(vf[0][1], pf1, st.o0);
    st.o1 = MFMA32(vf[1][0], pf0, st.o1); st.o1 = MFMA32(vf[1][1], pf1, st.o1);
}
template <int MODE>
DI void attn_range(const AttnCtx& c, const bf16x8 (&qf)[4], int lo, int hi, int t0, int d00, AttnSt& st, const unsigned* maskrow, int h8, int win, int dmask, bool lane_sel) {
    if (lo > hi) return;
    attn_dma(c, lo);
    unsigned Wn = 0u;
    if (MODE == 0) Wn = maskrow[lo];
#pragma unroll 1
    for (int kt = lo; kt <= hi; ++kt) {
        asm volatile("s_waitcnt vmcnt(0)" ::: "memory");
        bf16x8 kf[4], vf[2][2];
#pragma unroll
        for (int ks = 0; ks < 4; ++ks) kf[ks] = *(const LAS bf16x8*)(c.wl + c.kfo[ks]);
#pragma unroll
        for (int mt = 0; mt < 2; ++mt)
#pragma unroll
            for (int s = 0; s < 2; ++s) vf[mt][s] = *(const LAS bf16x8*)(c.wl + 4096 + c.vfo[mt][s]);
        const unsigned W = Wn >> h8;
        const int dlo = t0 - kt * 32 - 31;
        float ub = 0.f; bool uni = false;
        if (dlo >= 182) { const unsigned ua = __builtin_amdgcn_readfirstlane(__float_as_uint(c.lut[dlo])), ue = __builtin_amdgcn_readfirstlane(__float_as_uint(c.lut[dlo + 62])); uni = (ua == ue); ub = __uint_as_float(ua); }
        asm volatile("s_waitcnt lgkmcnt(0)" ::: "memory");
        if (kt < hi) { attn_dma(c, kt + 1); if (MODE == 0) Wn = maskrow[kt + 1]; }
        if (MODE == 1 && dmask != 0) attn_compute_sp4(qf, kf, vf, kt, d00, c.lut, st, win, dmask);
        else attn_compute<MODE, false>(qf, kf, vf, kt, d00, c.lut, 0.f, st, W, win, dmask, lane_sel);
    }
}

DI void load_lut(float* lut, const float* glut, int col, int lane) {
    __builtin_amdgcn_fence(__ATOMIC_ACQ_REL, "wavefront");
#pragma unroll
    for (int k = 0; k < 8; ++k) *(f32x4*)(lut + k * 256 + lane * 4) = *(const f32x4*)(glut + (size_t)col * 2048 + k * 256 + lane * 4);
    __builtin_amdgcn_fence(__ATOMIC_ACQ_REL, "wavefront");
    __builtin_amdgcn_wave_barrier();
}

DI void attn_job(const Args& a, unsigned char* wsh, LAS unsigned char* wl, int type, int b, int qt, int hd, const int tid) {
    const int lane = tid & 63, r = lane & 31, h = lane >> 5;
    const bf16_t* prm = (const bf16_t*)(a.ws + WS_R1);
    const bf16_t* prt = prm + (size_t)MTOK * RM_LD;
    const float* glut = (const float*)(a.ws + WS_LUT);
    const unsigned* mask = (const unsigned*)(a.ws + WS_MASK);
    const float* kmean = (const float*)(a.ws + WS_KMEAN);
    bf16_t* oabc = (bf16_t*)(a.ws + WS_OABC);
    float* lut = (float*)(wsh + 8192);
    const int t0 = qt * 32, tok0 = b * SEQ;
    const int d00 = t0 + r - 8 * h, h8 = 8 * h;
    const unsigned* maskrow = mask + (size_t)(tok0 + t0 + r) * 64;
    AttnCtx c; c.wl = wl; c.lut = lut; c.krs = 1;
#pragma unroll
    for (int j = 0; j < 4; ++j) {
        const int rk = 8 * j + (lane >> 3), ck = (lane & 7) ^ ((rk >> 1) & 7);
        c.koff[j] = (unsigned)(pi_row(rk) * RM_LD + ck * 8) * 2u;
        const int rv = 16 * j + (lane >> 2), cv = (lane & 3) ^ ((rv >> 2) & 3);
        c.voff[j] = (unsigned)(rv * MTOK + cv * 8) * 2u;
        c.kfo[j] = r * 128 + (((2 * j + h) ^ ((r >> 1) & 7)) * 16);
    }
#pragma unroll
    for (int mt = 0; mt < 2; ++mt)
#pragma unroll
        for (int s = 0; s < 2; ++s) c.vfo[mt][s] = (32 * mt + r) * 64 + (((2 * s + h) ^ ((r >> 2) & 3)) * 16);
    AttnSt st; st.m = NEGF; st.l = 0.f;
#pragma unroll
    for (int i = 0; i < 16; ++i) { st.o0[i] = 0.f; st.o1[i] = 0.f; }
    const int ng = (type == 1) ? 2 : 1;
    int ocol = 0;
    for (int g = 0; g < ng; ++g) {
        int qcol, kcol, vrow, bcol;
        if (type == 0) { qcol = C_AQ + hd * 64; kcol = C_AK; vrow = R_AV; bcol = hd; ocol = hd * 64; }
        else if (type == 1) { qcol = C_BQ + (g * 4 + hd) * 64; kcol = C_BK + hd * 64; vrow = R_BV + hd * 64; bcol = 6 + g * 4 + hd; ocol = 384 + hd * 64; }
        else { qcol = C_CQ + hd * 64; kcol = C_CK + hd * 64; vrow = R_CV + hd * 64; bcol = 18 + hd; ocol = 640 + hd * 64; }
        load_lut(lut, glut, bcol, lane);
        bf16x8 qf[4];
        const bf16_t* qp = prm + (size_t)(tok0 + t0 + r) * RM_LD + qcol + 8 * h;
#pragma unroll
        for (int ks = 0; ks < 4; ++ks) qf[ks] = *(const bf16x8*)(qp + 16 * ks);
        c.kg = prm + (size_t)tok0 * RM_LD + kcol;
        c.vg = prt + (size_t)vrow * MTOK + tok0;
        if (type == 0) {
            attn_range<0>(c, qf, 0, qt, t0, d00, st, maskrow, h8, 0, 0, false);
        } else if (type == 1) {
            const int win = (g == 0) ? 128 : (g == 1 ? 512 : 2048), dmask = (g == 0) ? 0 : (g == 1 ? 3 : 15);
            int lo = t0 - win; if (lo < 0) lo = 0;
            attn_range<1>(c, qf, lo >> 5, qt, t0, d00, st, maskrow, h8, win, dmask, false);
        } else {
            const int cur = qt >> 3;
            float gate[7];
            const float* km = kmean + (size_t)((b * 6 + hd) * 8) * 64 + 8 * h;
#pragma unroll
            for (int n = 0; n < 7; ++n) {
                float s = 0.f;
                if (n < cur) {
#pragma unroll
                    for (int ks = 0; ks < 4; ++ks) {
                        const f32x4 k0 = *(const f32x4*)(km + n * 64 + 16 * ks), k1 = *(const f32x4*)(km + n * 64 + 16 * ks + 4);
                        const u32x4 qw = __builtin_bit_cast(u32x4, qf[ks]);
                        s += bf_lo(qw.x) * k0[0] + bf_hi(qw.x) * k0[1] + bf_lo(qw.y) * k0[2] + bf_hi(qw.y) * k0[3]
                           + bf_lo(qw.z) * k1[0] + bf_hi(qw.z) * k1[1] + bf_lo(qw.w) * k1[2] + bf_hi(qw.w) * k1[3];
                    }
                    s += __shfl_xor(s, 32);
                } else s = -__builtin_inff();
                gate[n] = s;
            }
            unsigned sel = 0u;
#pragma unroll
            for (int rd = 0; rd < 3; ++rd) {
                float bv = -__builtin_inff(); int bi = -1;
#pragma unroll
                for (int n = 0; n < 7; ++n) if (gate[n] > bv) { bv = gate[n]; bi = n; }
                if (bi >= 0) sel |= 1u << bi;
#pragma unroll
                for (int n = 0; n < 7; ++n) if (n == bi) gate[n] = -__builtin_inff();
            }
            for (int n = 0; n < cur; ++n) {
                const bool ls = ((sel >> n) & 1u) != 0u;
                if (__ballot(ls) == 0ull) continue;
                attn_range<2>(c, qf, n * 8, n * 8 + 7, t0, d00, st, maskrow, h8, 0, 0, ls);
            }
            attn_range<3>(c, qf, cur * 8, qt, t0, d00, st, maskrow, h8, 0, 0, false);
        }
    }
    float lt = st.l + __shfl_xor(st.l, 32);
    if (type == 1) {
        const float* pp = (const float*)(a.ws + WS_G2) + ((size_t)(tok0 + t0 + r) * 4 + hd) * 68;
        const f32x2 ml = *(const f32x2*)(pp + 64);
        const float mn = fmaxf(st.m, ml[0]);
        const float a1 = __builtin_amdgcn_exp2f(st.m - mn), a2 = __builtin_amdgcn_exp2f(ml[0] - mn);
        lt = lt * a1 + ml[1] * a2;
#pragma unroll
        for (int g4 = 0; g4 < 4; ++g4) {
            const f32x4 p0 = *(const f32x4*)(pp + 8 * g4 + 4 * h), p1 = *(const f32x4*)(pp + 32 + 8 * g4 + 4 * h);
#pragma unroll
            for (int e = 0; e < 4; ++e) { st.o0[4 * g4 + e] = st.o0[4 * g4 + e] * a1 + p0[e] * a2; st.o1[4 * g4 + e] = st.o1[4 * g4 + e] * a1 + p1[e] * a2; }
        }
    }
    const float inv = 1.0f / lt;
    bf16_t* op = oabc + (size_t)(tok0 + t0 + r) * 1024 + ocol + 4 * h;
#pragma unroll
    for (int g4 = 0; g4 < 4; ++g4) {
        u32x2 w;
        w.x = pk2(st.o0[4 * g4] * inv, st.o0[4 * g4 + 1] * inv); w.y = pk2(st.o0[4 * g4 + 2] * inv, st.o0[4 * g4 + 3] * inv);
        *(u32x2*)(op + 8 * g4) = w;
        w.x = pk2(st.o1[4 * g4] * inv, st.o1[4 * g4 + 1] * inv); w.y = pk2(st.o1[4 * g4 + 2] * inv, st.o1[4 * g4 + 3] * inv);
        *(u32x2*)(op + 32 + 8 * g4) = w;
    }
}
DI void g2_job(const Args& a, unsigned char* wsh, LAS unsigned char* wl, int b, int slot, int cls, int it, const int tid) {
    const int lane = tid & 63, r = lane & 31, h = lane >> 5;
    const bf16_t* prm = (const bf16_t*)(a.ws + WS_R1);
    const bf16_t* vt16 = (const bf16_t*)(a.ws + WS_VT16);
    const float* glut = (const float*)(a.ws + WS_LUT);
    float* lut = (float*)(wsh + 8192);
    const int tok0 = b * SEQ;
    const int d00 = 32 * it + r - 8 * h;
    AttnCtx c; c.wl = wl; c.lut = lut; c.krs = 16;
#pragma unroll
    for (int j = 0; j < 4; ++j) {
        const int rk = 8 * j + (lane >> 3), ck = (lane & 7) ^ ((rk >> 1) & 7);
        c.koff[j] = (unsigned)(pi_row(rk) * 16 * RM_LD + ck * 8) * 2u;
        const int rv = 16 * j + (lane >> 2), cv = (lane & 3) ^ ((rv >> 2) & 3);
        c.voff[j] = (unsigned)(rv * MTOK + cv * 8) * 2u;
        c.kfo[j] = r * 128 + (((2 * j + h) ^ ((r >> 1) & 7)) * 16);
    }
#pragma unroll
    for (int mt = 0; mt < 2; ++mt)
#pragma unroll
        for (int s = 0; s < 2; ++s) c.vfo[mt][s] = (32 * mt + r) * 64 + (((2 * s + h) ^ ((r >> 2) & 3)) * 16);
    AttnSt st; st.m = NEGF; st.l = 0.f;
#pragma unroll
    for (int i = 0; i < 16; ++i) { st.o0[i] = 0.f; st.o1[i] = 0.f; }
    load_lut(lut, glut, 6 + 2 * 4 + slot, lane);
    const int tq = tok0 + cls + 16 * (32 * it + r);
    bf16x8 qf[4];
    const bf16_t* qp = prm + (size_t)tq * RM_LD + C_BQ + (2 * 4 + slot) * 64 + 8 * h;
#pragma unroll
    for (int ks = 0; ks < 4; ++ks) qf[ks] = *(const bf16x8*)(qp + 16 * ks);
    c.kg = prm + (size_t)(tok0 + cls) * RM_LD + C_BK + slot * 64;
    c.vg = vt16 + (size_t)(slot * 64) * MTOK + tok0 + cls * 128;
    attn_range<4>(c, qf, 0, it, 0, d00, st, nullptr, 0, 0, 0, false);
    const float lt = st.l + __shfl_xor(st.l, 32);
    float* pp = (float*)(a.ws + WS_G2) + ((size_t)tq * 4 + slot) * 68;
#pragma unroll
    for (int g4 = 0; g4 < 4; ++g4) {
        f32x4 p0, p1;
#pragma unroll
        for (int e = 0; e < 4; ++e) { p0[e] = st.o0[4 * g4 + e]; p1[e] = st.o1[4 * g4 + e]; }
        *(f32x4*)(pp + 8 * g4 + 4 * h) = p0; *(f32x4*)(pp + 32 + 8 * g4 + 4 * h) = p1;
    }
    if (h == 0) { f32x2 ml = {st.m, lt}; *(f32x2*)(pp + 64) = ml; }
}
DI void phase_attn(const Args& a, unsigned char* shm, const int tid) {
    const int wid = __builtin_amdgcn_readfirstlane(tid >> 6);
    unsigned char* wsh = shm + wid * 16384;
    LAS unsigned char* wl = (LAS unsigned char*)shm + wid * 16384;
    for (int it = 0;; ++it) {
        int b, qt; if (!task_map(it, b, qt)) break;
        const int role = (wid + it) & 7;
        if (role < 6) { attn_job(a, wsh, wl, 0, b, qt, role, tid); attn_job(a, wsh, wl, 2, b, qt, role, tid); }
        else { attn_job(a, wsh, wl, 1, b, qt, role - 6, tid); attn_job(a, wsh, wl, 1, b, qt, role - 4, tid); }
    }
}

#define XB_TMO      128
#define XB_XCNT(j)  (256  + 64 * (j))
#define XB_XSUB(j)  (1280 + 64 * (j))
#define XB_XGEN(j)  (2304 + 64 * (j))
#define XB_TOP      3328
#define XB_TOPGEN   3392
#define XCD_BAR_WORDS 3456
#define XB_SPIN_CAP (1u << 20)
DI unsigned xb_ld(unsigned* p)              { return __hip_atomic_load(p, __ATOMIC_RELAXED, __HIP_MEMORY_SCOPE_AGENT); }
DI unsigned xb_add(unsigned* p, unsigned v) { return __hip_atomic_fetch_add(p, v, __ATOMIC_RELAXED, __HIP_MEMORY_SCOPE_AGENT); }
DI unsigned xb_xcc_id() { return (unsigned)__builtin_amdgcn_s_getreg((3 << 11) | 20) & 0xFu; }
#define XB_SPIN(cond, bar) do { unsigned _sp = 0; while (cond) { __builtin_amdgcn_s_sleep(1); \
    if ((++_sp & 255u) == 0u) { if (xb_ld(&(bar)[XB_TMO])) break; if (_sp > XB_SPIN_CAP) { atomicAdd(&(bar)[XB_TMO], 1u); break; } } } } while (0)
struct XcdBarrier { unsigned* bar; unsigned x; volatile LAS unsigned* st; };
DI void xcd_barrier_complete(unsigned* bar, unsigned x, unsigned& nloc, unsigned& nx) {
    const unsigned G = gridDim.x * gridDim.y * gridDim.z;
    unsigned sum, cnt, mine, sp = 0u;
    for (;;) {
        sum = 0u; cnt = 0u; mine = 0u;
#pragma unroll
        for (unsigned j = 0; j < 16; ++j) { const unsigned c = xb_ld(&bar[XB_XCNT(j)]); sum += c; cnt += (c > 0u) ? 1u : 0u; mine = (j == x) ? c : mine; }
        if (sum == G) break;
        __builtin_amdgcn_s_sleep(1);
        if ((++sp & 255u) == 0u) { if (xb_ld(&bar[XB_TMO])) break; if (sp > XB_SPIN_CAP) { atomicAdd(&bar[XB_TMO], 1u); break; } }
    }
    nloc = mine > 0u ? mine : 1u; nx = cnt > 0u ? cnt : 1u;
}
DI void xcd_barrier(const XcdBarrier& b, const int tid) {
    asm volatile("s_waitcnt vmcnt(0)" ::: "memory");
    __syncthreads();
    if (tid == 0) {
        unsigned* bar = b.bar;
        __builtin_amdgcn_s_waitcnt(0);
        unsigned nloc = b.st[0], nx = b.st[1];
        if (nloc == 0u) { xcd_barrier_complete(bar, b.x, nloc, nx); b.st[0] = nloc; b.st[1] = nx; }
        const unsigned old = xb_add(&bar[XB_XSUB(b.x)], 1u);
        const unsigned gen = old / nloc;
        if (old + 1u == (gen + 1u) * nloc) {
            __builtin_amdgcn_fence(__ATOMIC_RELEASE, "agent");
            asm volatile("s_waitcnt vmcnt(0)" ::: "memory");
            const unsigned og = xb_add(&bar[XB_TOP], 1u);
            const unsigned tg = og / nx;
            if (og + 1u == (tg + 1u) * nx) xb_add(&bar[XB_TOPGEN], 1u);
            else XB_SPIN(xb_ld(&bar[XB_TOPGEN]) == tg, bar);
            __builtin_amdgcn_fence(__ATOMIC_ACQUIRE, "agent");
            xb_add(&bar[XB_XGEN(b.x)], 1u);
            asm volatile("s_waitcnt vmcnt(0)" ::: "memory");
        } else {
            XB_SPIN(xb_ld(&bar[XB_XGEN(b.x)]) == gen, bar);
            __builtin_amdgcn_fence(__ATOMIC_ACQUIRE, "agent");
            asm volatile("s_waitcnt vmcnt(0)" ::: "memory");
        }
    }
    __syncthreads();
}

__global__ void __launch_bounds__(512, 2) mega_fwd(Args a_) {
    extern __shared__ __attribute__((aligned(16))) unsigned char shm[];
    cg::grid_group grid = cg::this_grid();
    LAS unsigned char* lds = (LAS unsigned char*)shm;
    const int G = gridDim.x, c = blockIdx.x;
#ifndef PROBE_REP
#define PROBE_REP -2
#endif
    const int ph_lo = a_.ph_lo, ph_hi = a_.ph_hi;
    const int wave_id = __builtin_amdgcn_readfirstlane(threadIdx.x >> 6);
    XcdBarrier xbar;
    { volatile LAS unsigned* st = (volatile LAS unsigned*)(lds + 131072);
      if (threadIdx.x == 0) { st[0] = 0u; st[1] = 0u; }
      __syncthreads();
      xbar.bar = (unsigned*)(a_.ws + WS_BAR); xbar.x = xb_xcc_id(); xbar.st = st;
      if (threadIdx.x == 0) (void)xb_add(&xbar.bar[XB_XCNT(xbar.x)], 1u); }
    for (int phx = 2 * ph_lo; phx < 2 * ph_hi; ++phx) {
        const int ph = phx >> 1;
        if (phx & 1) { const bool rep = (PROBE_REP == -1) ? (ph == 0) : (ph > 0 && (ph - 1) % 9 == PROBE_REP); if (!rep) continue; }
        const Args& a = a_;
        int tid = wave_id * 64 + (int)__builtin_amdgcn_mbcnt_hi(~0u, __builtin_amdgcn_mbcnt_lo(~0u, 0u)); asm volatile("" : "+v"(tid));
        bf16_t* xb = (bf16_t*)(a.ws + WS_XB);
        bf16_t* r1 = (bf16_t*)(a.ws + WS_R1);
        bf16_t* oabc = (bf16_t*)(a.ws + WS_OABC);
        float* stats = (float*)(a.ws + WS_STATS);
        if (ph == 0) phase_convert(a, shm, tid);
        else {
            const int l = (ph - 1) / 9, sp = (ph - 1) % 9;
            const bf16_t* w = (const bf16_t*)(a.ws + WS_WB) + (size_t)l * W_LAYER;
            const float* xin = (l == 0) ? a.in[0] : a.out;
            if (sp == 0) {
                { pg8::Gemm g{xb, w + WO_IN, 1024, 1024, 1024, 0}; pg8::StaticOrder S; S.init(256, 11, G, c); pg8::EpiBf16<0> E{r1, RM_LD}; pg8::gemm_phase(lds, g, S, E, tid); }
                { pg8::Gemm g{w + WO_IN + (size_t)RM_LD * 1024, xb, 1024, 1024, 1024, 0}; pg8::StaticOrder S; S.init(3, 256, G, c); pg8::EpiBf16<0> E{r1 + (size_t)MTOK * RM_LD, MTOK}; pg8::gemm_phase(lds, g, S, E, tid); }
                { pg8::Gemm g{w + WO_IN + (size_t)2880 * 1024, xb, 1024, 16 * 1024, 1024, 2048}; pg8::OrderVT16 S{G, c}; pg8::EpiBf16<0> E{(bf16_t*)(a.ws + WS_VT16), MTOK}; pg8::gemm_phase(lds, g, S, E, tid); }
            } else if (sp == 1) phase_a1(a, shm, tid);
            else if (sp == 2) phase_attn(a, shm, tid);
            else if (sp == 3) {
                pg8::StaticOrder S; S.init(256, 4, G, c);
                { pg8::Gemm g{oabc, w + WO_BA, 1024, 384, 384, 0}; pg8::EpiBf16<0> E{r1, 3072}; pg8::gemm_phase(lds, g, S, E, tid); }
                { pg8::Gemm g{oabc + 384, w + WO_BB, 1024, 256, 256, 0}; pg8::EpiBf16<0> E{r1 + 1024, 3072}; pg8::gemm_phase(lds, g, S, E, tid); }
                { pg8::Gemm g{oabc + 640, w + WO_BC, 1024, 384, 384, 0}; pg8::EpiBf16<0> E{r1 + 2048, 3072}; pg8::gemm_phase(lds, g, S, E, tid); }
                { pg8::Gemm g{xb, w + WO_G, 1024, 1024, 1024, 0}; pg8::Order3 S3; S3.base = S; pg8::EpiGate E{r1, r1 + (size_t)MTOK * 3072}; pg8::gemm_phase(lds, g, S3, E, tid); }
            } else if (sp == 4) {
                pg8::Gemm g{r1 + (size_t)MTOK * 3072, w + WO_OUT, 1024, 1024, 1024, 0}; pg8::StaticOrder S; S.init(256, 4, G, c);
                if (l == 0) { pg8::EpiRes<false, false> E{xin, a.out, nullptr, nullptr, nullptr, nullptr}; pg8::gemm_phase(lds, g, S, E, tid); }
                else { pg8::EpiRes<false, true> E{xin, a.out, nullptr, stats, a.in[14], a.in[15]}; pg8::gemm_phase(lds, g, S, E, tid); }
            } else if (sp == 5) phase_ln<false>(a.out, xb, stats, a.in[8] + l * 1024, a.in[9] + l * 1024, tid);
            else if (sp == 6) {
                { pg8::Gemm g{xb, w + WO_UP, 1024, 1024, 1024, 0}; pg8::StaticOrder S; S.init(256, 16, G, c); pg8::EpiBf16<1> E{r1, 4096}; pg8::gemm_phase(lds, g, S, E, tid); }
                pg8::StaticOrder S; S.init(256, 4, G, c);
                { pg8::Gemm g{(const bf16_t*)(a.ws + WS_PB) + (size_t)l * MTOK * 256, w + WO_PL, 256, 256, 256, 0}; pg8::EpiBf16<0> E{oabc, 1024}; pg8::gemm_phase(lds, g, S, E, tid); }
                { pg8::Gemm g{xb, w + WO_PG, 1024, 1024, 1024, 0}; pg8::EpiT1 E{oabc}; pg8::gemm_phase(lds, g, S, E, tid); }
            } else if (sp == 7) {
                pg8::Gemm g{r1, w + WO_DN, 4096, 4096, 4096, 0}; pg8::StaticOrder S; S.init(256, 4, G, c);
                pg8::EpiRes<true, true> E{a.out, a.out, oabc, stats, a.in[8] + l * 1024, a.in[9] + l * 1024}; pg8::gemm_phase(lds, g, S, E, tid);
            } else { if (l == 0) phase_ln<false>(a.out, xb, stats, a.in[14], a.in[15], tid); else phase_ln<true>(a.out, xb, stats, a.in[14] + 1024, a.in[15] + 1024, tid); }
        }
        if (phx + 1 < 2 * ph_hi) { if (ph == 0) grid.sync(); else xcd_barrier(xbar, tid); }
    }
}

#ifndef N_LAUNCH_MODE
#define N_LAUNCH_MODE 1
#endif
extern "C" void kernel_launch(void* const* d_in, const int* in_sizes, int n_in, void* d_out, int out_size, void* d_ws, size_t ws_size, hipStream_t stream) {
    static int grid = 0;
    if (grid == 0) {
        if (n_in != 17 || out_size != MTOK * DM || ws_size < WS_END) { fprintf(stderr, "kernel_launch: unexpected shapes (n_in %d out %d ws %zu need %zu)\n", n_in, out_size, ws_size, (size_t)WS_END); grid = -1; return; }
        int dev = 0, cus = 0, per_cu = 0;
        hipGetDevice(&dev);
        hipDeviceGetAttribute(&cus, hipDeviceAttributeMultiprocessorCount, dev);
        if (hipFuncSetAttribute((const void*)mega_fwd, hipFuncAttributeMaxDynamicSharedMemorySize, LDS_BYTES) != hipSuccess) { fprintf(stderr, "kernel_launch: hipFuncSetAttribute failed\n"); grid = -1; return; }
        hipOccupancyMaxActiveBlocksPerMultiprocessor(&per_cu, (const void*)mega_fwd, 512, LDS_BYTES);
        if (per_cu < 1) { fprintf(stderr, "kernel_launch: occupancy query says %d\n", per_cu); per_cu = 1; }
        (void)hipGetLastError();
        grid = cus * per_cu;
    }
    if (grid < 0) return;
    if (hipMemsetAsync((char*)d_ws + WS_BAR, 0, (size_t)3456 * 4, stream) != hipSuccess) { fprintf(stderr, "kernel_launch: memset of the barrier words failed\n"); return; }
    Args a{};
    for (int i = 0; i < 17; ++i) a.in[i] = (const float*)d_in[i];
    a.out = (float*)d_out; a.ws = (unsigned char*)d_ws;
#if N_LAUNCH_MODE == 0
    for (int ph = 0; ph < 19; ++ph) {
        a.ph_lo = ph; a.ph_hi = ph + 1;
        hipLaunchKernelGGL(mega_fwd, dim3(grid), dim3(512), LDS_BYTES, stream, a);
    }
#else
    a.ph_lo = 0; a.ph_hi = 19;
    void* args[] = {&a};
    hipError_t e = hipLaunchCooperativeKernel((const void*)mega_fwd, dim3(grid), dim3(512), args, LDS_BYTES, stream);
    if (e != hipSuccess) fprintf(stderr, "cooperative launch failed: %s (grid %d)\n", hipGetErrorString(e), grid);
#endif
}
```

```cpp
#include <hip/hip_runtime.h>
#include <hip/hip_cooperative_groups.h>
#include <cstdio>
namespace cg = cooperative_groups;

#define LAS __attribute__((address_space(3)))
#define DI __device__ __forceinline__
typedef unsigned short bf16_t;
typedef short bf16x8 __attribute__((ext_vector_type(8)));
typedef float f32x2 __attribute__((ext_vector_type(2)));
typedef float f32x4 __attribute__((ext_vector_type(4)));
typedef float f32x16 __attribute__((ext_vector_type(16)));
typedef unsigned u32x2 __attribute__((ext_vector_type(2)));
typedef unsigned u32x4 __attribute__((ext_vector_type(4)));
typedef __bf16 bf2_t __attribute__((ext_vector_type(2)));

constexpr int MTOK = 65536, SEQ = 2048, DM = 1024, NB = 32, DFF = 4096, PLE = 256;
constexpr int RM_LD = 2816;
constexpr int C_AQ = 0, C_AK = 384, C_IQ = 448, C_IK = 960, C_BQ = 1024, C_BK = 1792, C_CQ = 2048, C_CK = 2432;
constexpr int T_ROWS = 768;
constexpr int R_AV = 0, R_BV = 64, R_CV = 320, R_IW = 704;
constexpr int NWIN = 3584;
constexpr float ALPHA = 1.41421356237309515f;
constexpr float LOG2E = 1.44269504088896341f;
constexpr float SC2 = 0.125f * LOG2E;
constexpr float NEGF = -1e30f;
constexpr int LDS_BYTES = 131072 + 16;

constexpr size_t WO_IN = 0;
constexpr size_t WO_G = WO_IN + (size_t)NWIN * 1024;
constexpr size_t WO_BA = WO_G + (size_t)3072 * 1024;
constexpr size_t WO_BB = WO_BA + (size_t)1024 * 384;
constexpr size_t WO_BC = WO_BB + (size_t)1024 * 256;
constexpr size_t WO_OUT = WO_BC + (size_t)1024 * 384;
constexpr size_t WO_UP = WO_OUT + (size_t)1024 * 1024;
constexpr size_t WO_DN = WO_UP + (size_t)4096 * 1024;
constexpr size_t WO_PG = WO_DN + (size_t)1024 * 4096;
constexpr size_t WO_PL = WO_PG + (size_t)1024 * 1024;
constexpr size_t W_LAYER = WO_PL + (size_t)1024 * 256;

constexpr size_t WS_WB = 0;
constexpr size_t WS_LUT = WS_WB + 2 * W_LAYER * 2;
constexpr size_t WS_KMEAN = WS_LUT + (size_t)24 * 2048 * 4;
constexpr size_t WS_MASK = WS_KMEAN + (size_t)32 * 6 * 8 * 64 * 4;
constexpr size_t WS_XB = WS_MASK + (size_t)MTOK * 64 * 4;
constexpr size_t WS_PB = WS_XB + (size_t)MTOK * 1024 * 2;
constexpr size_t WS_OABC = WS_PB + (size_t)2 * MTOK * 256 * 2;
constexpr size_t WS_R1 = WS_OABC + (size_t)MTOK * 1024 * 2;
constexpr size_t WS_BAR = WS_R1 + (size_t)MTOK * 4096 * 2;
constexpr size_t WS_STATS = WS_BAR + (size_t)4096 * 4;
constexpr size_t WS_G2 = WS_STATS + (size_t)MTOK * 2 * 4;
constexpr size_t WS_END = WS_G2 + (size_t)MTOK * 4 * 68 * 4;
constexpr size_t WS_VT16 = WS_R1 + ((size_t)MTOK * RM_LD + (size_t)T_ROWS * MTOK) * 2;

struct Args {
    const float* in[17];
    float* out;
    unsigned char* ws;
    int ph_lo, ph_hi;
};

DI unsigned short f2bf(float f) { unsigned u = __float_as_uint(f); u += 0x7FFFu + ((u >> 16) & 1u); return (unsigned short)(u >> 16); }
DI unsigned pk2(float lo, float hi) { f32x2 v = {lo, hi}; bf2_t b = __builtin_convertvector(v, bf2_t); return __builtin_bit_cast(unsigned, b); }
DI float bf_lo(unsigned w) { return __uint_as_float(w << 16); }
DI float bf_hi(unsigned w) { return __uint_as_float(w & 0xFFFF0000u); }
DI float bf2f(bf16_t b) { return __uint_as_float(((unsigned)b) << 16); }
DI float sigmoidf_(float x) { return __builtin_amdgcn_rcpf(1.0f + __expf(-x)); }
#define MFMA32(a, b, c) __builtin_amdgcn_mfma_f32_32x32x16_bf16((a), (b), (c), 0, 0, 0)

namespace pg8 {
constexpr int BM = 256, BK = 64, HALF = 128, HTB = HALF * BK * 2, NXCD = 8, WGM = 8;
DI int lds_byte(int r, int c) { const int st = (r >> 4) * 2 + (c >> 5), rr = r & 15, cc = c & 31, ob = rr * 64 + cc * 2; return st * 1024 + (ob ^ (((ob >> 9) & 1) << 5)); }
DI void stage_rc(int b, int& R, int& C) { const int st = b / 1024, sb = b % 1024, swz = sb ^ (((sb >> 9) & 1) << 5); R = (st >> 1) * 16 + swz / 64; C = (st & 1) * 32 + (swz % 64) / 2; }
DI int perm32(int rho) { const int n = rho >> 4, i = rho & 15; return 8 * (i >> 2) + 4 * n + (i & 3); }

struct Unit { int pm, pn; long bofs; };
struct Gemm { const bf16_t* A; const bf16_t* Bt; int lda, ldb, K; long hsB; };

struct StaticOrder {
    int nM, nN, nwg, G, c;
    DI void init(int nM_, int nN_, int G_, int c_) { nM = nM_; nN = nN_; nwg = nM * nN; G = G_; c = c_; }
    DI bool next(int i, Unit& u) const {
        const long L = (long)i * G + c; if (L >= nwg) return false;
        int wgid = (int)L; { const int q = nwg / NXCD, r = nwg % NXCD, xcd = wgid % NXCD, off = wgid / NXCD; wgid = (xcd < r ? xcd * (q + 1) : r * (q + 1) + (xcd - r) * q) + off; }
        const int nig = WGM * nN, gid = wgid / nig, fm = gid * WGM, gsz = (nM - fm) < WGM ? (nM - fm) : WGM;
        u.pm = fm + ((wgid % nig) % gsz); u.pn = (wgid % nig) / gsz; u.bofs = -1; return true;
    }
};
struct OrderVT16 {
    int G, c;
    DI bool next(int i, Unit& u) const { const int L = i * G + c; if (L >= 256) return false; u.pm = 0; u.pn = L; u.bofs = ((long)((L >> 3) * 2048 + 2 * (L & 7)) * 1024) * 2; return true; }
};
struct Order3 {
    StaticOrder base;
    DI bool next(int i, Unit& u) const { Unit v; if (!base.next(i / 3, v)) return false; u.pm = v.pm; u.pn = (i % 3) * 4 + v.pn; u.bofs = -1; return true; }
};

template <int ACT  > struct EpiBf16 {
    static constexpr bool PERM = true;
    bf16_t* O; int ldc;
    DI void operator()(const f32x4 (&acc)[2][2][4][2], const Unit& u, int wr, int wc, int fr, int fq) const {
        const int row0 = u.pm * BM + wr * 64 + fr, col0 = u.pn * BM + wc * 32 + 8 * fq;
#pragma unroll
        for (int ai = 0; ai < 2; ++ai)
#pragma unroll
            for (int m = 0; m < 4; ++m) { bf16_t* rowp = O + (size_t)(row0 + ai * HALF + m * 16) * ldc + col0;
#pragma unroll
                for (int bj = 0; bj < 2; ++bj) { f32x4 v0 = acc[ai][bj][m][0], v1 = acc[ai][bj][m][1];
                    if (ACT == 1) {
#pragma unroll
                        for (int j = 0; j < 4; ++j) { float a = fmaxf(v0[j], 0.f), b = fmaxf(v1[j], 0.f); v0[j] = a * a; v1[j] = b * b; } }
                    u32x4 w; w.x = pk2(v0[0], v0[1]); w.y = pk2(v0[2], v0[3]); w.z = pk2(v1[0], v1[1]); w.w = pk2(v1[2], v1[3]);
                    *(u32x4*)(rowp + bj * HALF) = w; } }
    }
};
struct EpiGate {
    static constexpr bool PERM = true;
    const bf16_t* obr; bf16_t* mg;
    DI void operator()(const f32x4 (&acc)[2][2][4][2], const Unit& u, int wr, int wc, int fr, int fq) const {
        const int b = u.pn >> 2, colt = (u.pn & 3) * BM;
        const int row0 = u.pm * BM + wr * 64 + fr, col0 = colt + wc * 32 + 8 * fq;
        const bf16_t* ob0 = obr + (size_t)row0 * 3072 + b * 1024 + col0;
        bf16_t* mp0 = mg + (size_t)row0 * 1024 + col0;
        u32x4 ob[2][4], pm[2][4];
#define GATE_LOAD(k, s) do { _Pragma("unroll") for (int q = 0; q < 4; ++q) { const int ai = (k) >> 1, m = 2 * ((k) & 1) + (q >> 1), bj = q & 1; const size_t ro = (size_t)(ai * HALF + m * 16); \
            ob[s][q] = *(const u32x4*)(ob0 + ro * 3072 + bj * HALF); if (b > 0) pm[s][q] = *(const u32x4*)(mp0 + ro * 1024 + bj * HALF); } } while (0)
        GATE_LOAD(0, 0);
#pragma unroll
        for (int k = 0; k < 4; ++k) {
            if (k + 1 < 4) GATE_LOAD(k + 1, (k + 1) & 1);
#pragma unroll
            for (int q = 0; q < 4; ++q) {
                const int ai = k >> 1, m = 2 * (k & 1) + (q >> 1), bj = q & 1;
                const f32x4 v0 = acc[ai][bj][m][0], v1 = acc[ai][bj][m][1];
                const u32x4 o = ob[k & 1][q];
                float r[8];
                r[0] = sigmoidf_(v0[0]) * bf_lo(o.x); r[1] = sigmoidf_(v0[1]) * bf_hi(o.x); r[2] = sigmoidf_(v0[2]) * bf_lo(o.y); r[3] = sigmoidf_(v0[3]) * bf_hi(o.y);
                r[4] = sigmoidf_(v1[0]) * bf_lo(o.z); r[5] = sigmoidf_(v1[1]) * bf_hi(o.z); r[6] = sigmoidf_(v1[2]) * bf_lo(o.w); r[7] = sigmoidf_(v1[3]) * bf_hi(o.w);
                if (b > 0) { const u32x4 pv = pm[k & 1][q];
                    r[0] += bf_lo(pv.x); r[1] += bf_hi(pv.x); r[2] += bf_lo(pv.y); r[3] += bf_hi(pv.y); r[4] += bf_lo(pv.z); r[5] += bf_hi(pv.z); r[6] += bf_lo(pv.w); r[7] += bf_hi(pv.w); }
                u32x4 w; w.x = pk2(r[0], r[1]); w.y = pk2(r[2], r[3]); w.z = pk2(r[4], r[5]); w.w = pk2(r[6], r[7]);
                *(u32x4*)(mp0 + (size_t)(ai * HALF + m * 16) * 1024 + bj * HALF) = w;
            }
        }
#undef GATE_LOAD
    }
};
struct EpiT1 {
    static constexpr bool PERM = true;
    bf16_t* T;
    DI void operator()(const f32x4 (&acc)[2][2][4][2], const Unit& u, int wr, int wc, int fr, int fq) const {
        const int row0 = u.pm * BM + wr * 64 + fr, col0 = u.pn * BM + wc * 32 + 8 * fq;
        bf16_t* tp0 = T + (size_t)row0 * 1024 + col0;
        u32x4 ob[2][8];
#pragma unroll
        for (int ai = 0; ai < 2; ++ai)
#pragma unroll
            for (int q = 0; q < 8; ++q) ob[ai][q] = *(const u32x4*)(tp0 + (size_t)(ai * HALF + (q >> 1) * 16) * 1024 + (q & 1) * HALF);
#pragma unroll
        for (int ai = 0; ai < 2; ++ai)
#pragma unroll
            for (int q = 0; q < 8; ++q) {
                const int m = q >> 1, bj = q & 1;
                const f32x4 v0 = acc[ai][bj][m][0], v1 = acc[ai][bj][m][1];
                const u32x4 o = ob[ai][q];
                float r[8];
                r[0] = sigmoidf_(v0[0]) * bf_lo(o.x); r[1] = sigmoidf_(v0[1]) * bf_hi(o.x); r[2] = sigmoidf_(v0[2]) * bf_lo(o.y); r[3] = sigmoidf_(v0[3]) * bf_hi(o.y);
                r[4] = sigmoidf_(v1[0]) * bf_lo(o.z); r[5] = sigmoidf_(v1[1]) * bf_hi(o.z); r[6] = sigmoidf_(v1[2]) * bf_lo(o.w); r[7] = sigmoidf_(v1[3]) * bf_hi(o.w);
                u32x4 w; w.x = pk2(r[0], r[1]); w.y = pk2(r[2], r[3]); w.z = pk2(r[4], r[5]); w.w = pk2(r[6], r[7]);
                *(u32x4*)(tp0 + (size_t)(ai * HALF + m * 16) * 1024 + bj * HALF) = w;
            }
    }
};
template <bool HAS_T, bool LNX> struct EpiRes {
    static constexpr bool PERM = false;
    const float* xin; float* y; const bf16_t* T; const float* stats; const float* lg; const float* lb;
    DI void operator()(const f32x4 (&acc)[2][2][4][2], const Unit& u, int wr, int wc, int fr, int fq) const {
        const int row0 = u.pm * BM + wr * 64 + fr, col0 = u.pn * BM + wc * 32 + 4 * fq;
        const size_t o0 = (size_t)row0 * 1024 + col0;
        f32x4 xv[2][4]; u32x2 tv[2][4]; f32x2 sm[2][4];
#define RES_LOAD(k, s) do { _Pragma("unroll") for (int m = 0; m < 4; ++m) { const int row = row0 + ((k) >> 2) * HALF + m * 16; const size_t o = (size_t)row * 1024 + col0 + (((k) >> 1) & 1) * HALF + ((k) & 1) * 16; \
            xv[s][m] = *(const f32x4*)(xin + o); if (HAS_T) tv[s][m] = *(const u32x2*)(T + o); if (LNX) sm[s][m] = *(const f32x2*)(stats + 2 * (size_t)row); } } while (0)
#pragma unroll
        for (int k = 0; k < 8; ++k) {
            RES_LOAD(k, k & 1);
            const int ai = k >> 2, bj = (k >> 1) & 1, n = k & 1;
            f32x4 gv = {1.f, 1.f, 1.f, 1.f}, bv = {0.f, 0.f, 0.f, 0.f};
            if (LNX) { gv = *(const f32x4*)(lg + col0 + bj * HALF + n * 16); bv = *(const f32x4*)(lb + col0 + bj * HALF + n * 16); }
#pragma unroll
            for (int m = 0; m < 4; ++m) {
                const size_t o = o0 + (size_t)(ai * HALF + m * 16) * 1024 + bj * HALF + n * 16;
                f32x4 x = xv[k & 1][m];
                if (LNX) x = (x - sm[k & 1][m][0]) * sm[k & 1][m][1] * gv + bv;
                f32x4 r = acc[ai][bj][m][n] + x * ALPHA;
                if (HAS_T) { const u32x2 t = tv[k & 1][m]; r[0] += bf_lo(t.x); r[1] += bf_hi(t.x); r[2] += bf_lo(t.y); r[3] += bf_hi(t.y); }
                *(f32x4*)(y + o) = r;
            }
        }
#undef RES_LOAD
    }
};

template <class Epi, class Sched>
DI void gemm_phase(LAS unsigned char* lds, const Gemm g, const Sched& S, const Epi& E, const int tid) {
    const int wid = __builtin_amdgcn_readfirstlane(tid >> 6), lane = tid & 63, wr = wid >> 2, wc = wid & 3, fr = lane & 15, fq = lane >> 4;
    const int K = g.K, nt = K / BK;
    unsigned voffA_, voffB_;
    { int R, C; stage_rc(tid * 16, R, C); const int Rb = Epi::PERM ? ((R & ~31) + perm32(R & 31)) : R;
      voffA_ = (unsigned)(R * g.lda + C) * 2u; voffB_ = (unsigned)(Rb * g.ldb + C) * 2u; }
    const size_t p64offA = (size_t)64 * g.lda * 2, p64offB = (size_t)64 * g.ldb * 2;
    const size_t kstep = (size_t)(BK * 2);
    const size_t hstepA = (size_t)HALF * g.lda * 2, hstepB = g.hsB > 0 ? (size_t)g.hsB : (size_t)HALF * g.ldb * 2;
    const size_t tstepA = 2 * hstepA, tstepB = 2 * hstepB;
    const unsigned ldsw = (unsigned)wid * 1024u;
    const int aoff = lds_byte(wr * 64 + fr, fq * 8), boff = lds_byte(wc * 32 + fr, fq * 8);
#define PG8_SA(b, h) (((b) * 2 + (h)) * HTB)
#define PG8_SB(b, h) ((4 + (b) * 2 + (h)) * HTB)
#define PG8_STAGE(bufoff, gbase, voff) do { _Pragma("unroll") for (int _i = 0; _i < 2; ++_i) \
        __builtin_amdgcn_global_load_lds((const unsigned*)((const char*)(gbase) + (size_t)_i * p64##voff + (v##voff##_)), (LAS unsigned*)(lds + (bufoff) + ldsw + _i * 8192), 16, 0, 0); } while (0)
#define PG8_LDA(dst, b, h) do { _Pragma("unroll") for (int m = 0; m < 4; ++m) _Pragma("unroll") for (int k = 0; k < 2; ++k) dst[m][k] = *(const LAS bf16x8*)(lds + PG8_SA(b, h) + aoff + m * 2048 + k * 1024); } while (0)
#define PG8_LDB(dst, b, h) do { _Pragma("unroll") for (int n = 0; n < 2; ++n) _Pragma("unroll") for (int k = 0; k < 2; ++k) dst[n][k] = *(const LAS bf16x8*)(lds + PG8_SB(b, h) + boff + n * 2048 + k * 1024); } while (0)
#define PG8_MMA(ai, bj, At, Bt) do { __builtin_amdgcn_s_setprio(1); _Pragma("unroll") for (int m = 0; m < 4; ++m) _Pragma("unroll") for (int n = 0; n < 2; ++n) _Pragma("unroll") for (int k = 0; k < 2; ++k) \
        acc[ai][bj][m][n] = __builtin_amdgcn_mfma_f32_16x16x32_bf16(Bt[n][k], At[m][k], acc[ai][bj][m][n], 0, 0, 0); __builtin_amdgcn_s_setprio(0); } while (0)
#define PG8_WAIT_V(n) asm volatile("s_waitcnt vmcnt(" #n ")" ::: "memory")
#define PG8_WAIT_L(n) asm volatile("s_waitcnt lgkmcnt(" #n ")" ::: "memory")
#define PG8_BAR __builtin_amdgcn_s_barrier()
#define PG8_SCHED __builtin_amdgcn_sched_barrier(0)
    Unit cur, nxt; int ui = 0;
    if (!S.next(0, cur)) return;
    f32x4 acc[2][2][4][2];
#pragma unroll
    for (int a = 0; a < 2; ++a)
#pragma unroll
        for (int b = 0; b < 2; ++b)
#pragma unroll
            for (int m = 0; m < 4; ++m)
#pragma unroll
                for (int n = 0; n < 2; ++n) acc[a][b][m][n] = (f32x4){0.f, 0.f, 0.f, 0.f};
    bf16x8 At[4][2], B0[2][2], B1[2][2];
    const char* cA = (const char*)g.A + (size_t)cur.pm * tstepA; const char* cB = (const char*)g.Bt + (cur.bofs >= 0 ? (size_t)cur.bofs : (size_t)cur.pn * tstepB);
    PG8_STAGE(PG8_SB(0, 0), cB, offB); PG8_STAGE(PG8_SA(0, 0), cA, offA); PG8_STAGE(PG8_SB(0, 1), cB + hstepB, offB); PG8_STAGE(PG8_SA(0, 1), cA + hstepA, offA);
    if (wr == 1) PG8_BAR;
    PG8_WAIT_V(4); PG8_BAR;
    PG8_STAGE(PG8_SB(1, 0), cB + kstep, offB); PG8_STAGE(PG8_SA(1, 0), cA + kstep, offA); PG8_STAGE(PG8_SB(1, 1), cB + hstepB + kstep, offB);
    PG8_WAIT_V(6); PG8_BAR;
    for (;;) {
        const bool has_next = S.next(ui + 1, nxt);
        const char* nA = has_next ? (const char*)g.A + (size_t)nxt.pm * tstepA : cA; const char* nB = has_next ? (const char*)g.Bt + (nxt.bofs >= 0 ? (size_t)nxt.bofs : (size_t)nxt.pn * tstepB) : cB;
        for (int t = 0; t < nt; t += 2) {
            const bool last = (t == nt - 2);
            const char* a1 = cA + (size_t)(t + 1) * kstep;
            const char* a2 = last ? nA : cA + (size_t)(t + 2) * kstep; const char* b2 = last ? nB : cB + (size_t)(t + 2) * kstep;
            const char* a3 = a2 + kstep; const char* b3 = b2 + kstep;
            PG8_LDB(B0, 0, 0); PG8_SCHED; PG8_LDA(At, 0, 0); PG8_STAGE(PG8_SA(1, 1), a1 + hstepA, offA);
            PG8_WAIT_L(8); PG8_BAR; PG8_WAIT_L(0); PG8_MMA(0, 0, At, B0); PG8_BAR; PG8_SCHED;
            PG8_LDB(B1, 0, 1); PG8_STAGE(PG8_SB(0, 0), b2, offB);
            PG8_BAR; PG8_WAIT_L(0); PG8_MMA(0, 1, At, B1); PG8_BAR;
            PG8_LDA(At, 0, 1); PG8_STAGE(PG8_SA(0, 0), a2, offA);
            PG8_BAR; PG8_WAIT_L(0); PG8_MMA(1, 0, At, B0); PG8_BAR; PG8_SCHED;
            PG8_STAGE(PG8_SB(0, 1), b2 + hstepB, offB);
            PG8_WAIT_V(6); PG8_BAR; PG8_MMA(1, 1, At, B1); PG8_BAR;
            PG8_LDB(B0, 1, 0); PG8_SCHED; PG8_LDA(At, 1, 0); PG8_STAGE(PG8_SA(0, 1), a2 + hstepA, offA);
            PG8_WAIT_L(8); PG8_BAR; PG8_WAIT_L(0); PG8_MMA(0, 0, At, B0); PG8_BAR; PG8_SCHED;
            PG8_LDB(B1, 1, 1); PG8_STAGE(PG8_SB(1, 0), b3, offB);
            PG8_BAR; PG8_WAIT_L(0); PG8_MMA(0, 1, At, B1); PG8_BAR;
            PG8_LDA(At, 1, 1); PG8_STAGE(PG8_SA(1, 0), a3, offA);
            PG8_BAR; PG8_WAIT_L(0); PG8_MMA(1, 0, At, B0); PG8_BAR; PG8_SCHED;
            PG8_STAGE(PG8_SB(1, 1), b3 + hstepB, offB);
            PG8_WAIT_V(6); PG8_BAR; PG8_MMA(1, 1, At, B1); PG8_BAR;
        }
        E(acc, cur, wr, wc, fr, fq);
        if (!has_next) break;
#pragma unroll
        for (int a = 0; a < 2; ++a)
#pragma unroll
            for (int b = 0; b < 2; ++b)
#pragma unroll
                for (int m = 0; m < 4; ++m)
#pragma unroll
                    for (int n = 0; n < 2; ++n) acc[a][b][m][n] = (f32x4){0.f, 0.f, 0.f, 0.f};
        cur = nxt; cA = nA; cB = nB; ++ui;
    }
    PG8_WAIT_V(0);
    if (wr == 0) PG8_BAR;
    PG8_BAR;
#undef PG8_SA
#undef PG8_SB
#undef PG8_STAGE
#undef PG8_LDA
#undef PG8_LDB
#undef PG8_MMA
#undef PG8_WAIT_V
#undef PG8_WAIT_L
#undef PG8_BAR
#undef PG8_SCHED
}
}

DI int win_srccol(int n) {
    if (n < 384) return n;
    if (n < 448) return 384 + (n - 384);
    if (n < 960) return 512 + (n - 448);
    if (n < 1024) return 1024 + (n - 960);
    if (n < 1792) return 1096 + (n - 1024);
    if (n < 2048) return 1864 + (n - 1792);
    if (n < 2432) return 2376 + (n - 2048);
    if (n < 2816) return 2760 + (n - 2432);
    if (n < 2880) return 448 + (n - 2816);
    if (n < 3136) return 2120 + (n - 2880);
    if (n < 3520) return 3144 + (n - 3136);
    if (n < 3528) return 1088 + (n - 3520);
    return -1;
}
DI void convT(unsigned char* shm, const float* src, int K, int Nsrc, bf16_t* dst, int Ndst, int mode, const int tid) {
    unsigned short* tl = (unsigned short*)shm;
    const int ntk = K / 64, ntiles = (Ndst / 64) * ntk;
    for (int tile = blockIdx.x; tile < ntiles; tile += gridDim.x) {
        const int n0 = (tile / ntk) * 64, k0 = (tile % ntk) * 64;
        const int nx = tid & 63, ky = tid >> 6;
        const int sc = mode ? win_srccol(n0 + nx) : (n0 + nx);
#pragma unroll
        for (int p = 0; p < 8; ++p) { const int k = k0 + ky + 8 * p; const float v = sc >= 0 ? src[(size_t)k * Nsrc + sc] : 0.f; tl[nx * 66 + ky + 8 * p] = f2bf(v); }
        __syncthreads();
#pragma unroll
        for (int p = 0; p < 8; ++p) { const int n = ky + 8 * p; dst[(size_t)(n0 + n) * K + k0 + nx] = tl[n * 66 + nx]; }
        __syncthreads();
    }
}
DI void conv_vec(const float* src, bf16_t* dst, size_t n8, const int tid) {
    for (size_t i = (size_t)blockIdx.x * 512 + tid; i < n8; i += (size_t)gridDim.x * 512) {
        const f32x4 a = *(const f32x4*)(src + i * 8), b = *(const f32x4*)(src + i * 8 + 4);
        u32x4 w; w.x = pk2(a[0], a[1]); w.y = pk2(a[2], a[3]); w.z = pk2(b[0], b[1]); w.w = pk2(b[2], b[3]);
        *(u32x4*)(dst + i * 8) = w;
    }
}
DI int rel_bucket(int n) {
    if (n < 16) return n;
    int large = 16 + (int)(logf((float)n / 16.0f) / 4.852030263919617f * 16.0f);
    return large < 31 ? large : 31;
}
DI void phase_convert(const Args& a, unsigned char* shm, const int tid) {
    bf16_t* wb = (bf16_t*)(a.ws + WS_WB);
    for (int l = 0; l < 2; ++l) {
        bf16_t* w = wb + (size_t)l * W_LAYER;
        convT(shm, a.in[2] + (size_t)l * 1024 * 3528, 1024, 3528, w + WO_IN, NWIN, 1, tid);
        convT(shm, a.in[3] + (size_t)l * 1024 * 3072, 1024, 3072, w + WO_G, 3072, 0, tid);
        convT(shm, a.in[4] + (size_t)l * 384 * 1024, 384, 1024, w + WO_BA, 1024, 0, tid);
        convT(shm, a.in[5] + (size_t)l * 256 * 1024, 256, 1024, w + WO_BB, 1024, 0, tid);
        convT(shm, a.in[6] + (size_t)l * 384 * 1024, 384, 1024, w + WO_BC, 1024, 0, tid);
        convT(shm, a.in[7] + (size_t)l * 1024 * 1024, 1024, 1024, w + WO_OUT, 1024, 0, tid);
        convT(shm, a.in[10] + (size_t)l * 1024 * 4096, 1024, 4096, w + WO_UP, 4096, 0, tid);
        convT(shm, a.in[11] + (size_t)l * 4096 * 1024, 4096, 1024, w + WO_DN, 1024, 0, tid);
        convT(shm, a.in[12] + (size_t)l * 1024 * 1024, 1024, 1024, w + WO_PG, 1024, 0, tid);
        convT(shm, a.in[13] + (size_t)l * 256 * 1024, 256, 1024, w + WO_PL, 1024, 0, tid);
    }
    conv_vec(a.in[0], (bf16_t*)(a.ws + WS_XB), (size_t)MTOK * 1024 / 8, tid);
    conv_vec(a.in[1], (bf16_t*)(a.ws + WS_PB), (size_t)2 * MTOK * 256 / 8, tid);
    float* lut = (float*)(a.ws + WS_LUT);
    const float* rb = a.in[16];
    for (int i = blockIdx.x * 512 + tid; i < 24 * 2048; i += gridDim.x * 512) {
        const int hd = i >> 11, d = i & 2047;
        lut[i] = rb[rel_bucket(d) * 24 + hd] * LOG2E;
    }
}

DI float wave_sum(float v) {
#pragma unroll
    for (int o = 32; o >= 1; o >>= 1) v += __shfl_xor(v, o);
    return v;
}
template <bool FINAL>
DI void phase_ln(float* y, bf16_t* xb, float* stats, const float* g, const float* b, const int tid) {
    const int wid = tid >> 6, lane = tid & 63;
    f32x4 gv[4], bv[4];
#pragma unroll
    for (int k = 0; k < 4; ++k) { gv[k] = *(const f32x4*)(g + k * 256 + lane * 4); bv[k] = *(const f32x4*)(b + k * 256 + lane * 4); }
    for (int row = blockIdx.x * 8 + wid; row < MTOK; row += gridDim.x * 8) {
        float* yp = y + (size_t)row * 1024;
        f32x4 v[4]; float s = 0.f;
#pragma unroll
        for (int k = 0; k < 4; ++k) { v[k] = *(const f32x4*)(yp + k * 256 + lane * 4); s += v[k][0] + v[k][1] + v[k][2] + v[k][3]; }
        const float mean = wave_sum(s) * (1.0f / 1024.0f);
        float q = 0.f;
#pragma unroll
        for (int k = 0; k < 4; ++k) { v[k] = v[k] - mean; q += v[k][0] * v[k][0] + v[k][1] * v[k][1] + v[k][2] * v[k][2] + v[k][3] * v[k][3]; }
        const float var = wave_sum(q) * (1.0f / 1024.0f);
        const float rs = 1.0f / sqrtf(var + 1e-5f);
        if (!FINAL && lane == 0) { f32x2 sm = {mean, rs}; *(f32x2*)(stats + 2 * (size_t)row) = sm; }
#pragma unroll
        for (int k = 0; k < 4; ++k) { const f32x4 o = v[k] * rs * gv[k] + bv[k];
            if (FINAL) *(f32x4*)(yp + k * 256 + lane * 4) = o;
            else { u32x2 w; w.x = pk2(o[0], o[1]); w.y = pk2(o[2], o[3]); *(u32x2*)(xb + (size_t)row * 1024 + k * 256 + lane * 4) = w; } }
    }
}

DI int pi_row(int r) { return (r & 3) | (((r >> 3) & 1) << 2) | (((r >> 2) & 1) << 3) | (r & 16); }
DI void task_rot(int tau, int& b, int& qt) { b = tau >> 6; qt = ((tau & 63) + 8 * (tau >> 8)) & 63; }
DI bool task_map(int k, int& b, int& qt) {
    if (gridDim.x == 256) { if (k >= 8) return false; const int xcd = blockIdx.x & 7, slot = blockIdx.x >> 3; b = xcd + 8 * (k >> 1); qt = (k & 1) ? 63 - slot : slot; return true; }
    const int tau = blockIdx.x + k * gridDim.x; if (tau >= 2048) return false; task_rot(tau, b, qt); return true;
}

DI void a1_task(unsigned char* shm, const bf16_t* prm, const bf16_t* prt, unsigned* mask, int b, int qt, const int tid) {
    const int wid = __builtin_amdgcn_readfirstlane(tid >> 6), lane = tid & 63, r = lane & 31, h = lane >> 5;
    const int t0 = qt * 32, tok0 = b * SEQ;
    unsigned* cnt = (unsigned*)(shm + 33280);
    { u32x4 t[4];
#pragma unroll
      for (int p = 0; p < 4; ++p) { const int c = tid + p * 512, row = c >> 6, ch = c & 63; t[p] = *(const u32x4*)(prm + (size_t)(tok0 + t0 + row) * RM_LD + C_IQ + ch * 8); }
#pragma unroll
      for (int p = 0; p < 4; ++p) { const int c = tid + p * 512, row = c >> 6, ch = c & 63; *(u32x4*)(shm + row * 1040 + ch * 16) = t[p]; } }
    cnt[tid] = 0u; cnt[tid + 512] = 0u;
    float* wqs = (float*)(shm + 33280 + 4096);
    if (tid < 256) wqs[tid] = bf2f(prt[(size_t)(R_IW + (tid >> 5)) * MTOK + tok0 + t0 + (tid & 31)]);
    __syncthreads();
    unsigned key[8][16];
    const bf16_t* kp = prm + (size_t)(tok0 + pi_row(r)) * RM_LD + C_IK + 8 * h;
    bf16x8 kf[4];
    if (wid <= qt) {
#pragma unroll
        for (int ks = 0; ks < 4; ++ks) kf[ks] = *(const bf16x8*)(kp + (size_t)(wid * 32) * RM_LD + 16 * ks);
    }
#pragma unroll
    for (int jt = 0; jt < 8; ++jt) {
        const int kt = wid + 8 * jt;
        if (kt <= qt) {
            const int s0 = kt * 32;
            bf16x8 kn[4];
            const bool hn = (jt < 7) && (kt + 8 <= qt);
            if (hn) {
#pragma unroll
                for (int ks = 0; ks < 4; ++ks) kn[ks] = *(const bf16x8*)(kp + (size_t)(s0 + 256) * RM_LD + 16 * ks);
            }
            float idx[16];
#pragma unroll
            for (int i = 0; i < 16; ++i) idx[i] = 0.f;
#pragma unroll 2
            for (int hh = 0; hh < 8; ++hh) {
                f32x16 acc;
#pragma unroll
                for (int i = 0; i < 16; ++i) acc[i] = 0.f;
                const unsigned char* qb = shm + r * 1040 + hh * 128 + 16 * h;
#pragma unroll
                for (int ks = 0; ks < 4; ++ks) { const bf16x8 qf = *(const bf16x8*)(qb + 32 * ks); acc = MFMA32(kf[ks], qf, acc); }
                const float wv = wqs[hh * 32 + r];
#pragma unroll
                for (int i = 0; i < 16; ++i) idx[i] = fmaf(wv, fmaxf(acc[i], 0.f), idx[i]);
            }
#pragma unroll
            for (int i = 0; i < 16; ++i) {
                const int s = s0 + 16 * (i >> 3) + 8 * h + (i & 7);
                const unsigned u = __float_as_uint(idx[i] + 0.0f);
                const unsigned k = (u & 0x80000000u) ? ~u : (u | 0x80000000u);
                key[jt][i] = (s <= t0 + r) ? k : 0u;
            }
            if (hn) {
#pragma unroll
                for (int ks = 0; ks < 4; ++ks) kf[ks] = kn[ks];
            }
        } else {
#pragma unroll
            for (int i = 0; i < 16; ++i) key[jt][i] = 0u;
        }
    }
    unsigned T = 0u;
    if (qt >= 8) {
        const int nheld = (qt >= wid) ? ((qt - wid) >> 3) + 1 : 0;
        bool done = false;
        for (int bit = 31; bit >= 0; --bit) {
            const unsigned cand = T | (1u << bit);
            int c = 0;
#pragma unroll
            for (int jt = 0; jt < 8; ++jt) {
                if (jt < nheld) {
#pragma unroll
                    for (int i = 0; i < 16; ++i) c += (key[jt][i] >= cand) ? 1 : 0;
                }
            }
            c += __shfl_xor(c, 32);
            if (h == 0 && c) atomicAdd(&cnt[(31 - bit) * 32 + r], (unsigned)c);
            __syncthreads();
            const unsigned tot = cnt[(31 - bit) * 32 + r];
            if (!done) { if (tot >= 256u) T = cand; if (tot == 256u) done = true; }
            if (__ballot(!done) == 0ull) break;
        }
    }
    if (T < 1u) T = 1u;
#pragma unroll
    for (int jt = 0; jt < 8; ++jt) {
        const int kt = wid + 8 * jt;
        if (kt <= qt) {
            unsigned part = 0u;
#pragma unroll
            for (int i = 0; i < 16; ++i) part |= (key[jt][i] >= T ? 1u : 0u) << (16 * (i >> 3) + 8 * h + (i & 7));
            part |= (unsigned)__shfl_xor((int)part, 32);
            if (h == 0) mask[(size_t)(tok0 + t0 + r) * 64 + kt] = part;
        }
    }
    __syncthreads();
}
DI void g2_job(const Args& a, unsigned char* wsh, LAS unsigned char* wl, int b, int slot, int cls, int it, const int tid);
DI void phase_a1(const Args& a, unsigned char* shm, const int tid) {
    const bf16_t* prm = (const bf16_t*)(a.ws + WS_R1);
    const bf16_t* prt = prm + (size_t)MTOK * RM_LD;
    unsigned* mask = (unsigned*)(a.ws + WS_MASK);
    float* kmean = (float*)(a.ws + WS_KMEAN);
    for (int k = 0;; ++k) { int b, qt; if (!task_map(k, b, qt)) break; a1_task(shm, prm, prt, mask, b, qt, tid); }
    for (int j = 2048 + blockIdx.x; j < 2048 + 192; j += gridDim.x) {
        {
            const int id = (j - 2048) * 8 + (tid >> 6), lane = tid & 63;
            const int b = id / 48, hd = (id >> 3) % 6, n = id & 7;
            const int c8 = lane & 7, rr = lane >> 3;
            const bf16_t* p = prm + (size_t)(b * SEQ + n * 256 + rr) * RM_LD + C_CK + hd * 64 + 8 * c8;
            float acc[8];
#pragma unroll
            for (int e = 0; e < 8; ++e) acc[e] = 0.f;
#pragma unroll 1
            for (int t0 = 0; t0 < 256; t0 += 64) {
                u32x4 v[8];
#pragma unroll
                for (int q = 0; q < 8; ++q) v[q] = *(const u32x4*)(p + (size_t)(t0 + 8 * q) * RM_LD);
#pragma unroll
                for (int q = 0; q < 8; ++q) { acc[0] += bf_lo(v[q].x); acc[1] += bf_hi(v[q].x); acc[2] += bf_lo(v[q].y); acc[3] += bf_hi(v[q].y);
                                              acc[4] += bf_lo(v[q].z); acc[5] += bf_hi(v[q].z); acc[6] += bf_lo(v[q].w); acc[7] += bf_hi(v[q].w); }
            }
#pragma unroll
            for (int e = 0; e < 8; ++e) { acc[e] += __shfl_xor(acc[e], 8); acc[e] += __shfl_xor(acc[e], 16); acc[e] += __shfl_xor(acc[e], 32); }
            if (rr == 0) {
                float* kd = kmean + (size_t)((b * 6 + hd) * 8 + n) * 64 + 8 * c8;
                *(f32x4*)kd = (f32x4){acc[0], acc[1], acc[2], acc[3]} * (1.0f / 256.0f);
                *(f32x4*)(kd + 4) = (f32x4){acc[4], acc[5], acc[6], acc[7]} * (1.0f / 256.0f);
            }
        }
    }
    __syncthreads();
    {
        const int wid = __builtin_amdgcn_readfirstlane(tid >> 6);
        unsigned char* wsh = shm + wid * 16384;
        LAS unsigned char* wl = (LAS unsigned char*)shm + wid * 16384;
        for (int j = blockIdx.x; j < 1024; j += gridDim.x) {
            const int id = j * 8 + wid;
            g2_job(a, wsh, wl, id >> 8, (id >> 6) & 3, (id >> 2) & 15, id & 3, tid);
        }
    }
    __syncthreads();
}


struct AttnSt { float m, l; f32x16 o0, o1; };
struct AttnCtx {
    LAS unsigned char* wl;
    const float* lut;
    const bf16_t* kg;
    const bf16_t* vg;
    unsigned koff[4], voff[4];
    int kfo[4], vfo[2][2];
    int krs;
};
DI void attn_dma(const AttnCtx& c, int kt) {
    const char* kb = (const char*)(c.kg + (size_t)(kt * 32 * c.krs) * RM_LD);
    const char* vb = (const char*)(c.vg + kt * 32);
#pragma unroll
    for (int j = 0; j < 4; ++j) __builtin_amdgcn_global_load_lds((const unsigned*)(kb + c.koff[j]), (LAS unsigned*)(c.wl + j * 1024), 16, 0, 0);
#pragma unroll
    for (int j = 0; j < 4; ++j) __builtin_amdgcn_global_load_lds((const unsigned*)(vb + c.voff[j]), (LAS unsigned*)(c.wl + 4096 + j * 1024), 16, 0, 0);
}
template <int MODE, bool UNI>
DI void attn_compute(const bf16x8 (&qf)[4], const bf16x8 (&kf)[4], const bf16x8 (&vf)[2][2], int kt, int d00, const float* lut, float ubias, AttnSt& st,
                     unsigned W, int win, int dmask, bool lane_sel) {
    const int s0 = kt * 32;
    f32x16 sx;
#pragma unroll
    for (int i = 0; i < 16; ++i) sx[i] = 0.f;
#pragma unroll
    for (int ks = 0; ks < 4; ++ks) sx = MFMA32(kf[ks], qf[ks], sx);
    const int d0 = d00 - s0;
    const LAS float* lb = (const LAS float*)lut + ((MODE == 4) ? 16 * (d0 - 23) : (d0 - 23));
    float sv[16]; float mx = NEGF;
#pragma unroll
    for (int i = 0; i < 16; ++i) {
        const int ci = 16 * (i >> 3) + (i & 7);
        const int dist = d0 - ci;
        bool v;
        if (MODE == 0) v = ((W >> ci) & 1u) != 0u;
        else if (MODE == 1) v = ((unsigned)dist <= (unsigned)win) && ((dist & dmask) == 0);
        else if (MODE == 2) v = lane_sel;
        else v = dist >= 0;
        const float bias = UNI ? ubias : ((MODE == 4) ? lb[16 * (23 - ci)] : lb[23 - ci]);
        float s = fmaf(sx[i], SC2, bias);
        if (MODE == 0) { const unsigned t = (unsigned)__builtin_amdgcn_sbfe((int)W, ci, 1);
            s = __uint_as_float((__float_as_uint(s) & t) | (__float_as_uint(NEGF) & ~t)); }
        else s = v ? s : NEGF;
        sv[i] = s; mx = fmaxf(mx, s);
    }
    mx = fmaxf(mx, __shfl_xor(mx, 32));
    const float mnew = fmaxf(st.m, mx);
    const float msafe = (mnew > -1e29f) ? mnew : 0.f;
    if (__ballot(mnew > st.m) != 0ull) {
        const float alpha = __builtin_amdgcn_exp2f(st.m - msafe);
        st.l *= alpha; st.m = mnew;
#pragma unroll
        for (int i = 0; i < 16; ++i) { st.o0[i] *= alpha; st.o1[i] *= alpha; }
    }
    float ps = 0.f; float p[16];
#pragma unroll
    for (int i = 0; i < 16; ++i) { const float e = __builtin_amdgcn_exp2f(sv[i] - msafe); p[i] = e; ps += e; }
    st.l += ps;
    u32x4 w0, w1;
    w0.x = pk2(p[0], p[1]); w0.y = pk2(p[2], p[3]); w0.z = pk2(p[4], p[5]); w0.w = pk2(p[6], p[7]);
    w1.x = pk2(p[8], p[9]); w1.y = pk2(p[10], p[11]); w1.z = pk2(p[12], p[13]); w1.w = pk2(p[14], p[15]);
    const bf16x8 pf0 = __builtin_bit_cast(bf16x8, w0), pf1 = __builtin_bit_cast(bf16x8, w1);
    st.o0 = MFMA32(vf[0][0], pf0, st.o0); st.o0 = MFMA32(vf[0][1], pf1, st.o0);
    st.o1 = MFMA32(vf[1][0], pf0, st.o1); st.o1 = MFMA32(vf[1][1], pf1, st.o1);
}
DI void attn_compute_sp4(const bf16x8 (&qf)[4], const bf16x8 (&kf)[4], const bf16x8 (&vf)[2][2], int kt, int d00, const float* lut, AttnSt& st, int win, int dmask) {
    const int s0 = kt * 32;
    f32x16 sx;
#pragma unroll
    for (int i = 0; i < 16; ++i) sx[i] = 0.f;
#pragma unroll
    for (int ks = 0; ks < 4; ++ks) sx = MFMA32(kf[ks], qf[ks], sx);
    const int d0 = d00 - s0, e = d0 & 3;
    const bool e0 = (e == 0), e1 = (e == 1), e2 = (e == 2);
    const LAS float* lb = (const LAS float*)lut + (d0 - e - 20);
    float sv[4]; float mx = NEGF;
#pragma unroll
    for (int g = 0; g < 4; ++g) {
        const float x = e0 ? sx[4 * g] : (e1 ? sx[4 * g + 1] : (e2 ? sx[4 * g + 2] : sx[4 * g + 3]));
        const int dist = d0 - (16 * (g >> 1) + 4 * (g & 1)) - e;
        const bool v = ((unsigned)dist <= (unsigned)win) && ((dist & dmask) == 0);
        const float bias = lb[20 - (16 * (g >> 1) + 4 * (g & 1))];
        float sc = fmaf(x, SC2, bias);
        sc = v ? sc : NEGF;
        sv[g] = sc; mx = fmaxf(mx, sc);
    }
    mx = fmaxf(mx, __shfl_xor(mx, 32));
    const float mnew = fmaxf(st.m, mx);
    const float msafe = (mnew > -1e29f) ? mnew : 0.f;
    if (__ballot(mnew > st.m) != 0ull) {
        const float alpha = __builtin_amdgcn_exp2f(st.m - msafe);
        st.l *= alpha; st.m = mnew;
#pragma unroll
        for (int i = 0; i < 16; ++i) { st.o0[i] *= alpha; st.o1[i] *= alpha; }
    }
    float ps = 0.f; float p[16];
#pragma unroll
    for (int g = 0; g < 4; ++g) {
        const float pe = __builtin_amdgcn_exp2f(sv[g] - msafe); ps += pe;
        p[4 * g] = e0 ? pe : 0.f; p[4 * g + 1] = e1 ? pe : 0.f; p[4 * g + 2] = e2 ? pe : 0.f; p[4 * g + 3] = (e == 3) ? pe : 0.f;
    }
    st.l += ps;
    u32x4 w0, w1;
    w0.x = pk2(p[0], p[1]); w0.y = pk2(p[2], p[3]); w0.z = pk2(p[4], p[5]); w0.w = pk2(p[6], p[7]);
    w1.x = pk2(p[8], p[9]); w1.y = pk2(p[10], p[11]); w1.z = pk2(p[12], p[13]); w1.w = pk2(p[14], p[15]);
    const bf16x8 pf0 = __builtin_bit_cast(bf16x8, w0), pf1 = __builtin_bit_cast(bf16x8, w1);
    st.o0 = MFMA32(vf[0][0], pf0, st.o0); st.o0 = MFMA32(vf[0][1], pf1, st.o0);
    st.o1 = MFMA32(vf[1][0], pf0, st.o1); st.o1 = MFMA32(vf[1][1], pf1, st.o1);
}
template <int MODE>
DI void attn_range(const AttnCtx& c, const bf16x8 (&qf)[4], int lo, int hi, int t0, int d00, AttnSt& st, const unsigned* maskrow, int h8, int win, int dmask, bool lane_sel) {
    if (lo > hi) return;
    attn_dma(c, lo);
    unsigned Wn = 0u;
    if (MODE == 0) Wn = maskrow[lo];
#pragma unroll 1
    for (int kt = lo; kt <= hi; ++kt) {
        asm volatile("s_waitcnt vmcnt(0)" ::: "memory");
        bf16x8 kf[4], vf[2][2];
#pragma unroll
        for (int ks = 0; ks < 4; ++ks) kf[ks] = *(const LAS bf16x8*)(c.wl + c.kfo[ks]);
#pragma unroll
        for (int mt = 0; mt < 2; ++mt)
#pragma unroll
            for (int s = 0; s < 2; ++s) vf[mt][s] = *(const LAS bf16x8*)(c.wl + 4096 + c.vfo[mt][s]);
        const unsigned W = Wn >> h8;
        const int dlo = t0 - kt * 32 - 31;
        float ub = 0.f; bool uni = false;
        if (dlo >= 182) { const unsigned ua = __builtin_amdgcn_readfirstlane(__float_as_uint(c.lut[dlo])), ue = __builtin_amdgcn_readfirstlane(__float_as_uint(c.lut[dlo + 62])); uni = (ua == ue); ub = __uint_as_float(ua); }
        asm volatile("s_waitcnt lgkmcnt(0)" ::: "memory");
        if (kt < hi) { attn_dma(c, kt + 1); if (MODE == 0) Wn = maskrow[kt + 1]; }
        if (MODE == 1 && dmask != 0) attn_compute_sp4(qf, kf, vf, kt, d00, c.lut, st, win, dmask);
        else attn_compute<MODE, false>(qf, kf, vf, kt, d00, c.lut, 0.f, st, W, win, dmask, lane_sel);
    }
}

DI void load_lut(float* lut, const float* glut, int col, int lane) {
    __builtin_amdgcn_fence(__ATOMIC_ACQ_REL, "wavefront");
    f32x4 t[8];
#pragma unroll
    for (int k = 0; k < 8; ++k) t[k] = *(const f32x4*)(glut + (size_t)col * 2048 + k * 256 + lane * 4);
#pragma unroll
    for (int k = 0; k < 8; ++k) *(f32x4*)(lut + k * 256 + lane * 4) = t[k];
    __builtin_amdgcn_fence(__ATOMIC_ACQ_REL, "wavefront");
    __builtin_amdgcn_wave_barrier();
}

DI void attn_job(const Args& a, unsigned char* wsh, LAS unsigned char* wl, int type, int b, int qt, int hd, const int tid) {
    const int lane = tid & 63, r = lane & 31, h = lane >> 5;
    const bf16_t* prm = (const bf16_t*)(a.ws + WS_R1);
    const bf16_t* prt = prm + (size_t)MTOK * RM_LD;
    const float* glut = (const float*)(a.ws + WS_LUT);
    const unsigned* mask = (const unsigned*)(a.ws + WS_MASK);
    const float* kmean = (const float*)(a.ws + WS_KMEAN);
    bf16_t* oabc = (bf16_t*)(a.ws + WS_OABC);
    float* lut = (float*)(wsh + 8192);
    const int t0 = qt * 32, tok0 = b * SEQ;
    const int d00 = t0 + r - 8 * h, h8 = 8 * h;
    const unsigned* maskrow = mask + (size_t)(tok0 + t0 + r) * 64;
    AttnCtx c; c.wl = wl; c.lut = lut; c.krs = 1;
#pragma unroll
    for (int j = 0; j < 4; ++j) {
        const int rk = 8 * j + (lane >> 3), ck = (lane & 7) ^ ((rk >> 1) & 7);
        c.koff[j] = (unsigned)(pi_row(rk) * RM_LD + ck * 8) * 2u;
        const int rv = 16 * j + (lane >> 2), cv = (lane & 3) ^ ((rv >> 2) & 3);
        c.voff[j] = (unsigned)(rv * MTOK + cv * 8) * 2u;
        c.kfo[j] = r * 128 + (((2 * j + h) ^ ((r >> 1) & 7)) * 16);
    }
#pragma unroll
    for (int mt = 0; mt < 2; ++mt)
#pragma unroll
        for (int s = 0; s < 2; ++s) c.vfo[mt][s] = (32 * mt + r) * 64 + (((2 * s + h) ^ ((r >> 2) & 3)) * 16);
    AttnSt st; st.m = NEGF; st.l = 0.f;
#pragma unroll
    for (int i = 0; i < 16; ++i) { st.o0[i] = 0.f; st.o1[i] = 0.f; }
    const int ng = (type == 1) ? 2 : 1;
    int ocol = 0;
    for (int g = 0; g < ng; ++g) {
        int qcol, kcol, vrow, bcol;
        if (type == 0) { qcol = C_AQ + hd * 64; kcol = C_AK; vrow = R_AV; bcol = hd; ocol = hd * 64; }
        else if (type == 1) { qcol = C_BQ + (g * 4 + hd) * 64; kcol = C_BK + hd * 64; vrow = R_BV + hd * 64; bcol = 6 + g * 4 + hd; ocol = 384 + hd * 64; }
        else { qcol = C_CQ + hd * 64; kcol = C_CK + hd * 64; vrow = R_CV + hd * 64; bcol = 18 + hd; ocol = 640 + hd * 64; }
        load_lut(lut, glut, bcol, lane);
        bf16x8 qf[4];
        const bf16_t* qp = prm + (size_t)(tok0 + t0 + r) * RM_LD + qcol + 8 * h;
#pragma unroll
        for (int ks = 0; ks < 4; ++ks) qf[ks] = *(const bf16x8*)(qp + 16 * ks);
        c.kg = prm + (size_t)tok0 * RM_LD + kcol;
        c.vg = prt + (size_t)vrow * MTOK + tok0;
        if (type == 0) {
            attn_range<0>(c, qf, 0, qt, t0, d00, st, maskrow, h8, 0, 0, false);
        } else if (type == 1) {
            const int win = (g == 0) ? 128 : (g == 1 ? 512 : 2048), dmask = (g == 0) ? 0 : (g == 1 ? 3 : 15);
            int lo = t0 - win; if (lo < 0) lo = 0;
            attn_range<1>(c, qf, lo >> 5, qt, t0, d00, st, maskrow, h8, win, dmask, false);
        } else {
            const int cur = qt >> 3;
            float gate[7];
            const float* km = kmean + (size_t)((b * 6 + hd) * 8) * 64 + 8 * h;
#pragma unroll
            for (int n = 0; n < 7; ++n) {
                float s = 0.f;
                if (n < cur) {
#pragma unroll
                    for (int ks = 0; ks < 4; ++ks) {
                        const f32x4 k0 = *(const f32x4*)(km + n * 64 + 16 * ks), k1 = *(const f32x4*)(km + n * 64 + 16 * ks + 4);
                        const u32x4 qw = __builtin_bit_cast(u32x4, qf[ks]);
                        s += bf_lo(qw.x) * k0[0] + bf_hi(qw.x) * k0[1] + bf_lo(qw.y) * k0[2] + bf_hi(qw.y) * k0[3]
                           + bf_lo(qw.z) * k1[0] + bf_hi(qw.z) * k1[1] + bf_lo(qw.w) * k1[2] + bf_hi(qw.w) * k1[3];
                    }
                    s += __shfl_xor(s, 32);
                } else s = -__builtin_inff();
                gate[n] = s;
            }
            unsigned sel = 0u;
#pragma unroll
            for (int rd = 0; rd < 3; ++rd) {
                float bv = -__builtin_inff(); int bi = -1;
#pragma unroll
                for (int n = 0; n < 7; ++n) if (gate[n] > bv) { bv = gate[n]; bi = n; }
                if (bi >= 0) sel |= 1u << bi;
#pragma unroll
                for (int n = 0; n < 7; ++n) if (n == bi) gate[n] = -__builtin_inff();
            }
            for (int n = 0; n < cur; ++n) {
                const bool ls = ((sel >> n) & 1u) != 0u;
                if (__ballot(ls) == 0ull) continue;
                attn_range<2>(c, qf, n * 8, n * 8 + 7, t0, d00, st, maskrow, h8, 0, 0, ls);
            }
            attn_range<3>(c, qf, cur * 8, qt, t0, d00, st, maskrow, h8, 0, 0, false);
        }
    }
    float lt = st.l + __shfl_xor(st.l, 32);
    if (type == 1) {
        const float* pp = (const float*)(a.ws + WS_G2) + ((size_t)(tok0 + t0 + r) * 4 + hd) * 68;
        const f32x2 ml = *(const f32x2*)(pp + 64);
        const float mn = fmaxf(st.m, ml[0]);
        const float a1 = __builtin_amdgcn_exp2f(st.m - mn), a2 = __builtin_amdgcn_exp2f(ml[0] - mn);
        lt = lt * a1 + ml[1] * a2;
#pragma unroll
        for (int g4 = 0; g4 < 4; ++g4) {
            const f32x4 p0 = *(const f32x4*)(pp + 8 * g4 + 4 * h), p1 = *(const f32x4*)(pp + 32 + 8 * g4 + 4 * h);
#pragma unroll
            for (int e = 0; e < 4; ++e) { st.o0[4 * g4 + e] = st.o0[4 * g4 + e] * a1 + p0[e] * a2; st.o1[4 * g4 + e] = st.o1[4 * g4 + e] * a1 + p1[e] * a2; }
        }
    }
    const float inv = 1.0f / lt;
    bf16_t* op = oabc + (size_t)(tok0 + t0 + r) * 1024 + ocol + 4 * h;
#pragma unroll
    for (int g4 = 0; g4 < 4; ++g4) {
        u32x2 w;
        w.x = pk2(st.o0[4 * g4] * inv, st.o0[4 * g4 + 1] * inv); w.y = pk2(st.o0[4 * g4 + 2] * inv, st.o0[4 * g4 + 3] * inv);
        *(u32x2*)(op + 8 * g4) = w;
        w.x = pk2(st.o1[4 * g4] * inv, st.o1[4 * g4 + 1] * inv); w.y = pk2(st.o1[4 * g4 + 2] * inv, st.o1[4 * g4 + 3] * inv);
        *(u32x2*)(op + 32 + 8 * g4) = w;
    }
}
DI void g2_job(const Args& a, unsigned char* wsh, LAS unsigned char* wl, int b, int slot, int cls, int it, const int tid) {
    const int lane = tid & 63, r = lane & 31, h = lane >> 5;
    const bf16_t* prm = (const bf16_t*)(a.ws + WS_R1);
    const bf16_t* vt16 = (const bf16_t*)(a.ws + WS_VT16);
    const float* glut = (const float*)(a.ws + WS_LUT);
    float* lut = (float*)(wsh + 8192);
    const int tok0 = b * SEQ;
    const int d00 = 32 * it + r - 8 * h;
    AttnCtx c; c.wl = wl; c.lut = lut; c.krs = 16;
#pragma unroll
    for (int j = 0; j < 4; ++j) {
        const int rk = 8 * j + (lane >> 3), ck = (lane & 7) ^ ((rk >> 1) & 7);
        c.koff[j] = (unsigned)(pi_row(rk) * 16 * RM_LD + ck * 8) * 2u;
        const int rv = 16 * j + (lane >> 2), cv = (lane & 3) ^ ((rv >> 2) & 3);
        c.voff[j] = (unsigned)(rv * MTOK + cv * 8) * 2u;
        c.kfo[j] = r * 128 + (((2 * j + h) ^ ((r >> 1) & 7)) * 16);
    }
#pragma unroll
    for (int mt = 0; mt < 2; ++mt)
#pragma unroll
        for (int s = 0; s < 2; ++s) c.vfo[mt][s] = (32 * mt + r) * 64 + (((2 * s + h) ^ ((r >> 2) & 3)) * 16);
    AttnSt st; st.m = NEGF; st.l = 0.f;
#pragma unroll
    for (int i = 0; i < 16; ++i) { st.o0[i] = 0.f; st.o1[i] = 0.f; }
    load_lut(lut, glut, 6 + 2 * 4 + slot, lane);
    const int tq = tok0 + cls + 16 * (32 * it + r);
    bf16x8 qf[4];
    const bf16_t* qp = prm + (size_t)tq * RM_LD + C_BQ + (2 * 4 + slot) * 64 + 8 * h;
#pragma unroll
    for (int ks = 0; ks < 4; ++ks) qf[ks] = *(const bf16x8*)(qp + 16 * ks);
    c.kg = prm + (size_t)(tok0 + cls) * RM_LD + C_BK + slot * 64;
    c.vg = vt16 + (size_t)(slot * 64) * MTOK + tok0 + cls * 128;
    attn_range<4>(c, qf, 0, it, 0, d00, st, nullptr, 0, 0, 0, false);
    const float lt = st.l + __shfl_xor(st.l, 32);
    float* pp = (float*)(a.ws + WS_G2) + ((size_t)tq * 4 + slot) * 68;
#pragma unroll
    for (int g4 = 0; g4 < 4; ++g4) {
        f32x4 p0, p1;
#pragma unroll
        for (int e = 0; e < 4; ++e) { p0[e] = st.o0[4 * g4 + e]; p1[e] = st.o1[4 * g4 + e]; }
        *(f32x4*)(pp + 8 * g4 + 4 * h) = p0; *(f32x4*)(pp + 32 + 8 * g4 + 4 * h) = p1;
    }
    if (h == 0) { f32x2 ml = {st.m, lt}; *(f32x2*)(pp + 64) = ml; }
}
DI void phase_attn(const Args& a, unsigned char* shm, const int tid) {
    const int wid = __builtin_amdgcn_readfirstlane(tid >> 6);
    unsigned char* wsh = shm + wid * 16384;
    LAS unsigned char* wl = (LAS unsigned char*)shm + wid * 16384;
    for (int it = 0;; ++it) {
        int b, qt; if (!task_map(it, b, qt)) break;
        const int role = (wid + it) & 7;
        if (role < 6) { attn_job(a, wsh, wl, 0, b, qt, role, tid); attn_job(a, wsh, wl, 2, b, qt, role, tid); }
        else { attn_job(a, wsh, wl, 1, b, qt, role - 6, tid); attn_job(a, wsh, wl, 1, b, qt, role - 4, tid); }
    }
}

#define XB_TMO      128
#define XB_XCNT(j)  (256  + 64 * (j))
#define XB_XSUB(j)  (1280 + 64 * (j))
#define XB_XGEN(j)  (2304 + 64 * (j))
#define XB_TOP      3328
#define XB_TOPGEN   3392
#define XCD_BAR_WORDS 3456
#define XB_SPIN_CAP (1u << 20)
DI unsigned xb_ld(unsigned* p)              { return __hip_atomic_load(p, __ATOMIC_RELAXED, __HIP_MEMORY_SCOPE_AGENT); }
DI unsigned xb_add(unsigned* p, unsigned v) { return __hip_atomic_fetch_add(p, v, __ATOMIC_RELAXED, __HIP_MEMORY_SCOPE_AGENT); }
DI unsigned xb_xcc_id() { return (unsigned)__builtin_amdgcn_s_getreg((3 << 11) | 20) & 0xFu; }
#define XB_SPIN(cond, bar) do { unsigned _sp = 0; while (cond) { __builtin_amdgcn_s_sleep(1); \
    if ((++_sp & 255u) == 0u) { if (xb_ld(&(bar)[XB_TMO])) break; if (_sp > XB_SPIN_CAP) { atomicAdd(&(bar)[XB_TMO], 1u); break; } } } } while (0)
struct XcdBarrier { unsigned* bar; unsigned x; volatile LAS unsigned* st; };
DI void xcd_barrier_complete(unsigned* bar, unsigned x, unsigned& nloc, unsigned& nx) {
    const unsigned G = gridDim.x * gridDim.y * gridDim.z;
    unsigned sum, cnt, mine, sp = 0u;
    for (;;) {
        sum = 0u; cnt = 0u; mine = 0u;
#pragma unroll
        for (unsigned j = 0; j < 16; ++j) { const unsigned c = xb_ld(&bar[XB_XCNT(j)]); sum += c; cnt += (c > 0u) ? 1u : 0u; mine = (j == x) ? c : mine; }
        if (sum == G) break;
        __builtin_amdgcn_s_sleep(1);
        if ((++sp & 255u) == 0u) { if (xb_ld(&bar[XB_TMO])) break; if (sp > XB_SPIN_CAP) { atomicAdd(&bar[XB_TMO], 1u); break; } }
    }
    nloc = mine > 0u ? mine : 1u; nx = cnt > 0u ? cnt : 1u;
}
DI void xcd_barrier(const XcdBarrier& b, const int tid) {
    asm volatile("s_waitcnt vmcnt(0)" ::: "memory");
    __syncthreads();
    if (tid == 0) {
        unsigned* bar = b.bar;
        __builtin_amdgcn_s_waitcnt(0);
        unsigned nloc = b.st[0], nx = b.st[1];
        if (nloc == 0u) { xcd_barrier_complete(bar, b.x, nloc, nx); b.st[0] = nloc; b.st[1] = nx; }
        const unsigned old = xb_add(&bar[XB_XSUB(b.x)], 1u);
        const unsigned gen = old / nloc;
        if (old + 1u == (gen + 1u) * nloc) {
            __builtin_amdgcn_fence(__ATOMIC_RELEASE, "agent");
            asm volatile("s_waitcnt vmcnt(0)" ::: "memory");
            const unsigned og = xb_add(&bar[XB_TOP], 1u);
            const unsigned tg = og / nx;
            if (og + 1u == (tg + 1u) * nx) xb_add(&bar[XB_TOPGEN], 1u);
            else XB_SPIN(xb_ld(&bar[XB_TOPGEN]) == tg, bar);
            __builtin_amdgcn_fence(__ATOMIC_ACQUIRE, "agent");
            xb_add(&bar[XB_XGEN(b.x)], 1u);
            asm volatile("s_waitcnt vmcnt(0)" ::: "memory");
        } else {
            XB_SPIN(xb_ld(&bar[XB_XGEN(b.x)]) == gen, bar);
            __builtin_amdgcn_fence(__ATOMIC_ACQUIRE, "agent");
            asm volatile("s_waitcnt vmcnt(0)" ::: "memory");
        }
    }
    __syncthreads();
}

__global__ void __launch_bounds__(512, 2) mega_fwd(Args a_) {
    extern __shared__ __attribute__((aligned(16))) unsigned char shm[];
    cg::grid_group grid = cg::this_grid();
    LAS unsigned char* lds = (LAS unsigned char*)shm;
    const int G = gridDim.x, c = blockIdx.x;
#ifndef PROBE_REP
#define PROBE_REP -2
#endif
    const int ph_lo = a_.ph_lo, ph_hi = a_.ph_hi;
    const int wave_id = __builtin_amdgcn_readfirstlane(threadIdx.x >> 6);
    XcdBarrier xbar;
    { volatile LAS unsigned* st = (volatile LAS unsigned*)(lds + 131072);
      if (threadIdx.x == 0) { st[0] = 0u; st[1] = 0u; }
      __syncthreads();
      xbar.bar = (unsigned*)(a_.ws + WS_BAR); xbar.x = xb_xcc_id(); xbar.st = st;
      if (threadIdx.x == 0) (void)xb_add(&xbar.bar[XB_XCNT(xbar.x)], 1u); }
    for (int phx = 2 * ph_lo; phx < 2 * ph_hi; ++phx) {
        const int ph = phx >> 1;
        if (phx & 1) { const bool rep = (PROBE_REP == -1) ? (ph == 0) : (ph > 0 && (ph - 1) % 9 == PROBE_REP); if (!rep) continue; }
        const Args& a = a_;
        int tid = wave_id * 64 + (int)__builtin_amdgcn_mbcnt_hi(~0u, __builtin_amdgcn_mbcnt_lo(~0u, 0u)); asm volatile("" : "+v"(tid));
        bf16_t* xb = (bf16_t*)(a.ws + WS_XB);
        bf16_t* r1 = (bf16_t*)(a.ws + WS_R1);
        bf16_t* oabc = (bf16_t*)(a.ws + WS_OABC);
        float* stats = (float*)(a.ws + WS_STATS);
        if (ph == 0) phase_convert(a, shm, tid);
        else {
            const int l = (ph - 1) / 9, sp = (ph - 1) % 9;
            const bf16_t* w = (const bf16_t*)(a.ws + WS_WB) + (size_t)l * W_LAYER;
            const float* xin = (l == 0) ? a.in[0] : a.out;
            if (sp == 0) {
                { pg8::Gemm g{xb, w + WO_IN, 1024, 1024, 1024, 0}; pg8::StaticOrder S; S.init(256, 11, G, c); pg8::EpiBf16<0> E{r1, RM_LD}; pg8::gemm_phase(lds, g, S, E, tid); }
                { pg8::Gemm g{w + WO_IN + (size_t)RM_LD * 1024, xb, 1024, 1024, 1024, 0}; pg8::StaticOrder S; S.init(3, 256, G, c); pg8::EpiBf16<0> E{r1 + (size_t)MTOK * RM_LD, MTOK}; pg8::gemm_phase(lds, g, S, E, tid); }
                { pg8::Gemm g{w + WO_IN + (size_t)2880 * 1024, xb, 1024, 16 * 1024, 1024, 2048}; pg8::OrderVT16 S{G, c}; pg8::EpiBf16<0> E{(bf16_t*)(a.ws + WS_VT16), MTOK}; pg8::gemm_phase(lds, g, S, E, tid); }
            } else if (sp == 1) phase_a1(a, shm, tid);
            else if (sp == 2) phase_attn(a, shm, tid);
            else if (sp == 3) {
                pg8::StaticOrder S; S.init(256, 4, G, c);
                { pg8::Gemm g{oabc, w + WO_BA, 1024, 384, 384, 0}; pg8::EpiBf16<0> E{r1, 3072}; pg8::gemm_phase(lds, g, S, E, tid); }
                { pg8::Gemm g{oabc + 384, w + WO_BB, 1024, 256, 256, 0}; pg8::EpiBf16<0> E{r1 + 1024, 3072}; pg8::gemm_phase(lds, g, S, E, tid); }
                { pg8::Gemm g{oabc + 640, w + WO_BC, 1024, 384, 384, 0}; pg8::EpiBf16<0> E{r1 + 2048, 3072}; pg8::gemm_phase(lds, g, S, E, tid); }
                { pg8::Gemm g{xb, w + WO_G, 1024, 1024, 1024, 0}; pg8::Order3 S3; S3.base = S; pg8::EpiGate E{r1, r1 + (size_t)MTOK * 3072}; pg8::gemm_phase(lds, g, S3, E, tid); }
            } else if (sp == 4) {
                pg8::Gemm g{r1 + (size_t)MTOK * 3072, w + WO_OUT, 1024, 1024, 1024, 0}; pg8::StaticOrder S; S.init(256, 4, G, c);
                if (l == 0) { pg8::EpiRes<false, false> E{xin, a.out, nullptr, nullptr, nullptr, nullptr}; pg8::gemm_phase(lds, g, S, E, tid); }
                else { pg8::EpiRes<false, true> E{xin, a.out, nullptr, stats, a.in[14], a.in[15]}; pg8::gemm_phase(lds, g, S, E, tid); }
            } else if (sp == 5) phase_ln<false>(a.out, xb, stats, a.in[8] + l * 1024, a.in[9] + l * 1024, tid);
            else if (sp == 6) {
                { pg8::Gemm g{xb, w + WO_UP, 1024, 1024, 1024, 0}; pg8::StaticOrder S; S.init(256, 16, G, c); pg8::EpiBf16<1> E{r1, 4096}; pg8::gemm_phase(lds, g, S, E, tid); }
                pg8::StaticOrder S; S.init(256, 4, G, c);
                { pg8::Gemm g{(const bf16_t*)(a.ws + WS_PB) + (size_t)l * MTOK * 256, w + WO_PL, 256, 256, 256, 0}; pg8::EpiBf16<0> E{oabc, 1024}; pg8::gemm_phase(lds, g, S, E, tid); }
                { pg8::Gemm g{xb, w + WO_PG, 1024, 1024, 1024, 0}; pg8::EpiT1 E{oabc}; pg8::gemm_phase(lds, g, S, E, tid); }
            } else if (sp == 7) {
                pg8::Gemm g{r1, w + WO_DN, 4096, 4096, 4096, 0}; pg8::StaticOrder S; S.init(256, 4, G, c);
                pg8::EpiRes<true, true> E{a.out, a.out, oabc, stats, a.in[8] + l * 1024, a.in[9] + l * 1024}; pg8::gemm_phase(lds, g, S, E, tid);
            } else { if (l == 0) phase_ln<false>(a.out, xb, stats, a.in[14], a.in[15], tid); else phase_ln<true>(a.out, xb, stats, a.in[14] + 1024, a.in[15] + 1024, tid); }
        }
        if (phx + 1 < 2 * ph_hi) { if (ph == 0) grid.sync(); else xcd_barrier(xbar, tid); }
    }
}

#ifndef N_LAUNCH_MODE
#define N_LAUNCH_MODE 1
#endif
extern "C" void kernel_launch(void* const* d_in, const int* in_sizes, int n_in, void* d_out, int out_size, void* d_ws, size_t ws_size, hipStream_t stream) {
    static int grid = 0;
    if (grid == 0) {
        if (n_in != 17 || out_size != MTOK * DM || ws_size < WS_END) { fprintf(stderr, "kernel_launch: unexpected shapes (n_in %d out %d ws %zu need %zu)\n", n_in, out_size, ws_size, (size_t)WS_END); grid = -1; return; }
        int dev = 0, cus = 0, per_cu = 0;
        hipGetDevice(&dev);
        hipDeviceGetAttribute(&cus, hipDeviceAttributeMultiprocessorCount, dev);
        if (hipFuncSetAttribute((const void*)mega_fwd, hipFuncAttributeMaxDynamicSharedMemorySize, LDS_BYTES) != hipSuccess) { fprintf(stderr, "kernel_launch: hipFuncSetAttribute failed\n"); grid = -1; return; }
        hipOccupancyMaxActiveBlocksPerMultiprocessor(&per_cu, (const void*)mega_fwd, 512, LDS_BYTES);
        if (per_cu < 1) { fprintf(stderr, "kernel_launch: occupancy query says %d\n", per_cu); per_cu = 1; }
        (void)hipGetLastError();
        grid = cus * per_cu;
    }
    if (grid < 0) return;
    if (hipMemsetAsync((char*)d_ws + WS_BAR, 0, (size_t)3456 * 4, stream) != hipSuccess) { fprintf(stderr, "kernel_launch: memset of the barrier words failed\n"); return; }
    Args a{};
    for (int i = 0; i < 17; ++i) a.in[i] = (const float*)d_in[i];
    a.out = (float*)d_out; a.ws = (unsigned char*)d_ws;
#if N_LAUNCH_MODE == 0
    for (int ph = 0; ph < 19; ++ph) {
        a.ph_lo = ph; a.ph_hi = ph + 1;
        hipLaunchKernelGGL(mega_fwd, dim3(grid), dim3(512), LDS_BYTES, stream, a);
    }
#else
    a.ph_lo = 0; a.ph_hi = 19;
    void* args[] = {&a};
    hipError_t e = hipLaunchCooperativeKernel((const void*)mega_fwd, dim3(grid), dim3(512), args, LDS_BYTES, stream);
    if (e != hipSuccess) fprintf(stderr, "cooperative launch failed: %s (grid %d)\n", hipGetErrorString(e), grid);
#endif
}
```

```cpp
#include <hip/hip_runtime.h>
#include <hip/hip_cooperative_groups.h>
#include <cstdio>
namespace cg = cooperative_groups;

#define LAS __attribute__((address_space(3)))
#define DI __device__ __forceinline__
typedef unsigned short bf16_t;
typedef short bf16x8 __attribute__((ext_vector_type(8)));
typedef float f32x2 __attribute__((ext_vector_type(2)));
typedef float f32x4 __attribute__((ext_vector_type(4)));
typedef float f32x16 __attribute__((ext_vector_type(16)));
typedef unsigned u32x2 __attribute__((ext_vector_type(2)));
typedef unsigned u32x4 __attribute__((ext_vector_type(4)));
typedef __bf16 bf2_t __attribute__((ext_vector_type(2)));

constexpr int MTOK = 65536, SEQ = 2048, DM = 1024, NB = 32, DFF = 4096, PLE = 256;
constexpr int RM_LD = 2816;
constexpr int C_AQ = 0, C_AK = 384, C_IQ = 448, C_IK = 960, C_BQ = 1024, C_BK = 1792, C_CQ = 2048, C_CK = 2432;
constexpr int T_ROWS = 768;
constexpr int R_AV = 0, R_BV = 64, R_CV = 320, R_IW = 704;
constexpr int NWIN = 3584;
constexpr float ALPHA = 1.41421356237309515f;
constexpr float LOG2E = 1.44269504088896341f;
constexpr float SC2 = 0.125f * LOG2E;
constexpr float NEGF = -1e30f;
constexpr int LDS_BYTES = 131072 + 16;

constexpr size_t WO_IN = 0;
constexpr size_t WO_G = WO_IN + (size_t)NWIN * 1024;
constexpr size_t WO_BA = WO_G + (size_t)3072 * 1024;
constexpr size_t WO_BB = WO_BA + (size_t)1024 * 384;
constexpr size_t WO_BC = WO_BB + (size_t)1024 * 256;
constexpr size_t WO_OUT = WO_BC + (size_t)1024 * 384;
constexpr size_t WO_UP = WO_OUT + (size_t)1024 * 1024;
constexpr size_t WO_DN = WO_UP + (size_t)4096 * 1024;
constexpr size_t WO_PG = WO_DN + (size_t)1024 * 4096;
constexpr size_t WO_PL = WO_PG + (size_t)1024 * 1024;
constexpr size_t W_LAYER = WO_PL + (size_t)1024 * 256;

constexpr size_t WS_WB = 0;
constexpr size_t WS_LUT = WS_WB + 2 * W_LAYER * 2;
constexpr size_t WS_KMEAN = WS_LUT + (size_t)24 * 2048 * 4;
constexpr size_t WS_MASK = WS_KMEAN + (size_t)32 * 6 * 8 * 64 * 4;
constexpr size_t WS_XB = WS_MASK + (size_t)MTOK * 64 * 4;
constexpr size_t WS_PB = WS_XB + (size_t)MTOK * 1024 * 2;
constexpr size_t WS_OABC = WS_PB + (size_t)2 * MTOK * 256 * 2;
constexpr size_t WS_R1 = WS_OABC + (size_t)MTOK * 1024 * 2;
constexpr size_t WS_BAR = WS_R1 + (size_t)MTOK * 4096 * 2;
constexpr size_t WS_STATS = WS_BAR + (size_t)4096 * 4;
constexpr size_t WS_G2 = WS_STATS + (size_t)MTOK * 2 * 4;
constexpr size_t WS_END = WS_G2 + (size_t)MTOK * 4 * 68 * 4;
constexpr size_t WS_VT16 = WS_R1 + ((size_t)MTOK * RM_LD + (size_t)T_ROWS * MTOK) * 2;

struct Args {
    const float* in[17];
    float* out;
    unsigned char* ws;
    int ph_lo, ph_hi;
};

DI unsigned short f2bf(float f) { unsigned u = __float_as_uint(f); u += 0x7FFFu + ((u >> 16) & 1u); return (unsigned short)(u >> 16); }
DI unsigned pk2(float lo, float hi) { f32x2 v = {lo, hi}; bf2_t b = __builtin_convertvector(v, bf2_t); return __builtin_bit_cast(unsigned, b); }
DI float bf_lo(unsigned w) { return __uint_as_float(w << 16); }
DI float bf_hi(unsigned w) { return __uint_as_float(w & 0xFFFF0000u); }
DI float bf2f(bf16_t b) { return __uint_as_float(((unsigned)b) << 16); }
DI float sigmoidf_(float x) { return __builtin_amdgcn_rcpf(1.0f + __expf(-x)); }
#define MFMA32(a, b, c) __builtin_amdgcn_mfma_f32_32x32x16_bf16((a), (b), (c), 0, 0, 0)

namespace pg8 {
constexpr int BM = 256, BK = 64, HALF = 128, HTB = HALF * BK * 2, NXCD = 8, WGM = 8;
DI int lds_byte(int r, int c) { const int st = (r >> 4) * 2 + (c >> 5), rr = r & 15, cc = c & 31, ob = rr * 64 + cc * 2; return st * 1024 + (ob ^ (((ob >> 9) & 1) << 5)); }
DI void stage_rc(int b, int& R, int& C) { const int st = b / 1024, sb = b % 1024, swz = sb ^ (((sb >> 9) & 1) << 5); R = (st >> 1) * 16 + swz / 64; C = (st & 1) * 32 + (swz % 64) / 2; }
DI int perm32(int rho) { const int n = rho >> 4, i = rho & 15; return 8 * (i >> 2) + 4 * n + (i & 3); }

struct Unit { int pm, pn; long bofs; };
struct Gemm { const bf16_t* A; const bf16_t* Bt; int lda, ldb, K; long hsB; };

struct StaticOrder {
    int nM, nN, nwg, G, c;
    DI void init(int nM_, int nN_, int G_, int c_) { nM = nM_; nN = nN_; nwg = nM * nN; G = G_; c = c_; }
    DI bool next(int i, Unit& u) const {
        const long L = (long)i * G + c; if (L >= nwg) return false;
        int wgid = (int)L; { const int q = nwg / NXCD, r = nwg % NXCD, xcd = wgid % NXCD, off = wgid / NXCD; wgid = (xcd < r ? xcd * (q + 1) : r * (q + 1) + (xcd - r) * q) + off; }
        const int nig = WGM * nN, gid = wgid / nig, fm = gid * WGM, gsz = (nM - fm) < WGM ? (nM - fm) : WGM;
        u.pm = fm + ((wgid % nig) % gsz); u.pn = (wgid % nig) / gsz; u.bofs = -1; return true;
    }
};
struct OrderVT16 {
    int G, c;
    DI bool next(int i, Unit& u) const { const int L = i * G + c; if (L >= 256) return false; u.pm = 0; u.pn = L; u.bofs = ((long)((L >> 3) * 2048 + 2 * (L & 7)) * 1024) * 2; return true; }
};
struct Order3 {
    StaticOrder base;
    DI bool next(int i, Unit& u) const { Unit v; if (!base.next(i / 3, v)) return false; u.pm = v.pm; u.pn = (i % 3) * 4 + v.pn; u.bofs = -1; return true; }
};

template <int ACT  > struct EpiBf16 {
    static constexpr bool PERM = true;
    bf16_t* O; int ldc;
    DI void operator()(const f32x4 (&acc)[2][2][4][2], const Unit& u, int wr, int wc, int fr, int fq) const {
        const int row0 = u.pm * BM + wr * 64 + fr, col0 = u.pn * BM + wc * 32 + 8 * fq;
#pragma unroll
        for (int ai = 0; ai < 2; ++ai)
#pragma unroll
            for (int m = 0; m < 4; ++m) { bf16_t* rowp = O + (size_t)(row0 + ai * HALF + m * 16) * ldc + col0;
#pragma unroll
                for (int bj = 0; bj < 2; ++bj) { f32x4 v0 = acc[ai][bj][m][0], v1 = acc[ai][bj][m][1];
                    if (ACT == 1) {
#pragma unroll
                        for (int j = 0; j < 4; ++j) { float a = fmaxf(v0[j], 0.f), b = fmaxf(v1[j], 0.f); v0[j] = a * a; v1[j] = b * b; } }
                    u32x4 w; w.x = pk2(v0[0], v0[1]); w.y = pk2(v0[2], v0[3]); w.z = pk2(v1[0], v1[1]); w.w = pk2(v1[2], v1[3]);
                    *(u32x4*)(rowp + bj * HALF) = w; } }
    }
};
struct EpiGate {
    static constexpr bool PERM = true;
    const bf16_t* obr; bf16_t* mg;
    DI void operator()(const f32x4 (&acc)[2][2][4][2], const Unit& u, int wr, int wc, int fr, int fq) const {
        const int b = u.pn >> 2, colt = (u.pn & 3) * BM;
        const int row0 = u.pm * BM + wr * 64 + fr, col0 = colt + wc * 32 + 8 * fq;
        const bf16_t* ob0 = obr + (size_t)row0 * 3072 + b * 1024 + col0;
        bf16_t* mp0 = mg + (size_t)row0 * 1024 + col0;
        u32x4 ob[2][4], pm[2][4];
#define GATE_LOAD(k, s) do { _Pragma("unroll") for (int q = 0; q < 4; ++q) { const int ai = (k) >> 1, m = 2 * ((k) & 1) + (q >> 1), bj = q & 1; const size_t ro = (size_t)(ai * HALF + m * 16); \
            ob[s][q] = *(const u32x4*)(ob0 + ro * 3072 + bj * HALF); if (b > 0) pm[s][q] = *(const u32x4*)(mp0 + ro * 1024 + bj * HALF); } } while (0)
        GATE_LOAD(0, 0);
#pragma unroll
        for (int k = 0; k < 4; ++k) {
            if (k + 1 < 4) GATE_LOAD(k + 1, (k + 1) & 1);
#pragma unroll
            for (int q = 0; q < 4; ++q) {
                const int ai = k >> 1, m = 2 * (k & 1) + (q >> 1), bj = q & 1;
                const f32x4 v0 = acc[ai][bj][m][0], v1 = acc[ai][bj][m][1];
                const u32x4 o = ob[k & 1][q];
                float r[8];
                r[0] = sigmoidf_(v0[0]) * bf_lo(o.x); r[1] = sigmoidf_(v0[1]) * bf_hi(o.x); r[2] = sigmoidf_(v0[2]) * bf_lo(o.y); r[3] = sigmoidf_(v0[3]) * bf_hi(o.y);
                r[4] = sigmoidf_(v1[0]) * bf_lo(o.z); r[5] = sigmoidf_(v1[1]) * bf_hi(o.z); r[6] = sigmoidf_(v1[2]) * bf_lo(o.w); r[7] = sigmoidf_(v1[3]) * bf_hi(o.w);
                if (b > 0) { const u32x4 pv = pm[k & 1][q];
                    r[0] += bf_lo(pv.x); r[1] += bf_hi(pv.x); r[2] += bf_lo(pv.y); r[3] += bf_hi(pv.y); r[4] += bf_lo(pv.z); r[5] += bf_hi(pv.z); r[6] += bf_lo(pv.w); r[7] += bf_hi(pv.w); }
                u32x4 w; w.x = pk2(r[0], r[1]); w.y = pk2(r[2], r[3]); w.z = pk2(r[4], r[5]); w.w = pk2(r[6], r[7]);
                *(u32x4*)(mp0 + (size_t)(ai * HALF + m * 16) * 1024 + bj * HALF) = w;
            }
        }
#undef GATE_LOAD
    }
};
struct EpiT1 {
    static constexpr bool PERM = true;
    bf16_t* T;
    DI void operator()(const f32x4 (&acc)[2][2][4][2], const Unit& u, int wr, int wc, int fr, int fq) const {
        const int row0 = u.pm * BM + wr * 64 + fr, col0 = u.pn * BM + wc * 32 + 8 * fq;
        bf16_t* tp0 = T + (size_t)row0 * 1024 + col0;
        u32x4 ob[2][8];
#pragma unroll
        for (int ai = 0; ai < 2; ++ai)
#pragma unroll
            for (int q = 0; q < 8; ++q) ob[ai][q] = *(const u32x4*)(tp0 + (size_t)(ai * HALF + (q >> 1) * 16) * 1024 + (q & 1) * HALF);
#pragma unroll
        for (int ai = 0; ai < 2; ++ai)
#pragma unroll
            for (int q = 0; q < 8; ++q) {
                const int m = q >> 1, bj = q & 1;
                const f32x4 v0 = acc[ai][bj][m][0], v1 = acc[ai][bj][m][1];
                const u32x4 o = ob[ai][q];
                float r[8];
                r[0] = sigmoidf_(v0[0]) * bf_lo(o.x); r[1] = sigmoidf_(v0[1]) * bf_hi(o.x); r[2] = sigmoidf_(v0[2]) * bf_lo(o.y); r[3] = sigmoidf_(v0[3]) * bf_hi(o.y);
                r[4] = sigmoidf_(v1[0]) * bf_lo(o.z); r[5] = sigmoidf_(v1[1]) * bf_hi(o.z); r[6] = sigmoidf_(v1[2]) * bf_lo(o.w); r[7] = sigmoidf_(v1[3]) * bf_hi(o.w);
                u32x4 w; w.x = pk2(r[0], r[1]); w.y = pk2(r[2], r[3]); w.z = pk2(r[4], r[5]); w.w = pk2(r[6], r[7]);
                *(u32x4*)(tp0 + (size_t)(ai * HALF + m * 16) * 1024 + bj * HALF) = w;
            }
    }
};
template <bool HAS_T, bool LNX> struct EpiRes {
    static constexpr bool PERM = false;
    const float* xin; float* y; const bf16_t* T; const float* stats; const float* lg; const float* lb;
    DI void operator()(const f32x4 (&acc)[2][2][4][2], const Unit& u, int wr, int wc, int fr, int fq) const {
        const int row0 = u.pm * BM + wr * 64 + fr, col0 = u.pn * BM + wc * 32 + 4 * fq;
        const size_t o0 = (size_t)row0 * 1024 + col0;
        f32x4 xv[2][4]; u32x2 tv[2][4]; f32x2 sm[2][4];
#define RES_LOAD(k, s) do { _Pragma("unroll") for (int m = 0; m < 4; ++m) { const int row = row0 + ((k) >> 2) * HALF + m * 16; const size_t o = (size_t)row * 1024 + col0 + (((k) >> 1) & 1) * HALF + ((k) & 1) * 16; \
            xv[s][m] = *(const f32x4*)(xin + o); if (HAS_T) tv[s][m] = *(const u32x2*)(T + o); if (LNX) sm[s][m] = *(const f32x2*)(stats + 2 * (size_t)row); } } while (0)
#pragma unroll
        for (int k = 0; k < 8; ++k) {
            RES_LOAD(k, k & 1);
            const int ai = k >> 2, bj = (k >> 1) & 1, n = k & 1;
            f32x4 gv = {1.f, 1.f, 1.f, 1.f}, bv = {0.f, 0.f, 0.f, 0.f};
            if (LNX) { gv = *(const f32x4*)(lg + col0 + bj * HALF + n * 16); bv = *(const f32x4*)(lb + col0 + bj * HALF + n * 16); }
#pragma unroll
            for (int m = 0; m < 4; ++m) {
                const size_t o = o0 + (size_t)(ai * HALF + m * 16) * 1024 + bj * HALF + n * 16;
                f32x4 x = xv[k & 1][m];
                if (LNX) x = (x - sm[k & 1][m][0]) * sm[k & 1][m][1] * gv + bv;
                f32x4 r = acc[ai][bj][m][n] + x * ALPHA;
                if (HAS_T) { const u32x2 t = tv[k & 1][m]; r[0] += bf_lo(t.x); r[1] += bf_hi(t.x); r[2] += bf_lo(t.y); r[3] += bf_hi(t.y); }
                *(f32x4*)(y + o) = r;
            }
        }
#undef RES_LOAD
    }
};

template <class Epi, class Sched>
DI void gemm_phase(LAS unsigned char* lds, const Gemm g, const Sched& S, const Epi& E, const int tid) {
    const int wid = __builtin_amdgcn_readfirstlane(tid >> 6), lane = tid & 63, wr = wid >> 2, wc = wid & 3, fr = lane & 15, fq = lane >> 4;
    const int K = g.K, nt = K / BK;
    unsigned voffA_, voffB_;
    { int R, C; stage_rc(tid * 16, R, C); const int Rb = Epi::PERM ? ((R & ~31) + perm32(R & 31)) : R;
      voffA_ = (unsigned)(R * g.lda + C) * 2u; voffB_ = (unsigned)(Rb * g.ldb + C) * 2u; }
    const size_t p64offA = (size_t)64 * g.lda * 2, p64offB = (size_t)64 * g.ldb * 2;
    const size_t kstep = (size_t)(BK * 2);
    const size_t hstepA = (size_t)HALF * g.lda * 2, hstepB = g.hsB > 0 ? (size_t)g.hsB : (size_t)HALF * g.ldb * 2;
    const size_t tstepA = 2 * hstepA, tstepB = 2 * hstepB;
    const unsigned ldsw = (unsigned)wid * 1024u;
    const int aoff = lds_byte(wr * 64 + fr, fq * 8), boff = lds_byte(wc * 32 + fr, fq * 8);
#define PG8_SA(b, h) (((b) * 2 + (h)) * HTB)
#define PG8_SB(b, h) ((4 + (b) * 2 + (h)) * HTB)
#define PG8_STAGE(bufoff, gbase, voff) do { _Pragma("unroll") for (int _i = 0; _i < 2; ++_i) \
        __builtin_amdgcn_global_load_lds((const unsigned*)((const char*)(gbase) + (size_t)_i * p64##voff + (v##voff##_)), (LAS unsigned*)(lds + (bufoff) + ldsw + _i * 8192), 16, 0, 0); } while (0)
#define PG8_LDA(dst, b, h) do { _Pragma("unroll") for (int m = 0; m < 4; ++m) _Pragma("unroll") for (int k = 0; k < 2; ++k) dst[m][k] = *(const LAS bf16x8*)(lds + PG8_SA(b, h) + aoff + m * 2048 + k * 1024); } while (0)
#define PG8_LDB(dst, b, h) do { _Pragma("unroll") for (int n = 0; n < 2; ++n) _Pragma("unroll") for (int k = 0; k < 2; ++k) dst[n][k] = *(const LAS bf16x8*)(lds + PG8_SB(b, h) + boff + n * 2048 + k * 1024); } while (0)
#define PG8_MMA(ai, bj, At, Bt) do { __builtin_amdgcn_s_setprio(1); _Pragma("unroll") for (int m = 0; m < 4; ++m) _Pragma("unroll") for (int n = 0; n < 2; ++n) _Pragma("unroll") for (int k = 0; k < 2; ++k) \
        acc[ai][bj][m][n] = __builtin_amdgcn_mfma_f32_16x16x32_bf16(Bt[n][k], At[m][k], acc[ai][bj][m][n], 0, 0, 0); __builtin_amdgcn_s_setprio(0); } while (0)
#define PG8_WAIT_V(n) asm volatile("s_waitcnt vmcnt(" #n ")" ::: "memory")
#define PG8_WAIT_L(n) asm volatile("s_waitcnt lgkmcnt(" #n ")" ::: "memory")
#define PG8_BAR __builtin_amdgcn_s_barrier()
#define PG8_SCHED __builtin_amdgcn_sched_barrier(0)
    Unit cur, nxt; int ui = 0;
    if (!S.next(0, cur)) return;
    f32x4 acc[2][2][4][2];
#pragma unroll
    for (int a = 0; a < 2; ++a)
#pragma unroll
        for (int b = 0; b < 2; ++b)
#pragma unroll
            for (int m = 0; m < 4; ++m)
#pragma unroll
                for (int n = 0; n < 2; ++n) acc[a][b][m][n] = (f32x4){0.f, 0.f, 0.f, 0.f};
    bf16x8 At[4][2], B0[2][2], B1[2][2];
    const char* cA = (const char*)g.A + (size_t)cur.pm * tstepA; const char* cB = (const char*)g.Bt + (cur.bofs >= 0 ? (size_t)cur.bofs : (size_t)cur.pn * tstepB);
    PG8_STAGE(PG8_SB(0, 0), cB, offB); PG8_STAGE(PG8_SA(0, 0), cA, offA); PG8_STAGE(PG8_SB(0, 1), cB + hstepB, offB); PG8_STAGE(PG8_SA(0, 1), cA + hstepA, offA);
    if (wr == 1) PG8_BAR;
    PG8_WAIT_V(4); PG8_BAR;
    PG8_STAGE(PG8_SB(1, 0), cB + kstep, offB); PG8_STAGE(PG8_SA(1, 0), cA + kstep, offA); PG8_STAGE(PG8_SB(1, 1), cB + hstepB + kstep, offB);
    PG8_WAIT_V(6); PG8_BAR;
    for (;;) {
        const bool has_next = S.next(ui + 1, nxt);
        const char* nA = has_next ? (const char*)g.A + (size_t)nxt.pm * tstepA : cA; const char* nB = has_next ? (const char*)g.Bt + (nxt.bofs >= 0 ? (size_t)nxt.bofs : (size_t)nxt.pn * tstepB) : cB;
        for (int t = 0; t < nt; t += 2) {
            const bool last = (t == nt - 2);
            const char* a1 = cA + (size_t)(t + 1) * kstep;
            const char* a2 = last ? nA : cA + (size_t)(t + 2) * kstep; const char* b2 = last ? nB : cB + (size_t)(t + 2) * kstep;
            const char* a3 = a2 + kstep; const char* b3 = b2 + kstep;
            PG8_LDB(B0, 0, 0); PG8_SCHED; PG8_LDA(At, 0, 0); PG8_STAGE(PG8_SA(1, 1), a1 + hstepA, offA);
            PG8_WAIT_L(8); PG8_BAR; PG8_WAIT_L(0); PG8_MMA(0, 0, At, B0); PG8_BAR; PG8_SCHED;
            PG8_LDB(B1, 0, 1); PG8_STAGE(PG8_SB(0, 0), b2, offB);
            PG8_BAR; PG8_WAIT_L(0); PG8_MMA(0, 1, At, B1); PG8_BAR;
            PG8_LDA(At, 0, 1); PG8_STAGE(PG8_SA(0, 0), a2, offA);
            PG8_BAR; PG8_WAIT_L(0); PG8_MMA(1, 0, At, B0); PG8_BAR; PG8_SCHED;
            PG8_STAGE(PG8_SB(0, 1), b2 + hstepB, offB);
            PG8_WAIT_V(6); PG8_BAR; PG8_MMA(1, 1, At, B1); PG8_BAR;
            PG8_LDB(B0, 1, 0); PG8_SCHED; PG8_LDA(At, 1, 0); PG8_STAGE(PG8_SA(0, 1), a2 + hstepA, offA);
            PG8_WAIT_L(8); PG8_BAR; PG8_WAIT_L(0); PG8_MMA(0, 0, At, B0); PG8_BAR; PG8_SCHED;
            PG8_LDB(B1, 1, 1); PG8_STAGE(PG8_SB(1, 0), b3, offB);
            PG8_BAR; PG8_WAIT_L(0); PG8_MMA(0, 1, At, B1); PG8_BAR;
            PG8_LDA(At, 1, 1); PG8_STAGE(PG8_SA(1, 0), a3, offA);
            PG8_BAR; PG8_WAIT_L(0); PG8_MMA(1, 0, At, B0); PG8_BAR; PG8_SCHED;
            PG8_STAGE(PG8_SB(1, 1), b3 + hstepB, offB);
            PG8_WAIT_V(6); PG8_BAR; PG8_MMA(1, 1, At, B1); PG8_BAR;
        }
        E(acc, cur, wr, wc, fr, fq);
        if (!has_next) break;
#pragma unroll
        for (int a = 0; a < 2; ++a)
#pragma unroll
            for (int b = 0; b < 2; ++b)
#pragma unroll
                for (int m = 0; m < 4; ++m)
#pragma unroll
                    for (int n = 0; n < 2; ++n) acc[a][b][m][n] = (f32x4){0.f, 0.f, 0.f, 0.f};
        cur = nxt; cA = nA; cB = nB; ++ui;
    }
    PG8_WAIT_V(0);
    if (wr == 0) PG8_BAR;
    PG8_BAR;
#undef PG8_SA
#undef PG8_SB
#undef PG8_STAGE
#undef PG8_LDA
#undef PG8_LDB
#undef PG8_MMA
#undef PG8_WAIT_V
#undef PG8_WAIT_L
#undef PG8_BAR
#undef PG8_SCHED
}
}

DI int win_srccol(int n) {
    if (n < 384) return n;
    if (n < 448) return 384 + (n - 384);
    if (n < 960) return 512 + (n - 448);
    if (n < 1024) return 1024 + (n - 960);
    if (n < 1792) return 1096 + (n - 1024);
    if (n < 2048) return 1864 + (n - 1792);
    if (n < 2432) return 2376 + (n - 2048);
    if (n < 2816) return 2760 + (n - 2432);
    if (n < 2880) return 448 + (n - 2816);
    if (n < 3136) return 2120 + (n - 2880);
    if (n < 3520) return 3144 + (n - 3136);
    if (n < 3528) return 1088 + (n - 3520);
    return -1;
}
DI void convT(unsigned char* shm, const float* src, int K, int Nsrc, bf16_t* dst, int Ndst, int mode, const int tid) {
    unsigned short* tl = (unsigned short*)shm;
    const int ntk = K / 64, ntiles = (Ndst / 64) * ntk;
    for (int tile = blockIdx.x; tile < ntiles; tile += gridDim.x) {
        const int n0 = (tile / ntk) * 64, k0 = (tile % ntk) * 64;
        const int nx = tid & 63, ky = tid >> 6;
        const int sc = mode ? win_srccol(n0 + nx) : (n0 + nx);
#pragma unroll
        for (int p = 0; p < 8; ++p) { const int k = k0 + ky + 8 * p; const float v = sc >= 0 ? src[(size_t)k * Nsrc + sc] : 0.f; tl[nx * 66 + ky + 8 * p] = f2bf(v); }
        __syncthreads();
#pragma unroll
        for (int p = 0; p < 8; ++p) { const int n = ky + 8 * p; dst[(size_t)(n0 + n) * K + k0 + nx] = tl[n * 66 + nx]; }
        __syncthreads();
    }
}
DI void conv_vec(const float* src, bf16_t* dst, size_t n8, const int tid) {
    for (size_t i = (size_t)blockIdx.x * 512 + tid; i < n8; i += (size_t)gridDim.x * 512) {
        const f32x4 a = *(const f32x4*)(src + i * 8), b = *(const f32x4*)(src + i * 8 + 4);
        u32x4 w; w.x = pk2(a[0], a[1]); w.y = pk2(a[2], a[3]); w.z = pk2(b[0], b[1]); w.w = pk2(b[2], b[3]);
        *(u32x4*)(dst + i * 8) = w;
    }
}
DI int rel_bucket(int n) {
    if (n < 16) return n;
    int large = 16 + (int)(logf((float)n / 16.0f) / 4.852030263919617f * 16.0f);
    return large < 31 ? large : 31;
}
DI void phase_convert(const Args& a, unsigned char* shm, const int tid) {
    bf16_t* wb = (bf16_t*)(a.ws + WS_WB);
    for (int l = 0; l < 2; ++l) {
        bf16_t* w = wb + (size_t)l * W_LAYER;
        convT(shm, a.in[2] + (size_t)l * 1024 * 3528, 1024, 3528, w + WO_IN, NWIN, 1, tid);
        convT(shm, a.in[3] + (size_t)l * 1024 * 3072, 1024, 3072, w + WO_G, 3072, 0, tid);
        convT(shm, a.in[4] + (size_t)l * 384 * 1024, 384, 1024, w + WO_BA, 1024, 0, tid);
        convT(shm, a.in[5] + (size_t)l * 256 * 1024, 256, 1024, w + WO_BB, 1024, 0, tid);
        convT(shm, a.in[6] + (size_t)l * 384 * 1024, 384, 1024, w + WO_BC, 1024, 0, tid);
        convT(shm, a.in[7] + (size_t)l * 1024 * 1024, 1024, 1024, w + WO_OUT, 1024, 0, tid);
        convT(shm, a.in[10] + (size_t)l * 1024 * 4096, 1024, 4096, w + WO_UP, 4096, 0, tid);
        convT(shm, a.in[11] + (size_t)l * 4096 * 1024, 4096, 1024, w + WO_DN, 1024, 0, tid);
        convT(shm, a.in[12] + (size_t)l * 1024 * 1024, 1024, 1024, w + WO_PG, 1024, 0, tid);
        convT(shm, a.in[13] + (size_t)l * 256 * 1024, 256, 1024, w + WO_PL, 1024, 0, tid);
    }
    conv_vec(a.in[0], (bf16_t*)(a.ws + WS_XB), (size_t)MTOK * 1024 / 8, tid);
    conv_vec(a.in[1], (bf16_t*)(a.ws + WS_PB), (size_t)2 * MTOK * 256 / 8, tid);
    float* lut = (float*)(a.ws + WS_LUT);
    const float* rb = a.in[16];
    for (int i = blockIdx.x * 512 + tid; i < 24 * 2048; i += gridDim.x * 512) {
        const int hd = i >> 11, d = i & 2047;
        lut[i] = rb[rel_bucket(d) * 24 + hd] * LOG2E;
    }
}

DI float wave_sum(float v) {
#pragma unroll
    for (int o = 32; o >= 1; o >>= 1) v += __shfl_xor(v, o);
    return v;
}
template <bool FINAL>
DI void phase_ln(float* y, bf16_t* xb, float* stats, const float* g, const float* b, const int tid) {
    const int wid = tid >> 6, lane = tid & 63;
    f32x4 gv[4], bv[4];
#pragma unroll
    for (int k = 0; k < 4; ++k) { gv[k] = *(const f32x4*)(g + k * 256 + lane * 4); bv[k] = *(const f32x4*)(b + k * 256 + lane * 4); }
    for (int row = blockIdx.x * 8 + wid; row < MTOK; row += gridDim.x * 8) {
        float* yp = y + (size_t)row * 1024;
        f32x4 v[4]; float s = 0.f;
#pragma unroll
        for (int k = 0; k < 4; ++k) { v[k] = *(const f32x4*)(yp + k * 256 + lane * 4); s += v[k][0] + v[k][1] + v[k][2] + v[k][3]; }
        const float mean = wave_sum(s) * (1.0f / 1024.0f);
        float q = 0.f;
#pragma unroll
        for (int k = 0; k < 4; ++k) { v[k] = v[k] - mean; q += v[k][0] * v[k][0] + v[k][1] * v[k][1] + v[k][2] * v[k][2] + v[k][3] * v[k][3]; }
        const float var = wave_sum(q) * (1.0f / 1024.0f);
        const float rs = 1.0f / sqrtf(var + 1e-5f);
        if (!FINAL && lane == 0) { f32x2 sm = {mean, rs}; *(f32x2*)(stats + 2 * (size_t)row) = sm; }
#pragma unroll
        for (int k = 0; k < 4; ++k) { const f32x4 o = v[k] * rs * gv[k] + bv[k];
            if (FINAL) *(f32x4*)(yp + k * 256 + lane * 4) = o;
            else { u32x2 w; w.x = pk2(o[0], o[1]); w.y = pk2(o[2], o[3]); *(u32x2*)(xb + (size_t)row * 1024 + k * 256 + lane * 4) = w; } }
    }
}

DI int pi_row(int r) { return (r & 3) | (((r >> 3) & 1) << 2) | (((r >> 2) & 1) << 3) | (r & 16); }
DI void task_rot(int tau, int& b, int& qt) { b = tau >> 6; qt = ((tau & 63) + 8 * (tau >> 8)) & 63; }
DI bool task_map(int k, int& b, int& qt) {
    if (gridDim.x == 256) { if (k >= 8) return false; const int xcd = blockIdx.x & 7, slot = blockIdx.x >> 3; b = xcd + 8 * (k >> 1); qt = (k & 1) ? 63 - slot : slot; return true; }
    const int tau = blockIdx.x + k * gridDim.x; if (tau >= 2048) return false; task_rot(tau, b, qt); return true;
}

DI void a1_task(unsigned char* shm, const bf16_t* prm, const bf16_t* prt, unsigned* mask, int b, int qt, const int tid) {
    const int wid = __builtin_amdgcn_readfirstlane(tid >> 6), lane = tid & 63, r = lane & 31, h = lane >> 5;
    const int t0 = qt * 32, tok0 = b * SEQ;
    unsigned* cnt = (unsigned*)(shm + 33280);
    { u32x4 t[4];
#pragma unroll
      for (int p = 0; p < 4; ++p) { const int c = tid + p * 512, row = c >> 6, ch = c & 63; t[p] = *(const u32x4*)(prm + (size_t)(tok0 + t0 + row) * RM_LD + C_IQ + ch * 8); }
#pragma unroll
      for (int p = 0; p < 4; ++p) { const int c = tid + p * 512, row = c >> 6, ch = c & 63; *(u32x4*)(shm + row * 1040 + ch * 16) = t[p]; } }
    cnt[tid] = 0u; cnt[tid + 512] = 0u;
    float* wqs = (float*)(shm + 33280 + 4096);
    if (tid < 256) wqs[tid] = bf2f(prt[(size_t)(R_IW + (tid >> 5)) * MTOK + tok0 + t0 + (tid & 31)]);
    __syncthreads();
    unsigned key[8][16];
    const bf16_t* kp = prm + (size_t)(tok0 + pi_row(r)) * RM_LD + C_IK + 8 * h;
    bf16x8 kf[4];
    if (wid <= qt) {
#pragma unroll
        for (int ks = 0; ks < 4; ++ks) kf[ks] = *(const bf16x8*)(kp + (size_t)(wid * 32) * RM_LD + 16 * ks);
    }
#pragma unroll
    for (int jt = 0; jt < 8; ++jt) {
        const int kt = wid + 8 * jt;
        if (kt <= qt) {
            const int s0 = kt * 32;
            bf16x8 kn[4];
            const bool hn = (jt < 7) && (kt + 8 <= qt);
            if (hn) {
#pragma unroll
                for (int ks = 0; ks < 4; ++ks) kn[ks] = *(const bf16x8*)(kp + (size_t)(s0 + 256) * RM_LD + 16 * ks);
            }
            float idx[16];
#pragma unroll
            for (int i = 0; i < 16; ++i) idx[i] = 0.f;
#pragma unroll 2
            for (int hh = 0; hh < 8; ++hh) {
                f32x16 acc;
#pragma unroll
                for (int i = 0; i < 16; ++i) acc[i] = 0.f;
                const unsigned char* qb = shm + r * 1040 + hh * 128 + 16 * h;
#pragma unroll
                for (int ks = 0; ks < 4; ++ks) { const bf16x8 qf = *(const bf16x8*)(qb + 32 * ks); acc = MFMA32(kf[ks], qf, acc); }
                const float wv = wqs[hh * 32 + r];
#pragma unroll
                for (int i = 0; i < 16; ++i) idx[i] = fmaf(wv, fmaxf(acc[i], 0.f), idx[i]);
            }
#pragma unroll
            for (int i = 0; i < 16; ++i) {
                const int s = s0 + 16 * (i >> 3) + 8 * h + (i & 7);
                const unsigned u = __float_as_uint(idx[i] + 0.0f);
                const unsigned k = (u & 0x80000000u) ? ~u : (u | 0x80000000u);
                key[jt][i] = (s <= t0 + r) ? k : 0u;
            }
            if (hn) {
#pragma unroll
                for (int ks = 0; ks < 4; ++ks) kf[ks] = kn[ks];
            }
        } else {
#pragma unroll
            for (int i = 0; i < 16; ++i) key[jt][i] = 0u;
        }
    }
    unsigned T = 0u;
    if (qt >= 8) {
        const int nheld = (qt >= wid) ? ((qt - wid) >> 3) + 1 : 0;
        bool done = false;
        for (int bit = 31; bit >= 0; --bit) {
            const unsigned cand = T | (1u << bit);
            int c = 0;
#pragma unroll
            for (int jt = 0; jt < 8; ++jt) {
                if (jt < nheld) {
#pragma unroll
                    for (int i = 0; i < 16; ++i) c += (key[jt][i] >= cand) ? 1 : 0;
                }
            }
            c += __shfl_xor(c, 32);
            if (h == 0 && c) atomicAdd(&cnt[(31 - bit) * 32 + r], (unsigned)c);
            __syncthreads();
            const unsigned tot = cnt[(31 - bit) * 32 + r];
            if (!done) { if (tot >= 256u) T = cand; if (tot == 256u) done = true; }
            if (__ballot(!done) == 0ull) break;
        }
    }
    if (T < 1u) T = 1u;
#pragma unroll
    for (int jt = 0; jt < 8; ++jt) {
        const int kt = wid + 8 * jt;
        if (kt <= qt) {
            unsigned part = 0u;
#pragma unroll
            for (int i = 0; i < 16; ++i) part |= (key[jt][i] >= T ? 1u : 0u) << (16 * (i >> 3) + 8 * h + (i & 7));
            part |= (unsigned)__shfl_xor((int)part, 32);
            if (h == 0) mask[(size_t)(tok0 + t0 + r) * 64 + kt] = part;
        }
    }
    __syncthreads();
}
DI void g2_job(const Args& a, unsigned char* wsh, LAS unsigned char* wl, int b, int slot, int cls, int it, const int tid);
DI void phase_a1(const Args& a, unsigned char* shm, const int tid) {
    const bf16_t* prm = (const bf16_t*)(a.ws + WS_R1);
    const bf16_t* prt = prm + (size_t)MTOK * RM_LD;
    unsigned* mask = (unsigned*)(a.ws + WS_MASK);
    float* kmean = (float*)(a.ws + WS_KMEAN);
    for (int k = 0;; ++k) { int b, qt; if (!task_map(k, b, qt)) break; a1_task(shm, prm, prt, mask, b, qt, tid); }
    for (int j = 2048 + blockIdx.x; j < 2048 + 192; j += gridDim.x) {
        {
            const int id = (j - 2048) * 8 + (tid >> 6), lane = tid & 63;
            const int b = id / 48, hd = (id >> 3) % 6, n = id & 7;
            const int c8 = lane & 7, rr = lane >> 3;
            const bf16_t* p = prm + (size_t)(b * SEQ + n * 256 + rr) * RM_LD + C_CK + hd * 64 + 8 * c8;
            float acc[8];
#pragma unroll
            for (int e = 0; e < 8; ++e) acc[e] = 0.f;
#pragma unroll 1
            for (int t0 = 0; t0 < 256; t0 += 64) {
                u32x4 v[8];
#pragma unroll
                for (int q = 0; q < 8; ++q) v[q] = *(const u32x4*)(p + (size_t)(t0 + 8 * q) * RM_LD);
#pragma unroll
                for (int q = 0; q < 8; ++q) { acc[0] += bf_lo(v[q].x); acc[1] += bf_hi(v[q].x); acc[2] += bf_lo(v[q].y); acc[3] += bf_hi(v[q].y);
                                              acc[4] += bf_lo(v[q].z); acc[5] += bf_hi(v[q].z); acc[6] += bf_lo(v[q].w); acc[7] += bf_hi(v[q].w); }
            }
#pragma unroll
            for (int e = 0; e < 8; ++e) { acc[e] += __shfl_xor(acc[e], 8); acc[e] += __shfl_xor(acc[e], 16); acc[e] += __shfl_xor(acc[e], 32); }
            if (rr == 0) {
                float* kd = kmean + (size_t)((b * 6 + hd) * 8 + n) * 64 + 8 * c8;
                *(f32x4*)kd = (f32x4){acc[0], acc[1], acc[2], acc[3]} * (1.0f / 256.0f);
                *(f32x4*)(kd + 4) = (f32x4){acc[4], acc[5], acc[6], acc[7]} * (1.0f / 256.0f);
            }
        }
    }
    __syncthreads();
    {
        const int wid = __builtin_amdgcn_readfirstlane(tid >> 6);
        unsigned char* wsh = shm + wid * 16384;
        LAS unsigned char* wl = (LAS unsigned char*)shm + wid * 16384;
        for (int j = blockIdx.x; j < 1024; j += gridDim.x) {
            const int id = j * 8 + wid;
            g2_job(a, wsh, wl, id >> 8, (id >> 6) & 3, (id >> 2) & 15, id & 3, tid);
        }
    }
    __syncthreads();
}


struct AttnSt { float m, l; f32x16 o0, o1; };
struct AttnCtx {
    LAS unsigned char* wl;
    const float* lut;
    const bf16_t* kg;
    const bf16_t* vg;
    unsigned koff[4], voff[4];
    int kfo[4], vfo[2][2];
    int krs;
};
DI void attn_dma(const AttnCtx& c, int kt) {
    const char* kb = (const char*)(c.kg + (size_t)(kt * 32 * c.krs) * RM_LD);
    const char* vb = (const char*)(c.vg + kt * 32);
#pragma unroll
    for (int j = 0; j < 4; ++j) __builtin_amdgcn_global_load_lds((const unsigned*)(kb + c.koff[j]), (LAS unsigned*)(c.wl + j * 1024), 16, 0, 0);
#pragma unroll
    for (int j = 0; j < 4; ++j) __builtin_amdgcn_global_load_lds((const unsigned*)(vb + c.voff[j]), (LAS unsigned*)(c.wl + 4096 + j * 1024), 16, 0, 0);
}
template <int MODE, bool UNI>
DI void attn_compute(const bf16x8 (&qf)[4], const bf16x8 (&kf)[4], const bf16x8 (&vf)[2][2], int kt, int d00, const float* lut, float ubias, AttnSt& st,
                     unsigned W, int win, int dmask, bool lane_sel) {
    const int s0 = kt * 32;
    const int d0 = d00 - s0;
    const LAS float* lb = (const LAS float*)lut + ((MODE == 4) ? 16 * (d0 - 23) : (d0 - 23));
    float bia[16];
    if (!UNI) {
#pragma unroll
        for (int i = 0; i < 16; ++i) { const int ci = 16 * (i >> 3) + (i & 7); bia[i] = (MODE == 4) ? lb[16 * (23 - ci)] : lb[23 - ci]; }
    }
    f32x16 sx;
#pragma unroll
    for (int i = 0; i < 16; ++i) sx[i] = 0.f;
#pragma unroll
    for (int ks = 0; ks < 4; ++ks) sx = MFMA32(kf[ks], qf[ks], sx);
    asm volatile("s_waitcnt lgkmcnt(0)" ::: "memory");
    float sv[16]; float mx = NEGF;
#pragma unroll
    for (int i = 0; i < 16; ++i) {
        const int ci = 16 * (i >> 3) + (i & 7);
        const int dist = d0 - ci;
        bool v;
        if (MODE == 0) v = ((W >> ci) & 1u) != 0u;
        else if (MODE == 1) v = ((unsigned)dist <= (unsigned)win) && ((dist & dmask) == 0);
        else if (MODE == 2) v = lane_sel;
        else v = dist >= 0;
        const float bias = UNI ? ubias : bia[i];
        float s = fmaf(sx[i], SC2, bias);
        if (MODE == 0) { const unsigned t = (unsigned)__builtin_amdgcn_sbfe((int)W, ci, 1);
            s = __uint_as_float((__float_as_uint(s) & t) | (__float_as_uint(NEGF) & ~t)); }
        else s = v ? s : NEGF;
        sv[i] = s; mx = fmaxf(mx, s);
    }
    mx = fmaxf(mx, __shfl_xor(mx, 32));
    const float mnew = fmaxf(st.m, mx);
    const float msafe = (mnew > -1e29f) ? mnew : 0.f;
    if (__ballot(mnew > st.m) != 0ull) {
        const float alpha = __builtin_amdgcn_exp2f(st.m - msafe);
        st.l *= alpha; st.m = mnew;
#pragma unroll
        for (int i = 0; i < 16; ++i) { st.o0[i] *= alpha; st.o1[i] *= alpha; }
    }
    float ps = 0.f; float p[16];
#pragma unroll
    for (int i = 0; i < 16; ++i) { const float e = __builtin_amdgcn_exp2f(sv[i] - msafe); p[i] = e; ps += e; }
    st.l += ps;
    u32x4 w0, w1;
    w0.x = pk2(p[0], p[1]); w0.y = pk2(p[2], p[3]); w0.z = pk2(p[4], p[5]); w0.w = pk2(p[6], p[7]);
    w1.x = pk2(p[8], p[9]); w1.y = pk2(p[10], p[11]); w1.z = pk2(p[12], p[13]); w1.w = pk2(p[14], p[15]);
    const bf16x8 pf0 = __builtin_bit_cast(bf16x8, w0), pf1 = __builtin_bit_cast(bf16x8, w1);
    st.o0 = MFMA32(vf[0][0], pf0, st.o0); st.o0 = MFMA32(vf[0][1], pf1, st.o0);
    st.o1 = MFMA32(vf[1][0], pf0, st.o1); st.o1 = MFMA32(vf[1][1], pf1, st.o1);
}
DI void attn_compute_sp4(const bf16x8 (&qf)[4], const bf16x8 (&kf)[4], const bf16x8 (&vf)[2][2], int kt, int d00, const float* lut, AttnSt& st, int win, int dmask) {
    const int s0 = kt * 32;
    f32x16 sx;
#pragma unroll
    for (int i = 0; i < 16; ++i) sx[i] = 0.f;
#pragma unroll
    for (int ks = 0; ks < 4; ++ks) sx = MFMA32(kf[ks], qf[ks], sx);
    const int d0 = d00 - s0, e = d0 & 3;
    const bool e0 = (e == 0), e1 = (e == 1), e2 = (e == 2);
    const LAS float* lb = (const LAS float*)lut + (d0 - e - 20);
    float sv[4]; float mx = NEGF;
#pragma unroll
    for (int g = 0; g < 4; ++g) {
        const float x = e0 ? sx[4 * g] : (e1 ? sx[4 * g + 1] : (e2 ? sx[4 * g + 2] : sx[4 * g + 3]));
        const int dist = d0 - (16 * (g >> 1) + 4 * (g & 1)) - e;
        const bool v = ((unsigned)dist <= (unsigned)win) && ((dist & dmask) == 0);
        const float bias = lb[20 - (16 * (g >> 1) + 4 * (g & 1))];
        float sc = fmaf(x, SC2, bias);
        sc = v ? sc : NEGF;
        sv[g] = sc; mx = fmaxf(mx, sc);
    }
    mx = fmaxf(mx, __shfl_xor(mx, 32));
    const float mnew = fmaxf(st.m, mx);
    const float msafe = (mnew > -1e29f) ? mnew : 0.f;
    if (__ballot(mnew > st.m) != 0ull) {
        const float alpha = __builtin_amdgcn_exp2f(st.m - msafe);
        st.l *= alpha; st.m = mnew;
#pragma unroll
        for (int i = 0; i < 16; ++i) { st.o0[i] *= alpha; st.o1[i] *= alpha; }
    }
    float ps = 0.f; float p[16];
#pragma unroll
    for (int g = 0; g < 4; ++g) {
        const float pe = __builtin_amdgcn_exp2f(sv[g] - msafe); ps += pe;
        p[4 * g] = e0 ? pe : 0.f; p[4 * g + 1] = e1 ? pe : 0.f; p[4 * g + 2] = e2 ? pe : 0.f; p[4 * g + 3] = (e == 3) ? pe : 0.f;
    }
    st.l += ps;
    u32x4 w0, w1;
    w0.x = pk2(p[0], p[1]); w0.y = pk2(p[2], p[3]); w0.z = pk2(p[4], p[5]); w0.w = pk2(p[6], p[7]);
    w1.x = pk2(p[8], p[9]); w1.y = pk2(p[10], p[11]); w1.z = pk2(p[12], p[13]); w1.w = pk2(p[14], p[15]);
    const bf16x8 pf0 = __builtin_bit_cast(bf16x8, w0), pf1 = __builtin_bit_cast(bf16x8, w1);
    st.o0 = MFMA32(vf[0][0], pf0, st.o0); st.o0 = MFMA32(vf[0][1], pf1, st.o0);
    st.o1 = MFMA32(vf[1][0], pf0, st.o1); st.o1 = MFMA32(vf[1][1], pf1, st.o1);
}
template <int MODE>
DI void attn_range(const AttnCtx& c, const bf16x8 (&qf)[4], int lo, int hi, int t0, int d00, AttnSt& st, const unsigned* maskrow, int h8, int win, int dmask, bool lane_sel) {
    if (lo > hi) return;
    attn_dma(c, lo);
    unsigned Wn = 0u;
    if (MODE == 0) Wn = maskrow[lo];
#pragma unroll 1
    for (int kt = lo; kt <= hi; ++kt) {
        asm volatile("s_waitcnt vmcnt(0)" ::: "memory");
        bf16x8 kf[4], vf[2][2];
#pragma unroll
        for (int ks = 0; ks < 4; ++ks) kf[ks] = *(const LAS bf16x8*)(c.wl + c.kfo[ks]);
#pragma unroll
        for (int mt = 0; mt < 2; ++mt)
#pragma unroll
            for (int s = 0; s < 2; ++s) vf[mt][s] = *(const LAS bf16x8*)(c.wl + 4096 + c.vfo[mt][s]);
        const unsigned W = Wn >> h8;
        const int dlo = t0 - kt * 32 - 31;
        float ub = 0.f; bool uni = false;
        if (dlo >= 182) { const unsigned ua = __builtin_amdgcn_readfirstlane(__float_as_uint(c.lut[dlo])), ue = __builtin_amdgcn_readfirstlane(__float_as_uint(c.lut[dlo + 62])); uni = (ua == ue); ub = __uint_as_float(ua); }
        asm volatile("s_waitcnt lgkmcnt(0)" ::: "memory");
        if (kt < hi) { attn_dma(c, kt + 1); if (MODE == 0) Wn = maskrow[kt + 1]; }
        if (MODE == 1 && dmask != 0) attn_compute_sp4(qf, kf, vf, kt, d00, c.lut, st, win, dmask);
        else attn_compute<MODE, false>(qf, kf, vf, kt, d00, c.lut, 0.f, st, W, win, dmask, lane_sel);
    }
}

DI void load_lut(float* lut, const float* glut, int col, int lane) {
    __builtin_amdgcn_fence(__ATOMIC_ACQ_REL, "wavefront");
    f32x4 t[8];
#pragma unroll
    for (int k = 0; k < 8; ++k) t[k] = *(const f32x4*)(glut + (size_t)col * 2048 + k * 256 + lane * 4);
#pragma unroll
    for (int k = 0; k < 8; ++k) *(f32x4*)(lut + k * 256 + lane * 4) = t[k];
    __builtin_amdgcn_fence(__ATOMIC_ACQ_REL, "wavefront");
    __builtin_amdgcn_wave_barrier();
}

DI void attn_job(const Args& a, unsigned char* wsh, LAS unsigned char* wl, int type, int b, int qt, int hd, const int tid) {
    const int lane = tid & 63, r = lane & 31, h = lane >> 5;
    const bf16_t* prm = (const bf16_t*)(a.ws + WS_R1);
    const bf16_t* prt = prm + (size_t)MTOK * RM_LD;
    const float* glut = (const float*)(a.ws + WS_LUT);
    const unsigned* mask = (const unsigned*)(a.ws + WS_MASK);
    const float* kmean = (const float*)(a.ws + WS_KMEAN);
    bf16_t* oabc = (bf16_t*)(a.ws + WS_OABC);
    float* lut = (float*)(wsh + 8192);
    const int t0 = qt * 32, tok0 = b * SEQ;
    const int d00 = t0 + r - 8 * h, h8 = 8 * h;
    const unsigned* maskrow = mask + (size_t)(tok0 + t0 + r) * 64;
    AttnCtx c; c.wl = wl; c.lut = lut; c.krs = 1;
#pragma unroll
    for (int j = 0; j < 4; ++j) {
        const int rk = 8 * j + (lane >> 3), ck = (lane & 7) ^ ((rk >> 1) & 7);
        c.koff[j] = (unsigned)(pi_row(rk) * RM_LD + ck * 8) * 2u;
        const int rv = 16 * j + (lane >> 2), cv = (lane & 3) ^ ((rv >> 2) & 3);
        c.voff[j] = (unsigned)(rv * MTOK + cv * 8) * 2u;
        c.kfo[j] = r * 128 + (((2 * j + h) ^ ((r >> 1) & 7)) * 16);
    }
#pragma unroll
    for (int mt = 0; mt < 2; ++mt)
#pragma unroll
        for (int s = 0; s < 2; ++s) c.vfo[mt][s] = (32 * mt + r) * 64 + (((2 * s + h) ^ ((r >> 2) & 3)) * 16);
    AttnSt st; st.m = NEGF; st.l = 0.f;
#pragma unroll
    for (int i = 0; i < 16; ++i) { st.o0[i] = 0.f; st.o1[i] = 0.f; }
    const int ng = (type == 1) ? 2 : 1;
    int ocol = 0;
    for (int g = 0; g < ng; ++g) {
        int qcol, kcol, vrow, bcol;
        if (type == 0) { qcol = C_AQ + hd * 64; kcol = C_AK; vrow = R_AV; bcol = hd; ocol = hd * 64; }
        else if (type == 1) { qcol = C_BQ + (g * 4 + hd) * 64; kcol = C_BK + hd * 64; vrow = R_BV + hd * 64; bcol = 6 + g * 4 + hd; ocol = 384 + hd * 64; }
        else { qcol = C_CQ + hd * 64; kcol = C_CK + hd * 64; vrow = R_CV + hd * 64; bcol = 18 + hd; ocol = 640 + hd * 64; }
        load_lut(lut, glut, bcol, lane);
        bf16x8 qf[4];
        const bf16_t* qp = prm + (size_t)(tok0 + t0 + r) * RM_LD + qcol + 8 * h;
#pragma unroll
        for (int ks = 0; ks < 4; ++ks) qf[ks] = *(const bf16x8*)(qp + 16 * ks);
        c.kg = prm + (size_t)tok0 * RM_LD + kcol;
        c.vg = prt + (size_t)vrow * MTOK + tok0;
        if (type == 0) {
            attn_range<0>(c, qf, 0, qt, t0, d00, st, maskrow, h8, 0, 0, false);
        } else if (type == 1) {
            const int win = (g == 0) ? 128 : (g == 1 ? 512 : 2048), dmask = (g == 0) ? 0 : (g == 1 ? 3 : 15);
            int lo = t0 - win; if (lo < 0) lo = 0;
            attn_range<1>(c, qf, lo >> 5, qt, t0, d00, st, maskrow, h8, win, dmask, false);
        } else {
            const int cur = qt >> 3;
            float gate[7];
            const float* km = kmean + (size_t)((b * 6 + hd) * 8) * 64 + 8 * h;
#pragma unroll
            for (int n = 0; n < 7; ++n) {
                float s = 0.f;
                if (n < cur) {
#pragma unroll
                    for (int ks = 0; ks < 4; ++ks) {
                        const f32x4 k0 = *(const f32x4*)(km + n * 64 + 16 * ks), k1 = *(const f32x4*)(km + n * 64 + 16 * ks + 4);
                        const u32x4 qw = __builtin_bit_cast(u32x4, qf[ks]);
                        s += bf_lo(qw.x) * k0[0] + bf_hi(qw.x) * k0[1] + bf_lo(qw.y) * k0[2] + bf_hi(qw.y) * k0[3]
                           + bf_lo(qw.z) * k1[0] + bf_hi(qw.z) * k1[1] + bf_lo(qw.w) * k1[2] + bf_hi(qw.w) * k1[3];
                    }
                    s += __shfl_xor(s, 32);
                } else s = -__builtin_inff();
                gate[n] = s;
            }
            unsigned sel = 0u;
#pragma unroll
            for (int rd = 0; rd < 3; ++rd) {
                float bv = -__builtin_inff(); int bi = -1;
#pragma unroll
                for (int n = 0; n < 7; ++n) if (gate[n] > bv) { bv = gate[n]; bi = n; }
                if (bi >= 0) sel |= 1u << bi;
#pragma unroll
                for (int n = 0; n < 7; ++n) if (n == bi) gate[n] = -__builtin_inff();
            }
            for (int n = 0; n < cur; ++n) {
                const bool ls = ((sel >> n) & 1u) != 0u;
                if (__ballot(ls) == 0ull) continue;
                attn_range<2>(c, qf, n * 8, n * 8 + 7, t0, d00, st, maskrow, h8, 0, 0, ls);
            }
            attn_range<3>(c, qf, cur * 8, qt, t0, d00, st, maskrow, h8, 0, 0, false);
        }
    }
    float lt = st.l + __shfl_xor(st.l, 32);
    if (type == 1) {
        const float* pp = (const float*)(a.ws + WS_G2) + ((size_t)(tok0 + t0 + r) * 4 + hd) * 68;
        const f32x2 ml = *(const f32x2*)(pp + 64);
        const float mn = fmaxf(st.m, ml[0]);
        const float a1 = __builtin_amdgcn_exp2f(st.m - mn), a2 = __builtin_amdgcn_exp2f(ml[0] - mn);
        lt = lt * a1 + ml[1] * a2;
#pragma unroll
        for (int g4 = 0; g4 < 4; ++g4) {
            const f32x4 p0 = *(const f32x4*)(pp + 8 * g4 + 4 * h), p1 = *(const f32x4*)(pp + 32 + 8 * g4 + 4 * h);
#pragma unroll
            for (int e = 0; e < 4; ++e) { st.o0[4 * g4 + e] = st.o0[4 * g4 + e] * a1 + p0[e] * a2; st.o1[4 * g4 + e] = st.o1[4 * g4 + e] * a1 + p1[e] * a2; }
        }
    }
    const float inv = 1.0f / lt;
    bf16_t* op = oabc + (size_t)(tok0 + t0 + r) * 1024 + ocol + 4 * h;
#pragma unroll
    for (int g4 = 0; g4 < 4; ++g4) {
        u32x2 w;
        w.x = pk2(st.o0[4 * g4] * inv, st.o0[4 * g4 + 1] * inv); w.y = pk2(st.o0[4 * g4 + 2] * inv, st.o0[4 * g4 + 3] * inv);
        *(u32x2*)(op + 8 * g4) = w;
        w.x = pk2(st.o1[4 * g4] * inv, st.o1[4 * g4 + 1] * inv); w.y = pk2(st.o1[4 * g4 + 2] * inv, st.o1[4 * g4 + 3] * inv);
        *(u32x2*)(op + 32 + 8 * g4) = w;
    }
}
DI void g2_job(const Args& a, unsigned char* wsh, LAS unsigned char* wl, int b, int slot, int cls, int it, const int tid) {
    const int lane = tid & 63, r = lane & 31, h = lane >> 5;
    const bf16_t* prm = (const bf16_t*)(a.ws + WS_R1);
    const bf16_t* vt16 = (const bf16_t*)(a.ws + WS_VT16);
    const float* glut = (const float*)(a.ws + WS_LUT);
    float* lut = (float*)(wsh + 8192);
    const int tok0 = b * SEQ;
    const int d00 = 32 * it + r - 8 * h;
    AttnCtx c; c.wl = wl; c.lut = lut; c.krs = 16;
#pragma unroll
    for (int j = 0; j < 4; ++j) {
        const int rk = 8 * j + (lane >> 3), ck = (lane & 7) ^ ((rk >> 1) & 7);
        c.koff[j] = (unsigned)(pi_row(rk) * 16 * RM_LD + ck * 8) * 2u;
        const int rv = 16 * j + (lane >> 2), cv = (lane & 3) ^ ((rv >> 2) & 3);
        c.voff[j] = (unsigned)(rv * MTOK + cv * 8) * 2u;
        c.kfo[j] = r * 128 + (((2 * j + h) ^ ((r >> 1) & 7)) * 16);
    }
#pragma unroll
    for (int mt = 0; mt < 2; ++mt)
#pragma unroll
        for (int s = 0; s < 2; ++s) c.vfo[mt][s] = (32 * mt + r) * 64 + (((2 * s + h) ^ ((r >> 2) & 3)) * 16);
    AttnSt st; st.m = NEGF; st.l = 0.f;
#pragma unroll
    for (int i = 0; i < 16; ++i) { st.o0[i] = 0.f; st.o1[i] = 0.f; }
    load_lut(lut, glut, 6 + 2 * 4 + slot, lane);
    const int tq = tok0 + cls + 16 * (32 * it + r);
    bf16x8 qf[4];
    const bf16_t* qp = prm + (size_t)tq * RM_LD + C_BQ + (2 * 4 + slot) * 64 + 8 * h;
#pragma unroll
    for (int ks = 0; ks < 4; ++ks) qf[ks] = *(const bf16x8*)(qp + 16 * ks);
    c.kg = prm + (size_t)(tok0 + cls) * RM_LD + C_BK + slot * 64;
    c.vg = vt16 + (size_t)(slot * 64) * MTOK + tok0 + cls * 128;
    attn_range<4>(c, qf, 0, it, 0, d00, st, nullptr, 0, 0, 0, false);
    const float lt = st.l + __shfl_xor(st.l, 32);
    float* pp = (float*)(a.ws + WS_G2) + ((size_t)tq * 4 + slot) * 68;
#pragma unroll
    for (int g4 = 0; g4 < 4; ++g4) {
        f32x4 p0, p1;
#pragma unroll
        for (int e = 0; e < 4; ++e) { p0[e] = st.o0[4 * g4 + e]; p1[e] = st.o1[4 * g4 + e]; }
        *(f32x4*)(pp + 8 * g4 + 4 * h) = p0; *(f32x4*)(pp + 32 + 8 * g4 + 4 * h) = p1;
    }
    if (h == 0) { f32x2 ml = {st.m, lt}; *(f32x2*)(pp + 64) = ml; }
}
DI void phase_attn(const Args& a, unsigned char* shm, const int tid) {
    const int wid = __builtin_amdgcn_readfirstlane(tid >> 6);
    unsigned char* wsh = shm + wid * 16384;
    LAS unsigned char* wl = (LAS unsigned char*)shm + wid * 16384;
    for (int it = 0;; ++it) {
        int b, qt; if (!task_map(it, b, qt)) break;
        const int role = (wid + it) & 7;
        if (role < 6) { attn_job(a, wsh, wl, 0, b, qt, role, tid); attn_job(a, wsh, wl, 2, b, qt, role, tid); }
        else { attn_job(a, wsh, wl, 1, b, qt, role - 6, tid); attn_job(a, wsh, wl, 1, b, qt, role - 4, tid); }
    }
}

#define XB_TMO      128
#define XB_XCNT(j)  (256  + 64 * (j))
#define XB_XSUB(j)  (1280 + 64 * (j))
#define XB_XGEN(j)  (2304 + 64 * (j))
#define XB_TOP      3328
#define XB_TOPGEN   3392
#define XCD_BAR_WORDS 3456
#define XB_SPIN_CAP (1u << 20)
DI unsigned xb_ld(unsigned* p)              { return __hip_atomic_load(p, __ATOMIC_RELAXED, __HIP_MEMORY_SCOPE_AGENT); }
DI unsigned xb_add(unsigned* p, unsigned v) { return __hip_atomic_fetch_add(p, v, __ATOMIC_RELAXED, __HIP_MEMORY_SCOPE_AGENT); }
DI unsigned xb_xcc_id() { return (unsigned)__builtin_amdgcn_s_getreg((3 << 11) | 20) & 0xFu; }
#define XB_SPIN(cond, bar) do { unsigned _sp = 0; while (cond) { __builtin_amdgcn_s_sleep(1); \
    if ((++_sp & 255u) == 0u) { if (xb_ld(&(bar)[XB_TMO])) break; if (_sp > XB_SPIN_CAP) { atomicAdd(&(bar)[XB_TMO], 1u); break; } } } } while (0)
struct XcdBarrier { unsigned* bar; unsigned x; volatile LAS unsigned* st; };
DI void xcd_barrier_complete(unsigned* bar, unsigned x, unsigned& nloc, unsigned& nx) {
    const unsigned G = gridDim.x * gridDim.y * gridDim.z;
    unsigned sum, cnt, mine, sp = 0u;
    for (;;) {
        sum = 0u; cnt = 0u; mine = 0u;
#pragma unroll
        for (unsigned j = 0; j < 16; ++j) { const unsigned c = xb_ld(&bar[XB_XCNT(j)]); sum += c; cnt += (c > 0u) ? 1u : 0u; mine = (j == x) ? c : mine; }
        if (sum == G) break;
        __builtin_amdgcn_s_sleep(1);
        if ((++sp & 255u) == 0u) { if (xb_ld(&bar[XB_TMO])) break; if (sp > XB_SPIN_CAP) { atomicAdd(&bar[XB_TMO], 1u); break; } }
    }
    nloc = mine > 0u ? mine : 1u; nx = cnt > 0u ? cnt : 1u;
}
DI void xcd_barrier(const XcdBarrier& b, const int tid) {
    asm volatile("s_waitcnt vmcnt(0)" ::: "memory");
    __syncthreads();
    if (tid == 0) {
        unsigned* bar = b.bar;
        __builtin_amdgcn_s_waitcnt(0);
        unsigned nloc = b.st[0], nx = b.st[1];
        if (nloc == 0u) { xcd_barrier_complete(bar, b.x, nloc, nx); b.st[0] = nloc; b.st[1] = nx; }
        const unsigned old = xb_add(&bar[XB_XSUB(b.x)], 1u);
        const unsigned gen = old / nloc;
        if (old + 1u == (gen + 1u) * nloc) {
            __builtin_amdgcn_fence(__ATOMIC_RELEASE, "agent");
            asm volatile("s_waitcnt vmcnt(0)" ::: "memory");
            const unsigned og = xb_add(&bar[XB_TOP], 1u);
            const unsigned tg = og / nx;
            if (og + 1u == (tg + 1u) * nx) xb_add(&bar[XB_TOPGEN], 1u);
            else XB_SPIN(xb_ld(&bar[XB_TOPGEN]) == tg, bar);
            __builtin_amdgcn_fence(__ATOMIC_ACQUIRE, "agent");
            xb_add(&bar[XB_XGEN(b.x)], 1u);
            asm volatile("s_waitcnt vmcnt(0)" ::: "memory");
        } else {
            XB_SPIN(xb_ld(&bar[XB_XGEN(b.x)]) == gen, bar);
            __builtin_amdgcn_fence(__ATOMIC_ACQUIRE, "agent");
            asm volatile("s_waitcnt vmcnt(0)" ::: "memory");
        }
    }
    __syncthreads();
}

__global__ void __launch_bounds__(512, 2) mega_fwd(Args a_) {
    extern __shared__ __attribute__((aligned(16))) unsigned char shm[];
    cg::grid_group grid = cg::this_grid();
    LAS unsigned char* lds = (LAS unsigned char*)shm;
    const int G = gridDim.x, c = blockIdx.x;
#ifndef PROBE_REP
#define PROBE_REP -2
#endif
    const int ph_lo = a_.ph_lo, ph_hi = a_.ph_hi;
    const int wave_id = __builtin_amdgcn_readfirstlane(threadIdx.x >> 6);
    XcdBarrier xbar;
    { volatile LAS unsigned* st = (volatile LAS unsigned*)(lds + 131072);
      if (threadIdx.x == 0) { st[0] = 0u; st[1] = 0u; }
      __syncthreads();
      xbar.bar = (unsigned*)(a_.ws + WS_BAR); xbar.x = xb_xcc_id(); xbar.st = st;
      if (threadIdx.x == 0) (void)xb_add(&xbar.bar[XB_XCNT(xbar.x)], 1u); }
    for (int phx = 2 * ph_lo; phx < 2 * ph_hi; ++phx) {
        const int ph = phx >> 1;
        if (phx & 1) { const bool rep = (PROBE_REP == -1) ? (ph == 0) : (ph > 0 && (ph - 1) % 9 == PROBE_REP); if (!rep) continue; }
        const Args& a = a_;
        int tid = wave_id * 64 + (int)__builtin_amdgcn_mbcnt_hi(~0u, __builtin_amdgcn_mbcnt_lo(~0u, 0u)); asm volatile("" : "+v"(tid));
        bf16_t* xb = (bf16_t*)(a.ws + WS_XB);
        bf16_t* r1 = (bf16_t*)(a.ws + WS_R1);
        bf16_t* oabc = (bf16_t*)(a.ws + WS_OABC);
        float* stats = (float*)(a.ws + WS_STATS);
        if (ph == 0) phase_convert(a, shm, tid);
        else {
            const int l = (ph - 1) / 9, sp = (ph - 1) % 9;
            const bf16_t* w = (const bf16_t*)(a.ws + WS_WB) + (size_t)l * W_LAYER;
            const float* xin = (l == 0) ? a.in[0] : a.out;
            if (sp == 0) {
                { pg8::Gemm g{xb, w + WO_IN, 1024, 1024, 1024, 0}; pg8::StaticOrder S; S.init(256, 11, G, c); pg8::EpiBf16<0> E{r1, RM_LD}; pg8::gemm_phase(lds, g, S, E, tid); }
                { pg8::Gemm g{w + WO_IN + (size_t)RM_LD * 1024, xb, 1024, 1024, 1024, 0}; pg8::StaticOrder S; S.init(3, 256, G, c); pg8::EpiBf16<0> E{r1 + (size_t)MTOK * RM_LD, MTOK}; pg8::gemm_phase(lds, g, S, E, tid); }
                { pg8::Gemm g{w + WO_IN + (size_t)2880 * 1024, xb, 1024, 16 * 1024, 1024, 2048}; pg8::OrderVT16 S{G, c}; pg8::EpiBf16<0> E{(bf16_t*)(a.ws + WS_VT16), MTOK}; pg8::gemm_phase(lds, g, S, E, tid); }
            } else if (sp == 1) phase_a1(a, shm, tid);
            else if (sp == 2) phase_attn(a, shm, tid);
            else if (sp == 3) {
                pg8::StaticOrder S; S.init(256, 4, G, c);
                { pg8::Gemm g{oabc, w + WO_BA, 1024, 384, 384, 0}; pg8::EpiBf16<0> E{r1, 3072}; pg8::gemm_phase(lds, g, S, E, tid); }
                { pg8::Gemm g{oabc + 384, w + WO_BB, 1024, 256, 256, 0}; pg8::EpiBf16<0> E{r1 + 1024, 3072}; pg8::gemm_phase(lds, g, S, E, tid); }
                { pg8::Gemm g{oabc + 640, w + WO_BC, 1024, 384, 384, 0}; pg8::EpiBf16<0> E{r1 + 2048, 3072}; pg8::gemm_phase(lds, g, S, E, tid); }
                { pg8::Gemm g{xb, w + WO_G, 1024, 1024, 1024, 0}; pg8::Order3 S3; S3.base = S; pg8::EpiGate E{r1, r1 + (size_t)MTOK * 3072}; pg8::gemm_phase(lds, g, S3, E, tid); }
            } else if (sp == 4) {
                pg8::Gemm g{r1 + (size_t)MTOK * 3072, w + WO_OUT, 1024, 1024, 1024, 0}; pg8::StaticOrder S; S.init(256, 4, G, c);
                if (l == 0) { pg8::EpiRes<false, false> E{xin, a.out, nullptr, nullptr, nullptr, nullptr}; pg8::gemm_phase(lds, g, S, E, tid); }
                else { pg8::EpiRes<false, true> E{xin, a.out, nullptr, stats, a.in[14], a.in[15]}; pg8::gemm_phase(lds, g, S, E, tid); }
            } else if (sp == 5) phase_ln<false>(a.out, xb, stats, a.in[8] + l * 1024, a.in[9] + l * 1024, tid);
            else if (sp == 6) {
                { pg8::Gemm g{xb, w + WO_UP, 1024, 1024, 1024, 0}; pg8::StaticOrder S; S.init(256, 16, G, c); pg8::EpiBf16<1> E{r1, 4096}; pg8::gemm_phase(lds, g, S, E, tid); }
                pg8::StaticOrder S; S.init(256, 4, G, c);
                { pg8::Gemm g{(const bf16_t*)(a.ws + WS_PB) + (size_t)l * MTOK * 256, w + WO_PL, 256, 256, 256, 0}; pg8::EpiBf16<0> E{oabc, 1024}; pg8::gemm_phase(lds, g, S, E, tid); }
                { pg8::Gemm g{xb, w + WO_PG, 1024, 1024, 1024, 0}; pg8::EpiT1 E{oabc}; pg8::gemm_phase(lds, g, S, E, tid); }
            } else if (sp == 7) {
                pg8::Gemm g{r1, w + WO_DN, 4096, 4096, 4096, 0}; pg8::StaticOrder S; S.init(256, 4, G, c);
                pg8::EpiRes<true, true> E{a.out, a.out, oabc, stats, a.in[8] + l * 1024, a.in[9] + l * 1024}; pg8::gemm_phase(lds, g, S, E, tid);
            } else { if (l == 0) phase_ln<false>(a.out, xb, stats, a.in[14], a.in[15], tid); else phase_ln<true>(a.out, xb, stats, a.in[14] + 1024, a.in[15] + 1024, tid); }
        }
        if (phx + 1 < 2 * ph_hi) { if (ph == 0) grid.sync(); else xcd_barrier(xbar, tid); }
    }
}

#ifndef N_LAUNCH_MODE
#define N_LAUNCH_MODE 1
#endif
extern "C" void kernel_launch(void* const* d_in, const int* in_sizes, int n_in, void* d_out, int out_size, void* d_ws, size_t ws_size, hipStream_t stream) {
    static int grid = 0;
    if (grid == 0) {
        if (n_in != 17 || out_size != MTOK * DM || ws_size < WS_END) { fprintf(stderr, "kernel_launch: unexpected shapes (n_in %d out %d ws %zu need %zu)\n", n_in, out_size, ws_size, (size_t)WS_END); grid = -1; return; }
        int dev = 0, cus = 0, per_cu = 0;
        hipGetDevice(&dev);
        hipDeviceGetAttribute(&cus, hipDeviceAttributeMultiprocessorCount, dev);
        if (hipFuncSetAttribute((const void*)mega_fwd, hipFuncAttributeMaxDynamicSharedMemorySize, LDS_BYTES) != hipSuccess) { fprintf(stderr, "kernel_launch: hipFuncSetAttribute failed\n"); grid = -1; return; }
        hipOccupancyMaxActiveBlocksPerMultiprocessor(&per_cu, (const void*)mega_fwd, 512, LDS_BYTES);
        if (per_cu < 1) { fprintf(stderr, "kernel_launch: occupancy query says %d\n", per_cu); per_cu = 1; }
        (void)hipGetLastError();
        grid = cus * per_cu;
    }
    if (grid < 0) return;
    if (hipMemsetAsync((char*)d_ws + WS_BAR, 0, (size_t)3456 * 4, stream) != hipSuccess) { fprintf(stderr, "kernel_launch: memset of the barrier words failed\n"); return; }
    Args a{};
    for (int i = 0; i < 17; ++i) a.in[i] = (const float*)d_in[i];
    a.out = (float*)d_out; a.ws = (unsigned char*)d_ws;
#if N_LAUNCH_MODE == 0
    for (int ph = 0; ph < 19; ++ph) {
        a.ph_lo = ph; a.ph_hi = ph + 1;
        hipLaunchKernelGGL(mega_fwd, dim3(grid), dim3(512), LDS_BYTES, stream, a);
    }
#else
    a.ph_lo = 0; a.ph_hi = 19;
    void* args[] = {&a};
    hipError_t e = hipLaunchCooperativeKernel((const void*)mega_fwd, dim3(grid), dim3(512), args, LDS_BYTES, stream);
    if (e != hipSuccess) fprintf(stderr, "cooperative launch failed: %s (grid %d)\n", hipGetErrorString(e), grid);
#endif
}
```

```cpp
#include <hip/hip_runtime.h>
#include <hip/hip_cooperative_groups.h>
#include <cstdio>
namespace cg = cooperative_groups;

#define LAS __attribute__((address_space(3)))
#define DI __device__ __forceinline__
typedef unsigned short bf16_t;
typedef short bf16x8 __attribute__((ext_vector_type(8)));
typedef float f32x2 __attribute__((ext_vector_type(2)));
typedef float f32x4 __attribute__((ext_vector_type(4)));
typedef float f32x16 __attribute__((ext_vector_type(16)));
typedef unsigned u32x2 __attribute__((ext_vector_type(2)));
typedef unsigned u32x4 __attribute__((ext_vector_type(4)));
typedef __bf16 bf2_t __attribute__((ext_vector_type(2)));

constexpr int MTOK = 65536, SEQ = 2048, DM = 1024, NB = 32, DFF = 4096, PLE = 256;
constexpr int RM_LD = 2816;
constexpr int C_AQ = 0, C_AK = 384, C_IQ = 448, C_IK = 960, C_BQ = 1024, C_BK = 1792, C_CQ = 2048, C_CK = 2432;
constexpr int T_ROWS = 768;
constexpr int R_AV = 0, R_BV = 64, R_CV = 320, R_IW = 704;
constexpr int NWIN = 3584;
constexpr float ALPHA = 1.41421356237309515f;
constexpr float LOG2E = 1.44269504088896341f;
constexpr float SC2 = 0.125f * LOG2E;
constexpr float NEGF = -1e30f;
constexpr int LDS_BYTES = 131072 + 16;

constexpr size_t WO_IN = 0;
constexpr size_t WO_G = WO_IN + (size_t)NWIN * 1024;
constexpr size_t WO_BA = WO_G + (size_t)3072 * 1024;
constexpr size_t WO_BB = WO_BA + (size_t)1024 * 384;
constexpr size_t WO_BC = WO_BB + (size_t)1024 * 256;
constexpr size_t WO_OUT = WO_BC + (size_t)1024 * 384;
constexpr size_t WO_UP = WO_OUT + (size_t)1024 * 1024;
constexpr size_t WO_DN = WO_UP + (size_t)4096 * 1024;
constexpr size_t WO_PG = WO_DN + (size_t)1024 * 4096;
constexpr size_t WO_PL = WO_PG + (size_t)1024 * 1024;
constexpr size_t W_LAYER = WO_PL + (size_t)1024 * 256;

constexpr size_t WS_WB = 0;
constexpr size_t WS_LUT = WS_WB + 2 * W_LAYER * 2;
constexpr size_t WS_KMEAN = WS_LUT + (size_t)24 * 2048 * 4;
constexpr size_t WS_MASK = WS_KMEAN + (size_t)32 * 6 * 8 * 64 * 4;
constexpr size_t WS_XB = WS_MASK + (size_t)MTOK * 64 * 4;
constexpr size_t WS_PB = WS_XB + (size_t)MTOK * 1024 * 2;
constexpr size_t WS_OABC = WS_PB + (size_t)2 * MTOK * 256 * 2;
constexpr size_t WS_R1 = WS_OABC + (size_t)MTOK * 1024 * 2;
constexpr size_t WS_BAR = WS_R1 + (size_t)MTOK * 4096 * 2;
constexpr size_t WS_STATS = WS_BAR + (size_t)4096 * 4;
constexpr size_t WS_G2 = WS_STATS + (size_t)MTOK * 2 * 4;
constexpr size_t WS_END = WS_G2 + (size_t)MTOK * 4 * 68 * 4;
constexpr size_t WS_VT16 = WS_R1 + ((size_t)MTOK * RM_LD + (size_t)T_ROWS * MTOK) * 2;

struct Args {
    const float* in[17];
    float* out;
    unsigned char* ws;
    int ph_lo, ph_hi;
};

DI unsigned short f2bf(float f) { unsigned u = __float_as_uint(f); u += 0x7FFFu + ((u >> 16) & 1u); return (unsigned short)(u >> 16); }
DI unsigned pk2(float lo, float hi) { f32x2 v = {lo, hi}; bf2_t b = __builtin_convertvector(v, bf2_t); return __builtin_bit_cast(unsigned, b); }
DI float bf_lo(unsigned w) { return __uint_as_float(w << 16); }
DI float bf_hi(unsigned w) { return __uint_as_float(w & 0xFFFF0000u); }
DI float bf2f(bf16_t b) { return __uint_as_float(((unsigned)b) << 16); }
DI float sigmoidf_(float x) { return __builtin_amdgcn_rcpf(1.0f + __expf(-x)); }
#define MFMA32(a, b, c) __builtin_amdgcn_mfma_f32_32x32x16_bf16((a), (b), (c), 0, 0, 0)

namespace pg8 {
constexpr int BM = 256, BK = 64, HALF = 128, HTB = HALF * BK * 2, NXCD = 8, WGM = 8;
DI int lds_byte(int r, int c) { const int st = (r >> 4) * 2 + (c >> 5), rr = r & 15, cc = c & 31, ob = rr * 64 + cc * 2; return st * 1024 + (ob ^ (((ob >> 9) & 1) << 5)); }
DI void stage_rc(int b, int& R, int& C) { const int st = b / 1024, sb = b % 1024, swz = sb ^ (((sb >> 9) & 1) << 5); R = (st >> 1) * 16 + swz / 64; C = (st & 1) * 32 + (swz % 64) / 2; }
DI int perm32(int rho) { const int n = rho >> 4, i = rho & 15; return 8 * (i >> 2) + 4 * n + (i & 3); }

struct Unit { int pm, pn; long bofs; };
struct Gemm { const bf16_t* A; const bf16_t* Bt; int lda, ldb, K; long hsB; };

struct StaticOrder {
    int nM, nN, nwg, G, c;
    DI void init(int nM_, int nN_, int G_, int c_) { nM = nM_; nN = nN_; nwg = nM * nN; G = G_; c = c_; }
    DI bool next(int i, Unit& u) const {
        const long L = (long)i * G + c; if (L >= nwg) return false;
        int wgid = (int)L; { const int q = nwg / NXCD, r = nwg % NXCD, xcd = wgid % NXCD, off = wgid / NXCD; wgid = (xcd < r ? xcd * (q + 1) : r * (q + 1) + (xcd - r) * q) + off; }
        const int nig = WGM * nN, gid = wgid / nig, fm = gid * WGM, gsz = (nM - fm) < WGM ? (nM - fm) : WGM;
        u.pm = fm + ((wgid % nig) % gsz); u.pn = (wgid % nig) / gsz; u.bofs = -1; return true;
    }
};
struct OrderVT16 {
    int G, c;
    DI bool next(int i, Unit& u) const { const int L = i * G + c; if (L >= 256) return false; u.pm = 0; u.pn = L; u.bofs = ((long)((L >> 3) * 2048 + 2 * (L & 7)) * 1024) * 2; return true; }
};
struct Order3 {
    StaticOrder base;
    DI bool next(int i, Unit& u) const { Unit v; if (!base.next(i / 3, v)) return false; u.pm = v.pm; u.pn = (i % 3) * 4 + v.pn; u.bofs = -1; return true; }
};

template <int ACT  > struct EpiBf16 {
    static constexpr bool PERM = true;
    bf16_t* O; int ldc;
    DI void operator()(const f32x4 (&acc)[2][2][4][2], const Unit& u, int wr, int wc, int fr, int fq) const {
        const int row0 = u.pm * BM + wr * 64 + fr, col0 = u.pn * BM + wc * 32 + 8 * fq;
#pragma unroll
        for (int ai = 0; ai < 2; ++ai)
#pragma unroll
            for (int m = 0; m < 4; ++m) { bf16_t* rowp = O + (size_t)(row0 + ai * HALF + m * 16) * ldc + col0;
#pragma unroll
                for (int bj = 0; bj < 2; ++bj) { f32x4 v0 = acc[ai][bj][m][0], v1 = acc[ai][bj][m][1];
                    if (ACT == 1) {
#pragma unroll
                        for (int j = 0; j < 4; ++j) { float a = fmaxf(v0[j], 0.f), b = fmaxf(v1[j], 0.f); v0[j] = a * a; v1[j] = b * b; } }
                    u32x4 w; w.x = pk2(v0[0], v0[1]); w.y = pk2(v0[2], v0[3]); w.z = pk2(v1[0], v1[1]); w.w = pk2(v1[2], v1[3]);
                    *(u32x4*)(rowp + bj * HALF) = w; } }
    }
};
struct EpiGate {
    static constexpr bool PERM = true;
    const bf16_t* obr; bf16_t* mg;
    DI void operator()(const f32x4 (&acc)[2][2][4][2], const Unit& u, int wr, int wc, int fr, int fq) const {
        const int b = u.pn >> 2, colt = (u.pn & 3) * BM;
        const int row0 = u.pm * BM + wr * 64 + fr, col0 = colt + wc * 32 + 8 * fq;
        const bf16_t* ob0 = obr + (size_t)row0 * 3072 + b * 1024 + col0;
        bf16_t* mp0 = mg + (size_t)row0 * 1024 + col0;
        u32x4 ob[2][4], pm[2][4];
#define GATE_LOAD(k, s) do { _Pragma("unroll") for (int q = 0; q < 4; ++q) { const int ai = (k) >> 1, m = 2 * ((k) & 1) + (q >> 1), bj = q & 1; const size_t ro = (size_t)(ai * HALF + m * 16); \
            ob[s][q] = *(const u32x4*)(ob0 + ro * 3072 + bj * HALF); if (b > 0) pm[s][q] = *(const u32x4*)(mp0 + ro * 1024 + bj * HALF); } } while (0)
        GATE_LOAD(0, 0);
#pragma unroll
        for (int k = 0; k < 4; ++k) {
            if (k + 1 < 4) GATE_LOAD(k + 1, (k + 1) & 1);
#pragma unroll
            for (int q = 0; q < 4; ++q) {
                const int ai = k >> 1, m = 2 * (k & 1) + (q >> 1), bj = q & 1;
                const f32x4 v0 = acc[ai][bj][m][0], v1 = acc[ai][bj][m][1];
                const u32x4 o = ob[k & 1][q];
                float r[8];
                r[0] = sigmoidf_(v0[0]) * bf_lo(o.x); r[1] = sigmoidf_(v0[1]) * bf_hi(o.x); r[2] = sigmoidf_(v0[2]) * bf_lo(o.y); r[3] = sigmoidf_(v0[3]) * bf_hi(o.y);
                r[4] = sigmoidf_(v1[0]) * bf_lo(o.z); r[5] = sigmoidf_(v1[1]) * bf_hi(o.z); r[6] = sigmoidf_(v1[2]) * bf_lo(o.w); r[7] = sigmoidf_(v1[3]) * bf_hi(o.w);
                if (b > 0) { const u32x4 pv = pm[k & 1][q];
                    r[0] += bf_lo(pv.x); r[1] += bf_hi(pv.x); r[2] += bf_lo(pv.y); r[3] += bf_hi(pv.y); r[4] += bf_lo(pv.z); r[5] += bf_hi(pv.z); r[6] += bf_lo(pv.w); r[7] += bf_hi(pv.w); }
                u32x4 w; w.x = pk2(r[0], r[1]); w.y = pk2(r[2], r[3]); w.z = pk2(r[4], r[5]); w.w = pk2(r[6], r[7]);
                *(u32x4*)(mp0 + (size_t)(ai * HALF + m * 16) * 1024 + bj * HALF) = w;
            }
        }
#undef GATE_LOAD
    }
};
struct EpiT1 {
    static constexpr bool PERM = true;
    bf16_t* T;
    DI void operator()(const f32x4 (&acc)[2][2][4][2], const Unit& u, int wr, int wc, int fr, int fq) const {
        const int row0 = u.pm * BM + wr * 64 + fr, col0 = u.pn * BM + wc * 32 + 8 * fq;
        bf16_t* tp0 = T + (size_t)row0 * 1024 + col0;
        u32x4 ob[2][8];
#pragma unroll
        for (int ai = 0; ai < 2; ++ai)
#pragma unroll
            for (int q = 0; q < 8; ++q) ob[ai][q] = *(const u32x4*)(tp0 + (size_t)(ai * HALF + (q >> 1) * 16) * 1024 + (q & 1) * HALF);
#pragma unroll
        for (int ai = 0; ai < 2; ++ai)
#pragma unroll
            for (int q = 0; q < 8; ++q) {
                const int m = q >> 1, bj = q & 1;
                const f32x4 v0 = acc[ai][bj][m][0], v1 = acc[ai][bj][m][1];
                const u32x4 o = ob[ai][q];
                float r[8];
                r[0] = sigmoidf_(v0[0]) * bf_lo(o.x); r[1] = sigmoidf_(v0[1]) * bf_hi(o.x); r[2] = sigmoidf_(v0[2]) * bf_lo(o.y); r[3] = sigmoidf_(v0[3]) * bf_hi(o.y);
                r[4] = sigmoidf_(v1[0]) * bf_lo(o.z); r[5] = sigmoidf_(v1[1]) * bf_hi(o.z); r[6] = sigmoidf_(v1[2]) * bf_lo(o.w); r[7] = sigmoidf_(v1[3]) * bf_hi(o.w);
                u32x4 w; w.x = pk2(r[0], r[1]); w.y = pk2(r[2], r[3]); w.z = pk2(r[4], r[5]); w.w = pk2(r[6], r[7]);
                *(u32x4*)(tp0 + (size_t)(ai * HALF + m * 16) * 1024 + bj * HALF) = w;
            }
    }
};
template <bool HAS_T, bool LNX> struct EpiRes {
    static constexpr bool PERM = false;
    const float* xin; float* y; const bf16_t* T; const float* stats; const float* lg; const float* lb;
    DI void operator()(const f32x4 (&acc)[2][2][4][2], const Unit& u, int wr, int wc, int fr, int fq) const {
        const int row0 = u.pm * BM + wr * 64 + fr, col0 = u.pn * BM + wc * 32 + 4 * fq;
        const size_t o0 = (size_t)row0 * 1024 + col0;
        f32x4 xv[2][4]; u32x2 tv[2][4]; f32x2 sm[2][4];
#define RES_LOAD(k, s) do { _Pragma("unroll") for (int m = 0; m < 4; ++m) { const int row = row0 + ((k) >> 2) * HALF + m * 16; const size_t o = (size_t)row * 1024 + col0 + (((k) >> 1) & 1) * HALF + ((k) & 1) * 16; \
            xv[s][m] = *(const f32x4*)(xin + o); if (HAS_T) tv[s][m] = *(const u32x2*)(T + o); if (LNX) sm[s][m] = *(const f32x2*)(stats + 2 * (size_t)row); } } while (0)
#pragma unroll
        for (int k = 0; k < 8; ++k) {
            RES_LOAD(k, k & 1);
            const int ai = k >> 2, bj = (k >> 1) & 1, n = k & 1;
            f32x4 gv = {1.f, 1.f, 1.f, 1.f}, bv = {0.f, 0.f, 0.f, 0.f};
            if (LNX) { gv = *(const f32x4*)(lg + col0 + bj * HALF + n * 16); bv = *(const f32x4*)(lb + col0 + bj * HALF + n * 16); }
#pragma unroll
            for (int m = 0; m < 4; ++m) {
                const size_t o = o0 + (size_t)(ai * HALF + m * 16) * 1024 + bj * HALF + n * 16;
                f32x4 x = xv[k & 1][m];
                if (LNX) x = (x - sm[k & 1][m][0]) * sm[k & 1][m][1] * gv + bv;
                f32x4 r = acc[ai][bj][m][n] + x * ALPHA;
                if (HAS_T) { const u32x2 t = tv[k & 1][m]; r[0] += bf_lo(t.x); r[1] += bf_hi(t.x); r[2] += bf_lo(t.y); r[3] += bf_hi(t.y); }
                *(f32x4*)(y + o) = r;
            }
        }
#undef RES_LOAD
    }
};

template <class Epi, class Sched>
DI void gemm_phase(LAS unsigned char* lds, const Gemm g, const Sched& S, const Epi& E, const int tid) {
    const int wid = __builtin_amdgcn_readfirstlane(tid >> 6), lane = tid & 63, wr = wid >> 2, wc = wid & 3, fr = lane & 15, fq = lane >> 4;
    const int K = g.K, nt = K / BK;
    unsigned voffA_, voffB_;
    { int R, C; stage_rc(tid * 16, R, C); const int Rb = Epi::PERM ? ((R & ~31) + perm32(R & 31)) : R;
      voffA_ = (unsigned)(R * g.lda + C) * 2u; voffB_ = (unsigned)(Rb * g.ldb + C) * 2u; }
    const size_t p64offA = (size_t)64 * g.lda * 2, p64offB = (size_t)64 * g.ldb * 2;
    const size_t kstep = (size_t)(BK * 2);
    const size_t hstepA = (size_t)HALF * g.lda * 2, hstepB = g.hsB > 0 ? (size_t)g.hsB : (size_t)HALF * g.ldb * 2;
    const size_t tstepA = 2 * hstepA, tstepB = 2 * hstepB;
    const unsigned ldsw = (unsigned)wid * 1024u;
    const int aoff = lds_byte(wr * 64 + fr, fq * 8), boff = lds_byte(wc * 32 + fr, fq * 8);
#define PG8_SA(b, h) (((b) * 2 + (h)) * HTB)
#define PG8_SB(b, h) ((4 + (b) * 2 + (h)) * HTB)
#define PG8_STAGE(bufoff, gbase, voff) do { _Pragma("unroll") for (int _i = 0; _i < 2; ++_i) \
        __builtin_amdgcn_global_load_lds((const unsigned*)((const char*)(gbase) + (size_t)_i * p64##voff + (v##voff##_)), (LAS unsigned*)(lds + (bufoff) + ldsw + _i * 8192), 16, 0, 0); } while (0)
#define PG8_LDA(dst, b, h) do { _Pragma("unroll") for (int m = 0; m < 4; ++m) _Pragma("unroll") for (int k = 0; k < 2; ++k) dst[m][k] = *(const LAS bf16x8*)(lds + PG8_SA(b, h) + aoff + m * 2048 + k * 1024); } while (0)
#define PG8_LDB(dst, b, h) do { _Pragma("unroll") for (int n = 0; n < 2; ++n) _Pragma("unroll") for (int k = 0; k < 2; ++k) dst[n][k] = *(const LAS bf16x8*)(lds + PG8_SB(b, h) + boff + n * 2048 + k * 1024); } while (0)
#define PG8_MMA(ai, bj, At, Bt) do { __builtin_amdgcn_s_setprio(1); _Pragma("unroll") for (int m = 0; m < 4; ++m) _Pragma("unroll") for (int n = 0; n < 2; ++n) _Pragma("unroll") for (int k = 0; k < 2; ++k) \
        acc[ai][bj][m][n] = __builtin_amdgcn_mfma_f32_16x16x32_bf16(Bt[n][k], At[m][k], acc[ai][bj][m][n], 0, 0, 0); __builtin_amdgcn_s_setprio(0); } while (0)
#define PG8_WAIT_V(n) asm volatile("s_waitcnt vmcnt(" #n ")" ::: "memory")
#define PG8_WAIT_L(n) asm volatile("s_waitcnt lgkmcnt(" #n ")" ::: "memory")
#define PG8_BAR __builtin_amdgcn_s_barrier()
#define PG8_SCHED __builtin_amdgcn_sched_barrier(0)
    Unit cur, nxt; int ui = 0;
    if (!S.next(0, cur)) return;
    f32x4 acc[2][2][4][2];
#pragma unroll
    for (int a = 0; a < 2; ++a)
#pragma unroll
        for (int b = 0; b < 2; ++b)
#pragma unroll
            for (int m = 0; m < 4; ++m)
#pragma unroll
                for (int n = 0; n < 2; ++n) acc[a][b][m][n] = (f32x4){0.f, 0.f, 0.f, 0.f};
    bf16x8 At[4][2], B0[2][2], B1[2][2];
    const char* cA = (const char*)g.A + (size_t)cur.pm * tstepA; const char* cB = (const char*)g.Bt + (cur.bofs >= 0 ? (size_t)cur.bofs : (size_t)cur.pn * tstepB);
    PG8_STAGE(PG8_SB(0, 0), cB, offB); PG8_STAGE(PG8_SA(0, 0), cA, offA); PG8_STAGE(PG8_SB(0, 1), cB + hstepB, offB); PG8_STAGE(PG8_SA(0, 1), cA + hstepA, offA);
    if (wr == 1) PG8_BAR;
    PG8_WAIT_V(4); PG8_BAR;
    PG8_STAGE(PG8_SB(1, 0), cB + kstep, offB); PG8_STAGE(PG8_SA(1, 0), cA + kstep, offA); PG8_STAGE(PG8_SB(1, 1), cB + hstepB + kstep, offB);
    PG8_WAIT_V(6); PG8_BAR;
    for (;;) {
        const bool has_next = S.next(ui + 1, nxt);
        const char* nA = has_next ? (const char*)g.A + (size_t)nxt.pm * tstepA : cA; const char* nB = has_next ? (const char*)g.Bt + (nxt.bofs >= 0 ? (size_t)nxt.bofs : (size_t)nxt.pn * tstepB) : cB;
        for (int t = 0; t < nt; t += 2) {
            const bool last = (t == nt - 2);
            const char* a1 = cA + (size_t)(t + 1) * kstep;
            const char* a2 = last ? nA : cA + (size_t)(t + 2) * kstep; const char* b2 = last ? nB : cB + (size_t)(t + 2) * kstep;
            const char* a3 = a2 + kstep; const char* b3 = b2 + kstep;
            PG8_LDB(B0, 0, 0); PG8_SCHED; PG8_LDA(At, 0, 0); PG8_STAGE(PG8_SA(1, 1), a1 + hstepA, offA);
            PG8_WAIT_L(8); PG8_BAR; PG8_WAIT_L(0); PG8_MMA(0, 0, At, B0); PG8_BAR; PG8_SCHED;
            PG8_LDB(B1, 0, 1); PG8_STAGE(PG8_SB(0, 0), b2, offB);
            PG8_BAR; PG8_WAIT_L(0); PG8_MMA(0, 1, At, B1); PG8_BAR;
            PG8_LDA(At, 0, 1); PG8_STAGE(PG8_SA(0, 0), a2, offA);
            PG8_BAR; PG8_WAIT_L(0); PG8_MMA(1, 0, At, B0); PG8_BAR; PG8_SCHED;
            PG8_STAGE(PG8_SB(0, 1), b2 + hstepB, offB);
            PG8_WAIT_V(6); PG8_BAR; PG8_MMA(1, 1, At, B1); PG8_BAR;
            PG8_LDB(B0, 1, 0); PG8_SCHED; PG8_LDA(At, 1, 0); PG8_STAGE(PG8_SA(0, 1), a2 + hstepA, offA);
            PG8_WAIT_L(8); PG8_BAR; PG8_WAIT_L(0); PG8_MMA(0, 0, At, B0); PG8_BAR; PG8_SCHED;
            PG8_LDB(B1, 1, 1); PG8_STAGE(PG8_SB(1, 0), b3, offB);
            PG8_BAR; PG8_WAIT_L(0); PG8_MMA(0, 1, At, B1); PG8_BAR;
            PG8_LDA(At, 1, 1); PG8_STAGE(PG8_SA(1, 0), a3, offA);
            PG8_BAR; PG8_WAIT_L(0); PG8_MMA(1, 0, At, B0); PG8_BAR; PG8_SCHED;
            PG8_STAGE(PG8_SB(1, 1), b3 + hstepB, offB);
            PG8_WAIT_V(6); PG8_BAR; PG8_MMA(1, 1, At, B1); PG8_BAR;
        }
        E(acc, cur, wr, wc, fr, fq);
        if (!has_next) break;
#pragma unroll
        for (int a = 0; a < 2; ++a)
#pragma unroll
            for (int b = 0; b < 2; ++b)
#pragma unroll
                for (int m = 0; m < 4; ++m)
#pragma unroll
                    for (int n = 0; n < 2; ++n) acc[a][b][m][n] = (f32x4){0.f, 0.f, 0.f, 0.f};
        cur = nxt; cA = nA; cB = nB; ++ui;
    }
    PG8_WAIT_V(0);
    if (wr == 0) PG8_BAR;
    PG8_BAR;
#undef PG8_SA
#undef PG8_SB
#undef PG8_STAGE
#undef PG8_LDA
#undef PG8_LDB
#undef PG8_MMA
#undef PG8_WAIT_V
#undef PG8_WAIT_L
#undef PG8_BAR
#undef PG8_SCHED
}
}

DI int win_srccol(int n) {
    if (n < 384) return n;
    if (n < 448) return 384 + (n - 384);
    if (n < 960) return 512 + (n - 448);
    if (n < 1024) return 1024 + (n - 960);
    if (n < 1792) return 1096 + (n - 1024);
    if (n < 2048) return 1864 + (n - 1792);
    if (n < 2432) return 2376 + (n - 2048);
    if (n < 2816) return 2760 + (n - 2432);
    if (n < 2880) return 448 + (n - 2816);
    if (n < 3136) return 2120 + (n - 2880);
    if (n < 3520) return 3144 + (n - 3136);
    if (n < 3528) return 1088 + (n - 3520);
    return -1;
}
DI void convT(unsigned char* shm, const float* src, int K, int Nsrc, bf16_t* dst, int Ndst, int mode, const int tid) {
    unsigned short* tl = (unsigned short*)shm;
    const int ntk = K / 64, ntiles = (Ndst / 64) * ntk;
    for (int tile = blockIdx.x; tile < ntiles; tile += gridDim.x) {
        const int n0 = (tile / ntk) * 64, k0 = (tile % ntk) * 64;
        const int nx = tid & 63, ky = tid >> 6;
        const int sc = mode ? win_srccol(n0 + nx) : (n0 + nx);
#pragma unroll
        for (int p = 0; p < 8; ++p) { const int k = k0 + ky + 8 * p; const float v = sc >= 0 ? src[(size_t)k * Nsrc + sc] : 0.f; tl[nx * 66 + ky + 8 * p] = f2bf(v); }
        __syncthreads();
#pragma unroll
        for (int p = 0; p < 8; ++p) { const int n = ky + 8 * p; dst[(size_t)(n0 + n) * K + k0 + nx] = tl[n * 66 + nx]; }
        __syncthreads();
    }
}
DI void conv_vec(const float* src, bf16_t* dst, size_t n8, const int tid) {
    for (size_t i = (size_t)blockIdx.x * 512 + tid; i < n8; i += (size_t)gridDim.x * 512) {
        const f32x4 a = *(const f32x4*)(src + i * 8), b = *(const f32x4*)(src + i * 8 + 4);
        u32x4 w; w.x = pk2(a[0], a[1]); w.y = pk2(a[2], a[3]); w.z = pk2(b[0], b[1]); w.w = pk2(b[2], b[3]);
        *(u32x4*)(dst + i * 8) = w;
    }
}
DI int rel_bucket(int n) {
    if (n < 16) return n;
    int large = 16 + (int)(logf((float)n / 16.0f) / 4.852030263919617f * 16.0f);
    return large < 31 ? large : 31;
}
DI void phase_convert(const Args& a, unsigned char* shm, const int tid) {
    bf16_t* wb = (bf16_t*)(a.ws + WS_WB);
    for (int l = 0; l < 2; ++l) {
        bf16_t* w = wb + (size_t)l * W_LAYER;
        convT(shm, a.in[2] + (size_t)l * 1024 * 3528, 1024, 3528, w + WO_IN, NWIN, 1, tid);
        convT(shm, a.in[3] + (size_t)l * 1024 * 3072, 1024, 3072, w + WO_G, 3072, 0, tid);
        convT(shm, a.in[4] + (size_t)l * 384 * 1024, 384, 1024, w + WO_BA, 1024, 0, tid);
        convT(shm, a.in[5] + (size_t)l * 256 * 1024, 256, 1024, w + WO_BB, 1024, 0, tid);
        convT(shm, a.in[6] + (size_t)l * 384 * 1024, 384, 1024, w + WO_BC, 1024, 0, tid);
        convT(shm, a.in[7] + (size_t)l * 1024 * 1024, 1024, 1024, w + WO_OUT, 1024, 0, tid);
        convT(shm, a.in[10] + (size_t)l * 1024 * 4096, 1024, 4096, w + WO_UP, 4096, 0, tid);
        convT(shm, a.in[11] + (size_t)l * 4096 * 1024, 4096, 1024, w + WO_DN, 1024, 0, tid);
        convT(shm, a.in[12] + (size_t)l * 1024 * 1024, 1024, 1024, w + WO_PG, 1024, 0, tid);
        convT(shm, a.in[13] + (size_t)l * 256 * 1024, 256, 1024, w + WO_PL, 1024, 0, tid);
    }
    conv_vec(a.in[0], (bf16_t*)(a.ws + WS_XB), (size_t)MTOK * 1024 / 8, tid);
    conv_vec(a.in[1], (bf16_t*)(a.ws + WS_PB), (size_t)2 * MTOK * 256 / 8, tid);
    float* lut = (float*)(a.ws + WS_LUT);
    const float* rb = a.in[16];
    for (int i = blockIdx.x * 512 + tid; i < 24 * 2048; i += gridDim.x * 512) {
        const int hd = i >> 11, d = i & 2047;
        lut[i] = rb[rel_bucket(d) * 24 + hd] * LOG2E;
    }
}

DI float wave_sum(float v) {
#pragma unroll
    for (int o = 32; o >= 1; o >>= 1) v += __shfl_xor(v, o);
    return v;
}
template <bool FINAL>
DI void phase_ln(float* y, bf16_t* xb, float* stats, const float* g, const float* b, const int tid) {
    const int wid = tid >> 6, lane = tid & 63;
    f32x4 gv[4], bv[4];
#pragma unroll
    for (int k = 0; k < 4; ++k) { gv[k] = *(const f32x4*)(g + k * 256 + lane * 4); bv[k] = *(const f32x4*)(b + k * 256 + lane * 4); }
    for (int row = blockIdx.x * 8 + wid; row < MTOK; row += gridDim.x * 8) {
        float* yp = y + (size_t)row * 1024;
        f32x4 v[4]; float s = 0.f;
#pragma unroll
        for (int k = 0; k < 4; ++k) { v[k] = *(const f32x4*)(yp + k * 256 + lane * 4); s += v[k][0] + v[k][1] + v[k][2] + v[k][3]; }
        const float mean = wave_sum(s) * (1.0f / 1024.0f);
        float q = 0.f;
#pragma unroll
        for (int k = 0; k < 4; ++k) { v[k] = v[k] - mean; q += v[k][0] * v[k][0] + v[k][1] * v[k][1] + v[k][2] * v[k][2] + v[k][3] * v[k][3]; }
        const float var = wave_sum(q) * (1.0f / 1024.0f);
        const float rs = 1.0f / sqrtf(var + 1e-5f);
        if (!FINAL && lane == 0) { f32x2 sm = {mean, rs}; *(f32x2*)(stats + 2 * (size_t)row) = sm; }
#pragma unroll
        for (int k = 0; k < 4; ++k) { const f32x4 o = v[k] * rs * gv[k] + bv[k];
            if (FINAL) *(f32x4*)(yp + k * 256 + lane * 4) = o;
            else { u32x2 w; w.x = pk2(o[0], o[1]); w.y = pk2(o[2], o[3]); *(u32x2*)(xb + (size_t)row * 1024 + k * 256 + lane * 4) = w; } }
    }
}

DI int pi_row(int r) { return (r & 3) | (((r >> 3) & 1) << 2) | (((r >> 2) & 1) << 3) | (r & 16); }
DI void task_rot(int tau, int& b, int& qt) { b = tau >> 6; qt = ((tau & 63) + 8 * (tau >> 8)) & 63; }
DI bool task_map(int k, int& b, int& qt) {
    if (gridDim.x == 256) { if (k >= 8) return false; const int xcd = blockIdx.x & 7, slot = blockIdx.x >> 3; b = xcd + 8 * (k >> 1); qt = (k & 1) ? 63 - slot : slot; return true; }
    const int tau = blockIdx.x + k * gridDim.x; if (tau >= 2048) return false; task_rot(tau, b, qt); return true;
}

DI void a1_task(unsigned char* shm, const bf16_t* prm, const bf16_t* prt, unsigned* mask, int b, int qt, const int tid) {
    const int wid = __builtin_amdgcn_readfirstlane(tid >> 6), lane = tid & 63, r = lane & 31, h = lane >> 5;
    const int t0 = qt * 32, tok0 = b * SEQ;
    unsigned* cnt = (unsigned*)(shm + 33280);
    { u32x4 t[4];
#pragma unroll
      for (int p = 0; p < 4; ++p) { const int c = tid + p * 512, row = c >> 6, ch = c & 63; t[p] = *(const u32x4*)(prm + (size_t)(tok0 + t0 + row) * RM_LD + C_IQ + ch * 8); }
#pragma unroll
      for (int p = 0; p < 4; ++p) { const int c = tid + p * 512, row = c >> 6, ch = c & 63; *(u32x4*)(shm + row * 1040 + ch * 16) = t[p]; } }
    cnt[tid] = 0u; cnt[tid + 512] = 0u;
    float* wqs = (float*)(shm + 33280 + 4096);
    if (tid < 256) wqs[tid] = bf2f(prt[(size_t)(R_IW + (tid >> 5)) * MTOK + tok0 + t0 + (tid & 31)]);
    __syncthreads();
    unsigned key[8][16];
    const bf16_t* kp = prm + (size_t)(tok0 + pi_row(r)) * RM_LD + C_IK + 8 * h;
    bf16x8 kf[4];
    if (wid <= qt) {
#pragma unroll
        for (int ks = 0; ks < 4; ++ks) kf[ks] = *(const bf16x8*)(kp + (size_t)(wid * 32) * RM_LD + 16 * ks);
    }
#pragma unroll
    for (int jt = 0; jt < 8; ++jt) {
        const int kt = wid + 8 * jt;
        if (kt <= qt) {
            const int s0 = kt * 32;
            bf16x8 kn[4];
            const bool hn = (jt < 7) && (kt + 8 <= qt);
            if (hn) {
#pragma unroll
                for (int ks = 0; ks < 4; ++ks) kn[ks] = *(const bf16x8*)(kp + (size_t)(s0 + 256) * RM_LD + 16 * ks);
            }
            float idx[16];
#pragma unroll
            for (int i = 0; i < 16; ++i) idx[i] = 0.f;
            const unsigned char* qb0 = shm + r * 1040 + 16 * h;
#pragma unroll 2
            for (int hh = 0; hh < 8; ++hh) {
                bf16x8 qa[4];
#pragma unroll
                for (int ks = 0; ks < 4; ++ks) qa[ks] = *(const bf16x8*)(qb0 + hh * 128 + 32 * ks);
                const float wv = wqs[hh * 32 + r];
                asm volatile("s_waitcnt lgkmcnt(0)" ::: "memory");
                f32x16 acc;
#pragma unroll
                for (int i = 0; i < 16; ++i) acc[i] = 0.f;
#pragma unroll
                for (int ks = 0; ks < 4; ++ks) acc = MFMA32(kf[ks], qa[ks], acc);
#pragma unroll
                for (int i = 0; i < 16; ++i) idx[i] = fmaf(wv, fmaxf(acc[i], 0.f), idx[i]);
            }
#pragma unroll
            for (int i = 0; i < 16; ++i) {
                const int s = s0 + 16 * (i >> 3) + 8 * h + (i & 7);
                const unsigned u = __float_as_uint(idx[i] + 0.0f);
                const unsigned k = (u & 0x80000000u) ? ~u : (u | 0x80000000u);
                key[jt][i] = (s <= t0 + r) ? k : 0u;
            }
            if (hn) {
#pragma unroll
                for (int ks = 0; ks < 4; ++ks) kf[ks] = kn[ks];
            }
        } else {
#pragma unroll
            for (int i = 0; i < 16; ++i) key[jt][i] = 0u;
        }
    }
    unsigned T = 0u;
    if (qt >= 8) {
        const int nheld = (qt >= wid) ? ((qt - wid) >> 3) + 1 : 0;
        bool done = false;
        for (int bit = 31; bit >= 0; --bit) {
            const unsigned cand = T | (1u << bit);
            int c = 0;
#pragma unroll
            for (int jt = 0; jt < 8; ++jt) {
                if (jt < nheld) {
#pragma unroll
                    for (int i = 0; i < 16; ++i) c += (key[jt][i] >= cand) ? 1 : 0;
                }
            }
            c += __shfl_xor(c, 32);
            if (h == 0 && c) atomicAdd(&cnt[(31 - bit) * 32 + r], (unsigned)c);
            __syncthreads();
            const unsigned tot = cnt[(31 - bit) * 32 + r];
            if (!done) { if (tot >= 256u) T = cand; if (tot == 256u) done = true; }
            if (__ballot(!done) == 0ull) break;
        }
    }
    if (T < 1u) T = 1u;
#pragma unroll
    for (int jt = 0; jt < 8; ++jt) {
        const int kt = wid + 8 * jt;
        if (kt <= qt) {
            unsigned part = 0u;
#pragma unroll
            for (int i = 0; i < 16; ++i) part |= (key[jt][i] >= T ? 1u : 0u) << (16 * (i >> 3) + 8 * h + (i & 7));
            part |= (unsigned)__shfl_xor((int)part, 32);
            if (h == 0) mask[(size_t)(tok0 + t0 + r) * 64 + kt] = part;
        }
    }
    __syncthreads();
}
DI void g2_job(const Args& a, unsigned char* wsh, LAS unsigned char* wl, int b, int slot, int cls, int it, const int tid);
DI void phase_a1(const Args& a, unsigned char* shm, const int tid) {
    const bf16_t* prm = (const bf16_t*)(a.ws + WS_R1);
    const bf16_t* prt = prm + (size_t)MTOK * RM_LD;
    unsigned* mask = (unsigned*)(a.ws + WS_MASK);
    float* kmean = (float*)(a.ws + WS_KMEAN);
    for (int k = 0;; ++k) { int b, qt; if (!task_map(k, b, qt)) break; a1_task(shm, prm, prt, mask, b, qt, tid); }
    for (int j = 2048 + blockIdx.x; j < 2048 + 192; j += gridDim.x) {
        {
            const int id = (j - 2048) * 8 + (tid >> 6), lane = tid & 63;
            const int b = id / 48, hd = (id >> 3) % 6, n = id & 7;
            const int c8 = lane & 7, rr = lane >> 3;
            const bf16_t* p = prm + (size_t)(b * SEQ + n * 256 + rr) * RM_LD + C_CK + hd * 64 + 8 * c8;
            float acc[8];
#pragma unroll
            for (int e = 0; e < 8; ++e) acc[e] = 0.f;
#pragma unroll 1
            for (int t0 = 0; t0 < 256; t0 += 64) {
                u32x4 v[8];
#pragma unroll
                for (int q = 0; q < 8; ++q) v[q] = *(const u32x4*)(p + (size_t)(t0 + 8 * q) * RM_LD);
#pragma unroll
                for (int q = 0; q < 8; ++q) { acc[0] += bf_lo(v[q].x); acc[1] += bf_hi(v[q].x); acc[2] += bf_lo(v[q].y); acc[3] += bf_hi(v[q].y);
                                              acc[4] += bf_lo(v[q].z); acc[5] += bf_hi(v[q].z); acc[6] += bf_lo(v[q].w); acc[7] += bf_hi(v[q].w); }
            }
#pragma unroll
            for (int e = 0; e < 8; ++e) { acc[e] += __shfl_xor(acc[e], 8); acc[e] += __shfl_xor(acc[e], 16); acc[e] += __shfl_xor(acc[e], 32); }
            if (rr == 0) {
                float* kd = kmean + (size_t)((b * 6 + hd) * 8 + n) * 64 + 8 * c8;
                *(f32x4*)kd = (f32x4){acc[0], acc[1], acc[2], acc[3]} * (1.0f / 256.0f);
                *(f32x4*)(kd + 4) = (f32x4){acc[4], acc[5], acc[6], acc[7]} * (1.0f / 256.0f);
            }
        }
    }
    __syncthreads();
    {
        const int wid = __builtin_amdgcn_readfirstlane(tid >> 6);
        unsigned char* wsh = shm + wid * 16384;
        LAS unsigned char* wl = (LAS unsigned char*)shm + wid * 16384;
        for (int j = blockIdx.x; j < 1024; j += gridDim.x) {
            const int id = j * 8 + wid;
            g2_job(a, wsh, wl, id >> 8, (id >> 6) & 3, (id >> 2) & 15, id & 3, tid);
        }
    }
    __syncthreads();
}


struct AttnSt { float m, l; f32x16 o0, o1; };
struct AttnCtx {
    LAS unsigned char* wl;
    const float* lut;
    const bf16_t* kg;
    const bf16_t* vg;
    unsigned koff[4], voff[4];
    int kfo[4], vfo[2][2];
    int krs;
};
DI void attn_dma(const AttnCtx& c, int kt) {
    const char* kb = (const char*)(c.kg + (size_t)(kt * 32 * c.krs) * RM_LD);
    const char* vb = (const char*)(c.vg + kt * 32);
#pragma unroll
    for (int j = 0; j < 4; ++j) __builtin_amdgcn_global_load_lds((const unsigned*)(kb + c.koff[j]), (LAS unsigned*)(c.wl + j * 1024), 16, 0, 0);
#pragma unroll
    for (int j = 0; j < 4; ++j) __builtin_amdgcn_global_load_lds((const unsigned*)(vb + c.voff[j]), (LAS unsigned*)(c.wl + 4096 + j * 1024), 16, 0, 0);
}
template <int MODE, bool UNI>
DI void attn_compute(const bf16x8 (&qf)[4], const bf16x8 (&kf)[4], const bf16x8 (&vf)[2][2], int kt, int d00, const float* lut, float ubias, AttnSt& st,
                     unsigned W, int win, int dmask, bool lane_sel) {
    const int s0 = kt * 32;
    const int d0 = d00 - s0;
    const LAS float* lb = (const LAS float*)lut + ((MODE == 4) ? 16 * (d0 - 23) : (d0 - 23));
    float bia[16];
    if (!UNI) {
#pragma unroll
        for (int i = 0; i < 16; ++i) { const int ci = 16 * (i >> 3) + (i & 7); bia[i] = (MODE == 4) ? lb[16 * (23 - ci)] : lb[23 - ci]; }
    }
    f32x16 sx;
#pragma unroll
    for (int i = 0; i < 16; ++i) sx[i] = 0.f;
#pragma unroll
    for (int ks = 0; ks < 4; ++ks) sx = MFMA32(kf[ks], qf[ks], sx);
    asm volatile("s_waitcnt lgkmcnt(0)" ::: "memory");
    float sv[16]; float mx = NEGF;
#pragma unroll
    for (int i = 0; i < 16; ++i) {
        const int ci = 16 * (i >> 3) + (i & 7);
        const int dist = d0 - ci;
        bool v;
        if (MODE == 0) v = ((W >> ci) & 1u) != 0u;
        else if (MODE == 1) v = ((unsigned)dist <= (unsigned)win) && ((dist & dmask) == 0);
        else if (MODE == 2) v = lane_sel;
        else v = dist >= 0;
        const float bias = UNI ? ubias : bia[i];
        float s = fmaf(sx[i], SC2, bias);
        if (MODE == 0) { const unsigned t = (unsigned)__builtin_amdgcn_sbfe((int)W, ci, 1);
            s = __uint_as_float((__float_as_uint(s) & t) | (__float_as_uint(NEGF) & ~t)); }
        else s = v ? s : NEGF;
        sv[i] = s; mx = fmaxf(mx, s);
    }
    mx = fmaxf(mx, __shfl_xor(mx, 32));
    const float mnew = fmaxf(st.m, mx);
    const float msafe = (mnew > -1e29f) ? mnew : 0.f;
    if (__ballot(mnew > st.m) != 0ull) {
        const float alpha = __builtin_amdgcn_exp2f(st.m - msafe);
        st.l *= alpha; st.m = mnew;
#pragma unroll
        for (int i = 0; i < 16; ++i) { st.o0[i] *= alpha; st.o1[i] *= alpha; }
    }
    float ps = 0.f; float p[16];
#pragma unroll
    for (int i = 0; i < 16; ++i) { const float e = __builtin_amdgcn_exp2f(sv[i] - msafe); p[i] = e; ps += e; }
    st.l += ps;
    u32x4 w0, w1;
    w0.x = pk2(p[0], p[1]); w0.y = pk2(p[2], p[3]); w0.z = pk2(p[4], p[5]); w0.w = pk2(p[6], p[7]);
    w1.x = pk2(p[8], p[9]); w1.y = pk2(p[10], p[11]); w1.z = pk2(p[12], p[13]); w1.w = pk2(p[14], p[15]);
    const bf16x8 pf0 = __builtin_bit_cast(bf16x8, w0), pf1 = __builtin_bit_cast(bf16x8, w1);
    st.o0 = MFMA32(vf[0][0], pf0, st.o0); st.o0 = MFMA32(vf[0][1], pf1, st.o0);
    st.o1 = MFMA32(vf[1][0], pf0, st.o1); st.o1 = MFMA32(vf[1][1], pf1, st.o1);
}
DI void attn_compute_sp4(const bf16x8 (&qf)[4], const bf16x8 (&kf)[4], const bf16x8 (&vf)[2][2], int kt, int d00, const float* lut, AttnSt& st, int win, int dmask) {
    const int s0 = kt * 32;
    f32x16 sx;
#pragma unroll
    for (int i = 0; i < 16; ++i) sx[i] = 0.f;
#pragma unroll
    for (int ks = 0; ks < 4; ++ks) sx = MFMA32(kf[ks], qf[ks], sx);
    const int d0 = d00 - s0, e = d0 & 3;
    const bool e0 = (e == 0), e1 = (e == 1), e2 = (e == 2);
    const LAS float* lb = (const LAS float*)lut + (d0 - e - 20);
    float sv[4]; float mx = NEGF;
#pragma unroll
    for (int g = 0; g < 4; ++g) {
        const float x = e0 ? sx[4 * g] : (e1 ? sx[4 * g + 1] : (e2 ? sx[4 * g + 2] : sx[4 * g + 3]));
        const int dist = d0 - (16 * (g >> 1) + 4 * (g & 1)) - e;
        const bool v = ((unsigned)dist <= (unsigned)win) && ((dist & dmask) == 0);
        const float bias = lb[20 - (16 * (g >> 1) + 4 * (g & 1))];
        float sc = fmaf(x, SC2, bias);
        sc = v ? sc : NEGF;
        sv[g] = sc; mx = fmaxf(mx, sc);
    }
    mx = fmaxf(mx, __shfl_xor(mx, 32));
    const float mnew = fmaxf(st.m, mx);
    const float msafe = (mnew > -1e29f) ? mnew : 0.f;
    if (__ballot(mnew > st.m) != 0ull) {
        const float alpha = __builtin_amdgcn_exp2f(st.m - msafe);
        st.l *= alpha; st.m = mnew;
#pragma unroll
        for (int i = 0; i < 16; ++i) { st.o0[i] *= alpha; st.o1[i] *= alpha; }
    }
    float ps = 0.f; float p[16];
#pragma unroll
    for (int g = 0; g < 4; ++g) {
        const float pe = __builtin_amdgcn_exp2f(sv[g] - msafe); ps += pe;
        p[4 * g] = e0 ? pe : 0.f; p[4 * g + 1] = e1 ? pe : 0.f; p[4 * g + 2] = e2 ? pe : 0.f; p[4 * g + 3] = (e == 3) ? pe : 0.f;
    }
    st.l += ps;
    u32x4 w0, w1;
    w0.x = pk2(p[0], p[1]); w0.y = pk2(p[2], p[3]); w0.z = pk2(p[4], p[5]); w0.w = pk2(p[6], p[7]);
    w1.x = pk2(p[8], p[9]); w1.y = pk2(p[10], p[11]); w1.z = pk2(p[12], p[13]); w1.w = pk2(p[14], p[15]);
    const bf16x8 pf0 = __builtin_bit_cast(bf16x8, w0), pf1 = __builtin_bit_cast(bf16x8, w1);
    st.o0 = MFMA32(vf[0][0], pf0, st.o0); st.o0 = MFMA32(vf[0][1], pf1, st.o0);
    st.o1 = MFMA32(vf[1][0], pf0, st.o1); st.o1 = MFMA32(vf[1][1], pf1, st.o1);
}
template <int MODE>
DI void attn_range(const AttnCtx& c, const bf16x8 (&qf)[4], int lo, int hi, int t0, int d00, AttnSt& st, const unsigned* maskrow, int h8, int win, int dmask, bool lane_sel) {
    if (lo > hi) return;
    attn_dma(c, lo);
    unsigned Wn = 0u;
    if (MODE == 0) Wn = maskrow[lo];
#pragma unroll 1
    for (int kt = lo; kt <= hi; ++kt) {
        asm volatile("s_waitcnt vmcnt(0)" ::: "memory");
        bf16x8 kf[4], vf[2][2];
#pragma unroll
        for (int ks = 0; ks < 4; ++ks) kf[ks] = *(const LAS bf16x8*)(c.wl + c.kfo[ks]);
#pragma unroll
        for (int mt = 0; mt < 2; ++mt)
#pragma unroll
            for (int s = 0; s < 2; ++s) vf[mt][s] = *(const LAS bf16x8*)(c.wl + 4096 + c.vfo[mt][s]);
        const unsigned W = Wn >> h8;
        const int dlo = t0 - kt * 32 - 31;
        float ub = 0.f; bool uni = false;
        if (dlo >= 182) { const unsigned ua = __builtin_amdgcn_readfirstlane(__float_as_uint(c.lut[dlo])), ue = __builtin_amdgcn_readfirstlane(__float_as_uint(c.lut[dlo + 62])); uni = (ua == ue); ub = __uint_as_float(ua); }
        asm volatile("s_waitcnt lgkmcnt(0)" ::: "memory");
        if (kt < hi) { attn_dma(c, kt + 1); if (MODE == 0) Wn = maskrow[kt + 1]; }
        if (MODE == 1 && dmask != 0) attn_compute_sp4(qf, kf, vf, kt, d00, c.lut, st, win, dmask);
        else attn_compute<MODE, false>(qf, kf, vf, kt, d00, c.lut, 0.f, st, W, win, dmask, lane_sel);
    }
}

DI void load_lut(float* lut, const float* glut, int col, int lane) {
    __builtin_amdgcn_fence(__ATOMIC_ACQ_REL, "wavefront");
    f32x4 t[8];
#pragma unroll
    for (int k = 0; k < 8; ++k) t[k] = *(const f32x4*)(glut + (size_t)col * 2048 + k * 256 + lane * 4);
#pragma unroll
    for (int k = 0; k < 8; ++k) *(f32x4*)(lut + k * 256 + lane * 4) = t[k];
    __builtin_amdgcn_fence(__ATOMIC_ACQ_REL, "wavefront");
    __builtin_amdgcn_wave_barrier();
}

DI void attn_job(const Args& a, unsigned char* wsh, LAS unsigned char* wl, int type, int b, int qt, int hd, const int tid) {
    const int lane = tid & 63, r = lane & 31, h = lane >> 5;
    const bf16_t* prm = (const bf16_t*)(a.ws + WS_R1);
    const bf16_t* prt = prm + (size_t)MTOK * RM_LD;
    const float* glut = (const float*)(a.ws + WS_LUT);
    const unsigned* mask = (const unsigned*)(a.ws + WS_MASK);
    const float* kmean = (const float*)(a.ws + WS_KMEAN);
    bf16_t* oabc = (bf16_t*)(a.ws + WS_OABC);
    float* lut = (float*)(wsh + 8192);
    const int t0 = qt * 32, tok0 = b * SEQ;
    const int d00 = t0 + r - 8 * h, h8 = 8 * h;
    const unsigned* maskrow = mask + (size_t)(tok0 + t0 + r) * 64;
    AttnCtx c; c.wl = wl; c.lut = lut; c.krs = 1;
#pragma unroll
    for (int j = 0; j < 4; ++j) {
        const int rk = 8 * j + (lane >> 3), ck = (lane & 7) ^ ((rk >> 1) & 7);
        c.koff[j] = (unsigned)(pi_row(rk) * RM_LD + ck * 8) * 2u;
        const int rv = 16 * j + (lane >> 2), cv = (lane & 3) ^ ((rv >> 2) & 3);
        c.voff[j] = (unsigned)(rv * MTOK + cv * 8) * 2u;
        c.kfo[j] = r * 128 + (((2 * j + h) ^ ((r >> 1) & 7)) * 16);
    }
#pragma unroll
    for (int mt = 0; mt < 2; ++mt)
#pragma unroll
        for (int s = 0; s < 2; ++s) c.vfo[mt][s] = (32 * mt + r) * 64 + (((2 * s + h) ^ ((r >> 2) & 3)) * 16);
    AttnSt st; st.m = NEGF; st.l = 0.f;
#pragma unroll
    for (int i = 0; i < 16; ++i) { st.o0[i] = 0.f; st.o1[i] = 0.f; }
    const int ng = (type == 1) ? 2 : 1;
    int ocol = 0;
    for (int g = 0; g < ng; ++g) {
        int qcol, kcol, vrow, bcol;
        if (type == 0) { qcol = C_AQ + hd * 64; kcol = C_AK; vrow = R_AV; bcol = hd; ocol = hd * 64; }
        else if (type == 1) { qcol = C_BQ + (g * 4 + hd) * 64; kcol = C_BK + hd * 64; vrow = R_BV + hd * 64; bcol = 6 + g * 4 + hd; ocol = 384 + hd * 64; }
        else { qcol = C_CQ + hd * 64; kcol = C_CK + hd * 64; vrow = R_CV + hd * 64; bcol = 18 + hd; ocol = 640 + hd * 64; }
        load_lut(lut, glut, bcol, lane);
        bf16x8 qf[4];
        const bf16_t* qp = prm + (size_t)(tok0 + t0 + r) * RM_LD + qcol + 8 * h;
#pragma unroll
        for (int ks = 0; ks < 4; ++ks) qf[ks] = *(const bf16x8*)(qp + 16 * ks);
        c.kg = prm + (size_t)tok0 * RM_LD + kcol;
        c.vg = prt + (size_t)vrow * MTOK + tok0;
        if (type == 0) {
            attn_range<0>(c, qf, 0, qt, t0, d00, st, maskrow, h8, 0, 0, false);
        } else if (type == 1) {
            const int win = (g == 0) ? 128 : (g == 1 ? 512 : 2048), dmask = (g == 0) ? 0 : (g == 1 ? 3 : 15);
            int lo = t0 - win; if (lo < 0) lo = 0;
            attn_range<1>(c, qf, lo >> 5, qt, t0, d00, st, maskrow, h8, win, dmask, false);
        } else {
            const int cur = qt >> 3;
            float gate[7];
            const float* km = kmean + (size_t)((b * 6 + hd) * 8) * 64 + 8 * h;
#pragma unroll
            for (int n = 0; n < 7; ++n) {
                float s = 0.f;
                if (n < cur) {
#pragma unroll
                    for (int ks = 0; ks < 4; ++ks) {
                        const f32x4 k0 = *(const f32x4*)(km + n * 64 + 16 * ks), k1 = *(const f32x4*)(km + n * 64 + 16 * ks + 4);
                        const u32x4 qw = __builtin_bit_cast(u32x4, qf[ks]);
                        s += bf_lo(qw.x) * k0[0] + bf_hi(qw.x) * k0[1] + bf_lo(qw.y) * k0[2] + bf_hi(qw.y) * k0[3]
                           + bf_lo(qw.z) * k1[0] + bf_hi(qw.z) * k1[1] + bf_lo(qw.w) * k1[2] + bf_hi(qw.w) * k1[3];
                    }
                    s += __shfl_xor(s, 32);
                } else s = -__builtin_inff();
                gate[n] = s;
            }
            unsigned sel = 0u;
#pragma unroll
            for (int rd = 0; rd < 3; ++rd) {
                float bv = -__builtin_inff(); int bi = -1;
#pragma unroll
                for (int n = 0; n < 7; ++n) if (gate[n] > bv) { bv = gate[n]; bi = n; }
                if (bi >= 0) sel |= 1u << bi;
#pragma unroll
                for (int n = 0; n < 7; ++n) if (n == bi) gate[n] = -__builtin_inff();
            }
            for (int n = 0; n < cur; ++n) {
                const bool ls = ((sel >> n) & 1u) != 0u;
                if (__ballot(ls) == 0ull) continue;
                attn_range<2>(c, qf, n * 8, n * 8 + 7, t0, d00, st, maskrow, h8, 0, 0, ls);
            }
            attn_range<3>(c, qf, cur * 8, qt, t0, d00, st, maskrow, h8, 0, 0, false);
        }
    }
    float lt = st.l + __shfl_xor(st.l, 32);
    if (type == 1) {
        const float* pp = (const float*)(a.ws + WS_G2) + ((size_t)(tok0 + t0 + r) * 4 + hd) * 68;
        const f32x2 ml = *(const f32x2*)(pp + 64);
        const float mn = fmaxf(st.m, ml[0]);
        const float a1 = __builtin_amdgcn_exp2f(st.m - mn), a2 = __builtin_amdgcn_exp2f(ml[0] - mn);
        lt = lt * a1 + ml[1] * a2;
#pragma unroll
        for (int g4 = 0; g4 < 4; ++g4) {
            const f32x4 p0 = *(const f32x4*)(pp + 8 * g4 + 4 * h), p1 = *(const f32x4*)(pp + 32 + 8 * g4 + 4 * h);
#pragma unroll
            for (int e = 0; e < 4; ++e) { st.o0[4 * g4 + e] = st.o0[4 * g4 + e] * a1 + p0[e] * a2; st.o1[4 * g4 + e] = st.o1[4 * g4 + e] * a1 + p1[e] * a2; }
        }
    }
    const float inv = 1.0f / lt;
    bf16_t* op = oabc + (size_t)(tok0 + t0 + r) * 1024 + ocol + 4 * h;
#pragma unroll
    for (int g4 = 0; g4 < 4; ++g4) {
        u32x2 w;
        w.x = pk2(st.o0[4 * g4] * inv, st.o0[4 * g4 + 1] * inv); w.y = pk2(st.o0[4 * g4 + 2] * inv, st.o0[4 * g4 + 3] * inv);
        *(u32x2*)(op + 8 * g4) = w;
        w.x = pk2(st.o1[4 * g4] * inv, st.o1[4 * g4 + 1] * inv); w.y = pk2(st.o1[4 * g4 + 2] * inv, st.o1[4 * g4 + 3] * inv);
        *(u32x2*)(op + 32 + 8 * g4) = w;
    }
}
DI void g2_job(const Args& a, unsigned char* wsh, LAS unsigned char* wl, int b, int slot, int cls, int it, const int tid) {
    const int lane = tid & 63, r = lane & 31, h = lane >> 5;
    const bf16_t* prm = (const bf16_t*)(a.ws + WS_R1);
    const bf16_t* vt16 = (const bf16_t*)(a.ws + WS_VT16);
    const float* glut = (const float*)(a.ws + WS_LUT);
    float* lut = (float*)(wsh + 8192);
    const int tok0 = b * SEQ;
    const int d00 = 32 * it + r - 8 * h;
    AttnCtx c; c.wl = wl; c.lut = lut; c.krs = 16;
#pragma unroll
    for (int j = 0; j < 4; ++j) {
        const int rk = 8 * j + (lane >> 3), ck = (lane & 7) ^ ((rk >> 1) & 7);
        c.koff[j] = (unsigned)(pi_row(rk) * 16 * RM_LD + ck * 8) * 2u;
        const int rv = 16 * j + (lane >> 2), cv = (lane & 3) ^ ((rv >> 2) & 3);
        c.voff[j] = (unsigned)(rv * MTOK + cv * 8) * 2u;
        c.kfo[j] = r * 128 + (((2 * j + h) ^ ((r >> 1) & 7)) * 16);
    }
#pragma unroll
    for (int mt = 0; mt < 2; ++mt)
#pragma unroll
        for (int s = 0; s < 2; ++s) c.vfo[mt][s] = (32 * mt + r) * 64 + (((2 * s + h) ^ ((r >> 2) & 3)) * 16);
    AttnSt st; st.m = NEGF; st.l = 0.f;
#pragma unroll
    for (int i = 0; i < 16; ++i) { st.o0[i] = 0.f; st.o1[i] = 0.f; }
    load_lut(lut, glut, 6 + 2 * 4 + slot, lane);
    const int tq = tok0 + cls + 16 * (32 * it + r);
    bf16x8 qf[4];
    const bf16_t* qp = prm + (size_t)tq * RM_LD + C_BQ + (2 * 4 + slot) * 64 + 8 * h;
#pragma unroll
    for (int ks = 0; ks < 4; ++ks) qf[ks] = *(const bf16x8*)(qp + 16 * ks);
    c.kg = prm + (size_t)(tok0 + cls) * RM_LD + C_BK + slot * 64;
    c.vg = vt16 + (size_t)(slot * 64) * MTOK + tok0 + cls * 128;
    attn_range<4>(c, qf, 0, it, 0, d00, st, nullptr, 0, 0, 0, false);
    const float lt = st.l + __shfl_xor(st.l, 32);
    float* pp = (float*)(a.ws + WS_G2) + ((size_t)tq * 4 + slot) * 68;
#pragma unroll
    for (int g4 = 0; g4 < 4; ++g4) {
        f32x4 p0, p1;
#pragma unroll
        for (int e = 0; e < 4; ++e) { p0[e] = st.o0[4 * g4 + e]; p1[e] = st.o1[4 * g4 + e]; }
        *(f32x4*)(pp + 8 * g4 + 4 * h) = p0; *(f32x4*)(pp + 32 + 8 * g4 + 4 * h) = p1;
    }
    if (h == 0) { f32x2 ml = {st.m, lt}; *(f32x2*)(pp + 64) = ml; }
}
DI void phase_attn(const Args& a, unsigned char* shm, const int tid) {
    const int wid = __builtin_amdgcn_readfirstlane(tid >> 6);
    unsigned char* wsh = shm + wid * 16384;
    LAS unsigned char* wl = (LAS unsigned char*)shm + wid * 16384;
    for (int it = 0;; ++it) {
        int b, qt; if (!task_map(it, b, qt)) break;
        const int role = (wid + it) & 7;
        if (role < 6) { attn_job(a, wsh, wl, 0, b, qt, role, tid); attn_job(a, wsh, wl, 2, b, qt, role, tid); }
        else { attn_job(a, wsh, wl, 1, b, qt, role - 6, tid); attn_job(a, wsh, wl, 1, b, qt, role - 4, tid); }
    }
}

#define XB_TMO      128
#define XB_XCNT(j)  (256  + 64 * (j))
#define XB_XSUB(j)  (1280 + 64 * (j))
#define XB_XGEN(j)  (2304 + 64 * (j))
#define XB_TOP      3328
#define XB_TOPGEN   3392
#define XCD_BAR_WORDS 3456
#define XB_SPIN_CAP (1u << 20)
DI unsigned xb_ld(unsigned* p)              { return __hip_atomic_load(p, __ATOMIC_RELAXED, __HIP_MEMORY_SCOPE_AGENT); }
DI unsigned xb_add(unsigned* p, unsigned v) { return __hip_atomic_fetch_add(p, v, __ATOMIC_RELAXED, __HIP_MEMORY_SCOPE_AGENT); }
DI unsigned xb_xcc_id() { return (unsigned)__builtin_amdgcn_s_getreg((3 << 11) | 20) & 0xFu; }
#define XB_SPIN(cond, bar) do { unsigned _sp = 0; while (cond) { __builtin_amdgcn_s_sleep(1); \
    if ((++_sp & 255u) == 0u) { if (xb_ld(&(bar)[XB_TMO])) break; if (_sp > XB_SPIN_CAP) { atomicAdd(&(bar)[XB_TMO], 1u); break; } } } } while (0)
struct XcdBarrier { unsigned* bar; unsigned x; volatile LAS unsigned* st; };
DI void xcd_barrier_complete(unsigned* bar, unsigned x, unsigned& nloc, unsigned& nx) {
    const unsigned G = gridDim.x * gridDim.y * gridDim.z;
    unsigned sum, cnt, mine, sp = 0u;
    for (;;) {
        sum = 0u; cnt = 0u; mine = 0u;
#pragma unroll
        for (unsigned j = 0; j < 16; ++j) { const unsigned c = xb_ld(&bar[XB_XCNT(j)]); sum += c; cnt += (c > 0u) ? 1u : 0u; mine = (j == x) ? c : mine; }
        if (sum == G) break;
        __builtin_amdgcn_s_sleep(1);
        if ((++sp & 255u) == 0u) { if (xb_ld(&bar[XB_TMO])) break; if (sp > XB_SPIN_CAP) { atomicAdd(&bar[XB_TMO], 1u); break; } }
    }
    nloc = mine > 0u ? mine : 1u; nx = cnt > 0u ? cnt : 1u;
}
DI void xcd_barrier(const XcdBarrier& b, const int tid) {
    asm volatile("s_waitcnt vmcnt(0)" ::: "memory");
    __syncthreads();
    if (tid == 0) {
        unsigned* bar = b.bar;
        __builtin_amdgcn_s_waitcnt(0);
        unsigned nloc = b.st[0], nx = b.st[1];
        if (nloc == 0u) { xcd_barrier_complete(bar, b.x, nloc, nx); b.st[0] = nloc; b.st[1] = nx; }
        const unsigned old = xb_add(&bar[XB_XSUB(b.x)], 1u);
        const unsigned gen = old / nloc;
        if (old + 1u == (gen + 1u) * nloc) {
            __builtin_amdgcn_fence(__ATOMIC_RELEASE, "agent");
            asm volatile("s_waitcnt vmcnt(0)" ::: "memory");
            const unsigned og = xb_add(&bar[XB_TOP], 1u);
            const unsigned tg = og / nx;
            if (og + 1u == (tg + 1u) * nx) xb_add(&bar[XB_TOPGEN], 1u);
            else XB_SPIN(xb_ld(&bar[XB_TOPGEN]) == tg, bar);
            __builtin_amdgcn_fence(__ATOMIC_ACQUIRE, "agent");
            xb_add(&bar[XB_XGEN(b.x)], 1u);
            asm volatile("s_waitcnt vmcnt(0)" ::: "memory");
        } else {
            XB_SPIN(xb_ld(&bar[XB_XGEN(b.x)]) == gen, bar);
            __builtin_amdgcn_fence(__ATOMIC_ACQUIRE, "agent");
            asm volatile("s_waitcnt vmcnt(0)" ::: "memory");
        }
    }
    __syncthreads();
}

__global__ void __launch_bounds__(512, 2) mega_fwd(Args a_) {
    extern __shared__ __attribute__((aligned(16))) unsigned char shm[];
    cg::grid_group grid = cg::this_grid();
    LAS unsigned char* lds = (LAS unsigned char*)shm;
    const int G = gridDim.x, c = blockIdx.x;
#ifndef PROBE_REP
#define PROBE_REP -2
#endif
    const int ph_lo = a_.ph_lo, ph_hi = a_.ph_hi;
    const int wave_id = __builtin_amdgcn_readfirstlane(threadIdx.x >> 6);
    XcdBarrier xbar;
    { volatile LAS unsigned* st = (volatile LAS unsigned*)(lds + 131072);
      if (threadIdx.x == 0) { st[0] = 0u; st[1] = 0u; }
      __syncthreads();
      xbar.bar = (unsigned*)(a_.ws + WS_BAR); xbar.x = xb_xcc_id(); xbar.st = st;
      if (threadIdx.x == 0) (void)xb_add(&xbar.bar[XB_XCNT(xbar.x)], 1u); }
    for (int phx = 2 * ph_lo; phx < 2 * ph_hi; ++phx) {
        const int ph = phx >> 1;
        if (phx & 1) { const bool rep = (PROBE_REP == -1) ? (ph == 0) : (ph > 0 && (ph - 1) % 9 == PROBE_REP); if (!rep) continue; }
        const Args& a = a_;
        int tid = wave_id * 64 + (int)__builtin_amdgcn_mbcnt_hi(~0u, __builtin_amdgcn_mbcnt_lo(~0u, 0u)); asm volatile("" : "+v"(tid));
        bf16_t* xb = (bf16_t*)(a.ws + WS_XB);
        bf16_t* r1 = (bf16_t*)(a.ws + WS_R1);
        bf16_t* oabc = (bf16_t*)(a.ws + WS_OABC);
        float* stats = (float*)(a.ws + WS_STATS);
        if (ph == 0) phase_convert(a, shm, tid);
        else {
            const int l = (ph - 1) / 9, sp = (ph - 1) % 9;
            const bf16_t* w = (const bf16_t*)(a.ws + WS_WB) + (size_t)l * W_LAYER;
            const float* xin = (l == 0) ? a.in[0] : a.out;
            if (sp == 0) {
                { pg8::Gemm g{xb, w + WO_IN, 1024, 1024, 1024, 0}; pg8::StaticOrder S; S.init(256, 11, G, c); pg8::EpiBf16<0> E{r1, RM_LD}; pg8::gemm_phase(lds, g, S, E, tid); }
                { pg8::Gemm g{w + WO_IN + (size_t)RM_LD * 1024, xb, 1024, 1024, 1024, 0}; pg8::StaticOrder S; S.init(3, 256, G, c); pg8::EpiBf16<0> E{r1 + (size_t)MTOK * RM_LD, MTOK}; pg8::gemm_phase(lds, g, S, E, tid); }
                { pg8::Gemm g{w + WO_IN + (size_t)2880 * 1024, xb, 1024, 16 * 1024, 1024, 2048}; pg8::OrderVT16 S{G, c}; pg8::EpiBf16<0> E{(bf16_t*)(a.ws + WS_VT16), MTOK}; pg8::gemm_phase(lds, g, S, E, tid); }
            } else if (sp == 1) phase_a1(a, shm, tid);
            else if (sp == 2) phase_attn(a, shm, tid);
            else if (sp == 3) {
                pg8::StaticOrder S; S.init(256, 4, G, c);
                { pg8::Gemm g{oabc, w + WO_BA, 1024, 384, 384, 0}; pg8::EpiBf16<0> E{r1, 3072}; pg8::gemm_phase(lds, g, S, E, tid); }
                { pg8::Gemm g{oabc + 384, w + WO_BB, 1024, 256, 256, 0}; pg8::EpiBf16<0> E{r1 + 1024, 3072}; pg8::gemm_phase(lds, g, S, E, tid); }
                { pg8::Gemm g{oabc + 640, w + WO_BC, 1024, 384, 384, 0}; pg8::EpiBf16<0> E{r1 + 2048, 3072}; pg8::gemm_phase(lds, g, S, E, tid); }
                { pg8::Gemm g{xb, w + WO_G, 1024, 1024, 1024, 0}; pg8::Order3 S3; S3.base = S; pg8::EpiGate E{r1, r1 + (size_t)MTOK * 3072}; pg8::gemm_phase(lds, g, S3, E, tid); }
            } else if (sp == 4) {
                pg8::Gemm g{r1 + (size_t)MTOK * 3072, w + WO_OUT, 1024, 1024, 1024, 0}; pg8::StaticOrder S; S.init(256, 4, G, c);
                if (l == 0) { pg8::EpiRes<false, false> E{xin, a.out, nullptr, nullptr, nullptr, nullptr}; pg8::gemm_phase(lds, g, S, E, tid); }
                else { pg8::EpiRes<false, true> E{xin, a.out, nullptr, stats, a.in[14], a.in[15]}; pg8::gemm_phase(lds, g, S, E, tid); }
            } else if (sp == 5) phase_ln<false>(a.out, xb, stats, a.in[8] + l * 1024, a.in[9] + l * 1024, tid);
            else if (sp == 6) {
                { pg8::Gemm g{xb, w + WO_UP, 1024, 1024, 1024, 0}; pg8::StaticOrder S; S.init(256, 16, G, c); pg8::EpiBf16<1> E{r1, 4096}; pg8::gemm_phase(lds, g, S, E, tid); }
                pg8::StaticOrder S; S.init(256, 4, G, c);
                { pg8::Gemm g{(const bf16_t*)(a.ws + WS_PB) + (size_t)l * MTOK * 256, w + WO_PL, 256, 256, 256, 0}; pg8::EpiBf16<0> E{oabc, 1024}; pg8::gemm_phase(lds, g, S, E, tid); }
                { pg8::Gemm g{xb, w + WO_PG, 1024, 1024, 1024, 0}; pg8::EpiT1 E{oabc}; pg8::gemm_phase(lds, g, S, E, tid); }
            } else if (sp == 7) {
                pg8::Gemm g{r1, w + WO_DN, 4096, 4096, 4096, 0}; pg8::StaticOrder S; S.init(256, 4, G, c);
                pg8::EpiRes<true, true> E{a.out, a.out, oabc, stats, a.in[8] + l * 1024, a.in[9] + l * 1024}; pg8::gemm_phase(lds, g, S, E, tid);
            } else { if (l == 0) phase_ln<false>(a.out, xb, stats, a.in[14], a.in[15], tid); else phase_ln<true>(a.out, xb, stats, a.in[14] + 1024, a.in[15] + 1024, tid); }
        }
        if (phx + 1 < 2 * ph_hi) { if (ph == 0) grid.sync(); else xcd_barrier(xbar, tid); }
    }
}

#ifndef N_LAUNCH_MODE
#define N_LAUNCH_MODE 1
#endif
extern "C" void kernel_launch(void* const* d_in, const int* in_sizes, int n_in, void* d_out, int out_size, void* d_ws, size_t ws_size, hipStream_t stream) {
    static int grid = 0;
    if (grid == 0) {
        if (n_in != 17 || out_size != MTOK * DM || ws_size < WS_END) { fprintf(stderr, "kernel_launch: unexpected shapes (n_in %d out %d ws %zu need %zu)\n", n_in, out_size, ws_size, (size_t)WS_END); grid = -1; return; }
        int dev = 0, cus = 0, per_cu = 0;
        hipGetDevice(&dev);
        hipDeviceGetAttribute(&cus, hipDeviceAttributeMultiprocessorCount, dev);
        if (hipFuncSetAttribute((const void*)mega_fwd, hipFuncAttributeMaxDynamicSharedMemorySize, LDS_BYTES) != hipSuccess) { fprintf(stderr, "kernel_launch: hipFuncSetAttribute failed\n"); grid = -1; return; }
        hipOccupancyMaxActiveBlocksPerMultiprocessor(&per_cu, (const void*)mega_fwd, 512, LDS_BYTES);
        if (per_cu < 1) { fprintf(stderr, "kernel_launch: occupancy query says %d\n", per_cu); per_cu = 1; }
        (void)hipGetLastError();
        grid = cus * per_cu;
    }
    if (grid < 0) return;
    if (hipMemsetAsync((char*)d_ws + WS_BAR, 0, (size_t)3456 * 4, stream) != hipSuccess) { fprintf(stderr, "kernel_launch: memset of the barrier words failed\n"); return; }
    Args a{};
    for (int i = 0; i < 17; ++i) a.in[i] = (const float*)d_in[i];
    a.out = (float*)d_out; a.ws = (unsigned char*)d_ws;
#if N_LAUNCH_MODE == 0
    for (int ph = 0; ph < 19; ++ph) {
        a.ph_lo = ph; a.ph_hi = ph + 1;
        hipLaunchKernelGGL(mega_fwd, dim3(grid), dim3(512), LDS_BYTES, stream, a);
    }
#else
    a.ph_lo = 0; a.ph_hi = 19;
    void* args[] = {&a};
    hipError_t e = hipLaunchCooperativeKernel((const void*)mega_fwd, dim3(grid), dim3(512), args, LDS_BYTES, stream);
    if (e != hipSuccess) fprintf(stderr, "cooperative launch failed: %s (grid %d)\n", hipGetErrorString(e), grid);
#endif
}
```
